# Optimizing an MI355X kernel written in HIP

```python
import jax, jax.numpy as jnp
from jax import lax
import numpy as np

D_MODEL = 1024
BATCH = 4
SEQ = 8192
DEPTH = 4

GRID_W = 64
CTX_LEN = 256
HG_HEADS = 4
HG_DK = 128
HG_DV = 128
GLA_HEADS = 4
GLA_DK = 64
GLA_DV = 128
GLA_GATE_RANK = 16
GLA_GATE_NORM = 16.0
HG_KW = HG_HEADS * HG_DK
HG_VW = HG_HEADS * HG_DV
GLA_KW = GLA_HEADS * GLA_DK
GLA_VW = GLA_HEADS * GLA_DV
D_MIX = HG_VW + GLA_VW
CHUNK = 64
PEER_HEADS = 8
PEER_NKEYS = 128
PEER_EXPERTS = PEER_NKEYS * PEER_NKEYS
PEER_DQ = 256
PEER_TOPK = 16
PEER_BLOCK = 128
ALPHA = (2.0 * DEPTH) ** 0.25
BETA = (8.0 * DEPTH) ** -0.25
EPS = 1e-6
LB_FLOOR = 1e-30
IN_SPLITS = (HG_KW, HG_KW, HG_KW, HG_VW, HG_VW, GLA_KW, GLA_KW, GLA_VW, GLA_VW, GLA_GATE_RANK, GLA_GATE_RANK)
D_IN = sum(IN_SPLITS)
IN_SPLIT_POINTS = [int(p) for p in np.cumsum(IN_SPLITS)[:-1]]

kernel_name = 'hybrid_hgrn2_gla_peer_dit'


def layer_norm(x, gamma=None, beta=None):
    xf = x.astype(jnp.float32)
    mu = jnp.mean(xf, axis=-1, keepdims=True)
    var = jnp.mean(jnp.square(xf - mu), axis=-1, keepdims=True)
    y = (xf - mu) * lax.rsqrt(var + EPS)
    if gamma is not None:
        y = y * gamma.astype(jnp.float32) + beta.astype(jnp.float32)
    return y.astype(x.dtype)


def modulate(x, shift, scale):
    return layer_norm(x) * (1.0 + scale) + shift


def heads(t, n):
    B, L, _ = t.shape
    return t.reshape(B, L, n, -1).transpose(0, 2, 1, 3).astype(jnp.float32)


def head_rms_merge(o, gain):
    o = o * lax.rsqrt(jnp.mean(o * o, axis=-1, keepdims=True) + EPS) * gain.astype(jnp.float32)
    B, n, L, d = o.shape
    return o.transpose(0, 2, 1, 3).reshape(B, L, n * d)


def to_col_major(t, rows):
    B, L, C = t.shape
    return t.reshape(B, rows, GRID_W, C).transpose(0, 2, 1, 3).reshape(B, L, C)


def from_col_major(t, rows):
    B, L, C = t.shape
    return t.reshape(B, GRID_W, rows, C).transpose(0, 2, 1, 3).reshape(B, L, C)


def chunk_scan(q, k, v, log_a, s0):
    B, H, L, dk = q.shape
    dv = v.shape[-1]
    n = L // CHUNK

    def split(t):
        return jnp.moveaxis(t.reshape(B, H, n, CHUNK, t.shape[-1]), 2, 0)

    incl = jnp.tril(jnp.ones((CHUNK, CHUNK), dtype=bool))[:, :, None]

    def step(s, inp):
        qc, kc, vc, ac = inp
        b = jnp.cumsum(ac, axis=-2)
        rel = b[..., :, None, :] - b[..., None, :, :]
        decay = jnp.where(incl, jnp.exp(jnp.minimum(rel, 0.0)), 0.0)
        scores = jnp.einsum('bhtk,bhsk,bhtsk->bhts', qc, kc, decay)
        o = jnp.einsum('bhts,bhsv->bhtv', scores, vc) + jnp.einsum('bhtk,bhkv->bhtv', qc * jnp.exp(b), s)
        b_end = b[..., -1:, :]
        s_new = jnp.exp(b_end[..., 0, :])[..., None] * s + jnp.einsum('bhsk,bhsv->bhkv', kc * jnp.exp(b_end - b), vc)
        return s_new, o

    s_end, o = lax.scan(step, s0, (split(q), split(k), split(v), split(log_a)))
    return jnp.moveaxis(o, 0, 2).reshape(B, H, L, dv), s_end


def scan_two_way(ctx_parts, lat_parts):
    qc, vc, kcf, acf, kcb, acb = ctx_parts
    ql, vl, klf, alf, klb, alb = lat_parts
    B, H, _, dk = qc.shape
    s0 = jnp.zeros((B, H, dk, vc.shape[-1]), jnp.float32)
    flip = lambda t: jnp.flip(t, axis=2)
    oc_f, sc_f = chunk_scan(qc, kcf, vc, acf, s0)
    ol_f, _ = chunk_scan(ql, klf, vl, alf, sc_f)
    oc_b, sc_b = chunk_scan(flip(qc), flip(kcb), flip(vc), flip(acb), s0)
    ol_b, _ = chunk_scan(flip(ql), flip(klb), flip(vl), flip(alb), sc_b)
    return oc_f + flip(oc_b), ol_f + flip(ol_b)


def hgrn2_inputs(hq, hff, hfb, hi, lb_f, lb_b):
    def gate(z, lb):
        z = z.astype(jnp.float32)
        log_lb = jnp.log(jnp.maximum(lb, LB_FLOOR))
        log_f = jnp.logaddexp(log_lb, jnp.log1p(-lb) + jax.nn.log_sigmoid(z))
        k = (1.0 - lb) * jax.nn.sigmoid(-z)
        return heads(k, HG_HEADS), heads(log_f, HG_HEADS)
    kf, af = gate(hff, lb_f)
    kb, ab = gate(hfb, lb_b)
    return (heads(hq, HG_HEADS), heads(hi, HG_HEADS), kf, af, kb, ab)


def gla_inputs(gq, gk, gv, glf, glb, w_gk2, b_gk):
    def gate(r, w, b):
        la = jax.nn.log_sigmoid((r @ w + b).astype(jnp.float32)) / GLA_GATE_NORM
        return heads(la, GLA_HEADS)
    k = heads(gk, GLA_HEADS)
    q = heads(gq, GLA_HEADS) * (GLA_DK ** -0.5)
    return (q, heads(gv, GLA_HEADS), k, gate(glf, w_gk2[0], b_gk[0]), k, gate(glb, w_gk2[1], b_gk[1]))


def token_mixer(u_c, u_l, rows, lb_f, lb_b, w_gk2, b_gk, hg_gain, gla_gain):
    pc = jnp.split(u_c, IN_SPLIT_POINTS, axis=-1)
    pl = jnp.split(u_l, IN_SPLIT_POINTS, axis=-1)
    a_c, a_l = scan_two_way(hgrn2_inputs(pc[0], pc[1], pc[2], pc[3], lb_f, lb_b),
                            hgrn2_inputs(pl[0], pl[1], pl[2], pl[3], lb_f, lb_b))
    out_a_c = head_rms_merge(a_c, hg_gain).astype(u_c.dtype) * jax.nn.silu(pc[4])
    out_a_l = head_rms_merge(a_l, hg_gain).astype(u_l.dtype) * jax.nn.silu(pl[4])
    gl = [to_col_major(pl[j], rows) for j in (5, 6, 7, 9, 10)]
    b_c, b_l = scan_two_way(gla_inputs(pc[5], pc[6], pc[7], pc[9], pc[10], w_gk2, b_gk),
                            gla_inputs(gl[0], gl[1], gl[2], gl[3], gl[4], w_gk2, b_gk))
    out_b_c = head_rms_merge(b_c, gla_gain).astype(u_c.dtype) * jax.nn.silu(pc[8])
    out_b_l = from_col_major(head_rms_merge(b_l, gla_gain), rows).astype(u_l.dtype) * jax.nn.silu(pl[8])
    return (jnp.concatenate([out_a_c, out_b_c], axis=-1), jnp.concatenate([out_a_l, out_b_l], axis=-1))


def peer(h, w_query, sub_keys, expert_u, expert_v):
    B, L, D = h.shape
    tok = h.reshape(-1, PEER_BLOCK, D)
    k1 = sub_keys[0].astype(jnp.float32)
    k2 = sub_keys[1].astype(jnp.float32)

    def block(t):
        q = (t @ w_query).reshape(PEER_BLOCK, PEER_HEADS, 2, PEER_DQ // 2).astype(jnp.float32)
        s1 = jnp.einsum('thd,nd->thn', q[:, :, 0], k1)
        s2 = jnp.einsum('thd,nd->thn', q[:, :, 1], k2)
        v1, i1 = lax.top_k(s1, PEER_TOPK)
        v2, i2 = lax.top_k(s2, PEER_TOPK)
        cand_s = (v1[..., :, None] + v2[..., None, :]).reshape(PEER_BLOCK, PEER_HEADS, PEER_TOPK * PEER_TOPK)
        cand_i = (i1[..., :, None] * PEER_NKEYS + i2[..., None, :]).reshape(PEER_BLOCK, PEER_HEADS, PEER_TOPK * PEER_TOPK)
        top_s, pos = lax.top_k(cand_s, PEER_TOPK)
        idx = jnp.take_along_axis(cand_i, pos, axis=-1)
        g = jax.nn.softmax(top_s, axis=-1)
        act = jax.nn.gelu(jnp.einsum('thkd,td->thk', expert_u[idx], t).astype(jnp.float32))
        return jnp.einsum('thk,thkd->td', (g * act).astype(t.dtype), expert_v[idx])

    return lax.map(block, tok).reshape(B, L, D)


def setup_inputs(seed: int = 0) -> dict:
    key = jax.random.key(seed)
    ks = jax.random.split(key, 20)
    f32 = jnp.float32
    nrm = lambda k, shape, s: jax.random.normal(k, shape, f32) * s
    return {
        'x': nrm(ks[0], (BATCH, SEQ, D_MODEL), 1.0),
        'c': nrm(ks[1], (BATCH, D_MODEL), 1.0),
        'ctx': nrm(ks[2], (BATCH, CTX_LEN, D_MODEL), 1.0),
        'c_ctx': nrm(ks[3], (D_MODEL,), 1.0),
        'w_ada': nrm(ks[4], (DEPTH, D_MODEL, 6 * D_MODEL), 0.5 * D_MODEL ** -0.5),
        'b_ada': nrm(ks[5], (DEPTH, 6 * D_MODEL), 0.01),
        'w_in': nrm(ks[6], (DEPTH, D_MODEL, D_IN), D_MODEL ** -0.5),
        'w_gk2': nrm(ks[7], (DEPTH, 2, GLA_GATE_RANK, GLA_KW), GLA_GATE_RANK ** -0.5),
        'b_gk': nrm(ks[8], (DEPTH, 2, GLA_KW), 0.01),
        'hg_lower_bounds': nrm(ks[9], (2, DEPTH, HG_KW), 0.1),
        'hg_norm': 1.0 + nrm(ks[10], (DEPTH, HG_DV), 0.01),
        'gla_norm': 1.0 + nrm(ks[11], (DEPTH, GLA_DV), 0.01),
        'w_out': nrm(ks[12], (DEPTH, D_MIX, D_MODEL), BETA * D_MIX ** -0.5),
        'ln_gamma': 1.0 + nrm(ks[13], (DEPTH, 2, D_MODEL), 0.01),
        'ln_beta': nrm(ks[14], (DEPTH, 2, D_MODEL), 0.01),
        'peer_w_query': nrm(ks[15], (DEPTH, D_MODEL, PEER_HEADS * PEER_DQ), D_MODEL ** -0.5),
        'peer_sub_keys': nrm(ks[16], (DEPTH, 2, PEER_NKEYS, PEER_DQ // 2), (PEER_DQ // 2) ** -0.5),
        'peer_u': nrm(ks[17], (DEPTH, PEER_EXPERTS, D_MODEL), D_MODEL ** -0.5),
        'peer_v': nrm(ks[18], (DEPTH, PEER_EXPERTS, D_MODEL), BETA),
    }


def reference(x, c, ctx, c_ctx, w_ada, b_ada, w_in, w_gk2, b_gk, hg_lower_bounds, hg_norm, gla_norm,
              w_out, ln_gamma, ln_beta, peer_w_query, peer_sub_keys, peer_u, peer_v):
    rows = x.shape[1] // GRID_W
    sm = jax.nn.softmax(hg_lower_bounds.astype(jnp.float32), axis=1)
    lb_all = jnp.clip(jnp.cumsum(sm, axis=1) - sm[:, :1], 0.0, 1.0 - 1e-6)
    xc = ctx
    for i in range(DEPTH):
        last = i == DEPTH - 1
        m_l = jax.nn.silu(c) @ w_ada[i] + b_ada[i]
        m_c = jax.nn.silu(c_ctx) @ w_ada[i] + b_ada[i]
        sh1_l, sc1_l, g1_l, sh2_l, sc2_l, g2_l = [t[:, None, :] for t in jnp.split(m_l, 6, axis=-1)]
        sh1_c, sc1_c, g1_c, sh2_c, sc2_c, g2_c = jnp.split(m_c, 6, axis=-1)
        u_l = modulate(x, sh1_l, sc1_l) @ w_in[i]
        u_c = modulate(xc, sh1_c, sc1_c) @ w_in[i]
        mix_c, mix_l = token_mixer(u_c, u_l, rows, lb_all[0, i], lb_all[1, i], w_gk2[i], b_gk[i],
                                   hg_norm[i], gla_norm[i])
        x = layer_norm(ALPHA * x + g1_l * (mix_l @ w_out[i]), ln_gamma[i, 0], ln_beta[i, 0])
        if not last:
            xc = layer_norm(ALPHA * xc + g1_c * (mix_c @ w_out[i]), ln_gamma[i, 0], ln_beta[i, 0])
        y_l = peer(modulate(x, sh2_l, sc2_l), peer_w_query[i], peer_sub_keys[i], peer_u[i], peer_v[i])
        x = layer_norm(ALPHA * x + g2_l * y_l, ln_gamma[i, 1], ln_beta[i, 1])
        if not last:
            y_c = peer(modulate(xc, sh2_c, sc2_c), peer_w_query[i], peer_sub_keys[i], peer_u[i], peer_v[i])
            xc = layer_norm(ALPHA * xc + g2_c * y_c, ln_gamma[i, 1], ln_beta[i, 1])
    return x
```

```cpp
#include <hip/hip_runtime.h>
#include <hip/hip_cooperative_groups.h>
#include <cstdio>
namespace cg = cooperative_groups;

#define DI __device__ __forceinline__
typedef unsigned short u16;
typedef unsigned int u32;
typedef __attribute__((ext_vector_type(8))) short bf16x8;
typedef __attribute__((ext_vector_type(16))) float f32x16;
typedef __attribute__((ext_vector_type(2))) __bf16 bf2;

#ifndef REPMASK
#define REPMASK 0
#endif
#ifndef DRYVAR
#define DRYVAR 0
#endif
#ifndef ONE_LAUNCH
#define ONE_LAUNCH 1
#endif

constexpr int D = 1024, NB = 4, SEQ = 8192, DEPTH = 4, CTX = 256;
constexpr int NLAT = NB * SEQ;
constexpr int NCTX = NB * CTX;
constexpr int NROW = NLAT + NCTX;
constexpr int DIN = 4128, DINP = 4224;
constexpr int LPOS = CTX + SEQ;
constexpr int NBLK = LPOS / 32;
constexpr float ALPHA = 1.681792830507429f;
constexpr float EPS = 1e-6f;
constexpr int LDS_BYTES = 73728;

struct Params {
  const float *x, *c, *ctx, *c_ctx, *w_ada, *b_ada, *w_in, *w_gk2, *b_gk, *hg_lb, *hg_norm, *gla_norm,
      *w_out, *ln_gamma, *ln_beta, *wq, *sub_keys, *peer_u, *peer_v;
  float* out;
  u16 *wt_in, *wt_out, *wt_q, *keysb;
  float *ada_part, *ada;
  float* X;
  u16 *H, *G, *U;
  char* S;
  char* PT;
  unsigned* bar;
  int ph_lo, ph_hi;
};

constexpr size_t SZ_HQ = (size_t)2 * 16 * LPOS * 128 * 2;
constexpr size_t SZ_HVT = (size_t)16 * 128 * LPOS * 2;
constexpr size_t SZ_HD = (size_t)2 * 16 * NBLK * 128 * 4;
constexpr size_t SZ_GQ = (size_t)2 * 16 * LPOS * 64 * 2;
constexpr size_t SZ_GD = (size_t)2 * 16 * NBLK * 64 * 4;
constexpr size_t OFF_HQ = 0, OFF_HK = OFF_HQ + SZ_HQ, OFF_HKT = OFF_HK + SZ_HQ, OFF_HVT = OFF_HKT + SZ_HQ,
                 OFF_HD = OFF_HVT + SZ_HVT, OFF_GQ = OFF_HD + SZ_HD, OFF_GK = OFF_GQ + SZ_GQ, OFF_GKT = OFF_GK + SZ_GQ,
                 OFF_GVT = OFF_GKT + SZ_GQ, OFF_GD = OFF_GVT + SZ_HVT, SZ_S = OFF_GD + SZ_GD;
constexpr size_t OFF_XP = 0, SZ_XP = (size_t)NROW * D * 4;
constexpr size_t OFF_IDX = OFF_XP + SZ_XP, SZ_IDX = (size_t)NROW * 128 * 4;
constexpr size_t OFF_GATE = OFF_IDX + SZ_IDX;
constexpr size_t OFF_PU = OFF_GATE + SZ_IDX, SZ_PU = (size_t)16384 * D * 2;
constexpr size_t OFF_PV = OFF_PU + SZ_PU;
constexpr size_t OFF_PSC = OFF_PV + SZ_PU;
static_assert(OFF_PSC + 2 * 16384 * 4 <= SZ_S, "alias overflow");
constexpr size_t PT_U = 0, PT_V = (size_t)16384 * D, PT_SC = 2 * (size_t)16384 * D, SZ_PT = PT_SC + 2 * 16384 * 4;

DI int otid() { int t = threadIdx.x; asm volatile("" : "+v"(t)); return t; }
DI int obid() { int t = blockIdx.x; asm volatile("" : "+s"(t)); return t; }
DI float bf2f(u16 h) { return __uint_as_float(((u32)h) << 16); }
DI u16 f2bf(float x) { return __builtin_bit_cast(u16, (__bf16)x); }
typedef __attribute__((ext_vector_type(2))) float f32x2v;
typedef __attribute__((ext_vector_type(2))) __bf16 bf16x2v;
DI u32 pack2(float a, float b) { f32x2v v = {a, b}; return __builtin_bit_cast(u32, __builtin_convertvector(v, bf16x2v)); }
DI float wave_sum(float v) {
#pragma unroll
  for (int o = 32; o > 0; o >>= 1) v += __shfl_xor(v, o);
  return v;
}
DI int crow(int i, int h) { return (i & 3) + 8 * (i >> 2) + 4 * h; }
DI int perm16(int k) {
  int kk = k & 15;
  return (k & ~15) | (((kk >> 2) & 1) << 3) | ((kk >> 3) << 2) | (kk & 3);
}
DI bf16x8 pack_frag(const f32x16& x, int s) {
  union { bf16x8 v; u32 u[4]; } r;
#pragma unroll
  for (int j = 0; j < 4; j++) r.u[j] = pack2(x[8 * s + 2 * j], x[8 * s + 2 * j + 1]);
  return r.v;
}
#define MFMA32(a, b, c) __builtin_amdgcn_mfma_f32_32x32x16_bf16((a), (b), (c), 0, 0, 0)

DI const float* ada_ptr(const Params& p, int layer, int r, int j) { return p.ada + ((size_t)(layer * 5 + r) * 6 + j) * D; }
DI int row_batch(int r) { return r < NLAT ? (r >> 13) : 4; }

DI void weight_convert(const Params& p, int l, int vbid, int vgrid) {
  const size_t gtid = (size_t)vbid * 256 + otid(), gsz = (size_t)vgrid * 256;
  for (size_t i = gtid; i < (size_t)128 * DINP; i += gsz) {
    int n = i % DINP; int k8 = i / DINP;
    u32 o[4] = {0, 0, 0, 0};
    if (n < DIN) {
      const float* s = p.w_in + ((size_t)l * D + k8 * 8) * DIN + n;
#pragma unroll
      for (int j = 0; j < 4; j++) o[j] = pack2(s[(size_t)(2 * j) * DIN], s[(size_t)(2 * j + 1) * DIN]);
    }
    *(uint4*)(p.wt_in + ((size_t)l * DINP + n) * D + k8 * 8) = make_uint4(o[0], o[1], o[2], o[3]);
  }
  for (size_t i = gtid; i < (size_t)128 * 1024; i += gsz) {
    int n = i & 1023; int k8 = i >> 10;
    const float* s = p.w_out + ((size_t)l * D + k8 * 8) * D + n;
    u32 o[4];
#pragma unroll
    for (int j = 0; j < 4; j++) o[j] = pack2(s[(size_t)(2 * j) * D], s[(size_t)(2 * j + 1) * D]);
    *(uint4*)(p.wt_out + ((size_t)l * D + n) * D + k8 * 8) = make_uint4(o[0], o[1], o[2], o[3]);
  }
  for (size_t i = gtid; i < (size_t)128 * 2048; i += gsz) {
    int n = i & 2047; int k8 = i >> 11;
    const float* s = p.wq + ((size_t)l * D + k8 * 8) * 2048 + n;
    u32 o[4];
#pragma unroll
    for (int j = 0; j < 4; j++) o[j] = pack2(s[(size_t)(2 * j) * 2048], s[(size_t)(2 * j + 1) * 2048]);
    *(uint4*)(p.wt_q + ((size_t)l * 2048 + n) * D + k8 * 8) = make_uint4(o[0], o[1], o[2], o[3]);
  }
}

DI void phase0(const Params& p, float* lds) {
  for (int it = obid(); it < 768; it += gridDim.x) {
    int kp = it & 7, nb = (it >> 3) % 24, l = it / 192;
    __syncthreads();
    for (int i = otid(); i < 640; i += 256) {
      int r = i >> 7, k = i & 127;
      float v = (r < 4) ? p.c[r * D + kp * 128 + k] : p.c_ctx[kp * 128 + k];
      lds[i] = v / (1.f + __expf(-v));
    }
    __syncthreads();
    int n = nb * 256 + otid();
    const float* w = p.w_ada + ((size_t)l * D + kp * 128) * 6144 + n;
    float a0 = 0, a1 = 0, a2 = 0, a3 = 0, a4 = 0;
#pragma unroll 8
    for (int k = 0; k < 128; k++) {
      float wv = w[(size_t)k * 6144];
      a0 += lds[k] * wv; a1 += lds[128 + k] * wv; a2 += lds[256 + k] * wv; a3 += lds[384 + k] * wv; a4 += lds[512 + k] * wv;
    }
    float* o = p.ada_part + ((size_t)(kp * 4 + l) * 5) * 6144 + n;
    o[0] = a0; o[6144] = a1; o[2 * 6144] = a2; o[3 * 6144] = a3; o[4 * 6144] = a4;
  }
  weight_convert(p, 0, obid(), gridDim.x);
  const size_t gtid = (size_t)obid() * 256 + otid(), gsz = (size_t)gridDim.x * 256;
  for (size_t i = gtid; i < (size_t)4 * 2 * 128 * 128; i += gsz) p.keysb[i] = f2bf(p.sub_keys[i]);
}

DI void phase0b(const Params& p) {
  const size_t gtid = (size_t)obid() * 256 + otid(), gsz = (size_t)gridDim.x * 256;
  for (size_t i = gtid; i < (size_t)4 * 5 * 6144; i += gsz) {
    int n = i % 6144; int l = i / (5 * 6144);
    float a = p.b_ada[l * 6144 + n];
#pragma unroll
    for (int kp = 0; kp < 8; kp++) a += p.ada_part[(size_t)kp * 4 * 5 * 6144 + i];
    p.ada[i] = a;
  }
}

DI void peer_convert(const Params& p, int layer, int vbid, int vgrid) {
  const int tid = otid(), wave = tid >> 6, lane = tid & 63;
  unsigned char* du = (unsigned char*)(p.PT + PT_U);
  unsigned char* dv = (unsigned char*)(p.PT + PT_V);
  float* su = (float*)(p.PT + PT_SC);
  for (int it = vbid * 4 + wave; it < 2 * 16384; it += vgrid * 4) {
    const int tbl = it >> 14, e = it & 16383;
    const float* src = (tbl ? p.peer_v : p.peer_u) + ((size_t)layer * 16384 + e) * D + lane * 16;
    float4 a = *(const float4*)(src), b = *(const float4*)(src + 4), c = *(const float4*)(src + 8), d = *(const float4*)(src + 12);
    float m = fmaxf(fmaxf(fmaxf(fabsf(a.x), fabsf(a.y)), fmaxf(fabsf(a.z), fabsf(a.w))), fmaxf(fmaxf(fabsf(b.x), fabsf(b.y)), fmaxf(fabsf(b.z), fabsf(b.w))));
    m = fmaxf(m, fmaxf(fmaxf(fmaxf(fabsf(c.x), fabsf(c.y)), fmaxf(fabsf(c.z), fabsf(c.w))), fmaxf(fmaxf(fabsf(d.x), fabsf(d.y)), fmaxf(fabsf(d.z), fabsf(d.w)))));
#pragma unroll
    for (int o = 32; o > 0; o >>= 1) m = fmaxf(m, __shfl_xor(m, o));
    m = fmaxf(m, 1e-30f);
    const float sc = 224.f / m;
    int w0 = __builtin_amdgcn_cvt_pk_fp8_f32(a.x * sc, a.y * sc, 0, false); w0 = __builtin_amdgcn_cvt_pk_fp8_f32(a.z * sc, a.w * sc, w0, true);
    int w1 = __builtin_amdgcn_cvt_pk_fp8_f32(b.x * sc, b.y * sc, 0, false); w1 = __builtin_amdgcn_cvt_pk_fp8_f32(b.z * sc, b.w * sc, w1, true);
    int w2 = __builtin_amdgcn_cvt_pk_fp8_f32(c.x * sc, c.y * sc, 0, false); w2 = __builtin_amdgcn_cvt_pk_fp8_f32(c.z * sc, c.w * sc, w2, true);
    int w3 = __builtin_amdgcn_cvt_pk_fp8_f32(d.x * sc, d.y * sc, 0, false); w3 = __builtin_amdgcn_cvt_pk_fp8_f32(d.z * sc, d.w * sc, w3, true);
    if (tbl == 0) *(int4*)(du + (size_t)e * D + lane * 16) = make_int4(w0, w1, w2, w3);
    else *(int4*)(dv + ((size_t)(lane >> 3) * 16384 + e) * 128 + (lane & 7) * 16) = make_int4(w0, w1, w2, w3);
    if (lane == 0) su[it] = m * (1.f / 224.f);
  }
}

template <int MODE>
DI void lnmod_phase(const Params& p, int layer, int nrows) {
  const int wave = otid() >> 6, lane = otid() & 63;
  const float* XP = (const float*)(p.S + OFF_XP);
  for (int r = obid() * 4 + wave; r < nrows; r += gridDim.x * 4) {
    const float* src;
    if (MODE == 0) src = (r < NLAT) ? p.x + (size_t)r * D : p.ctx + (size_t)(r - NLAT) * D;
    else src = XP + (size_t)r * D;
    const int b = row_batch(r);
    float4 v[4];
#pragma unroll
    for (int c = 0; c < 4; c++) v[c] = *(const float4*)(src + c * 256 + lane * 4);
    float s = 0;
#pragma unroll
    for (int c = 0; c < 4; c++) s += v[c].x + v[c].y + v[c].z + v[c].w;
    float mu = wave_sum(s) * (1.f / D);
    float q = 0;
#pragma unroll
    for (int c = 0; c < 4; c++) {
      v[c].x -= mu; v[c].y -= mu; v[c].z -= mu; v[c].w -= mu;
      q += v[c].x * v[c].x + v[c].y * v[c].y + v[c].z * v[c].z + v[c].w * v[c].w;
    }
    float rstd = rsqrtf(wave_sum(q) * (1.f / D) + EPS);
    if (MODE == 1) {
      const float* gm = p.ln_gamma + (size_t)(layer * 2 + 0) * D;
      const float* bt = p.ln_beta + (size_t)(layer * 2 + 0) * D;
      float s2 = 0;
#pragma unroll
      for (int c = 0; c < 4; c++) {
        int col = c * 256 + lane * 4;
        float4 g = *(const float4*)(gm + col), be = *(const float4*)(bt + col);
        v[c].x = v[c].x * rstd * g.x + be.x; v[c].y = v[c].y * rstd * g.y + be.y;
        v[c].z = v[c].z * rstd * g.z + be.z; v[c].w = v[c].w * rstd * g.w + be.w;
        *(float4*)(p.X + (size_t)r * D + col) = v[c];
        s2 += v[c].x + v[c].y + v[c].z + v[c].w;
      }
      float mu2 = wave_sum(s2) * (1.f / D);
      float q2 = 0;
#pragma unroll
      for (int c = 0; c < 4; c++) {
        v[c].x -= mu2; v[c].y -= mu2; v[c].z -= mu2; v[c].w -= mu2;
        q2 += v[c].x * v[c].x + v[c].y * v[c].y + v[c].z * v[c].z + v[c].w * v[c].w;
      }
      rstd = rsqrtf(wave_sum(q2) * (1.f / D) + EPS);
    }
    const float* sh = ada_ptr(p, layer, b, MODE == 0 ? 0 : 3);
    const float* sc = ada_ptr(p, layer, b, MODE == 0 ? 1 : 4);
#pragma unroll
    for (int c = 0; c < 4; c++) {
      int col = c * 256 + lane * 4;
      float4 a = *(const float4*)(sh + col), m = *(const float4*)(sc + col);
      float y0 = v[c].x * rstd * (1.f + m.x) + a.x, y1 = v[c].y * rstd * (1.f + m.y) + a.y;
      float y2 = v[c].z * rstd * (1.f + m.z) + a.z, y3 = v[c].w * rstd * (1.f + m.w) + a.w;
      *(uint2*)(p.H + (size_t)r * D + col) = make_uint2(pack2(y0, y1), pack2(y2, y3));
    }
  }
}

constexpr int LDS_STRIDE = 72;
constexpr int CT_STRIDE = 132;
template <int MODE>
DI void gemm_store(const Params& p, int layer, int row, int nt, int n0, int c4, const float4 v, const bool dry) {
  if (MODE == 0) {
          u16* dst;
          if (nt >= 16 && nt < 20) dst = p.G + (size_t)row * D + (n0 - 2048) + c4;
          else if (nt >= 28 && nt < 32) dst = p.G + (size_t)row * D + (n0 - 3584 + 512) + c4;
          else dst = p.U + (size_t)row * DIN + n0 + c4;
          if (dry) dst = (u16*)p.S + (size_t)row * DIN + n0 + c4;
          if (n0 + c4 < DIN) *(uint2*)dst = make_uint2(pack2(v.x, v.y), pack2(v.z, v.w));
        } else if (MODE == 1) {
          float* XP = dry ? (float*)p.U : (float*)(p.S + OFF_XP);
          const float* xo = (layer == 0) ? ((row < NLAT) ? p.x + (size_t)row * D : p.ctx + (size_t)(row - NLAT) * D) : p.X + (size_t)row * D;
          const float4 xv = *(const float4*)(xo + n0 + c4);
          const float4 g1 = *(const float4*)(ada_ptr(p, layer, row_batch(row), 2) + n0 + c4);
          *(float4*)(XP + (size_t)row * D + n0 + c4) =
              make_float4(ALPHA * xv.x + g1.x * v.x, ALPHA * xv.y + g1.y * v.y, ALPHA * xv.z + g1.z * v.z, ALPHA * xv.w + g1.w * v.w);
        } else {
          *(uint2*)((dry ? (u16*)(p.S + OFF_PU) : p.U) + (size_t)row * 2048 + n0 + c4) = make_uint2(pack2(v.x, v.y), pack2(v.z, v.w));
        }
}

template <int MODE>
DI void gemm_phase(const Params& p, int layer, char* smem, const u16* A, const u16* Bt, int Mtiles, int Ntiles, const bool dry) {
  u16* As = (u16*)smem;
  u16* Bs = (u16*)smem + 256 * LDS_STRIDE;
  float* Ct = (float*)smem;
  const int tid = otid(), wave = tid >> 6, lane = tid & 63, r = lane & 31, h = lane >> 5;
  const int wm = wave >> 1, wn = wave & 1;
  const int srow = tid >> 3, sc8 = (tid & 7) * 8;
  const int bid = obid(), xcd = bid & 7, jx = bid >> 3, wpx = (gridDim.x + 7 - xcd) >> 3;
  const int ntiles = Mtiles * Ntiles, nchunks = (ntiles + 63) >> 6;
  for (int ch = xcd; ch < nchunks; ch += 8)
  for (int jj = jx; jj < 64; jj += wpx) {
    const int L = ch * 64 + jj;
    if (L >= ntiles) continue;
    const int mt = (L / (4 * Ntiles)) * 4 + (L & 3), nt = (L >> 2) % Ntiles;
    const u16* Ag = A + ((size_t)mt * 256 + srow) * D + sc8;
    const u16* Bg = Bt + ((size_t)nt * 128 + srow) * D + sc8;
    f32x16 acc[4][2];
#pragma unroll
    for (int i = 0; i < 4; i++)
#pragma unroll
      for (int j = 0; j < 2; j++)
#pragma unroll
        for (int e = 0; e < 16; e++) acc[i][j][e] = 0.f;
    bf16x8 ra0, ra1, ra2, ra3, ra4, ra5, ra6, ra7, rb0, rb1, rb2, rb3;
#define GLOAD(kt_) { const u16* ag = Ag + (kt_) * 64; const u16* bg = Bg + (kt_) * 64; \
      ra0 = *(const bf16x8*)(ag); ra1 = *(const bf16x8*)(ag + 32 * D); ra2 = *(const bf16x8*)(ag + 64 * D); ra3 = *(const bf16x8*)(ag + 96 * D); \
      ra4 = *(const bf16x8*)(ag + 128 * D); ra5 = *(const bf16x8*)(ag + 160 * D); ra6 = *(const bf16x8*)(ag + 192 * D); ra7 = *(const bf16x8*)(ag + 224 * D); \
      rb0 = *(const bf16x8*)(bg); rb1 = *(const bf16x8*)(bg + 32 * D); rb2 = *(const bf16x8*)(bg + 64 * D); rb3 = *(const bf16x8*)(bg + 96 * D); }
#define LSTORE() { u16* ad = As + srow * LDS_STRIDE + sc8; u16* bd = Bs + srow * LDS_STRIDE + sc8; \
      *(bf16x8*)(ad) = ra0; *(bf16x8*)(ad + 32 * LDS_STRIDE) = ra1; *(bf16x8*)(ad + 64 * LDS_STRIDE) = ra2; *(bf16x8*)(ad + 96 * LDS_STRIDE) = ra3; \
      *(bf16x8*)(ad + 128 * LDS_STRIDE) = ra4; *(bf16x8*)(ad + 160 * LDS_STRIDE) = ra5; *(bf16x8*)(ad + 192 * LDS_STRIDE) = ra6; *(bf16x8*)(ad + 224 * LDS_STRIDE) = ra7; \
      *(bf16x8*)(bd) = rb0; *(bf16x8*)(bd + 32 * LDS_STRIDE) = rb1; *(bf16x8*)(bd + 64 * LDS_STRIDE) = rb2; *(bf16x8*)(bd + 96 * LDS_STRIDE) = rb3; }
    GLOAD(0)
    __syncthreads();
    LSTORE()
    __syncthreads();
#pragma unroll 1
    for (int kt = 0; kt < 16; kt++) {
      if (kt + 1 < 16 && !(dry && DRYVAR == 1)) GLOAD(kt + 1)
      const u16* as = As + (wm * 128 + r) * LDS_STRIDE + h * 8;
      const u16* bs = Bs + (wn * 64 + r) * LDS_STRIDE + h * 8;
      if (!(dry && DRYVAR == 2)) {
        bf16x8 af[2][4], b0, b1;
#pragma unroll
        for (int i = 0; i < 4; i++) af[0][i] = *(const bf16x8*)(as + i * 32 * LDS_STRIDE);
        b0 = *(const bf16x8*)(bs); b1 = *(const bf16x8*)(bs + 32 * LDS_STRIDE);
#pragma unroll
        for (int kk = 0; kk < 4; kk++) {
          const int cur = kk & 1, nxt = cur ^ 1;
          if (kk < 3) {
#pragma unroll
            for (int i = 0; i < 4; i++) af[nxt][i] = *(const bf16x8*)(as + i * 32 * LDS_STRIDE + (kk + 1) * 16);
          }
          __builtin_amdgcn_s_setprio(1);
#pragma unroll
          for (int i = 0; i < 4; i++) acc[i][0] = MFMA32(af[cur][i], b0, acc[i][0]);
          if (kk < 3) b0 = *(const bf16x8*)(bs + (kk + 1) * 16);
#pragma unroll
          for (int i = 0; i < 4; i++) acc[i][1] = MFMA32(af[cur][i], b1, acc[i][1]);
          if (kk < 3) b1 = *(const bf16x8*)(bs + 32 * LDS_STRIDE + (kk + 1) * 16);
          __builtin_amdgcn_s_setprio(0);
        }
      }
      __syncthreads();
      if (kt + 1 < 16 && !(dry && DRYVAR == 1)) LSTORE()
      __syncthreads();
    }
#undef GLOAD
#undef LSTORE
    const int m0 = mt * 256, n0 = nt * 128;
    const int c4 = (tid & 31) * 4, rr0 = tid >> 5;
#pragma unroll
    for (int ph = 0; ph < 2; ph++) {
      if (ph) __syncthreads();
#pragma unroll
      for (int ii = 0; ii < 2; ii++)
#pragma unroll
        for (int j = 0; j < 2; j++)
#pragma unroll
          for (int e = 0; e < 16; e++) Ct[(wm * 64 + ii * 32 + crow(e, h)) * CT_STRIDE + wn * 64 + j * 32 + r] = acc[ph * 2 + ii][j][e];
      __syncthreads();
#pragma unroll 2
      for (int q = 0; q < 16; q++) {
        const int rl = rr0 + q * 8, row = m0 + (rl >> 6) * 128 + ph * 64 + (rl & 63);
        const float4 v = *(const float4*)(Ct + rl * CT_STRIDE + c4);
        gemm_store<MODE>(p, layer, row, nt, n0, c4, v, dry);
      }
    }
  }
}

template <int MODE>
DI void gemm_thin(const Params& p, int layer, char* smem, const u16* A, const u16* Bt, int row0, int Mtiles, int Ntiles, const bool dry) {
  u16* As = (u16*)smem;
  u16* Bs = (u16*)smem + 64 * LDS_STRIDE;
  float* Ct = (float*)smem;
  const int tid = otid(), wave = tid >> 6, lane = tid & 63, r = lane & 31, h = lane >> 5;
  const int wm = wave >> 1, wn = wave & 1;
  const int srow = tid >> 3, sc8 = (tid & 7) * 8;
  const int ntiles = Mtiles * Ntiles;
  for (int L = obid(); L < ntiles; L += gridDim.x) {
    const int mt = L / Ntiles, nt = L % Ntiles;
    const u16* Ag = A + ((size_t)row0 + mt * 64 + srow) * D + sc8;
    const u16* Bg = Bt + ((size_t)nt * 128 + srow) * D + sc8;
    f32x16 acc0, acc1;
#pragma unroll
    for (int e = 0; e < 16; e++) { acc0[e] = 0.f; acc1[e] = 0.f; }
    bf16x8 ra0, ra1, rb0, rb1, rb2, rb3;
#define GLOADT(kt_) { const u16* ag = Ag + (kt_) * 64; const u16* bg = Bg + (kt_) * 64; \
      ra0 = *(const bf16x8*)(ag); ra1 = *(const bf16x8*)(ag + 32 * D); \
      rb0 = *(const bf16x8*)(bg); rb1 = *(const bf16x8*)(bg + 32 * D); rb2 = *(const bf16x8*)(bg + 64 * D); rb3 = *(const bf16x8*)(bg + 96 * D); }
#define LSTORET() { u16* ad = As + srow * LDS_STRIDE + sc8; u16* bd = Bs + srow * LDS_STRIDE + sc8; \
      *(bf16x8*)(ad) = ra0; *(bf16x8*)(ad + 32 * LDS_STRIDE) = ra1; \
      *(bf16x8*)(bd) = rb0; *(bf16x8*)(bd + 32 * LDS_STRIDE) = rb1; *(bf16x8*)(bd + 64 * LDS_STRIDE) = rb2; *(bf16x8*)(bd + 96 * LDS_STRIDE) = rb3; }
    GLOADT(0)
    __syncthreads();
    LSTORET()
    __syncthreads();
#pragma unroll 1
    for (int kt = 0; kt < 16; kt++) {
      if (kt + 1 < 16) GLOADT(kt + 1)
      const u16* as = As + (wm * 32 + r) * LDS_STRIDE + h * 8;
      const u16* bs = Bs + (wn * 64 + r) * LDS_STRIDE + h * 8;
#pragma unroll
      for (int kk = 0; kk < 4; kk++) {
        const bf16x8 af = *(const bf16x8*)(as + kk * 16);
        const bf16x8 bf0 = *(const bf16x8*)(bs + kk * 16), bf1 = *(const bf16x8*)(bs + 32 * LDS_STRIDE + kk * 16);
        acc0 = MFMA32(af, bf0, acc0);
        acc1 = MFMA32(af, bf1, acc1);
      }
      __syncthreads();
      if (kt + 1 < 16) LSTORET()
      __syncthreads();
    }
#undef GLOADT
#undef LSTORET
#pragma unroll
    for (int e = 0; e < 16; e++) {
      Ct[(wm * 32 + crow(e, h)) * CT_STRIDE + wn * 64 + r] = acc0[e];
      Ct[(wm * 32 + crow(e, h)) * CT_STRIDE + wn * 64 + 32 + r] = acc1[e];
    }
    __syncthreads();
    const int n0 = nt * 128, c4 = (tid & 31) * 4, rr0 = tid >> 5;
#pragma unroll 2
    for (int q = 0; q < 8; q++) {
      const int rl = rr0 + q * 8, row = row0 + mt * 64 + rl;
      const float4 v = *(const float4*)(Ct + rl * CT_STRIDE + c4);
      gemm_store<MODE>(p, layer, row, nt, n0, c4, v, dry);
    }
  }
}

DI int tokrow(int grp, int b, int pos) {
  if (pos < CTX) return NLAT + b * CTX + pos;
  int pp = pos - CTX;
  return b * SEQ + (grp == 0 ? pp : ((pp & 127) * 64 + (pp >> 7)));
}
DI float log_sigmoid(float z) { return fminf(z, 0.f) - __logf(1.f + __expf(-fabsf(z))); }

template <int DK, int DIR>
DI void prep_k(const Params& p, int layer, int grp, int hb, int blk, int cgi) {
  constexpr int CH = DK / 32;
  const int b = hb >> 2, head = hb & 3, k0 = cgi * CH;
  float lb[CH], log_lb[CH], l1m[CH], wg[CH][16], bias[CH], bacc[CH];
#pragma unroll
  for (int c = 0; c < CH; c++) {
    bacc[c] = 0.f; lb[c] = 0.f; log_lb[c] = 0.f; l1m[c] = 0.f; bias[c] = 0.f;
    if (DK == 128) {
      const float* lbp = p.hg_lb + (size_t)DIR * DEPTH * 512 + head * 128 + k0 + c;
      float e0 = lbp[0], e1 = lbp[512], e2 = lbp[1024], e3 = lbp[1536];
      const float mx = fmaxf(fmaxf(e0, e1), fmaxf(e2, e3));
      e0 = __expf(e0 - mx); e1 = __expf(e1 - mx); e2 = __expf(e2 - mx); e3 = __expf(e3 - mx);
      const float inv = 1.f / (e0 + e1 + e2 + e3);
      float cs = 0.f;
      if (layer >= 1) cs += e1 * inv;
      if (layer >= 2) cs += e2 * inv;
      if (layer >= 3) cs += e3 * inv;
      lb[c] = fminf(fmaxf(cs, 0.f), 1.f - 1e-6f);
      log_lb[c] = __logf(fmaxf(lb[c], 1e-30f));
      l1m[c] = __logf(1.f - lb[c]);
    } else {
#pragma unroll
      for (int rr = 0; rr < 16; rr++) wg[c][rr] = p.w_gk2[((size_t)(layer * 2 + DIR) * 16 + rr) * 256 + head * 64 + k0 + c];
      bias[c] = p.b_gk[(size_t)(layer * 2 + DIR) * 256 + head * 64 + k0 + c];
    }
  }
  const size_t chain = (size_t)DIR * 16 + hb;
  const int pk0 = perm16(k0);
  u16* Qd = (u16*)(p.S + (DK == 128 ? OFF_HQ : OFF_GQ)) + (chain * LPOS + (size_t)blk * 32) * DK + pk0;
  u16* Kd = (u16*)(p.S + (DK == 128 ? OFF_HK : OFF_GK)) + (chain * LPOS + (size_t)blk * 32) * DK + pk0;
  u16* KTd = (u16*)(p.S + (DK == 128 ? OFF_HKT : OFF_GKT)) + ((chain * NBLK + blk) * DK + k0) * 32;
#pragma unroll 1
  for (int s2 = 0; s2 < 2; s2++) {
    const int tg = DIR ? 1 - s2 : s2;
    u16 kt[CH][16];
#pragma unroll
    for (int j2 = 0; j2 < 16; j2++) {
      const int t16 = DIR ? 15 - j2 : j2;
      const int t = tg * 16 + t16;
      const u16* urow = p.U + (size_t)tokrow(grp, b, blk * 32 + t) * DIN;
      float qv[CH], kv[CH], la[CH];
      if (DK == 128) {
        const uint2 zz = *(const uint2*)(urow + 512 * (1 + DIR) + head * 128 + k0);
        const uint2 qq = *(const uint2*)(urow + head * 128 + k0);
        const u32 zw[2] = {zz.x, zz.y}, qw[2] = {qq.x, qq.y};
#pragma unroll
        for (int c = 0; c < CH; c++) {
          const float z = (c & 1) ? __uint_as_float(zw[c >> 1] & 0xffff0000u) : __uint_as_float(zw[c >> 1] << 16);
          qv[c] = (c & 1) ? __uint_as_float(qw[c >> 1] & 0xffff0000u) : __uint_as_float(qw[c >> 1] << 16);
          const float ez = __expf(-fabsf(z));
          const float rc = __frcp_rn(1.f + ez);
          const float sp = (z < 0.f) ? ez * rc : rc;
          const float sn = (z < 0.f) ? rc : ez * rc;
          la[c] = __logf(fmaxf(lb[c], 1e-30f) + (1.f - lb[c]) * sp);
          kv[c] = (1.f - lb[c]) * sn;
        }
      } else {
        const u32 qq = *(const u32*)(urow + 2560 + head * 64 + k0);
        const u32 kq = *(const u32*)(urow + 2816 + head * 64 + k0);
        const uint4* gr = (const uint4*)(urow + 4096 + DIR * 16);
        const uint4 g0 = gr[0], g1 = gr[1];
        const u32 gw[8] = {g0.x, g0.y, g0.z, g0.w, g1.x, g1.y, g1.z, g1.w};
#pragma unroll
        for (int c = 0; c < CH; c++) {
          qv[c] = ((c & 1) ? __uint_as_float(qq & 0xffff0000u) : __uint_as_float(qq << 16)) * 0.125f;
          kv[c] = (c & 1) ? __uint_as_float(kq & 0xffff0000u) : __uint_as_float(kq << 16);
          float d = bias[c];
#pragma unroll
          for (int rr = 0; rr < 8; rr++)
            d += __uint_as_float(gw[rr] << 16) * wg[c][2 * rr] + __uint_as_float(gw[rr] & 0xffff0000u) * wg[c][2 * rr + 1];
          la[c] = (fminf(d, 0.f) - __logf(1.f + __expf(-fabsf(d)))) * (1.f / 16.f);
        }
      }
      float qo[CH], ko[CH];
#pragma unroll
      for (int c = 0; c < CH; c++) {
        bacc[c] += la[c];
        const float eb = __expf(bacc[c]);
        qo[c] = qv[c] * eb;
        ko[c] = kv[c] * __expf(-bacc[c]);
        kt[c][perm16(t16)] = f2bf(ko[c]);
      }
      if (CH == 4) {
        *(uint2*)(Qd + (size_t)t * DK) = make_uint2(pack2(qo[0], qo[1]), pack2(qo[2], qo[3]));
        *(uint2*)(Kd + (size_t)t * DK) = make_uint2(pack2(ko[0], ko[1]), pack2(ko[2], ko[3]));
      } else {
        *(u32*)(Qd + (size_t)t * DK) = pack2(qo[0], qo[1]);
        *(u32*)(Kd + (size_t)t * DK) = pack2(ko[0], ko[1]);
      }
    }
#pragma unroll
    for (int c = 0; c < CH; c++) {
      u16* dst = KTd + c * 32 + tg * 16;
#pragma unroll
      for (int q8 = 0; q8 < 2; q8++) {
        uint4 o;
        o.x = (u32)kt[c][q8 * 8 + 0] | ((u32)kt[c][q8 * 8 + 1] << 16); o.y = (u32)kt[c][q8 * 8 + 2] | ((u32)kt[c][q8 * 8 + 3] << 16);
        o.z = (u32)kt[c][q8 * 8 + 4] | ((u32)kt[c][q8 * 8 + 5] << 16); o.w = (u32)kt[c][q8 * 8 + 6] | ((u32)kt[c][q8 * 8 + 7] << 16);
        *(uint4*)(dst + q8 * 8) = o;
      }
    }
  }
  float* Dd = (float*)(p.S + (DK == 128 ? OFF_HD : OFF_GD)) + (chain * NBLK + blk) * DK + k0;
#pragma unroll
  for (int c = 0; c < CH; c++) Dd[c] = __expf(bacc[c]);
}

DI void prep_phase(const Params& p, int layer) {
  const int tid = otid();
  for (int it = obid(); it < 2 * 16 * (NBLK / 4); it += gridDim.x) {
    const int bg = it % (NBLK / 4), hb = (it / (NBLK / 4)) & 15, grp = it / ((NBLK / 4) * 16);
    const int b = hb >> 2, head = hb & 3;
    {
      const int dir = tid >> 7, blk = bg * 4 + ((tid >> 5) & 3), cgi = tid & 31;
      if (grp == 0) {
        if (dir == 0) prep_k<128, 0>(p, layer, 0, hb, blk, cgi);
        else prep_k<128, 1>(p, layer, 0, hb, blk, cgi);
      } else {
        if (dir == 0) prep_k<64, 0>(p, layer, 1, hb, blk, cgi);
        else prep_k<64, 1>(p, layer, 1, hb, blk, cgi);
      }
    }
    {
      const int vg = tid & 31, tg = tid >> 5;
      const int col = (grp == 0 ? 1536 : 3072) + head * 128 + vg * 4;
      const int pos0 = bg * 128 + tg * 16;
      u16 vt[4][16];
#pragma unroll
      for (int t = 0; t < 16; t++) {
        const uint2 vv = *(const uint2*)(p.U + (size_t)tokrow(grp, b, pos0 + t) * DIN + col);
        vt[0][perm16(t)] = (u16)(vv.x & 0xffffu); vt[1][perm16(t)] = (u16)(vv.x >> 16);
        vt[2][perm16(t)] = (u16)(vv.y & 0xffffu); vt[3][perm16(t)] = (u16)(vv.y >> 16);
      }
#pragma unroll
      for (int c = 0; c < 4; c++) {
        u16* dst = (u16*)(p.S + (grp == 0 ? OFF_HVT : OFF_GVT)) + (((size_t)hb * NBLK + (pos0 >> 5)) * 128 + vg * 4 + c) * 32 + (pos0 & 31);
#pragma unroll
        for (int q8 = 0; q8 < 2; q8++) {
          uint4 o;
          o.x = (u32)vt[c][q8 * 8 + 0] | ((u32)vt[c][q8 * 8 + 1] << 16); o.y = (u32)vt[c][q8 * 8 + 2] | ((u32)vt[c][q8 * 8 + 3] << 16);
          o.z = (u32)vt[c][q8 * 8 + 4] | ((u32)vt[c][q8 * 8 + 5] << 16); o.w = (u32)vt[c][q8 * 8 + 6] | ((u32)vt[c][q8 * 8 + 7] << 16);
          *(uint4*)(dst + q8 * 8) = o;
        }
      }
    }
  }
}

template <int DK>
DI void scan_wg(const Params& p, char* smem, int grp, int dir, int hb) {
  constexpr int NT = DK / 32, NF = DK / 16;
  constexpr int QS = DK + 8;
  constexpr int KTS = 40;
  constexpr int OFF_K = 32 * QS * 2, OFF_KT = 2 * 32 * QS * 2, OFF_D = OFF_KT + DK * KTS * 2, BUFB = OFF_D + DK * 4;
  constexpr int QN = DK / 64;
  constexpr int CPR = DK / 8;
  static_assert(2 * BUFB <= LDS_BYTES, "scan LDS");
  const int tid = otid(), vs = tid >> 6, lane = tid & 63, r = lane & 31, h = lane >> 5;
  const int b = hb >> 2, head = hb & 3;
  const size_t chain = (size_t)dir * 16 + hb;
  const u16* Qb = (const u16*)(p.S + (DK == 128 ? OFF_HQ : OFF_GQ)) + chain * LPOS * DK;
  const u16* Kb = (const u16*)(p.S + (DK == 128 ? OFF_HK : OFF_GK)) + chain * LPOS * DK;
  const u16* KTb = (const u16*)(p.S + (DK == 128 ? OFF_HKT : OFF_GKT)) + chain * NBLK * DK * 32;
  const u16* VTb = (const u16*)(p.S + (DK == 128 ? OFF_HVT : OFF_GVT)) + (size_t)hb * NBLK * 128 * 32 + (vs * 32 + r) * 32 + h * 8;
  const float* Db = (const float*)(p.S + (DK == 128 ? OFF_HD : OFF_GD)) + chain * NBLK * DK;
  u16* Ob = p.U + (size_t)dir * NROW * D + grp * 512 + head * 128 + vs * 32;
  f32x16 S[NT];
#pragma unroll
  for (int kt = 0; kt < NT; kt++)
#pragma unroll
    for (int e = 0; e < 16; e++) S[kt][e] = 0.f;
  bf16x8 sq[QN], sk[QN], skt[QN], vn0, vn1;
  float4 sd = make_float4(0.f, 0.f, 0.f, 0.f);
  auto blk_of = [&](int step) { return dir ? (step < 8 ? 7 - step : 271 - step) : step; };
  auto gload = [&](int step) {
    const size_t pos0 = (size_t)blk_of(step) * 32;
#pragma unroll
    for (int i = 0; i < QN; i++) {
      const int id = tid + i * 256;
      sq[i] = *(const bf16x8*)(Qb + (pos0 + id / CPR) * DK + (id % CPR) * 8);
      sk[i] = *(const bf16x8*)(Kb + (pos0 + id / CPR) * DK + (id % CPR) * 8);
      skt[i] = *(const bf16x8*)(KTb + (size_t)blk_of(step) * DK * 32 + id * 8);
    }
    if (tid < DK / 4) sd = *(const float4*)(Db + (size_t)blk_of(step) * DK + tid * 4);
    vn0 = *(const bf16x8*)(VTb + (size_t)blk_of(step) * 128 * 32);
    vn1 = *(const bf16x8*)(VTb + (size_t)blk_of(step) * 128 * 32 + 16);
  };
  auto lstore = [&](int buf) {
    char* base = smem + buf * BUFB;
#pragma unroll
    for (int i = 0; i < QN; i++) {
      const int id = tid + i * 256;
      *(bf16x8*)(base + ((id / CPR) * QS + (id % CPR) * 8) * 2) = sq[i];
      *(bf16x8*)(base + OFF_K + ((id / CPR) * QS + (id % CPR) * 8) * 2) = sk[i];
      *(bf16x8*)(base + OFF_KT + ((id >> 2) * KTS + (id & 3) * 8) * 2) = skt[i];
    }
    if (tid < DK / 4) *(float4*)(base + OFF_D + tid * 16) = sd;
  };
  __syncthreads();
  gload(0);
  lstore(0);
  bf16x8 vf0 = vn0, vf1 = vn1;
  __syncthreads();
#pragma unroll 1
  for (int step = 0; step < NBLK; step++) {
    const int blk = blk_of(step);
    if (step + 1 < NBLK) gload(step + 1);
    const char* base = smem + (step & 1) * BUFB;
    const u16* Qs = (const u16*)base + r * QS + h * 8;
    const u16* Ks = (const u16*)(base + OFF_K) + r * QS + h * 8;
    const u16* KTs = (const u16*)(base + OFF_KT) + r * KTS + h * 8;
    const float* Ds = (const float*)(base + OFF_D) + 4 * h;
    bf16x8 qf[NF];
    f32x16 P0, P1;
#pragma unroll
    for (int e = 0; e < 16; e++) { P0[e] = 0.f; P1[e] = 0.f; }
#pragma unroll
    for (int f = 0; f < NF; f += 2) {
      qf[f] = *(const bf16x8*)(Qs + f * 16);
      qf[f + 1] = *(const bf16x8*)(Qs + f * 16 + 16);
      P0 = MFMA32(*(const bf16x8*)(Ks + f * 16), qf[f], P0);
      P1 = MFMA32(*(const bf16x8*)(Ks + f * 16 + 16), qf[f + 1], P1);
    }
#pragma unroll
    for (int e = 0; e < 16; e++) {
      const int s = crow(e, h);
      const bool keep = dir ? (s >= r) : (s <= r);
      P0[e] = keep ? P0[e] + P1[e] : 0.f;
    }
    f32x16 oA, oB;
#pragma unroll
    for (int e = 0; e < 16; e++) { oA[e] = 0.f; oB[e] = 0.f; }
    oA = MFMA32(vf0, pack_frag(P0, 0), oA);
    oA = MFMA32(vf1, pack_frag(P0, 1), oA);
#pragma unroll
    for (int kt = 0; kt < NT; kt++) {
      if (kt & 1) {
        oA = MFMA32(pack_frag(S[kt], 0), qf[kt * 2], oA);
        oA = MFMA32(pack_frag(S[kt], 1), qf[kt * 2 + 1], oA);
      } else {
        oB = MFMA32(pack_frag(S[kt], 0), qf[kt * 2], oB);
        oB = MFMA32(pack_frag(S[kt], 1), qf[kt * 2 + 1], oB);
      }
    }
#pragma unroll
    for (int kt = 0; kt < NT; kt++) {
      S[kt] = MFMA32(*(const bf16x8*)(KTs + kt * 32 * KTS), vf0, S[kt]);
      S[kt] = MFMA32(*(const bf16x8*)(KTs + kt * 32 * KTS + 16), vf1, S[kt]);
#pragma unroll
      for (int g = 0; g < 4; g++) {
        const float4 dv = *(const float4*)(Ds + kt * 32 + 8 * g);
        S[kt][4 * g + 0] *= dv.x; S[kt][4 * g + 1] *= dv.y; S[kt][4 * g + 2] *= dv.z; S[kt][4 * g + 3] *= dv.w;
      }
    }
    {
      const int pos0 = blk * 32;
      int rbase, rstride;
      if (pos0 < CTX) { rbase = NLAT + b * CTX + pos0; rstride = 1; }
      else if (grp == 0) { rbase = b * SEQ + pos0 - CTX; rstride = 1; }
      else { const int pp = pos0 - CTX; rbase = b * SEQ + (pp & 127) * 64 + (pp >> 7); rstride = 64; }
      u16* orow = Ob + (size_t)(rbase + r * rstride) * D + 4 * h;
#pragma unroll
      for (int g = 0; g < 4; g++)
        *(uint2*)(orow + 8 * g) = make_uint2(pack2(oA[4 * g] + oB[4 * g], oA[4 * g + 1] + oB[4 * g + 1]),
                                             pack2(oA[4 * g + 2] + oB[4 * g + 2], oA[4 * g + 3] + oB[4 * g + 3]));
    }
    if (step + 1 < NBLK) lstore((step + 1) & 1);
    vf0 = vn0; vf1 = vn1;
    __syncthreads();
  }
}

DI void scan_phase(const Params& p, char* smem, int layer) {
  const int bid = obid(), nscan = gridDim.x > 64 ? 64 : gridDim.x;
  if (bid < nscan) {
    for (int w = bid; w < 64; w += nscan) {
      const int grp = w >> 5, dir = (w >> 4) & 1, hb = w & 15;
      if (grp == 0) scan_wg<128>(p, smem, 0, dir, hb);
      else scan_wg<64>(p, smem, 1, dir, hb);
    }
  }
  if (gridDim.x <= 64 || bid >= 64) {
    const int vbid = gridDim.x <= 64 ? bid : bid - 64, vgrid = gridDim.x <= 64 ? gridDim.x : gridDim.x - 64;
    peer_convert(p, layer, vbid, vgrid);
    if (layer + 1 < DEPTH) weight_convert(p, layer + 1, vbid, vgrid);
  }
}

DI void combine_phase(const Params& p, int layer, int nrows) {
  const int wave = otid() >> 6, lane = otid() & 63;
  const int c0 = lane * 16;
  const float* gain = (c0 < 512 ? p.hg_norm : p.gla_norm) + (size_t)layer * 128 + (c0 & 127);
  float gn[16];
#pragma unroll
  for (int j = 0; j < 16; j++) gn[j] = gain[j];
  for (int r = obid() * 4 + wave; r < nrows; r += gridDim.x * 4) {
    const uint4* of = (const uint4*)(p.U + (size_t)r * D + c0);
    const uint4* ob = (const uint4*)(p.U + (size_t)NROW * D + (size_t)r * D + c0);
    const uint4* gg = (const uint4*)(p.G + (size_t)r * D + c0);
    float o[16], g[16];
#pragma unroll
    for (int c = 0; c < 2; c++) {
      uint4 a = of[c], bq = ob[c], gq = gg[c];
      u32 aw[4] = {a.x, a.y, a.z, a.w}, bw[4] = {bq.x, bq.y, bq.z, bq.w}, gw[4] = {gq.x, gq.y, gq.z, gq.w};
#pragma unroll
      for (int j = 0; j < 4; j++) {
        o[c * 8 + 2 * j] = __uint_as_float(aw[j] << 16) + __uint_as_float(bw[j] << 16);
        o[c * 8 + 2 * j + 1] = __uint_as_float(aw[j] & 0xffff0000u) + __uint_as_float(bw[j] & 0xffff0000u);
        g[c * 8 + 2 * j] = __uint_as_float(gw[j] << 16);
        g[c * 8 + 2 * j + 1] = __uint_as_float(gw[j] & 0xffff0000u);
      }
    }
    float ss = 0;
#pragma unroll
    for (int j = 0; j < 16; j++) ss += o[j] * o[j];
    ss += __shfl_xor(ss, 1); ss += __shfl_xor(ss, 2); ss += __shfl_xor(ss, 4);
    float rs = rsqrtf(ss * (1.f / 128.f) + EPS);
    u32 ow[8];
#pragma unroll
    for (int j = 0; j < 8; j++) {
      float g0 = g[2 * j], g1 = g[2 * j + 1];
      float y0 = o[2 * j] * rs * gn[2 * j] * (g0 / (1.f + __expf(-g0)));
      float y1 = o[2 * j + 1] * rs * gn[2 * j + 1] * (g1 / (1.f + __expf(-g1)));
      ow[j] = pack2(y0, y1);
    }
    uint4* dst = (uint4*)(p.H + (size_t)r * D + c0);
    dst[0] = make_uint4(ow[0], ow[1], ow[2], ow[3]);
    dst[1] = make_uint4(ow[4], ow[5], ow[6], ow[7]);
  }
}

template <bool PAY>
DI void ce(u32& a, u32& b, u32& pa, u32& pb) {
  if (!PAY) { u32 hi = a > b ? a : b, lo = a > b ? b : a; a = hi; b = lo; }
  else { bool c = a >= b; u32 hi = c ? a : b, lo = c ? b : a, ph = c ? pa : pb, pl = c ? pb : pa; a = hi; b = lo; pa = ph; pb = pl; }
}
template <bool PAY>
DI void sort16(u32 (&k)[16], u32 (&q)[16]) {
#pragma unroll
  for (int size = 2; size <= 16; size <<= 1) {
#pragma unroll
    for (int stride = size >> 1; stride > 0; stride >>= 1) {
#pragma unroll
      for (int i = 0; i < 16; i++) {
        int j = i ^ stride;
        if (j > i) {
          if ((i & size) == 0) ce<PAY>(k[i], k[j], q[i], q[j]);
          else ce<PAY>(k[j], k[i], q[j], q[i]);
        }
      }
    }
  }
}
template <bool PAY>
DI void merge16(u32 (&R)[16], u32 (&RP)[16], u32 (&N)[16], u32 (&NP)[16]) {
#pragma unroll
  for (int i = 0; i < 16; i++) {
    bool c = N[15 - i] > R[i];
    R[i] = c ? N[15 - i] : R[i];
    if (PAY) RP[i] = c ? NP[15 - i] : RP[i];
  }
#pragma unroll
  for (int stride = 8; stride > 0; stride >>= 1) {
#pragma unroll
    for (int i = 0; i < 16; i++) {
      int j = i ^ stride;
      if (j > i) ce<PAY>(R[i], R[j], RP[i], RP[j]);
    }
  }
}
DI u32 ord_f(float f) { u32 u = __float_as_uint(f); return (u & 0x80000000u) ? ~u : (u | 0x80000000u); }
DI float unord_f(u32 u) { return __uint_as_float((u & 0x80000000u) ? (u ^ 0x80000000u) : ~u); }

DI void topk_phase(const Params& p, int layer, char* smem, int nrows) {
  const int tid = otid(), wave = tid >> 6, lane = tid & 63, r = lane & 31, h = lane >> 5;
  float* sc = (float*)smem + wave * 4096;
  const u16* Q = p.U;
  const u16* keys = p.keysb + (size_t)layer * 2 * 128 * 128;
  int* IDX = (int*)(p.S + OFF_IDX);
  float* GATE = (float*)(p.S + OFF_GATE);
  const int nunits = (nrows / 64) * 8;
  for (int wu = obid() * 4 + wave; wu < nunits; wu += gridDim.x * 4) {
    const int tok0 = (wu >> 3) * 64, head = wu & 7;
    u32 RA[16], RB[16], dummy[16];
#pragma unroll
    for (int i = 0; i < 16; i++) { RA[i] = 0; RB[i] = 0; dummy[i] = 0; }
    auto do_half = [&](const int half, u32 (&R)[16]) {
      bf16x8 qf[2][8];
#pragma unroll
      for (int nt = 0; nt < 2; nt++) {
        const u16* qp = Q + (size_t)(tok0 + nt * 32 + r) * 2048 + head * 256 + half * 128 + h * 8;
#pragma unroll
        for (int f = 0; f < 8; f++) qf[nt][f] = *(const bf16x8*)(qp + f * 16);
      }
      f32x16 acc0, acc1;
      auto mm = [&](const int kr) {
        const u16* kp = keys + ((size_t)half * 128 + kr * 32 + r) * 128 + h * 8;
#pragma unroll
        for (int e = 0; e < 16; e++) { acc0[e] = 0.f; acc1[e] = 0.f; }
#pragma unroll
        for (int f = 0; f < 8; f++) {
          const bf16x8 af = *(const bf16x8*)(kp + f * 16);
          acc0 = MFMA32(af, qf[0][f], acc0);
          acc1 = MFMA32(af, qf[1][f], acc1);
        }
      };
      auto put = [&](const int buf) {
        float* d = sc + buf * 2048;
#pragma unroll
        for (int e = 0; e < 16; e++) {
          d[crow(e, h) * 64 + r] = acc0[e];
          d[crow(e, h) * 64 + 32 + r] = acc1[e];
        }
      };
      mm(0);
      put(0);
#pragma unroll
      for (int kr = 0; kr < 4; kr++) {
        if (kr < 3) mm(kr + 1);
        __builtin_amdgcn_wave_barrier();
        const float* sp = sc + (kr & 1) * 2048 + lane;
#pragma unroll
        for (int grp = 0; grp < 2; grp++) {
          u32 N[16];
#pragma unroll
          for (int i = 0; i < 16; i++) {
            const float v = sp[(grp * 16 + i) * 64];
            N[i] = (ord_f(v) & 0xFFFFFF80u) | (u32)(127 - (kr * 32 + grp * 16 + i));
          }
          sort16<false>(N, dummy);
          merge16<false>(R, dummy, N, dummy);
        }
        __builtin_amdgcn_wave_barrier();
        if (kr < 3) put((kr + 1) & 1);
      }
    };
    do_half(0, RA);
    do_half(1, RB);
    {
      float v1[16], v2[16]; u32 i1[16], i2[16];
#pragma unroll
      for (int i = 0; i < 16; i++) {
        v1[i] = unord_f(RA[i] & 0xFFFFFF80u); i1[i] = 127 - (RA[i] & 127u);
        v2[i] = unord_f(RB[i] & 0xFFFFFF80u); i2[i] = 127 - (RB[i] & 127u);
      }
      u32 TK[16], TP[16], NK[16], NP[16];
#define CAND(slot, a, bq) { NK[slot] = ord_f(v1[a] + v2[bq]); NP[slot] = i1[a] * 128u + i2[bq]; }
#pragma unroll
      for (int bq = 0; bq < 16; bq++) { TK[bq] = ord_f(v1[0] + v2[bq]); TP[bq] = i1[0] * 128u + i2[bq]; }
      sort16<true>(TK, TP);
#pragma unroll
      for (int bq = 0; bq < 8; bq++) CAND(bq, 1, bq)
#pragma unroll
      for (int bq = 0; bq < 5; bq++) CAND(8 + bq, 2, bq)
#pragma unroll
      for (int bq = 0; bq < 3; bq++) CAND(13 + bq, 4, bq)
      sort16<true>(NK, NP); merge16<true>(TK, TP, NK, NP);
#pragma unroll
      for (int bq = 0; bq < 4; bq++) CAND(bq, 3, bq)
      CAND(4, 5, 0) CAND(5, 5, 1) CAND(6, 6, 0) CAND(7, 6, 1) CAND(8, 7, 0) CAND(9, 7, 1)
      CAND(10, 8, 0) CAND(11, 9, 0) CAND(12, 10, 0) CAND(13, 11, 0) CAND(14, 12, 0) CAND(15, 13, 0)
      sort16<true>(NK, NP); merge16<true>(TK, TP, NK, NP);
      CAND(0, 14, 0) CAND(1, 15, 0)
#pragma unroll
      for (int i = 2; i < 16; i++) { NK[i] = 0; NP[i] = 0; }
      sort16<true>(NK, NP); merge16<true>(TK, TP, NK, NP);
#undef CAND
      const float mx = unord_f(TK[0]);
      float ev[16], sum = 0.f;
#pragma unroll
      for (int i = 0; i < 16; i++) { ev[i] = __expf(unord_f(TK[i]) - mx); sum += ev[i]; }
      const float inv = 1.f / sum;
      int* ip = IDX + (size_t)(tok0 + lane) * 128 + head * 16;
      float* gp = GATE + (size_t)(tok0 + lane) * 128 + head * 16;
#pragma unroll
      for (int c = 0; c < 4; c++) {
        *(int4*)(ip + c * 4) = make_int4((int)TP[c * 4], (int)TP[c * 4 + 1], (int)TP[c * 4 + 2], (int)TP[c * 4 + 3]);
        *(float4*)(gp + c * 4) = make_float4(ev[c * 4] * inv, ev[c * 4 + 1] * inv, ev[c * 4 + 2] * inv, ev[c * 4 + 3] * inv);
      }
    }
  }
}

DI float row16_sum(float v) {
  v += __int_as_float(__builtin_amdgcn_update_dpp(0, __float_as_int(v), 0x128, 0xf, 0xf, false));
  v += __int_as_float(__builtin_amdgcn_update_dpp(0, __float_as_int(v), 0x124, 0xf, 0xf, false));
  v += __int_as_float(__builtin_amdgcn_update_dpp(0, __float_as_int(v), 0x122, 0xf, 0xf, false));
  v += __int_as_float(__builtin_amdgcn_update_dpp(0, __float_as_int(v), 0x121, 0xf, 0xf, false));
  return v;
}
DI float gelu_tanh(float x) {
  float u = 0.7978845608028654f * (x + 0.044715f * x * x * x);
  float e = __expf(2.f * u);
  float th = 1.f - 2.f / (e + 1.f);
  return 0.5f * x * (1.f + th);
}
DI float dot8(uint4 a, uint4 b, float acc) {
  acc = __builtin_amdgcn_fdot2_f32_bf16(__builtin_bit_cast(bf2, a.x), __builtin_bit_cast(bf2, b.x), acc, false);
  acc = __builtin_amdgcn_fdot2_f32_bf16(__builtin_bit_cast(bf2, a.y), __builtin_bit_cast(bf2, b.y), acc, false);
  acc = __builtin_amdgcn_fdot2_f32_bf16(__builtin_bit_cast(bf2, a.z), __builtin_bit_cast(bf2, b.z), acc, false);
  acc = __builtin_amdgcn_fdot2_f32_bf16(__builtin_bit_cast(bf2, a.w), __builtin_bit_cast(bf2, b.w), acc, false);
  return acc;
}

typedef float f2 __attribute__((ext_vector_type(2)));
DI void expert_dots(const Params& p, int nrows, char* smem) {
  const int tid = otid(), wave = tid >> 6, lane = tid & 63, g = lane >> 4, s = lane & 15;
  const int bid = obid(), x = bid & 7, jx = bid >> 3, wpx = (gridDim.x + 7 - x) >> 3;
  u32* list = (u32*)smem + wave * 128;
  const int* IDX = (const int*)(p.S + OFF_IDX);
  float* GATE = (float*)(p.S + OFF_GATE);
  const unsigned char* PU = (const unsigned char*)(p.PT + PT_U) + s * 16;
  const float* PSU = (const float*)(p.PT + PT_SC);
  const float* PSV = PSU + 16384;
  const int tstep = wpx * 4;
  int t = jx * 4 + wave;
  int ni0 = 0, ni1 = 0;
  uint4 nh[8];
  auto prefetch = [&](int tt) {
    ni0 = IDX[(size_t)tt * 128 + lane]; ni1 = IDX[(size_t)tt * 128 + 64 + lane];
#pragma unroll
    for (int c = 0; c < 4; c++) {
      const u16* hp = p.H + (size_t)tt * D + (c * 16 + s) * 16;
      nh[2 * c] = *(const uint4*)(hp); nh[2 * c + 1] = *(const uint4*)(hp + 8);
    }
  };
  auto dot_row = [&](const int4 (&uu)[4], const f2 (&hf)[32]) {
    const int uw[16] = {uu[0].x, uu[0].y, uu[0].z, uu[0].w, uu[1].x, uu[1].y, uu[1].z, uu[1].w,
                        uu[2].x, uu[2].y, uu[2].z, uu[2].w, uu[3].x, uu[3].y, uu[3].z, uu[3].w};
    f2 acc = {0.f, 0.f}, acc2 = {0.f, 0.f};
#pragma unroll
    for (int j = 0; j < 16; j++) {
      acc = __builtin_elementwise_fma(__builtin_amdgcn_cvt_pk_f32_fp8(uw[j], false), hf[2 * j], acc);
      acc2 = __builtin_elementwise_fma(__builtin_amdgcn_cvt_pk_f32_fp8(uw[j], true), hf[2 * j + 1], acc2);
    }
    return row16_sum((acc.x + acc.y) + (acc2.x + acc2.y));
  };
  if (t < nrows) prefetch(t);
  for (; t < nrows; t += tstep) {
    const int i0 = ni0, i1 = ni1;
    f2 hf[32];
#pragma unroll
    for (int c = 0; c < 4; c++) {
      const u32 hw[8] = {nh[2 * c].x, nh[2 * c].y, nh[2 * c].z, nh[2 * c].w, nh[2 * c + 1].x, nh[2 * c + 1].y, nh[2 * c + 1].z, nh[2 * c + 1].w};
#pragma unroll
      for (int j = 0; j < 8; j++) { hf[c * 8 + j].x = __uint_as_float(hw[j] << 16); hf[c * 8 + j].y = __uint_as_float(hw[j] & 0xffff0000u); }
    }
    if (t + tstep < nrows) prefetch(t + tstep);
    const bool b0 = (i0 >> 11) == x, b1 = (i1 >> 11) == x;
    const unsigned long long m0 = __ballot(b0), m1 = __ballot(b1);
    const int n0 = __popcll(m0);
    const int r0 = __builtin_amdgcn_mbcnt_hi((u32)(m0 >> 32), __builtin_amdgcn_mbcnt_lo((u32)m0, 0u));
    const int r1 = n0 + __builtin_amdgcn_mbcnt_hi((u32)(m1 >> 32), __builtin_amdgcn_mbcnt_lo((u32)m1, 0u));
    const int n = n0 + __popcll(m1);
    __builtin_amdgcn_wave_barrier();
    if (b0) list[r0] = ((u32)lane << 16) | (u32)i0;
    if (b1) list[r1] = ((u32)(64 + lane) << 16) | (u32)i1;
    __builtin_amdgcn_wave_barrier();
    for (int cb = 0; cb < n; cb += 64) {
      const int nend = min(n, cb + 64);
      float dk = 0.f;
      for (int base = cb; base < nend; base += 8) {
        const int k0 = base + g, k1 = base + 4 + g;
        const u32 ent0 = list[min(k0, n - 1)], ent1 = list[min(k1, n - 1)];
        const unsigned char* ur0 = PU + (size_t)(ent0 & 0xffffu) * D;
        const unsigned char* ur1 = PU + (size_t)(ent1 & 0xffffu) * D;
        int4 ua[4], ub[4];
        ua[0] = *(const int4*)(ur0); ua[1] = *(const int4*)(ur0 + 256); ua[2] = *(const int4*)(ur0 + 512); ua[3] = *(const int4*)(ur0 + 768);
        ub[0] = *(const int4*)(ur1); ub[1] = *(const int4*)(ur1 + 256); ub[2] = *(const int4*)(ur1 + 512); ub[3] = *(const int4*)(ur1 + 768);
        const float d0 = dot_row(ua, hf);
        const float d1 = dot_row(ub, hf);
        const int it0 = (base - cb) >> 2;
        dk = (s == it0) ? d0 : dk;
        dk = (s == it0 + 1) ? d1 : dk;
      }
      const int kk = cb + 4 * s + g;
      if (kk < nend) {
        const u32 ent = list[kk];
        const int e = (int)(ent & 0xffffu), slot = (int)(ent >> 16);
        float* gp = GATE + (size_t)t * 128 + slot;
        *gp = *gp * PSV[e] * gelu_tanh(dk * PSU[e]);
      }
    }
  }
}

DI void expert_vsum(const Params& p, int nrows) {
  const int tid = otid(), wave = tid >> 6, lane = tid & 63, g = lane >> 3, s = lane & 7;
  const int bid = obid(), x = bid & 7, jx = bid >> 3, wpx = (gridDim.x + 7 - x) >> 3;
  const int* IDX = (const int*)(p.S + OFF_IDX) + g * 16;
  const float* AV = (const float*)(p.S + OFF_GATE) + g * 16;
  const unsigned char* PV = (const unsigned char*)(p.PT + PT_V) + (size_t)x * 16384 * 128 + s * 16;
  float* Y = (float*)((char*)p.U + (size_t)NROW * 2048 * 2);
  const int b5 = (lane >> 5) & 1, b4 = (lane >> 4) & 1, b3 = (lane >> 3) & 1;
  const int tstep = wpx * 4;
  int t = jx * 4 + wave;
  int4 ni[4]; float4 na[4];
  auto prefetch = [&](int tt) {
#pragma unroll
    for (int j = 0; j < 4; j++) { ni[j] = *(const int4*)(IDX + (size_t)tt * 128 + j * 4); na[j] = *(const float4*)(AV + (size_t)tt * 128 + j * 4); }
  };
  if (t < nrows) prefetch(t);
  for (; t < nrows; t += tstep) {
    const int ee[16] = {ni[0].x, ni[0].y, ni[0].z, ni[0].w, ni[1].x, ni[1].y, ni[1].z, ni[1].w, ni[2].x, ni[2].y, ni[2].z, ni[2].w, ni[3].x, ni[3].y, ni[3].z, ni[3].w};
    const float aa[16] = {na[0].x, na[0].y, na[0].z, na[0].w, na[1].x, na[1].y, na[1].z, na[1].w, na[2].x, na[2].y, na[2].z, na[2].w, na[3].x, na[3].y, na[3].z, na[3].w};
    int4 vv[16];
#pragma unroll
    for (int it = 0; it < 16; it++) vv[it] = *(const int4*)(PV + (size_t)ee[it] * 128);
    if (t + tstep < nrows) prefetch(t + tstep);
    f2 y[8];
#pragma unroll
    for (int i = 0; i < 8; i++) { y[i].x = 0.f; y[i].y = 0.f; }
#pragma unroll
    for (int it = 0; it < 16; it++) {
      const f2 a2 = {aa[it], aa[it]};
      const int vw[4] = {vv[it].x, vv[it].y, vv[it].z, vv[it].w};
#pragma unroll
      for (int j = 0; j < 4; j++) {
        y[2 * j] = __builtin_elementwise_fma(__builtin_amdgcn_cvt_pk_f32_fp8(vw[j], false), a2, y[2 * j]);
        y[2 * j + 1] = __builtin_elementwise_fma(__builtin_amdgcn_cvt_pk_f32_fp8(vw[j], true), a2, y[2 * j + 1]);
      }
    }
    f2 k4[4], k2[2], k1;
#pragma unroll
    for (int i = 0; i < 4; i++) {
      const f2 keep = b5 ? y[4 + i] : y[i], send = b5 ? y[i] : y[4 + i];
      k4[i].x = keep.x + __shfl_xor(send.x, 32); k4[i].y = keep.y + __shfl_xor(send.y, 32);
    }
#pragma unroll
    for (int i = 0; i < 2; i++) {
      const f2 keep = b4 ? k4[2 + i] : k4[i], send = b4 ? k4[i] : k4[2 + i];
      k2[i].x = keep.x + __shfl_xor(send.x, 16); k2[i].y = keep.y + __shfl_xor(send.y, 16);
    }
    {
      const f2 keep = b3 ? k2[1] : k2[0], send = b3 ? k2[0] : k2[1];
      k1.x = keep.x + __shfl_xor(send.x, 8); k1.y = keep.y + __shfl_xor(send.y, 8);
    }
    *(float2*)(Y + (size_t)t * D + x * 128 + s * 16 + b5 * 8 + b4 * 4 + b3 * 2) = make_float2(k1.x, k1.y);
  }
}

DI void expert_epilogue(const Params& p, int layer, int nrows) {
  const int tid = otid(), wave = tid >> 6, lane = tid & 63, g = lane >> 5, s = lane & 31;
  const bool last = (layer == DEPTH - 1);
  const float* Y = (const float*)((const char*)p.U + (size_t)NROW * 2048 * 2);
  for (int tk = obid() * 4 + wave; tk < nrows; tk += gridDim.x * 4) {
    const int b = row_batch(tk);
    const int col = (g * 32 + s) * 16;
    const float* g2 = ada_ptr(p, layer, b, 5) + col;
    const float* gm = p.ln_gamma + (size_t)(layer * 2 + 1) * D + col;
    const float* bt = p.ln_beta + (size_t)(layer * 2 + 1) * D + col;
    float xv[16];
    float sum = 0.f;
#pragma unroll
    for (int j4 = 0; j4 < 4; j4++) {
      const float4 xo = *(const float4*)(p.X + (size_t)tk * D + col + j4 * 4);
      const float4 gg = *(const float4*)(g2 + j4 * 4);
      const float4 yy = *(const float4*)(Y + (size_t)tk * D + col + j4 * 4);
      float* o = xv + j4 * 4;
      o[0] = ALPHA * xo.x + gg.x * yy.x; o[1] = ALPHA * xo.y + gg.y * yy.y;
      o[2] = ALPHA * xo.z + gg.z * yy.z; o[3] = ALPHA * xo.w + gg.w * yy.w;
      sum += o[0] + o[1] + o[2] + o[3];
    }
    float mu = wave_sum(sum) * (1.f / D);
    float q = 0.f;
#pragma unroll
    for (int j = 0; j < 16; j++) { xv[j] -= mu; q += xv[j] * xv[j]; }
    float rstd = rsqrtf(wave_sum(q) * (1.f / D) + EPS);
    float* dstx = (last ? p.out : p.X) + (size_t)tk * D + col;
    float s2 = 0.f;
#pragma unroll
    for (int j4 = 0; j4 < 4; j4++) {
      const float4 gmv = *(const float4*)(gm + j4 * 4);
      const float4 btv = *(const float4*)(bt + j4 * 4);
      float* o = xv + j4 * 4;
      o[0] = o[0] * rstd * gmv.x + btv.x; o[1] = o[1] * rstd * gmv.y + btv.y;
      o[2] = o[2] * rstd * gmv.z + btv.z; o[3] = o[3] * rstd * gmv.w + btv.w;
      s2 += o[0] + o[1] + o[2] + o[3];
      *(float4*)(dstx + j4 * 4) = make_float4(o[0], o[1], o[2], o[3]);
    }
    if (!last) {
      float mu2 = wave_sum(s2) * (1.f / D);
      float q2 = 0.f;
#pragma unroll
      for (int j = 0; j < 16; j++) { xv[j] -= mu2; q2 += xv[j] * xv[j]; }
      float rstd2 = rsqrtf(wave_sum(q2) * (1.f / D) + EPS);
      const float* sh = ada_ptr(p, layer + 1, b, 0) + col;
      const float* sc = ada_ptr(p, layer + 1, b, 1) + col;
      u32 ow[8];
#pragma unroll
      for (int j = 0; j < 8; j++) {
        float y0 = xv[2 * j] * rstd2 * (1.f + sc[2 * j]) + sh[2 * j];
        float y1 = xv[2 * j + 1] * rstd2 * (1.f + sc[2 * j + 1]) + sh[2 * j + 1];
        ow[j] = pack2(y0, y1);
      }
      *(uint4*)(p.H + (size_t)tk * D + col) = make_uint4(ow[0], ow[1], ow[2], ow[3]);
      *(uint4*)(p.H + (size_t)tk * D + col + 8) = make_uint4(ow[4], ow[5], ow[6], ow[7]);
    }
  }
}

#define XB_TMO      128
#define XB_XCNT(j)  (256  + 64 * (j))
#define XB_XSUB(j)  (1280 + 64 * (j))
#define XB_XGEN(j)  (2304 + 64 * (j))
#define XB_TOP      3328
#define XB_TOPGEN   3392
#define XCD_BAR_WORDS 3456
#define XB_SPIN_CAP (1u << 18)
#define LAS __attribute__((address_space(3)))

__device__ __forceinline__ unsigned xb_ld(unsigned* p)              { return __hip_atomic_load(p, __ATOMIC_RELAXED, __HIP_MEMORY_SCOPE_AGENT); }
__device__ __forceinline__ unsigned xb_add(unsigned* p, unsigned v) { return __hip_atomic_fetch_add(p, v, __ATOMIC_RELAXED, __HIP_MEMORY_SCOPE_AGENT); }
__device__ __forceinline__ unsigned xb_xcc_id() { return (unsigned)__builtin_amdgcn_s_getreg((3 << 11) | 20) & 0xFu; }
#define XB_SPIN(cond, bar) do { unsigned _sp = 0; while (cond) { __builtin_amdgcn_s_sleep(1); \
    if ((++_sp & 255u) == 0u) { if (xb_ld(&(bar)[XB_TMO])) break; if (_sp > XB_SPIN_CAP) { atomicAdd(&(bar)[XB_TMO], 1u); break; } } } } while (0)

struct XcdBarrier {
    unsigned* bar; unsigned x;
    volatile LAS unsigned* st;
};

__device__ __forceinline__ XcdBarrier xcd_barrier_post(unsigned* bar, volatile LAS unsigned* st) {
    XcdBarrier b; b.bar = bar; b.x = xb_xcc_id(); b.st = st;
    if (threadIdx.x == 0) (void)xb_add(&bar[XB_XCNT(b.x)], 1u);
    return b;
}
__device__ __forceinline__ void xcd_barrier_complete(unsigned* bar, unsigned x, unsigned& nloc, unsigned& nx) {
    const unsigned G = gridDim.x * gridDim.y * gridDim.z;
    unsigned sum, cnt, mine, sp = 0u;
    for (;;) {
        sum = 0u; cnt = 0u; mine = 0u;
#pragma unroll
        for (unsigned j = 0; j < 16; ++j) { const unsigned c = xb_ld(&bar[XB_XCNT(j)]); sum += c; cnt += (c > 0u) ? 1u : 0u; mine = (j == x) ? c : mine; }
        if (sum == G) break;
        __builtin_amdgcn_s_sleep(1);
        if ((++sp & 255u) == 0u) { if (xb_ld(&bar[XB_TMO])) break; if (sp > XB_SPIN_CAP) { atomicAdd(&bar[XB_TMO], 1u); break; } }
    }
    nloc = mine > 0u ? mine : 1u; nx = cnt > 0u ? cnt : 1u;
}

__device__ __forceinline__ void xcd_barrier(const XcdBarrier& b) {
    asm volatile("s_waitcnt vmcnt(0)" ::: "memory");
    __syncthreads();
    if (threadIdx.x == 0) {
        unsigned* bar = b.bar;
        __builtin_amdgcn_s_waitcnt(0);
        unsigned nloc = b.st[0], nx = b.st[1];
        if (nloc == 0u) { xcd_barrier_complete(bar, b.x, nloc, nx); b.st[0] = nloc; b.st[1] = nx; }
        const unsigned old = xb_add(&bar[XB_XSUB(b.x)], 1u);
        const unsigned gen = old / nloc;
        if (old + 1u == (gen + 1u) * nloc) {
            __builtin_amdgcn_fence(__ATOMIC_RELEASE, "agent");
            asm volatile("s_waitcnt vmcnt(0)" ::: "memory");
            const unsigned og = xb_add(&bar[XB_TOP], 1u);
            const unsigned tg = og / nx;
            if (og + 1u == (tg + 1u) * nx) xb_add(&bar[XB_TOPGEN], 1u);
            else XB_SPIN(xb_ld(&bar[XB_TOPGEN]) == tg, bar);
            __builtin_amdgcn_fence(__ATOMIC_ACQUIRE, "agent");
            xb_add(&bar[XB_XGEN(b.x)], 1u);
            asm volatile("s_waitcnt vmcnt(0)" ::: "memory");
        } else {
            XB_SPIN(xb_ld(&bar[XB_XGEN(b.x)]) == gen, bar);
            __builtin_amdgcn_fence(__ATOMIC_ACQUIRE, "agent");
            asm volatile("s_waitcnt vmcnt(0)" ::: "memory");
        }
    }
    __syncthreads();
}


DI void grid_barrier(unsigned* ctr, unsigned& target) {
  asm volatile("s_waitcnt vmcnt(0)" ::: "memory");
  __syncthreads();
  if (threadIdx.x == 0) {
    target += gridDim.x;
    __builtin_amdgcn_fence(__ATOMIC_RELEASE, "agent");
    asm volatile("s_waitcnt vmcnt(0)" ::: "memory");
    __hip_atomic_fetch_add(ctr, 1u, __ATOMIC_RELAXED, __HIP_MEMORY_SCOPE_AGENT);
    while (__hip_atomic_load(ctr, __ATOMIC_RELAXED, __HIP_MEMORY_SCOPE_AGENT) < target) __builtin_amdgcn_s_sleep(1);
    __builtin_amdgcn_fence(__ATOMIC_ACQUIRE, "agent");
    asm volatile("s_waitcnt vmcnt(0)" ::: "memory");
  }
  __syncthreads();
}

__global__ void __launch_bounds__(256, 2) mk_forward(Params p) {
  __shared__ __attribute__((aligned(16))) char smem[LDS_BYTES];
  cg::grid_group grid = cg::this_grid();
  int pc = 0;
#define GSYNC() xcd_barrier(xb)
#define PHASE(body) PHASER(15, body)
#define PHASER(kind, body)                              \
  {                                                     \
    if (pc >= p.ph_lo && pc < p.ph_hi) {                \
      if ((REPMASK >> (kind)) & 1) { const bool dry = true; (void)dry; body; GSYNC(); } \
      { const bool dry = false; (void)dry; body; }      \
      if (pc + 1 < p.ph_hi) GSYNC();                    \
    }                                                   \
    pc++;                                               \
  }
  __shared__ __attribute__((aligned(16))) unsigned xb_words[4];
  if (threadIdx.x == 0) { xb_words[0] = 0u; xb_words[1] = 0u; xb_words[2] = 0u; xb_words[3] = 0u; }
  __syncthreads();
  const XcdBarrier xb = xcd_barrier_post(p.bar, (volatile LAS unsigned*)xb_words);
  if (0 >= p.ph_lo && 0 < p.ph_hi) {
    phase0(p, (float*)smem);
    if (1 < p.ph_hi) grid.sync();
  }
  pc++;
  PHASE(phase0b(p))
  PHASE(lnmod_phase<0>(p, 0, NROW))
  for (int layer = 0; layer < DEPTH; layer++) {
    const bool last = (layer == DEPTH - 1);
    const int nrows = last ? NLAT : NROW;
    PHASER(0, gemm_phase<0>(p, layer, smem, p.H, p.wt_in + (size_t)layer * DINP * D, NROW / 256, DINP / 128, dry))
    PHASER(1, prep_phase(p, layer))
    PHASER(2, scan_phase(p, smem, layer))
    PHASER(3, combine_phase(p, layer, nrows))
    PHASER(4, { gemm_phase<1>(p, layer, smem, p.H, p.wt_out + (size_t)layer * D * D, NLAT / 256, 8, dry);
                 if (nrows > NLAT) gemm_thin<1>(p, layer, smem, p.H, p.wt_out + (size_t)layer * D * D, NLAT, NCTX / 64, 8, dry); })
    PHASER(5, lnmod_phase<1>(p, layer, nrows))
    PHASER(6, { gemm_phase<2>(p, layer, smem, p.H, p.wt_q + (size_t)layer * 2048 * D, NLAT / 256, 16, dry);
                 if (nrows > NLAT) gemm_thin<2>(p, layer, smem, p.H, p.wt_q + (size_t)layer * 2048 * D, NLAT, NCTX / 64, 16, dry); })
    PHASER(7, topk_phase(p, layer, smem, nrows))
    PHASER(8, expert_dots(p, nrows, smem))
    PHASER(9, expert_vsum(p, nrows))
    PHASER(10, expert_epilogue(p, layer, nrows))
  }
#undef PHASE
#undef PHASER
}
constexpr int NPHASES = 3 + 11 * DEPTH;

extern "C" void kernel_launch(void* const* d_in, const int* in_sizes, int n_in, void* d_out, int out_size, void* d_ws,
                              size_t ws_size, hipStream_t stream) {
  Params p{};
  p.x = (const float*)d_in[0]; p.c = (const float*)d_in[1]; p.ctx = (const float*)d_in[2]; p.c_ctx = (const float*)d_in[3];
  p.w_ada = (const float*)d_in[4]; p.b_ada = (const float*)d_in[5]; p.w_in = (const float*)d_in[6];
  p.w_gk2 = (const float*)d_in[7]; p.b_gk = (const float*)d_in[8]; p.hg_lb = (const float*)d_in[9];
  p.hg_norm = (const float*)d_in[10]; p.gla_norm = (const float*)d_in[11]; p.w_out = (const float*)d_in[12];
  p.ln_gamma = (const float*)d_in[13]; p.ln_beta = (const float*)d_in[14]; p.wq = (const float*)d_in[15];
  p.sub_keys = (const float*)d_in[16]; p.peer_u = (const float*)d_in[17]; p.peer_v = (const float*)d_in[18];
  p.out = (float*)d_out;
  char* w = (char*)d_ws;
  size_t off = 0;
  auto take = [&](size_t bytes) { char* q = w + off; off += (bytes + 255) & ~(size_t)255; return q; };
  p.wt_in = (u16*)take((size_t)4 * DINP * D * 2);
  p.wt_out = (u16*)take((size_t)4 * D * D * 2);
  p.wt_q = (u16*)take((size_t)4 * 2048 * D * 2);
  p.keysb = (u16*)take((size_t)4 * 2 * 128 * 128 * 2);
  p.ada_part = (float*)take((size_t)8 * 4 * 5 * 6144 * 4);
  p.ada = (float*)take((size_t)4 * 5 * 6144 * 4);
  p.X = (float*)take((size_t)NROW * D * 4);
  p.H = (u16*)take((size_t)NROW * D * 2);
  p.G = (u16*)take((size_t)NROW * D * 2);
  p.U = (u16*)take((size_t)NROW * DIN * 2);
  p.S = take(SZ_S);
  p.PT = take(SZ_PT);
  p.bar = (unsigned*)take(XCD_BAR_WORDS * 4);
  if (off > ws_size) { fprintf(stderr, "workspace too small: need %zu have %zu\n", off, ws_size); return; }

  static int grid_blocks = 0;
  if (!grid_blocks) {
    int dev = 0, cus = 0, per_cu = 0;
    hipGetDevice(&dev);
    hipDeviceGetAttribute(&cus, hipDeviceAttributeMultiprocessorCount, dev);
    hipOccupancyMaxActiveBlocksPerMultiprocessor(&per_cu, mk_forward, 256, 0);
    if (per_cu > 2) per_cu = 2;
    grid_blocks = cus * per_cu;
  }
#if ONE_LAUNCH
  hipMemsetAsync(p.bar, 0, XCD_BAR_WORDS * 4, stream);
  p.ph_lo = 0; p.ph_hi = NPHASES;
  void* args[] = {&p};
  hipError_t e = hipLaunchCooperativeKernel((void*)mk_forward, dim3(grid_blocks), dim3(256), args, 0, stream);
  if (e != hipSuccess) fprintf(stderr, "cooperative launch failed: %s (grid %d)\n", hipGetErrorString(e), grid_blocks);
#else
  for (int ph = 0; ph < NPHASES; ph++) {
    p.ph_lo = ph; p.ph_hi = ph + 1;
    hipLaunchKernelGGL(mk_forward, dim3(grid_blocks), dim3(256), 0, stream, p);
  }
#endif
}
```

```cpp
#include <hip/hip_runtime.h>
#include <hip/hip_cooperative_groups.h>
#include <cstdio>
namespace cg = cooperative_groups;

#define DI __device__ __forceinline__
typedef unsigned short u16;
typedef unsigned int u32;
typedef __attribute__((ext_vector_type(8))) short bf16x8;
typedef __attribute__((ext_vector_type(16))) float f32x16;
typedef __attribute__((ext_vector_type(2))) __bf16 bf2;

#ifndef REPMASK
#define REPMASK 0
#endif
#ifndef DRYVAR
#define DRYVAR 0
#endif
#ifndef ONE_LAUNCH
#define ONE_LAUNCH 1
#endif

constexpr int D = 1024, NB = 4, SEQ = 8192, DEPTH = 4, CTX = 256;
constexpr int NLAT = NB * SEQ;
constexpr int NCTX = NB * CTX;
constexpr int NROW = NLAT + NCTX;
constexpr int DIN = 4128, DINP = 4224;
constexpr int LPOS = CTX + SEQ;
constexpr int NBLK = LPOS / 32;
constexpr float ALPHA = 1.681792830507429f;
constexpr float EPS = 1e-6f;
constexpr int LDS_BYTES = 73728;

struct Params {
  const float *x, *c, *ctx, *c_ctx, *w_ada, *b_ada, *w_in, *w_gk2, *b_gk, *hg_lb, *hg_norm, *gla_norm,
      *w_out, *ln_gamma, *ln_beta, *wq, *sub_keys, *peer_u, *peer_v;
  float* out;
  u16 *wt_in, *wt_out, *wt_q, *keysb;
  float *ada_part, *ada;
  float* X;
  u16 *H, *G, *U;
  char* S;
  char* PT;
  unsigned* bar;
  int ph_lo, ph_hi;
};

constexpr size_t SZ_HQ = (size_t)2 * 16 * LPOS * 128 * 2;
constexpr size_t SZ_HVT = (size_t)16 * 128 * LPOS * 2;
constexpr size_t SZ_HD = (size_t)2 * 16 * NBLK * 128 * 4;
constexpr size_t SZ_GQ = (size_t)2 * 16 * LPOS * 64 * 2;
constexpr size_t SZ_GD = (size_t)2 * 16 * NBLK * 64 * 4;
constexpr size_t OFF_HQ = 0, OFF_HK = OFF_HQ + SZ_HQ, OFF_HKT = OFF_HK + SZ_HQ, OFF_HVT = OFF_HKT + SZ_HQ,
                 OFF_HD = OFF_HVT + SZ_HVT, OFF_GQ = OFF_HD + SZ_HD, OFF_GK = OFF_GQ + SZ_GQ, OFF_GKT = OFF_GK + SZ_GQ,
                 OFF_GVT = OFF_GKT + SZ_GQ, OFF_GD = OFF_GVT + SZ_HVT, SZ_S = OFF_GD + SZ_GD;
constexpr size_t OFF_XP = 0, SZ_XP = (size_t)NROW * D * 4;
constexpr size_t OFF_IDX = OFF_XP + SZ_XP, SZ_IDX = (size_t)NROW * 128 * 4;
constexpr size_t OFF_GATE = OFF_IDX + SZ_IDX;
constexpr size_t OFF_PU = OFF_GATE + SZ_IDX, SZ_PU = (size_t)16384 * D * 2;
constexpr size_t OFF_PV = OFF_PU + SZ_PU;
constexpr size_t OFF_PSC = OFF_PV + SZ_PU;
static_assert(OFF_PSC + 2 * 16384 * 4 <= SZ_S, "alias overflow");
constexpr size_t PT_U = 0, PT_V = (size_t)16384 * D, PT_SC = 2 * (size_t)16384 * D, SZ_PT = PT_SC + 2 * 16384 * 4;

DI int otid() { int t = threadIdx.x; asm volatile("" : "+v"(t)); return t; }
DI int obid() { int t = blockIdx.x; asm volatile("" : "+s"(t)); return t; }
DI float bf2f(u16 h) { return __uint_as_float(((u32)h) << 16); }
DI u16 f2bf(float x) { return __builtin_bit_cast(u16, (__bf16)x); }
typedef __attribute__((ext_vector_type(2))) float f32x2v;
typedef __attribute__((ext_vector_type(2))) __bf16 bf16x2v;
DI u32 pack2(float a, float b) { f32x2v v = {a, b}; return __builtin_bit_cast(u32, __builtin_convertvector(v, bf16x2v)); }
DI float wave_sum(float v) {
#pragma unroll
  for (int o = 32; o > 0; o >>= 1) v += __shfl_xor(v, o);
  return v;
}
DI int crow(int i, int h) { return (i & 3) + 8 * (i >> 2) + 4 * h; }
DI int perm16(int k) {
  int kk = k & 15;
  return (k & ~15) | (((kk >> 2) & 1) << 3) | ((kk >> 3) << 2) | (kk & 3);
}
DI bf16x8 pack_frag(const f32x16& x, int s) {
  union { bf16x8 v; u32 u[4]; } r;
#pragma unroll
  for (int j = 0; j < 4; j++) r.u[j] = pack2(x[8 * s + 2 * j], x[8 * s + 2 * j + 1]);
  return r.v;
}
#define MFMA32(a, b, c) __builtin_amdgcn_mfma_f32_32x32x16_bf16((a), (b), (c), 0, 0, 0)

DI const float* ada_ptr(const Params& p, int layer, int r, int j) { return p.ada + ((size_t)(layer * 5 + r) * 6 + j) * D; }
DI int row_batch(int r) { return r < NLAT ? (r >> 13) : 4; }

DI void weight_convert(const Params& p, int l, int vbid, int vgrid) {
  const size_t gtid = (size_t)vbid * 256 + otid(), gsz = (size_t)vgrid * 256;
  for (size_t i = gtid; i < (size_t)128 * DINP; i += gsz) {
    int n = i % DINP; int k8 = i / DINP;
    u32 o[4] = {0, 0, 0, 0};
    if (n < DIN) {
      const float* s = p.w_in + ((size_t)l * D + k8 * 8) * DIN + n;
#pragma unroll
      for (int j = 0; j < 4; j++) o[j] = pack2(s[(size_t)(2 * j) * DIN], s[(size_t)(2 * j + 1) * DIN]);
    }
    *(uint4*)(p.wt_in + ((size_t)l * DINP + n) * D + k8 * 8) = make_uint4(o[0], o[1], o[2], o[3]);
  }
  for (size_t i = gtid; i < (size_t)128 * 1024; i += gsz) {
    int n = i & 1023; int k8 = i >> 10;
    const float* s = p.w_out + ((size_t)l * D + k8 * 8) * D + n;
    u32 o[4];
#pragma unroll
    for (int j = 0; j < 4; j++) o[j] = pack2(s[(size_t)(2 * j) * D], s[(size_t)(2 * j + 1) * D]);
    *(uint4*)(p.wt_out + ((size_t)l * D + n) * D + k8 * 8) = make_uint4(o[0], o[1], o[2], o[3]);
  }
  for (size_t i = gtid; i < (size_t)128 * 2048; i += gsz) {
    int n = i & 2047; int k8 = i >> 11;
    const float* s = p.wq + ((size_t)l * D + k8 * 8) * 2048 + n;
    u32 o[4];
#pragma unroll
    for (int j = 0; j < 4; j++) o[j] = pack2(s[(size_t)(2 * j) * 2048], s[(size_t)(2 * j + 1) * 2048]);
    *(uint4*)(p.wt_q + ((size_t)l * 2048 + n) * D + k8 * 8) = make_uint4(o[0], o[1], o[2], o[3]);
  }
}

DI void phase0(const Params& p, float* lds) {
  for (int it = obid(); it < 768; it += gridDim.x) {
    int kp = it & 7, nb = (it >> 3) % 24, l = it / 192;
    __syncthreads();
    for (int i = otid(); i < 640; i += 256) {
      int r = i >> 7, k = i & 127;
      float v = (r < 4) ? p.c[r * D + kp * 128 + k] : p.c_ctx[kp * 128 + k];
      lds[i] = v / (1.f + __expf(-v));
    }
    __syncthreads();
    int n = nb * 256 + otid();
    const float* w = p.w_ada + ((size_t)l * D + kp * 128) * 6144 + n;
    float a0 = 0, a1 = 0, a2 = 0, a3 = 0, a4 = 0;
#pragma unroll 8
    for (int k = 0; k < 128; k++) {
      float wv = w[(size_t)k * 6144];
      a0 += lds[k] * wv; a1 += lds[128 + k] * wv; a2 += lds[256 + k] * wv; a3 += lds[384 + k] * wv; a4 += lds[512 + k] * wv;
    }
    float* o = p.ada_part + ((size_t)(kp * 4 + l) * 5) * 6144 + n;
    o[0] = a0; o[6144] = a1; o[2 * 6144] = a2; o[3 * 6144] = a3; o[4 * 6144] = a4;
  }
  weight_convert(p, 0, obid(), gridDim.x);
  const size_t gtid = (size_t)obid() * 256 + otid(), gsz = (size_t)gridDim.x * 256;
  for (size_t i = gtid; i < (size_t)4 * 2 * 128 * 128; i += gsz) p.keysb[i] = f2bf(p.sub_keys[i]);
}

DI void phase0b(const Params& p) {
  const size_t gtid = (size_t)obid() * 256 + otid(), gsz = (size_t)gridDim.x * 256;
  for (size_t i = gtid; i < (size_t)4 * 5 * 6144; i += gsz) {
    int n = i % 6144; int l = i / (5 * 6144);
    float a = p.b_ada[l * 6144 + n];
#pragma unroll
    for (int kp = 0; kp < 8; kp++) a += p.ada_part[(size_t)kp * 4 * 5 * 6144 + i];
    p.ada[i] = a;
  }
}

DI void peer_convert(const Params& p, int layer, int vbid, int vgrid) {
  const int tid = otid(), wave = tid >> 6, lane = tid & 63;
  unsigned char* du = (unsigned char*)(p.PT + PT_U);
  unsigned char* dv = (unsigned char*)(p.PT + PT_V);
  float* su = (float*)(p.PT + PT_SC);
  for (int it = vbid * 4 + wave; it < 2 * 16384; it += vgrid * 4) {
    const int tbl = it >> 14, e = it & 16383;
    const float* src = (tbl ? p.peer_v : p.peer_u) + ((size_t)layer * 16384 + e) * D + lane * 16;
    float4 a = *(const float4*)(src), b = *(const float4*)(src + 4), c = *(const float4*)(src + 8), d = *(const float4*)(src + 12);
    float m = fmaxf(fmaxf(fmaxf(fabsf(a.x), fabsf(a.y)), fmaxf(fabsf(a.z), fabsf(a.w))), fmaxf(fmaxf(fabsf(b.x), fabsf(b.y)), fmaxf(fabsf(b.z), fabsf(b.w))));
    m = fmaxf(m, fmaxf(fmaxf(fmaxf(fabsf(c.x), fabsf(c.y)), fmaxf(fabsf(c.z), fabsf(c.w))), fmaxf(fmaxf(fabsf(d.x), fabsf(d.y)), fmaxf(fabsf(d.z), fabsf(d.w)))));
#pragma unroll
    for (int o = 32; o > 0; o >>= 1) m = fmaxf(m, __shfl_xor(m, o));
    m = fmaxf(m, 1e-30f);
    const float sc = 224.f / m;
    int w0 = __builtin_amdgcn_cvt_pk_fp8_f32(a.x * sc, a.y * sc, 0, false); w0 = __builtin_amdgcn_cvt_pk_fp8_f32(a.z * sc, a.w * sc, w0, true);
    int w1 = __builtin_amdgcn_cvt_pk_fp8_f32(b.x * sc, b.y * sc, 0, false); w1 = __builtin_amdgcn_cvt_pk_fp8_f32(b.z * sc, b.w * sc, w1, true);
    int w2 = __builtin_amdgcn_cvt_pk_fp8_f32(c.x * sc, c.y * sc, 0, false); w2 = __builtin_amdgcn_cvt_pk_fp8_f32(c.z * sc, c.w * sc, w2, true);
    int w3 = __builtin_amdgcn_cvt_pk_fp8_f32(d.x * sc, d.y * sc, 0, false); w3 = __builtin_amdgcn_cvt_pk_fp8_f32(d.z * sc, d.w * sc, w3, true);
    if (tbl == 0) *(int4*)(du + (size_t)e * D + lane * 16) = make_int4(w0, w1, w2, w3);
    else *(int4*)(dv + ((size_t)(lane >> 3) * 16384 + e) * 128 + (lane & 7) * 16) = make_int4(w0, w1, w2, w3);
    if (lane == 0) su[it] = m * (1.f / 224.f);
  }
}

template <int MODE>
DI void lnmod_phase(const Params& p, int layer, int nrows) {
  const int wave = otid() >> 6, lane = otid() & 63;
  const float* XP = (const float*)(p.S + OFF_XP);
  for (int r = obid() * 4 + wave; r < nrows; r += gridDim.x * 4) {
    const float* src;
    if (MODE == 0) src = (r < NLAT) ? p.x + (size_t)r * D : p.ctx + (size_t)(r - NLAT) * D;
    else src = XP + (size_t)r * D;
    const int b = row_batch(r);
    float4 v[4];
#pragma unroll
    for (int c = 0; c < 4; c++) v[c] = *(const float4*)(src + c * 256 + lane * 4);
    float s = 0;
#pragma unroll
    for (int c = 0; c < 4; c++) s += v[c].x + v[c].y + v[c].z + v[c].w;
    float mu = wave_sum(s) * (1.f / D);
    float q = 0;
#pragma unroll
    for (int c = 0; c < 4; c++) {
      v[c].x -= mu; v[c].y -= mu; v[c].z -= mu; v[c].w -= mu;
      q += v[c].x * v[c].x + v[c].y * v[c].y + v[c].z * v[c].z + v[c].w * v[c].w;
    }
    float rstd = rsqrtf(wave_sum(q) * (1.f / D) + EPS);
    if (MODE == 1) {
      const float* gm = p.ln_gamma + (size_t)(layer * 2 + 0) * D;
      const float* bt = p.ln_beta + (size_t)(layer * 2 + 0) * D;
      float s2 = 0;
#pragma unroll
      for (int c = 0; c < 4; c++) {
        int col = c * 256 + lane * 4;
        float4 g = *(const float4*)(gm + col), be = *(const float4*)(bt + col);
        v[c].x = v[c].x * rstd * g.x + be.x; v[c].y = v[c].y * rstd * g.y + be.y;
        v[c].z = v[c].z * rstd * g.z + be.z; v[c].w = v[c].w * rstd * g.w + be.w;
        *(float4*)(p.X + (size_t)r * D + col) = v[c];
        s2 += v[c].x + v[c].y + v[c].z + v[c].w;
      }
      float mu2 = wave_sum(s2) * (1.f / D);
      float q2 = 0;
#pragma unroll
      for (int c = 0; c < 4; c++) {
        v[c].x -= mu2; v[c].y -= mu2; v[c].z -= mu2; v[c].w -= mu2;
        q2 += v[c].x * v[c].x + v[c].y * v[c].y + v[c].z * v[c].z + v[c].w * v[c].w;
      }
      rstd = rsqrtf(wave_sum(q2) * (1.f / D) + EPS);
    }
    const float* sh = ada_ptr(p, layer, b, MODE == 0 ? 0 : 3);
    const float* sc = ada_ptr(p, layer, b, MODE == 0 ? 1 : 4);
#pragma unroll
    for (int c = 0; c < 4; c++) {
      int col = c * 256 + lane * 4;
      float4 a = *(const float4*)(sh + col), m = *(const float4*)(sc + col);
      float y0 = v[c].x * rstd * (1.f + m.x) + a.x, y1 = v[c].y * rstd * (1.f + m.y) + a.y;
      float y2 = v[c].z * rstd * (1.f + m.z) + a.z, y3 = v[c].w * rstd * (1.f + m.w) + a.w;
      *(uint2*)(p.H + (size_t)r * D + col) = make_uint2(pack2(y0, y1), pack2(y2, y3));
    }
  }
}

constexpr int LDS_STRIDE = 72;
constexpr int CT_STRIDE = 132;
template <int MODE>
DI void gemm_store(const Params& p, int layer, int row, int nt, int n0, int c4, const float4 v, const bool dry) {
  if (MODE == 0) {
          u16* dst;
          if (nt >= 16 && nt < 20) dst = p.G + (size_t)row * D + (n0 - 2048) + c4;
          else if (nt >= 28 && nt < 32) dst = p.G + (size_t)row * D + (n0 - 3584 + 512) + c4;
          else dst = p.U + (size_t)row * DIN + n0 + c4;
          if (dry) dst = (u16*)p.S + (size_t)row * DIN + n0 + c4;
          if (n0 + c4 < DIN) *(uint2*)dst = make_uint2(pack2(v.x, v.y), pack2(v.z, v.w));
        } else if (MODE == 1) {
          float* XP = dry ? (float*)p.U : (float*)(p.S + OFF_XP);
          const float* xo = (layer == 0) ? ((row < NLAT) ? p.x + (size_t)row * D : p.ctx + (size_t)(row - NLAT) * D) : p.X + (size_t)row * D;
          const float4 xv = *(const float4*)(xo + n0 + c4);
          const float4 g1 = *(const float4*)(ada_ptr(p, layer, row_batch(row), 2) + n0 + c4);
          *(float4*)(XP + (size_t)row * D + n0 + c4) =
              make_float4(ALPHA * xv.x + g1.x * v.x, ALPHA * xv.y + g1.y * v.y, ALPHA * xv.z + g1.z * v.z, ALPHA * xv.w + g1.w * v.w);
        } else {
          *(uint2*)((dry ? (u16*)(p.S + OFF_PU) : p.U) + (size_t)row * 2048 + n0 + c4) = make_uint2(pack2(v.x, v.y), pack2(v.z, v.w));
        }
}

template <int MODE>
DI void gemm_phase(const Params& p, int layer, char* smem, const u16* A, const u16* Bt, int Mtiles, int Ntiles, const bool dry) {
  u16* As = (u16*)smem;
  u16* Bs = (u16*)smem + 256 * LDS_STRIDE;
  float* Ct = (float*)smem;
  const int tid = otid(), wave = tid >> 6, lane = tid & 63, r = lane & 31, h = lane >> 5;
  const int wm = wave >> 1, wn = wave & 1;
  const int srow = tid >> 3, sc8 = (tid & 7) * 8;
  const int bid = obid(), xcd = bid & 7, jx = bid >> 3, wpx = (gridDim.x + 7 - xcd) >> 3;
  const int ntiles = Mtiles * Ntiles, nchunks = (ntiles + 63) >> 6;
  for (int ch = xcd; ch < nchunks; ch += 8)
  for (int jj = jx; jj < 64; jj += wpx) {
    const int L = ch * 64 + jj;
    if (L >= ntiles) continue;
    const int mt = (L / (4 * Ntiles)) * 4 + (L & 3), nt = (L >> 2) % Ntiles;
    const u16* Ag = A + ((size_t)mt * 256 + srow) * D + sc8;
    const u16* Bg = Bt + ((size_t)nt * 128 + srow) * D + sc8;
    f32x16 acc[4][2];
#pragma unroll
    for (int i = 0; i < 4; i++)
#pragma unroll
      for (int j = 0; j < 2; j++)
#pragma unroll
        for (int e = 0; e < 16; e++) acc[i][j][e] = 0.f;
    bf16x8 ra0, ra1, ra2, ra3, ra4, ra5, ra6, ra7, rb0, rb1, rb2, rb3;
#define GLOAD(kt_) { const u16* ag = Ag + (kt_) * 64; const u16* bg = Bg + (kt_) * 64; \
      ra0 = *(const bf16x8*)(ag); ra1 = *(const bf16x8*)(ag + 32 * D); ra2 = *(const bf16x8*)(ag + 64 * D); ra3 = *(const bf16x8*)(ag + 96 * D); \
      ra4 = *(const bf16x8*)(ag + 128 * D); ra5 = *(const bf16x8*)(ag + 160 * D); ra6 = *(const bf16x8*)(ag + 192 * D); ra7 = *(const bf16x8*)(ag + 224 * D); \
      rb0 = *(const bf16x8*)(bg); rb1 = *(const bf16x8*)(bg + 32 * D); rb2 = *(const bf16x8*)(bg + 64 * D); rb3 = *(const bf16x8*)(bg + 96 * D); }
#define LSTORE() { u16* ad = As + srow * LDS_STRIDE + sc8; u16* bd = Bs + srow * LDS_STRIDE + sc8; \
      *(bf16x8*)(ad) = ra0; *(bf16x8*)(ad + 32 * LDS_STRIDE) = ra1; *(bf16x8*)(ad + 64 * LDS_STRIDE) = ra2; *(bf16x8*)(ad + 96 * LDS_STRIDE) = ra3; \
      *(bf16x8*)(ad + 128 * LDS_STRIDE) = ra4; *(bf16x8*)(ad + 160 * LDS_STRIDE) = ra5; *(bf16x8*)(ad + 192 * LDS_STRIDE) = ra6; *(bf16x8*)(ad + 224 * LDS_STRIDE) = ra7; \
      *(bf16x8*)(bd) = rb0; *(bf16x8*)(bd + 32 * LDS_STRIDE) = rb1; *(bf16x8*)(bd + 64 * LDS_STRIDE) = rb2; *(bf16x8*)(bd + 96 * LDS_STRIDE) = rb3; }
    GLOAD(0)
    __syncthreads();
    LSTORE()
    __syncthreads();
#pragma unroll 1
    for (int kt = 0; kt < 16; kt++) {
      if (kt + 1 < 16 && !(dry && DRYVAR == 1)) GLOAD(kt + 1)
      const u16* as = As + (wm * 128 + r) * LDS_STRIDE + h * 8;
      const u16* bs = Bs + (wn * 64 + r) * LDS_STRIDE + h * 8;
      if (!(dry && DRYVAR == 2)) {
        bf16x8 af[2][4], b0, b1;
#pragma unroll
        for (int i = 0; i < 4; i++) af[0][i] = *(const bf16x8*)(as + i * 32 * LDS_STRIDE);
        b0 = *(const bf16x8*)(bs); b1 = *(const bf16x8*)(bs + 32 * LDS_STRIDE);
#pragma unroll
        for (int kk = 0; kk < 4; kk++) {
          const int cur = kk & 1, nxt = cur ^ 1;
          if (kk < 3) {
#pragma unroll
            for (int i = 0; i < 4; i++) af[nxt][i] = *(const bf16x8*)(as + i * 32 * LDS_STRIDE + (kk + 1) * 16);
          }
          __builtin_amdgcn_s_setprio(1);
#pragma unroll
          for (int i = 0; i < 4; i++) acc[i][0] = MFMA32(af[cur][i], b0, acc[i][0]);
          if (kk < 3) b0 = *(const bf16x8*)(bs + (kk + 1) * 16);
#pragma unroll
          for (int i = 0; i < 4; i++) acc[i][1] = MFMA32(af[cur][i], b1, acc[i][1]);
          if (kk < 3) b1 = *(const bf16x8*)(bs + 32 * LDS_STRIDE + (kk + 1) * 16);
          __builtin_amdgcn_s_setprio(0);
        }
      }
      __syncthreads();
      if (kt + 1 < 16 && !(dry && DRYVAR == 1)) LSTORE()
      __syncthreads();
    }
#undef GLOAD
#undef LSTORE
    const int m0 = mt * 256, n0 = nt * 128;
    const int c4 = (tid & 31) * 4, rr0 = tid >> 5;
#pragma unroll
    for (int ph = 0; ph < 2; ph++) {
      if (ph) __syncthreads();
#pragma unroll
      for (int ii = 0; ii < 2; ii++)
#pragma unroll
        for (int j = 0; j < 2; j++)
#pragma unroll
          for (int e = 0; e < 16; e++) Ct[(wm * 64 + ii * 32 + crow(e, h)) * CT_STRIDE + wn * 64 + j * 32 + r] = acc[ph * 2 + ii][j][e];
      __syncthreads();
#pragma unroll 2
      for (int q = 0; q < 16; q++) {
        const int rl = rr0 + q * 8, row = m0 + (rl >> 6) * 128 + ph * 64 + (rl & 63);
        const float4 v = *(const float4*)(Ct + rl * CT_STRIDE + c4);
        gemm_store<MODE>(p, layer, row, nt, n0, c4, v, dry);
      }
    }
  }
}

template <int MODE>
DI void gemm_thin(const Params& p, int layer, char* smem, const u16* A, const u16* Bt, int row0, int Mtiles, int Ntiles, const bool dry) {
  u16* As = (u16*)smem;
  u16* Bs = (u16*)smem + 64 * LDS_STRIDE;
  float* Ct = (float*)smem;
  const int tid = otid(), wave = tid >> 6, lane = tid & 63, r = lane & 31, h = lane >> 5;
  const int wm = wave >> 1, wn = wave & 1;
  const int srow = tid >> 3, sc8 = (tid & 7) * 8;
  const int ntiles = Mtiles * Ntiles;
  for (int L = obid(); L < ntiles; L += gridDim.x) {
    const int mt = L / Ntiles, nt = L % Ntiles;
    const u16* Ag = A + ((size_t)row0 + mt * 64 + srow) * D + sc8;
    const u16* Bg = Bt + ((size_t)nt * 128 + srow) * D + sc8;
    f32x16 acc0, acc1;
#pragma unroll
    for (int e = 0; e < 16; e++) { acc0[e] = 0.f; acc1[e] = 0.f; }
    bf16x8 ra0, ra1, rb0, rb1, rb2, rb3;
#define GLOADT(kt_) { const u16* ag = Ag + (kt_) * 64; const u16* bg = Bg + (kt_) * 64; \
      ra0 = *(const bf16x8*)(ag); ra1 = *(const bf16x8*)(ag + 32 * D); \
      rb0 = *(const bf16x8*)(bg); rb1 = *(const bf16x8*)(bg + 32 * D); rb2 = *(const bf16x8*)(bg + 64 * D); rb3 = *(const bf16x8*)(bg + 96 * D); }
#define LSTORET() { u16* ad = As + srow * LDS_STRIDE + sc8; u16* bd = Bs + srow * LDS_STRIDE + sc8; \
      *(bf16x8*)(ad) = ra0; *(bf16x8*)(ad + 32 * LDS_STRIDE) = ra1; \
      *(bf16x8*)(bd) = rb0; *(bf16x8*)(bd + 32 * LDS_STRIDE) = rb1; *(bf16x8*)(bd + 64 * LDS_STRIDE) = rb2; *(bf16x8*)(bd + 96 * LDS_STRIDE) = rb3; }
    GLOADT(0)
    __syncthreads();
    LSTORET()
    __syncthreads();
#pragma unroll 1
    for (int kt = 0; kt < 16; kt++) {
      if (kt + 1 < 16) GLOADT(kt + 1)
      const u16* as = As + (wm * 32 + r) * LDS_STRIDE + h * 8;
      const u16* bs = Bs + (wn * 64 + r) * LDS_STRIDE + h * 8;
#pragma unroll
      for (int kk = 0; kk < 4; kk++) {
        const bf16x8 af = *(const bf16x8*)(as + kk * 16);
        const bf16x8 bf0 = *(const bf16x8*)(bs + kk * 16), bf1 = *(const bf16x8*)(bs + 32 * LDS_STRIDE + kk * 16);
        acc0 = MFMA32(af, bf0, acc0);
        acc1 = MFMA32(af, bf1, acc1);
      }
      __syncthreads();
      if (kt + 1 < 16) LSTORET()
      __syncthreads();
    }
#undef GLOADT
#undef LSTORET
#pragma unroll
    for (int e = 0; e < 16; e++) {
      Ct[(wm * 32 + crow(e, h)) * CT_STRIDE + wn * 64 + r] = acc0[e];
      Ct[(wm * 32 + crow(e, h)) * CT_STRIDE + wn * 64 + 32 + r] = acc1[e];
    }
    __syncthreads();
    const int n0 = nt * 128, c4 = (tid & 31) * 4, rr0 = tid >> 5;
#pragma unroll 2
    for (int q = 0; q < 8; q++) {
      const int rl = rr0 + q * 8, row = row0 + mt * 64 + rl;
      const float4 v = *(const float4*)(Ct + rl * CT_STRIDE + c4);
      gemm_store<MODE>(p, layer, row, nt, n0, c4, v, dry);
    }
  }
}

DI int tokrow(int grp, int b, int pos) {
  if (pos < CTX) return NLAT + b * CTX + pos;
  int pp = pos - CTX;
  return b * SEQ + (grp == 0 ? pp : ((pp & 127) * 64 + (pp >> 7)));
}
DI float log_sigmoid(float z) { return fminf(z, 0.f) - __logf(1.f + __expf(-fabsf(z))); }

template <int DK, int DIR>
DI void prep_k(const Params& p, int layer, int grp, int hb, int blk, int cgi) {
  constexpr int CH = DK / 32;
  const int b = hb >> 2, head = hb & 3, k0 = cgi * CH;
  float lb[CH], log_lb[CH], l1m[CH], wg[CH][16], bias[CH], bacc[CH];
#pragma unroll
  for (int c = 0; c < CH; c++) {
    bacc[c] = 0.f; lb[c] = 0.f; log_lb[c] = 0.f; l1m[c] = 0.f; bias[c] = 0.f;
    if (DK == 128) {
      const float* lbp = p.hg_lb + (size_t)DIR * DEPTH * 512 + head * 128 + k0 + c;
      float e0 = lbp[0], e1 = lbp[512], e2 = lbp[1024], e3 = lbp[1536];
      const float mx = fmaxf(fmaxf(e0, e1), fmaxf(e2, e3));
      e0 = __expf(e0 - mx); e1 = __expf(e1 - mx); e2 = __expf(e2 - mx); e3 = __expf(e3 - mx);
      const float inv = 1.f / (e0 + e1 + e2 + e3);
      float cs = 0.f;
      if (layer >= 1) cs += e1 * inv;
      if (layer >= 2) cs += e2 * inv;
      if (layer >= 3) cs += e3 * inv;
      lb[c] = fminf(fmaxf(cs, 0.f), 1.f - 1e-6f);
      log_lb[c] = __logf(fmaxf(lb[c], 1e-30f));
      l1m[c] = __logf(1.f - lb[c]);
    } else {
#pragma unroll
      for (int rr = 0; rr < 16; rr++) wg[c][rr] = p.w_gk2[((size_t)(layer * 2 + DIR) * 16 + rr) * 256 + head * 64 + k0 + c];
      bias[c] = p.b_gk[(size_t)(layer * 2 + DIR) * 256 + head * 64 + k0 + c];
    }
  }
  const size_t chain = (size_t)DIR * 16 + hb;
  const int pk0 = perm16(k0);
  u16* Qd = (u16*)(p.S + (DK == 128 ? OFF_HQ : OFF_GQ)) + (chain * LPOS + (size_t)blk * 32) * DK + pk0;
  u16* Kd = (u16*)(p.S + (DK == 128 ? OFF_HK : OFF_GK)) + (chain * LPOS + (size_t)blk * 32) * DK + pk0;
  u16* KTd = (u16*)(p.S + (DK == 128 ? OFF_HKT : OFF_GKT)) + ((chain * NBLK + blk) * DK + k0) * 32;
#pragma unroll 1
  for (int s2 = 0; s2 < 2; s2++) {
    const int tg = DIR ? 1 - s2 : s2;
    u16 kt[CH][16];
#pragma unroll
    for (int j2 = 0; j2 < 16; j2++) {
      const int t16 = DIR ? 15 - j2 : j2;
      const int t = tg * 16 + t16;
      const u16* urow = p.U + (size_t)tokrow(grp, b, blk * 32 + t) * DIN;
      float qv[CH], kv[CH], la[CH];
      if (DK == 128) {
        const uint2 zz = *(const uint2*)(urow + 512 * (1 + DIR) + head * 128 + k0);
        const uint2 qq = *(const uint2*)(urow + head * 128 + k0);
        const u32 zw[2] = {zz.x, zz.y}, qw[2] = {qq.x, qq.y};
#pragma unroll
        for (int c = 0; c < CH; c++) {
          const float z = (c & 1) ? __uint_as_float(zw[c >> 1] & 0xffff0000u) : __uint_as_float(zw[c >> 1] << 16);
          qv[c] = (c & 1) ? __uint_as_float(qw[c >> 1] & 0xffff0000u) : __uint_as_float(qw[c >> 1] << 16);
          const float ez = __expf(-fabsf(z));
          const float rc = __frcp_rn(1.f + ez);
          const float sp = (z < 0.f) ? ez * rc : rc;
          const float sn = (z < 0.f) ? rc : ez * rc;
          la[c] = __logf(fmaxf(lb[c], 1e-30f) + (1.f - lb[c]) * sp);
          kv[c] = (1.f - lb[c]) * sn;
        }
      } else {
        const u32 qq = *(const u32*)(urow + 2560 + head * 64 + k0);
        const u32 kq = *(const u32*)(urow + 2816 + head * 64 + k0);
        const uint4* gr = (const uint4*)(urow + 4096 + DIR * 16);
        const uint4 g0 = gr[0], g1 = gr[1];
        const u32 gw[8] = {g0.x, g0.y, g0.z, g0.w, g1.x, g1.y, g1.z, g1.w};
#pragma unroll
        for (int c = 0; c < CH; c++) {
          qv[c] = ((c & 1) ? __uint_as_float(qq & 0xffff0000u) : __uint_as_float(qq << 16)) * 0.125f;
          kv[c] = (c & 1) ? __uint_as_float(kq & 0xffff0000u) : __uint_as_float(kq << 16);
          float d = bias[c];
#pragma unroll
          for (int rr = 0; rr < 8; rr++)
            d += __uint_as_float(gw[rr] << 16) * wg[c][2 * rr] + __uint_as_float(gw[rr] & 0xffff0000u) * wg[c][2 * rr + 1];
          la[c] = (fminf(d, 0.f) - __logf(1.f + __expf(-fabsf(d)))) * (1.f / 16.f);
        }
      }
      float qo[CH], ko[CH];
#pragma unroll
      for (int c = 0; c < CH; c++) {
        bacc[c] += la[c];
        const float eb = __expf(bacc[c]);
        qo[c] = qv[c] * eb;
        ko[c] = kv[c] * __expf(-bacc[c]);
        kt[c][perm16(t16)] = f2bf(ko[c]);
      }
      if (CH == 4) {
        *(uint2*)(Qd + (size_t)t * DK) = make_uint2(pack2(qo[0], qo[1]), pack2(qo[2], qo[3]));
        *(uint2*)(Kd + (size_t)t * DK) = make_uint2(pack2(ko[0], ko[1]), pack2(ko[2], ko[3]));
      } else {
        *(u32*)(Qd + (size_t)t * DK) = pack2(qo[0], qo[1]);
        *(u32*)(Kd + (size_t)t * DK) = pack2(ko[0], ko[1]);
      }
    }
#pragma unroll
    for (int c = 0; c < CH; c++) {
      u16* dst = KTd + c * 32 + tg * 16;
#pragma unroll
      for (int q8 = 0; q8 < 2; q8++) {
        uint4 o;
        o.x = (u32)kt[c][q8 * 8 + 0] | ((u32)kt[c][q8 * 8 + 1] << 16); o.y = (u32)kt[c][q8 * 8 + 2] | ((u32)kt[c][q8 * 8 + 3] << 16);
        o.z = (u32)kt[c][q8 * 8 + 4] | ((u32)kt[c][q8 * 8 + 5] << 16); o.w = (u32)kt[c][q8 * 8 + 6] | ((u32)kt[c][q8 * 8 + 7] << 16);
        *(uint4*)(dst + q8 * 8) = o;
      }
    }
  }
  float* Dd = (float*)(p.S + (DK == 128 ? OFF_HD : OFF_GD)) + (chain * NBLK + blk) * DK + k0;
#pragma unroll
  for (int c = 0; c < CH; c++) Dd[c] = __expf(bacc[c]);
}

DI void prep_phase(const Params& p, int layer) {
  const int tid = otid();
  for (int it = obid(); it < 2 * 16 * (NBLK / 4); it += gridDim.x) {
    const int bg = it % (NBLK / 4), hb = (it / (NBLK / 4)) & 15, grp = it / ((NBLK / 4) * 16);
    const int b = hb >> 2, head = hb & 3;
    {
      const int dir = tid >> 7, blk = bg * 4 + ((tid >> 5) & 3), cgi = tid & 31;
      if (grp == 0) {
        if (dir == 0) prep_k<128, 0>(p, layer, 0, hb, blk, cgi);
        else prep_k<128, 1>(p, layer, 0, hb, blk, cgi);
      } else {
        if (dir == 0) prep_k<64, 0>(p, layer, 1, hb, blk, cgi);
        else prep_k<64, 1>(p, layer, 1, hb, blk, cgi);
      }
    }
    {
      const int vg = tid & 31, tg = tid >> 5;
      const int col = (grp == 0 ? 1536 : 3072) + head * 128 + vg * 4;
      const int pos0 = bg * 128 + tg * 16;
      u16 vt[4][16];
#pragma unroll
      for (int t = 0; t < 16; t++) {
        const uint2 vv = *(const uint2*)(p.U + (size_t)tokrow(grp, b, pos0 + t) * DIN + col);
        vt[0][perm16(t)] = (u16)(vv.x & 0xffffu); vt[1][perm16(t)] = (u16)(vv.x >> 16);
        vt[2][perm16(t)] = (u16)(vv.y & 0xffffu); vt[3][perm16(t)] = (u16)(vv.y >> 16);
      }
#pragma unroll
      for (int c = 0; c < 4; c++) {
        u16* dst = (u16*)(p.S + (grp == 0 ? OFF_HVT : OFF_GVT)) + (((size_t)hb * NBLK + (pos0 >> 5)) * 128 + vg * 4 + c) * 32 + (pos0 & 31);
#pragma unroll
        for (int q8 = 0; q8 < 2; q8++) {
          uint4 o;
          o.x = (u32)vt[c][q8 * 8 + 0] | ((u32)vt[c][q8 * 8 + 1] << 16); o.y = (u32)vt[c][q8 * 8 + 2] | ((u32)vt[c][q8 * 8 + 3] << 16);
          o.z = (u32)vt[c][q8 * 8 + 4] | ((u32)vt[c][q8 * 8 + 5] << 16); o.w = (u32)vt[c][q8 * 8 + 6] | ((u32)vt[c][q8 * 8 + 7] << 16);
          *(uint4*)(dst + q8 * 8) = o;
        }
      }
    }
  }
}

template <int DK>
DI void scan_wg(const Params& p, char* smem, int grp, int dir, int hb) {
  constexpr int NT = DK / 32, NF = DK / 16;
  constexpr int QS = DK + 8;
  constexpr int KTS = 40;
  constexpr int OFF_K = 32 * QS * 2, OFF_KT = 2 * 32 * QS * 2, OFF_D = OFF_KT + DK * KTS * 2, BUFB = OFF_D + DK * 4;
  constexpr int QN = DK / 64;
  constexpr int CPR = DK / 8;
  static_assert(2 * BUFB <= LDS_BYTES, "scan LDS");
  const int tid = otid(), vs = tid >> 6, lane = tid & 63, r = lane & 31, h = lane >> 5;
  const int b = hb >> 2, head = hb & 3;
  const size_t chain = (size_t)dir * 16 + hb;
  const u16* Qb = (const u16*)(p.S + (DK == 128 ? OFF_HQ : OFF_GQ)) + chain * LPOS * DK;
  const u16* Kb = (const u16*)(p.S + (DK == 128 ? OFF_HK : OFF_GK)) + chain * LPOS * DK;
  const u16* KTb = (const u16*)(p.S + (DK == 128 ? OFF_HKT : OFF_GKT)) + chain * NBLK * DK * 32;
  const u16* VTb = (const u16*)(p.S + (DK == 128 ? OFF_HVT : OFF_GVT)) + (size_t)hb * NBLK * 128 * 32 + (vs * 32 + r) * 32 + h * 8;
  const float* Db = (const float*)(p.S + (DK == 128 ? OFF_HD : OFF_GD)) + chain * NBLK * DK;
  u16* Ob = p.U + (size_t)dir * NROW * D + grp * 512 + head * 128 + vs * 32;
  f32x16 S[NT];
#pragma unroll
  for (int kt = 0; kt < NT; kt++)
#pragma unroll
    for (int e = 0; e < 16; e++) S[kt][e] = 0.f;
  bf16x8 sq[QN], sk[QN], skt[QN], vn0, vn1;
  float4 sd = make_float4(0.f, 0.f, 0.f, 0.f);
  auto blk_of = [&](int step) { return dir ? (step < 8 ? 7 - step : 271 - step) : step; };
  auto gload = [&](int step) {
    const size_t pos0 = (size_t)blk_of(step) * 32;
#pragma unroll
    for (int i = 0; i < QN; i++) {
      const int id = tid + i * 256;
      sq[i] = *(const bf16x8*)(Qb + (pos0 + id / CPR) * DK + (id % CPR) * 8);
      sk[i] = *(const bf16x8*)(Kb + (pos0 + id / CPR) * DK + (id % CPR) * 8);
      skt[i] = *(const bf16x8*)(KTb + (size_t)blk_of(step) * DK * 32 + id * 8);
    }
    if (tid < DK / 4) sd = *(const float4*)(Db + (size_t)blk_of(step) * DK + tid * 4);
    vn0 = *(const bf16x8*)(VTb + (size_t)blk_of(step) * 128 * 32);
    vn1 = *(const bf16x8*)(VTb + (size_t)blk_of(step) * 128 * 32 + 16);
  };
  auto lstore = [&](int buf) {
    char* base = smem + buf * BUFB;
#pragma unroll
    for (int i = 0; i < QN; i++) {
      const int id = tid + i * 256;
      *(bf16x8*)(base + ((id / CPR) * QS + (id % CPR) * 8) * 2) = sq[i];
      *(bf16x8*)(base + OFF_K + ((id / CPR) * QS + (id % CPR) * 8) * 2) = sk[i];
      *(bf16x8*)(base + OFF_KT + ((id >> 2) * KTS + (id & 3) * 8) * 2) = skt[i];
    }
    if (tid < DK / 4) *(float4*)(base + OFF_D + tid * 16) = sd;
  };
  __syncthreads();
  gload(0);
  lstore(0);
  bf16x8 vf0 = vn0, vf1 = vn1;
  __syncthreads();
#pragma unroll 1
  for (int step = 0; step < NBLK; step++) {
    const int blk = blk_of(step);
    if (step + 1 < NBLK) gload(step + 1);
    const char* base = smem + (step & 1) * BUFB;
    const u16* Qs = (const u16*)base + r * QS + h * 8;
    const u16* Ks = (const u16*)(base + OFF_K) + r * QS + h * 8;
    const u16* KTs = (const u16*)(base + OFF_KT) + r * KTS + h * 8;
    const float* Ds = (const float*)(base + OFF_D) + 4 * h;
    bf16x8 qf[NF];
    f32x16 P0, P1;
#pragma unroll
    for (int e = 0; e < 16; e++) { P0[e] = 0.f; P1[e] = 0.f; }
#pragma unroll
    for (int f = 0; f < NF; f += 2) {
      qf[f] = *(const bf16x8*)(Qs + f * 16);
      qf[f + 1] = *(const bf16x8*)(Qs + f * 16 + 16);
      P0 = MFMA32(*(const bf16x8*)(Ks + f * 16), qf[f], P0);
      P1 = MFMA32(*(const bf16x8*)(Ks + f * 16 + 16), qf[f + 1], P1);
    }
#pragma unroll
    for (int e = 0; e < 16; e++) {
      const int s = crow(e, h);
      const bool keep = dir ? (s >= r) : (s <= r);
      P0[e] = keep ? P0[e] + P1[e] : 0.f;
    }
    f32x16 oA, oB;
#pragma unroll
    for (int e = 0; e < 16; e++) { oA[e] = 0.f; oB[e] = 0.f; }
    oA = MFMA32(vf0, pack_frag(P0, 0), oA);
    oA = MFMA32(vf1, pack_frag(P0, 1), oA);
#pragma unroll
    for (int kt = 0; kt < NT; kt++) {
      if (kt & 1) {
        oA = MFMA32(pack_frag(S[kt], 0), qf[kt * 2], oA);
        oA = MFMA32(pack_frag(S[kt], 1), qf[kt * 2 + 1], oA);
      } else {
        oB = MFMA32(pack_frag(S[kt], 0), qf[kt * 2], oB);
        oB = MFMA32(pack_frag(S[kt], 1), qf[kt * 2 + 1], oB);
      }
    }
#pragma unroll
    for (int kt = 0; kt < NT; kt++) {
      S[kt] = MFMA32(*(const bf16x8*)(KTs + kt * 32 * KTS), vf0, S[kt]);
      S[kt] = MFMA32(*(const bf16x8*)(KTs + kt * 32 * KTS + 16), vf1, S[kt]);
#pragma unroll
      for (int g = 0; g < 4; g++) {
        const float4 dv = *(const float4*)(Ds + kt * 32 + 8 * g);
        S[kt][4 * g + 0] *= dv.x; S[kt][4 * g + 1] *= dv.y; S[kt][4 * g + 2] *= dv.z; S[kt][4 * g + 3] *= dv.w;
      }
    }
    {
      const int pos0 = blk * 32;
      int rbase, rstride;
      if (pos0 < CTX) { rbase = NLAT + b * CTX + pos0; rstride = 1; }
      else if (grp == 0) { rbase = b * SEQ + pos0 - CTX; rstride = 1; }
      else { const int pp = pos0 - CTX; rbase = b * SEQ + (pp & 127) * 64 + (pp >> 7); rstride = 64; }
      u16* orow = Ob + (size_t)(rbase + r * rstride) * D + 4 * h;
#pragma unroll
      for (int g = 0; g < 4; g++)
        *(uint2*)(orow + 8 * g) = make_uint2(pack2(oA[4 * g] + oB[4 * g], oA[4 * g + 1] + oB[4 * g + 1]),
                                             pack2(oA[4 * g + 2] + oB[4 * g + 2], oA[4 * g + 3] + oB[4 * g + 3]));
    }
    if (step + 1 < NBLK) lstore((step + 1) & 1);
    vf0 = vn0; vf1 = vn1;
    __syncthreads();
  }
}

DI void scan_phase(const Params& p, char* smem, int layer) {
  const int bid = obid(), nscan = gridDim.x > 64 ? 64 : gridDim.x;
  if (bid < nscan) {
    for (int w = bid; w < 64; w += nscan) {
      const int grp = w >> 5, dir = (w >> 4) & 1, hb = w & 15;
      if (grp == 0) scan_wg<128>(p, smem, 0, dir, hb);
      else scan_wg<64>(p, smem, 1, dir, hb);
    }
  }
  if (gridDim.x <= 64 || bid >= 64) {
    const int vbid = gridDim.x <= 64 ? bid : bid - 64, vgrid = gridDim.x <= 64 ? gridDim.x : gridDim.x - 64;
    peer_convert(p, layer, vbid, vgrid);
    if (layer + 1 < DEPTH) weight_convert(p, layer + 1, vbid, vgrid);
  }
}

DI void combine_phase(const Params& p, int layer, int nrows) {
  const int wave = otid() >> 6, lane = otid() & 63;
  const int c0 = lane * 16;
  const float* gain = (c0 < 512 ? p.hg_norm : p.gla_norm) + (size_t)layer * 128 + (c0 & 127);
  float gn[16];
#pragma unroll
  for (int j = 0; j < 16; j++) gn[j] = gain[j];
  for (int r = obid() * 4 + wave; r < nrows; r += gridDim.x * 4) {
    const uint4* of = (const uint4*)(p.U + (size_t)r * D + c0);
    const uint4* ob = (const uint4*)(p.U + (size_t)NROW * D + (size_t)r * D + c0);
    const uint4* gg = (const uint4*)(p.G + (size_t)r * D + c0);
    float o[16], g[16];
#pragma unroll
    for (int c = 0; c < 2; c++) {
      uint4 a = of[c], bq = ob[c], gq = gg[c];
      u32 aw[4] = {a.x, a.y, a.z, a.w}, bw[4] = {bq.x, bq.y, bq.z, bq.w}, gw[4] = {gq.x, gq.y, gq.z, gq.w};
#pragma unroll
      for (int j = 0; j < 4; j++) {
        o[c * 8 + 2 * j] = __uint_as_float(aw[j] << 16) + __uint_as_float(bw[j] << 16);
        o[c * 8 + 2 * j + 1] = __uint_as_float(aw[j] & 0xffff0000u) + __uint_as_float(bw[j] & 0xffff0000u);
        g[c * 8 + 2 * j] = __uint_as_float(gw[j] << 16);
        g[c * 8 + 2 * j + 1] = __uint_as_float(gw[j] & 0xffff0000u);
      }
    }
    float ss = 0;
#pragma unroll
    for (int j = 0; j < 16; j++) ss += o[j] * o[j];
    ss += __shfl_xor(ss, 1); ss += __shfl_xor(ss, 2); ss += __shfl_xor(ss, 4);
    float rs = rsqrtf(ss * (1.f / 128.f) + EPS);
    u32 ow[8];
#pragma unroll
    for (int j = 0; j < 8; j++) {
      float g0 = g[2 * j], g1 = g[2 * j + 1];
      float y0 = o[2 * j] * rs * gn[2 * j] * (g0 / (1.f + __expf(-g0)));
      float y1 = o[2 * j + 1] * rs * gn[2 * j + 1] * (g1 / (1.f + __expf(-g1)));
      ow[j] = pack2(y0, y1);
    }
    uint4* dst = (uint4*)(p.H + (size_t)r * D + c0);
    dst[0] = make_uint4(ow[0], ow[1], ow[2], ow[3]);
    dst[1] = make_uint4(ow[4], ow[5], ow[6], ow[7]);
  }
}

template <bool PAY>
DI void ce(u32& a, u32& b, u32& pa, u32& pb) {
  if (!PAY) { u32 hi = a > b ? a : b, lo = a > b ? b : a; a = hi; b = lo; }
  else { bool c = a >= b; u32 hi = c ? a : b, lo = c ? b : a, ph = c ? pa : pb, pl = c ? pb : pa; a = hi; b = lo; pa = ph; pb = pl; }
}
template <bool PAY>
DI void sort16(u32 (&k)[16], u32 (&q)[16]) {
#pragma unroll
  for (int size = 2; size <= 16; size <<= 1) {
#pragma unroll
    for (int stride = size >> 1; stride > 0; stride >>= 1) {
#pragma unroll
      for (int i = 0; i < 16; i++) {
        int j = i ^ stride;
        if (j > i) {
          if ((i & size) == 0) ce<PAY>(k[i], k[j], q[i], q[j]);
          else ce<PAY>(k[j], k[i], q[j], q[i]);
        }
      }
    }
  }
}
template <bool PAY>
DI void merge16(u32 (&R)[16], u32 (&RP)[16], u32 (&N)[16], u32 (&NP)[16]) {
#pragma unroll
  for (int i = 0; i < 16; i++) {
    bool c = N[15 - i] > R[i];
    R[i] = c ? N[15 - i] : R[i];
    if (PAY) RP[i] = c ? NP[15 - i] : RP[i];
  }
#pragma unroll
  for (int stride = 8; stride > 0; stride >>= 1) {
#pragma unroll
    for (int i = 0; i < 16; i++) {
      int j = i ^ stride;
      if (j > i) ce<PAY>(R[i], R[j], RP[i], RP[j]);
    }
  }
}
DI u32 ord_f(float f) { u32 u = __float_as_uint(f); return (u & 0x80000000u) ? ~u : (u | 0x80000000u); }
DI float unord_f(u32 u) { return __uint_as_float((u & 0x80000000u) ? (u ^ 0x80000000u) : ~u); }

DI void topk_phase(const Params& p, int layer, char* smem, int nrows) {
  const int tid = otid(), wave = tid >> 6, lane = tid & 63, r = lane & 31, h = lane >> 5;
  float* sc = (float*)smem + wave * 4096;
  const u16* Q = p.U;
  const u16* keys = p.keysb + (size_t)layer * 2 * 128 * 128;
  int* IDX = (int*)(p.S + OFF_IDX);
  float* GATE = (float*)(p.S + OFF_GATE);
  const int nunits = (nrows / 64) * 8;
  for (int wu = obid() * 4 + wave; wu < nunits; wu += gridDim.x * 4) {
    const int tok0 = (wu >> 3) * 64, head = wu & 7;
    u32 RA[16], RB[16], dummy[16];
#pragma unroll
    for (int i = 0; i < 16; i++) { RA[i] = 0; RB[i] = 0; dummy[i] = 0; }
    auto do_half = [&](const int half, u32 (&R)[16]) {
      bf16x8 qf[2][8];
#pragma unroll
      for (int nt = 0; nt < 2; nt++) {
        const u16* qp = Q + (size_t)(tok0 + nt * 32 + r) * 2048 + head * 256 + half * 128 + h * 8;
#pragma unroll
        for (int f = 0; f < 8; f++) qf[nt][f] = *(const bf16x8*)(qp + f * 16);
      }
      f32x16 acc0, acc1;
      auto mm = [&](const int kr) {
        const u16* kp = keys + ((size_t)half * 128 + kr * 32 + r) * 128 + h * 8;
#pragma unroll
        for (int e = 0; e < 16; e++) { acc0[e] = 0.f; acc1[e] = 0.f; }
#pragma unroll
        for (int f = 0; f < 8; f++) {
          const bf16x8 af = *(const bf16x8*)(kp + f * 16);
          acc0 = MFMA32(af, qf[0][f], acc0);
          acc1 = MFMA32(af, qf[1][f], acc1);
        }
      };
      auto put = [&](const int buf) {
        float* d = sc + buf * 2048;
#pragma unroll
        for (int e = 0; e < 16; e++) {
          d[crow(e, h) * 64 + r] = acc0[e];
          d[crow(e, h) * 64 + 32 + r] = acc1[e];
        }
      };
      mm(0);
      put(0);
#pragma unroll
      for (int kr = 0; kr < 4; kr++) {
        if (kr < 3) mm(kr + 1);
        __builtin_amdgcn_wave_barrier();
        const float* sp = sc + (kr & 1) * 2048 + lane;
#pragma unroll
        for (int grp = 0; grp < 2; grp++) {
          u32 N[16];
#pragma unroll
          for (int i = 0; i < 16; i++) {
            const float v = sp[(grp * 16 + i) * 64];
            N[i] = (ord_f(v) & 0xFFFFFF80u) | (u32)(127 - (kr * 32 + grp * 16 + i));
          }
          sort16<false>(N, dummy);
          merge16<false>(R, dummy, N, dummy);
        }
        __builtin_amdgcn_wave_barrier();
        if (kr < 3) put((kr + 1) & 1);
      }
    };
    do_half(0, RA);
    do_half(1, RB);
    {
      float v1[16], v2[16]; u32 i1[16], i2[16];
#pragma unroll
      for (int i = 0; i < 16; i++) {
        v1[i] = unord_f(RA[i] & 0xFFFFFF80u); i1[i] = 127 - (RA[i] & 127u);
        v2[i] = unord_f(RB[i] & 0xFFFFFF80u); i2[i] = 127 - (RB[i] & 127u);
      }
      u32 TK[16], TP[16], NK[16], NP[16];
#define CAND(slot, a, bq) { NK[slot] = ord_f(v1[a] + v2[bq]); NP[slot] = i1[a] * 128u + i2[bq]; }
#pragma unroll
      for (int bq = 0; bq < 16; bq++) { TK[bq] = ord_f(v1[0] + v2[bq]); TP[bq] = i1[0] * 128u + i2[bq]; }
      sort16<true>(TK, TP);
#pragma unroll
      for (int bq = 0; bq < 8; bq++) CAND(bq, 1, bq)
#pragma unroll
      for (int bq = 0; bq < 5; bq++) CAND(8 + bq, 2, bq)
#pragma unroll
      for (int bq = 0; bq < 3; bq++) CAND(13 + bq, 4, bq)
      sort16<true>(NK, NP); merge16<true>(TK, TP, NK, NP);
#pragma unroll
      for (int bq = 0; bq < 4; bq++) CAND(bq, 3, bq)
      CAND(4, 5, 0) CAND(5, 5, 1) CAND(6, 6, 0) CAND(7, 6, 1) CAND(8, 7, 0) CAND(9, 7, 1)
      CAND(10, 8, 0) CAND(11, 9, 0) CAND(12, 10, 0) CAND(13, 11, 0) CAND(14, 12, 0) CAND(15, 13, 0)
      sort16<true>(NK, NP); merge16<true>(TK, TP, NK, NP);
      CAND(0, 14, 0) CAND(1, 15, 0)
#pragma unroll
      for (int i = 2; i < 16; i++) { NK[i] = 0; NP[i] = 0; }
      sort16<true>(NK, NP); merge16<true>(TK, TP, NK, NP);
#undef CAND
      const float mx = unord_f(TK[0]);
      float ev[16], sum = 0.f;
#pragma unroll
      for (int i = 0; i < 16; i++) { ev[i] = __expf(unord_f(TK[i]) - mx); sum += ev[i]; }
      const float inv = 1.f / sum;
      u16* ip = (u16*)IDX + (size_t)(tok0 + lane) * 128 + head * 16;
      float* gp = GATE + (size_t)(tok0 + lane) * 128 + head * 16;
#pragma unroll
      for (int c = 0; c < 2; c++)
        *(uint4*)(ip + c * 8) = make_uint4(TP[c * 8] | (TP[c * 8 + 1] << 16), TP[c * 8 + 2] | (TP[c * 8 + 3] << 16),
                                           TP[c * 8 + 4] | (TP[c * 8 + 5] << 16), TP[c * 8 + 6] | (TP[c * 8 + 7] << 16));
#pragma unroll
      for (int c = 0; c < 4; c++)
        *(float4*)(gp + c * 4) = make_float4(ev[c * 4] * inv, ev[c * 4 + 1] * inv, ev[c * 4 + 2] * inv, ev[c * 4 + 3] * inv);
    }
  }
}

DI float row16_sum(float v) {
  v += __int_as_float(__builtin_amdgcn_update_dpp(0, __float_as_int(v), 0x128, 0xf, 0xf, false));
  v += __int_as_float(__builtin_amdgcn_update_dpp(0, __float_as_int(v), 0x124, 0xf, 0xf, false));
  v += __int_as_float(__builtin_amdgcn_update_dpp(0, __float_as_int(v), 0x122, 0xf, 0xf, false));
  v += __int_as_float(__builtin_amdgcn_update_dpp(0, __float_as_int(v), 0x121, 0xf, 0xf, false));
  return v;
}
DI float gelu_tanh(float x) {
  float u = 0.7978845608028654f * (x + 0.044715f * x * x * x);
  float e = __expf(2.f * u);
  float th = 1.f - 2.f / (e + 1.f);
  return 0.5f * x * (1.f + th);
}
DI float dot8(uint4 a, uint4 b, float acc) {
  acc = __builtin_amdgcn_fdot2_f32_bf16(__builtin_bit_cast(bf2, a.x), __builtin_bit_cast(bf2, b.x), acc, false);
  acc = __builtin_amdgcn_fdot2_f32_bf16(__builtin_bit_cast(bf2, a.y), __builtin_bit_cast(bf2, b.y), acc, false);
  acc = __builtin_amdgcn_fdot2_f32_bf16(__builtin_bit_cast(bf2, a.z), __builtin_bit_cast(bf2, b.z), acc, false);
  acc = __builtin_amdgcn_fdot2_f32_bf16(__builtin_bit_cast(bf2, a.w), __builtin_bit_cast(bf2, b.w), acc, false);
  return acc;
}

typedef float f2 __attribute__((ext_vector_type(2)));
DI void expert_dots(const Params& p, int nrows, char* smem) {
  const int tid = otid(), wave = tid >> 6, lane = tid & 63, g = lane >> 4, s = lane & 15;
  const int bid = obid(), x = bid & 7, jx = bid >> 3, wpx = (gridDim.x + 7 - x) >> 3;
  u32* list = (u32*)smem + wave * 128;
  const int* IDX = (const int*)(p.S + OFF_IDX);
  const float* GATE = (const float*)(p.S + OFF_GATE);
  u16* AV16 = (u16*)(p.S + OFF_PU);
  const unsigned char* PU = (const unsigned char*)(p.PT + PT_U) + s * 16;
  const float* PSU = (const float*)(p.PT + PT_SC);
  const float* PSV = PSU + 16384;
  const int tstep = wpx * 4;
  int t = jx * 4 + wave;
  int ni0 = 0, ni1 = 0;
  uint4 nh[8];
  auto prefetch = [&](int tt) {
    { const u32 w2 = ((const u32*)IDX)[(size_t)tt * 64 + lane]; ni0 = (int)(w2 & 0xffffu); ni1 = (int)(w2 >> 16); }
#pragma unroll
    for (int c = 0; c < 4; c++) {
      const u16* hp = p.H + (size_t)tt * D + (c * 16 + s) * 16;
      nh[2 * c] = *(const uint4*)(hp); nh[2 * c + 1] = *(const uint4*)(hp + 8);
    }
  };
  auto dot_row = [&](const int4 (&uu)[4], const f2 (&hf)[32]) {
    const int uw[16] = {uu[0].x, uu[0].y, uu[0].z, uu[0].w, uu[1].x, uu[1].y, uu[1].z, uu[1].w,
                        uu[2].x, uu[2].y, uu[2].z, uu[2].w, uu[3].x, uu[3].y, uu[3].z, uu[3].w};
    f2 acc = {0.f, 0.f}, acc2 = {0.f, 0.f};
#pragma unroll
    for (int j = 0; j < 16; j++) {
      acc = __builtin_elementwise_fma(__builtin_amdgcn_cvt_pk_f32_fp8(uw[j], false), hf[2 * j], acc);
      acc2 = __builtin_elementwise_fma(__builtin_amdgcn_cvt_pk_f32_fp8(uw[j], true), hf[2 * j + 1], acc2);
    }
    return row16_sum((acc.x + acc.y) + (acc2.x + acc2.y));
  };
  if (t < nrows) prefetch(t);
  for (; t < nrows; t += tstep) {
    const int i0 = ni0, i1 = ni1;
    f2 hf[32];
#pragma unroll
    for (int c = 0; c < 4; c++) {
      const u32 hw[8] = {nh[2 * c].x, nh[2 * c].y, nh[2 * c].z, nh[2 * c].w, nh[2 * c + 1].x, nh[2 * c + 1].y, nh[2 * c + 1].z, nh[2 * c + 1].w};
#pragma unroll
      for (int j = 0; j < 8; j++) { hf[c * 8 + j].x = __uint_as_float(hw[j] << 16); hf[c * 8 + j].y = __uint_as_float(hw[j] & 0xffff0000u); }
    }
    if (t + tstep < nrows) prefetch(t + tstep);
    const bool b0 = (i0 >> 11) == x, b1 = (i1 >> 11) == x;
    const unsigned long long m0 = __ballot(b0), m1 = __ballot(b1);
    const int n0 = __popcll(m0);
    const int r0 = __builtin_amdgcn_mbcnt_hi((u32)(m0 >> 32), __builtin_amdgcn_mbcnt_lo((u32)m0, 0u));
    const int r1 = n0 + __builtin_amdgcn_mbcnt_hi((u32)(m1 >> 32), __builtin_amdgcn_mbcnt_lo((u32)m1, 0u));
    const int n = n0 + __popcll(m1);
    __builtin_amdgcn_wave_barrier();
    if (b0) list[r0] = ((u32)(2 * lane) << 16) | (u32)i0;
    if (b1) list[r1] = ((u32)(2 * lane + 1) << 16) | (u32)i1;
    __builtin_amdgcn_wave_barrier();
    for (int cb = 0; cb < n; cb += 64) {
      const int nend = min(n, cb + 64);
      float dk = 0.f;
      for (int base = cb; base < nend; base += 8) {
        const int k0 = base + g, k1 = base + 4 + g;
        const u32 ent0 = list[min(k0, n - 1)], ent1 = list[min(k1, n - 1)];
        const unsigned char* ur0 = PU + (size_t)(ent0 & 0xffffu) * D;
        const unsigned char* ur1 = PU + (size_t)(ent1 & 0xffffu) * D;
        int4 ua[4], ub[4];
        ua[0] = *(const int4*)(ur0); ua[1] = *(const int4*)(ur0 + 256); ua[2] = *(const int4*)(ur0 + 512); ua[3] = *(const int4*)(ur0 + 768);
        ub[0] = *(const int4*)(ur1); ub[1] = *(const int4*)(ur1 + 256); ub[2] = *(const int4*)(ur1 + 512); ub[3] = *(const int4*)(ur1 + 768);
        const float d0 = dot_row(ua, hf);
        const float d1 = dot_row(ub, hf);
        const int it0 = (base - cb) >> 2;
        dk = (s == it0) ? d0 : dk;
        dk = (s == it0 + 1) ? d1 : dk;
      }
      const int kk = cb + 4 * s + g;
      if (kk < nend) {
        const u32 ent = list[kk];
        const int e = (int)(ent & 0xffffu), slot = (int)(ent >> 16);
        AV16[(size_t)t * 128 + slot] = f2bf(GATE[(size_t)t * 128 + slot] * PSV[e] * gelu_tanh(dk * PSU[e]));
      }
    }
  }
}

DI void expert_vsum(const Params& p, int nrows) {
  const int tid = otid(), wave = tid >> 6, lane = tid & 63, g = lane >> 3, s = lane & 7;
  const int bid = obid(), x = bid & 7, jx = bid >> 3, wpx = (gridDim.x + 7 - x) >> 3;
  const u16* IDX = (const u16*)(p.S + OFF_IDX) + g * 16;
  const u16* AV = (const u16*)(p.S + OFF_PU) + g * 16;
  const unsigned char* PV = (const unsigned char*)(p.PT + PT_V) + (size_t)x * 16384 * 128 + s * 16;
  u16* Y = (u16*)((char*)p.U + (size_t)NROW * 2048 * 2);
  const int b5 = (lane >> 5) & 1, b4 = (lane >> 4) & 1, b3 = (lane >> 3) & 1;
  const int tstep = wpx * 4;
  int t = jx * 4 + wave;
  uint4 ni[2], na[2];
  auto prefetch = [&](int tt) {
#pragma unroll
    for (int j = 0; j < 2; j++) { ni[j] = *(const uint4*)(IDX + (size_t)tt * 128 + j * 8); na[j] = *(const uint4*)(AV + (size_t)tt * 128 + j * 8); }
  };
  if (t < nrows) prefetch(t);
  for (; t < nrows; t += tstep) {
    const u32 iw[8] = {ni[0].x, ni[0].y, ni[0].z, ni[0].w, ni[1].x, ni[1].y, ni[1].z, ni[1].w};
    const u32 aw[8] = {na[0].x, na[0].y, na[0].z, na[0].w, na[1].x, na[1].y, na[1].z, na[1].w};
    int ee[16]; float aa[16];
#pragma unroll
    for (int j = 0; j < 8; j++) {
      ee[2 * j] = (int)(iw[j] & 0xffffu); ee[2 * j + 1] = (int)(iw[j] >> 16);
      aa[2 * j] = __uint_as_float(aw[j] << 16); aa[2 * j + 1] = __uint_as_float(aw[j] & 0xffff0000u);
    }
    int4 vv[16];
#pragma unroll
    for (int it = 0; it < 16; it++) vv[it] = *(const int4*)(PV + (size_t)ee[it] * 128);
    if (t + tstep < nrows) prefetch(t + tstep);
    f2 y[8];
#pragma unroll
    for (int i = 0; i < 8; i++) { y[i].x = 0.f; y[i].y = 0.f; }
#pragma unroll
    for (int it = 0; it < 16; it++) {
      const f2 a2 = {aa[it], aa[it]};
      const int vw[4] = {vv[it].x, vv[it].y, vv[it].z, vv[it].w};
#pragma unroll
      for (int j = 0; j < 4; j++) {
        y[2 * j] = __builtin_elementwise_fma(__builtin_amdgcn_cvt_pk_f32_fp8(vw[j], false), a2, y[2 * j]);
        y[2 * j + 1] = __builtin_elementwise_fma(__builtin_amdgcn_cvt_pk_f32_fp8(vw[j], true), a2, y[2 * j + 1]);
      }
    }
    f2 k4[4], k2[2], k1;
#pragma unroll
    for (int i = 0; i < 4; i++) {
      const f2 keep = b5 ? y[4 + i] : y[i], send = b5 ? y[i] : y[4 + i];
      k4[i].x = keep.x + __shfl_xor(send.x, 32); k4[i].y = keep.y + __shfl_xor(send.y, 32);
    }
#pragma unroll
    for (int i = 0; i < 2; i++) {
      const f2 keep = b4 ? k4[2 + i] : k4[i], send = b4 ? k4[i] : k4[2 + i];
      k2[i].x = keep.x + __shfl_xor(send.x, 16); k2[i].y = keep.y + __shfl_xor(send.y, 16);
    }
    {
      const f2 keep = b3 ? k2[1] : k2[0], send = b3 ? k2[0] : k2[1];
      k1.x = keep.x + __shfl_xor(send.x, 8); k1.y = keep.y + __shfl_xor(send.y, 8);
    }
    *(u32*)(Y + (size_t)t * D + x * 128 + s * 16 + b5 * 8 + b4 * 4 + b3 * 2) = pack2(k1.x, k1.y);
  }
}

DI void expert_epilogue(const Params& p, int layer, int nrows) {
  const int tid = otid(), wave = tid >> 6, lane = tid & 63, g = lane >> 5, s = lane & 31;
  const bool last = (layer == DEPTH - 1);
  const u16* Y = (const u16*)((const char*)p.U + (size_t)NROW * 2048 * 2);
  for (int tk = obid() * 4 + wave; tk < nrows; tk += gridDim.x * 4) {
    const int b = row_batch(tk);
    const int col = (g * 32 + s) * 16;
    const float* g2 = ada_ptr(p, layer, b, 5) + col;
    const float* gm = p.ln_gamma + (size_t)(layer * 2 + 1) * D + col;
    const float* bt = p.ln_beta + (size_t)(layer * 2 + 1) * D + col;
    float xv[16];
    float sum = 0.f;
    const uint4 yq0 = *(const uint4*)(Y + (size_t)tk * D + col), yq1 = *(const uint4*)(Y + (size_t)tk * D + col + 8);
    const u32 yw[8] = {yq0.x, yq0.y, yq0.z, yq0.w, yq1.x, yq1.y, yq1.z, yq1.w};
#pragma unroll
    for (int j4 = 0; j4 < 4; j4++) {
      const float4 xo = *(const float4*)(p.X + (size_t)tk * D + col + j4 * 4);
      const float4 gg = *(const float4*)(g2 + j4 * 4);
      const float4 yy = make_float4(__uint_as_float(yw[2 * j4] << 16), __uint_as_float(yw[2 * j4] & 0xffff0000u),
                                    __uint_as_float(yw[2 * j4 + 1] << 16), __uint_as_float(yw[2 * j4 + 1] & 0xffff0000u));
      float* o = xv + j4 * 4;
      o[0] = ALPHA * xo.x + gg.x * yy.x; o[1] = ALPHA * xo.y + gg.y * yy.y;
      o[2] = ALPHA * xo.z + gg.z * yy.z; o[3] = ALPHA * xo.w + gg.w * yy.w;
      sum += o[0] + o[1] + o[2] + o[3];
    }
    float mu = wave_sum(sum) * (1.f / D);
    float q = 0.f;
#pragma unroll
    for (int j = 0; j < 16; j++) { xv[j] -= mu; q += xv[j] * xv[j]; }
    float rstd = rsqrtf(wave_sum(q) * (1.f / D) + EPS);
    float* dstx = (last ? p.out : p.X) + (size_t)tk * D + col;
    float s2 = 0.f;
#pragma unroll
    for (int j4 = 0; j4 < 4; j4++) {
      const float4 gmv = *(const float4*)(gm + j4 * 4);
      const float4 btv = *(const float4*)(bt + j4 * 4);
      float* o = xv + j4 * 4;
      o[0] = o[0] * rstd * gmv.x + btv.x; o[1] = o[1] * rstd * gmv.y + btv.y;
      o[2] = o[2] * rstd * gmv.z + btv.z; o[3] = o[3] * rstd * gmv.w + btv.w;
      s2 += o[0] + o[1] + o[2] + o[3];
      *(float4*)(dstx + j4 * 4) = make_float4(o[0], o[1], o[2], o[3]);
    }
    if (!last) {
      float mu2 = wave_sum(s2) * (1.f / D);
      float q2 = 0.f;
#pragma unroll
      for (int j = 0; j < 16; j++) { xv[j] -= mu2; q2 += xv[j] * xv[j]; }
      float rstd2 = rsqrtf(wave_sum(q2) * (1.f / D) + EPS);
      const float* sh = ada_ptr(p, layer + 1, b, 0) + col;
      const float* sc = ada_ptr(p, layer + 1, b, 1) + col;
      u32 ow[8];
#pragma unroll
      for (int j = 0; j < 8; j++) {
        float y0 = xv[2 * j] * rstd2 * (1.f + sc[2 * j]) + sh[2 * j];
        float y1 = xv[2 * j + 1] * rstd2 * (1.f + sc[2 * j + 1]) + sh[2 * j + 1];
        ow[j] = pack2(y0, y1);
      }
      *(uint4*)(p.H + (size_t)tk * D + col) = make_uint4(ow[0], ow[1], ow[2], ow[3]);
      *(uint4*)(p.H + (size_t)tk * D + col + 8) = make_uint4(ow[4], ow[5], ow[6], ow[7]);
    }
  }
}

#define XB_TMO      128
#define XB_XCNT(j)  (256  + 64 * (j))
#define XB_XSUB(j)  (1280 + 64 * (j))
#define XB_XGEN(j)  (2304 + 64 * (j))
#define XB_TOP      3328
#define XB_TOPGEN   3392
#define XCD_BAR_WORDS 3456
#define XB_SPIN_CAP (1u << 18)
#define LAS __attribute__((address_space(3)))

__device__ __forceinline__ unsigned xb_ld(unsigned* p)              { return __hip_atomic_load(p, __ATOMIC_RELAXED, __HIP_MEMORY_SCOPE_AGENT); }
__device__ __forceinline__ unsigned xb_add(unsigned* p, unsigned v) { return __hip_atomic_fetch_add(p, v, __ATOMIC_RELAXED, __HIP_MEMORY_SCOPE_AGENT); }
__device__ __forceinline__ unsigned xb_xcc_id() { return (unsigned)__builtin_amdgcn_s_getreg((3 << 11) | 20) & 0xFu; }
#define XB_SPIN(cond, bar) do { unsigned _sp = 0; while (cond) { __builtin_amdgcn_s_sleep(1); \
    if ((++_sp & 255u) == 0u) { if (xb_ld(&(bar)[XB_TMO])) break; if (_sp > XB_SPIN_CAP) { atomicAdd(&(bar)[XB_TMO], 1u); break; } } } } while (0)

struct XcdBarrier {
    unsigned* bar; unsigned x;
    volatile LAS unsigned* st;
};

__device__ __forceinline__ XcdBarrier xcd_barrier_post(unsigned* bar, volatile LAS unsigned* st) {
    XcdBarrier b; b.bar = bar; b.x = xb_xcc_id(); b.st = st;
    if (threadIdx.x == 0) (void)xb_add(&bar[XB_XCNT(b.x)], 1u);
    return b;
}
__device__ __forceinline__ void xcd_barrier_complete(unsigned* bar, unsigned x, unsigned& nloc, unsigned& nx) {
    const unsigned G = gridDim.x * gridDim.y * gridDim.z;
    unsigned sum, cnt, mine, sp = 0u;
    for (;;) {
        sum = 0u; cnt = 0u; mine = 0u;
#pragma unroll
        for (unsigned j = 0; j < 16; ++j) { const unsigned c = xb_ld(&bar[XB_XCNT(j)]); sum += c; cnt += (c > 0u) ? 1u : 0u; mine = (j == x) ? c : mine; }
        if (sum == G) break;
        __builtin_amdgcn_s_sleep(1);
        if ((++sp & 255u) == 0u) { if (xb_ld(&bar[XB_TMO])) break; if (sp > XB_SPIN_CAP) { atomicAdd(&bar[XB_TMO], 1u); break; } }
    }
    nloc = mine > 0u ? mine : 1u; nx = cnt > 0u ? cnt : 1u;
}

__device__ __forceinline__ void xcd_barrier(const XcdBarrier& b) {
    asm volatile("s_waitcnt vmcnt(0)" ::: "memory");
    __syncthreads();
    if (threadIdx.x == 0) {
        unsigned* bar = b.bar;
        __builtin_amdgcn_s_waitcnt(0);
        unsigned nloc = b.st[0], nx = b.st[1];
        if (nloc == 0u) { xcd_barrier_complete(bar, b.x, nloc, nx); b.st[0] = nloc; b.st[1] = nx; }
        const unsigned old = xb_add(&bar[XB_XSUB(b.x)], 1u);
        const unsigned gen = old / nloc;
        if (old + 1u == (gen + 1u) * nloc) {
            __builtin_amdgcn_fence(__ATOMIC_RELEASE, "agent");
            asm volatile("s_waitcnt vmcnt(0)" ::: "memory");
            const unsigned og = xb_add(&bar[XB_TOP], 1u);
            const unsigned tg = og / nx;
            if (og + 1u == (tg + 1u) * nx) xb_add(&bar[XB_TOPGEN], 1u);
            else XB_SPIN(xb_ld(&bar[XB_TOPGEN]) == tg, bar);
            __builtin_amdgcn_fence(__ATOMIC_ACQUIRE, "agent");
            xb_add(&bar[XB_XGEN(b.x)], 1u);
            asm volatile("s_waitcnt vmcnt(0)" ::: "memory");
        } else {
            XB_SPIN(xb_ld(&bar[XB_XGEN(b.x)]) == gen, bar);
            __builtin_amdgcn_fence(__ATOMIC_ACQUIRE, "agent");
            asm volatile("s_waitcnt vmcnt(0)" ::: "memory");
        }
    }
    __syncthreads();
}


DI void grid_barrier(unsigned* ctr, unsigned& target) {
  asm volatile("s_waitcnt vmcnt(0)" ::: "memory");
  __syncthreads();
  if (threadIdx.x == 0) {
    target += gridDim.x;
    __builtin_amdgcn_fence(__ATOMIC_RELEASE, "agent");
    asm volatile("s_waitcnt vmcnt(0)" ::: "memory");
    __hip_atomic_fetch_add(ctr, 1u, __ATOMIC_RELAXED, __HIP_MEMORY_SCOPE_AGENT);
    while (__hip_atomic_load(ctr, __ATOMIC_RELAXED, __HIP_MEMORY_SCOPE_AGENT) < target) __builtin_amdgcn_s_sleep(1);
    __builtin_amdgcn_fence(__ATOMIC_ACQUIRE, "agent");
    asm volatile("s_waitcnt vmcnt(0)" ::: "memory");
  }
  __syncthreads();
}

__global__ void __launch_bounds__(256, 2) mk_forward(Params p) {
  __shared__ __attribute__((aligned(16))) char smem[LDS_BYTES];
  cg::grid_group grid = cg::this_grid();
  int pc = 0;
#define GSYNC() xcd_barrier(xb)
#define PHASE(body) PHASER(15, body)
#define PHASER(kind, body)                              \
  {                                                     \
    if (pc >= p.ph_lo && pc < p.ph_hi) {                \
      if ((REPMASK >> (kind)) & 1) { const bool dry = true; (void)dry; body; GSYNC(); } \
      { const bool dry = false; (void)dry; body; }      \
      if (pc + 1 < p.ph_hi) GSYNC();                    \
    }                                                   \
    pc++;                                               \
  }
  __shared__ __attribute__((aligned(16))) unsigned xb_words[4];
  if (threadIdx.x == 0) { xb_words[0] = 0u; xb_words[1] = 0u; xb_words[2] = 0u; xb_words[3] = 0u; }
  __syncthreads();
  const XcdBarrier xb = xcd_barrier_post(p.bar, (volatile LAS unsigned*)xb_words);
  if (0 >= p.ph_lo && 0 < p.ph_hi) {
    phase0(p, (float*)smem);
    if (1 < p.ph_hi) grid.sync();
  }
  pc++;
  PHASE(phase0b(p))
  PHASE(lnmod_phase<0>(p, 0, NROW))
  for (int layer = 0; layer < DEPTH; layer++) {
    const bool last = (layer == DEPTH - 1);
    const int nrows = last ? NLAT : NROW;
    PHASER(0, gemm_phase<0>(p, layer, smem, p.H, p.wt_in + (size_t)layer * DINP * D, NROW / 256, DINP / 128, dry))
    PHASER(1, prep_phase(p, layer))
    PHASER(2, scan_phase(p, smem, layer))
    PHASER(3, combine_phase(p, layer, nrows))
    PHASER(4, { gemm_phase<1>(p, layer, smem, p.H, p.wt_out + (size_t)layer * D * D, NLAT / 256, 8, dry);
                 if (nrows > NLAT) gemm_thin<1>(p, layer, smem, p.H, p.wt_out + (size_t)layer * D * D, NLAT, NCTX / 64, 8, dry); })
    PHASER(5, lnmod_phase<1>(p, layer, nrows))
    PHASER(6, { gemm_phase<2>(p, layer, smem, p.H, p.wt_q + (size_t)layer * 2048 * D, NLAT / 256, 16, dry);
                 if (nrows > NLAT) gemm_thin<2>(p, layer, smem, p.H, p.wt_q + (size_t)layer * 2048 * D, NLAT, NCTX / 64, 16, dry); })
    PHASER(7, topk_phase(p, layer, smem, nrows))
    PHASER(8, expert_dots(p, nrows, smem))
    PHASER(9, expert_vsum(p, nrows))
    PHASER(10, expert_epilogue(p, layer, nrows))
  }
#undef PHASE
#undef PHASER
}
constexpr int NPHASES = 3 + 11 * DEPTH;

extern "C" void kernel_launch(void* const* d_in, const int* in_sizes, int n_in, void* d_out, int out_size, void* d_ws,
                              size_t ws_size, hipStream_t stream) {
  Params p{};
  p.x = (const float*)d_in[0]; p.c = (const float*)d_in[1]; p.ctx = (const float*)d_in[2]; p.c_ctx = (const float*)d_in[3];
  p.w_ada = (const float*)d_in[4]; p.b_ada = (const float*)d_in[5]; p.w_in = (const float*)d_in[6];
  p.w_gk2 = (const float*)d_in[7]; p.b_gk = (const float*)d_in[8]; p.hg_lb = (const float*)d_in[9];
  p.hg_norm = (const float*)d_in[10]; p.gla_norm = (const float*)d_in[11]; p.w_out = (const float*)d_in[12];
  p.ln_gamma = (const float*)d_in[13]; p.ln_beta = (const float*)d_in[14]; p.wq = (const float*)d_in[15];
  p.sub_keys = (const float*)d_in[16]; p.peer_u = (const float*)d_in[17]; p.peer_v = (const float*)d_in[18];
  p.out = (float*)d_out;
  char* w = (char*)d_ws;
  size_t off = 0;
  auto take = [&](size_t bytes) { char* q = w + off; off += (bytes + 255) & ~(size_t)255; return q; };
  p.wt_in = (u16*)take((size_t)4 * DINP * D * 2);
  p.wt_out = (u16*)take((size_t)4 * D * D * 2);
  p.wt_q = (u16*)take((size_t)4 * 2048 * D * 2);
  p.keysb = (u16*)take((size_t)4 * 2 * 128 * 128 * 2);
  p.ada_part = (float*)take((size_t)8 * 4 * 5 * 6144 * 4);
  p.ada = (float*)take((size_t)4 * 5 * 6144 * 4);
  p.X = (float*)take((size_t)NROW * D * 4);
  p.H = (u16*)take((size_t)NROW * D * 2);
  p.G = (u16*)take((size_t)NROW * D * 2);
  p.U = (u16*)take((size_t)NROW * DIN * 2);
  p.S = take(SZ_S);
  p.PT = take(SZ_PT);
  p.bar = (unsigned*)take(XCD_BAR_WORDS * 4);
  if (off > ws_size) { fprintf(stderr, "workspace too small: need %zu have %zu\n", off, ws_size); return; }

  static int grid_blocks = 0;
  if (!grid_blocks) {
    int dev = 0, cus = 0, per_cu = 0;
    hipGetDevice(&dev);
    hipDeviceGetAttribute(&cus, hipDeviceAttributeMultiprocessorCount, dev);
    hipOccupancyMaxActiveBlocksPerMultiprocessor(&per_cu, mk_forward, 256, 0);
    if (per_cu > 2) per_cu = 2;
    grid_blocks = cus * per_cu;
  }
#if ONE_LAUNCH
  hipMemsetAsync(p.bar, 0, XCD_BAR_WORDS * 4, stream);
  p.ph_lo = 0; p.ph_hi = NPHASES;
  void* args[] = {&p};
  hipError_t e = hipLaunchCooperativeKernel((void*)mk_forward, dim3(grid_blocks), dim3(256), args, 0, stream);
  if (e != hipSuccess) fprintf(stderr, "cooperative launch failed: %s (grid %d)\n", hipGetErrorString(e), grid_blocks);
#else
  for (int ph = 0; ph < NPHASES; ph++) {
    p.ph_lo = ph; p.ph_hi = ph + 1;
    hipLaunchKernelGGL(mk_forward, dim3(grid_blocks), dim3(256), 0, stream, p);
  }
#endif
}
```

```cpp
#include <hip/hip_runtime.h>
#include <hip/hip_cooperative_groups.h>
#include <cstdio>
namespace cg = cooperative_groups;

#define DI __device__ __forceinline__
typedef unsigned short u16;
typedef unsigned int u32;
typedef __attribute__((ext_vector_type(8))) short bf16x8;
typedef __attribute__((ext_vector_type(16))) float f32x16;
typedef __attribute__((ext_vector_type(2))) __bf16 bf2;

#ifndef REPMASK
#define REPMASK 0
#endif
#ifndef DRYVAR
#define DRYVAR 0
#endif
#ifndef ONE_LAUNCH
#define ONE_LAUNCH 1
#endif

constexpr int D = 1024, NB = 4, SEQ = 8192, DEPTH = 4, CTX = 256;
constexpr int NLAT = NB * SEQ;
constexpr int NCTX = NB * CTX;
constexpr int NROW = NLAT + NCTX;
constexpr int DIN = 4128, DINP = 4224;
constexpr int LPOS = CTX + SEQ;
constexpr int NBLK = LPOS / 32;
constexpr float ALPHA = 1.681792830507429f;
constexpr float EPS = 1e-6f;
constexpr int LDS_BYTES = 73728;

struct Params {
  const float *x, *c, *ctx, *c_ctx, *w_ada, *b_ada, *w_in, *w_gk2, *b_gk, *hg_lb, *hg_norm, *gla_norm,
      *w_out, *ln_gamma, *ln_beta, *wq, *sub_keys, *peer_u, *peer_v;
  float* out;
  u16 *wt_in, *wt_out, *wt_q, *keysb;
  float *ada_part, *ada;
  float* X;
  u16 *H, *G, *U;
  char* S;
  char* PT;
  unsigned* bar;
  int ph_lo, ph_hi;
};

constexpr size_t SZ_HQ = (size_t)2 * 16 * LPOS * 128 * 2;
constexpr size_t SZ_HVT = (size_t)16 * 128 * LPOS * 2;
constexpr size_t SZ_HD = (size_t)2 * 16 * NBLK * 128 * 4;
constexpr size_t SZ_GQ = (size_t)2 * 16 * LPOS * 64 * 2;
constexpr size_t SZ_GD = (size_t)2 * 16 * NBLK * 64 * 4;
constexpr size_t OFF_HQ = 0, OFF_HK = OFF_HQ + SZ_HQ, OFF_HKT = OFF_HK + SZ_HQ, OFF_HVT = OFF_HKT + SZ_HQ,
                 OFF_HD = OFF_HVT + SZ_HVT, OFF_GQ = OFF_HD + SZ_HD, OFF_GK = OFF_GQ + SZ_GQ, OFF_GKT = OFF_GK + SZ_GQ,
                 OFF_GVT = OFF_GKT + SZ_GQ, OFF_GD = OFF_GVT + SZ_HVT, SZ_S = OFF_GD + SZ_GD;
constexpr size_t OFF_XP = 0, SZ_XP = (size_t)NROW * D * 4;
constexpr size_t OFF_IDX = OFF_XP + SZ_XP, SZ_IDX = (size_t)NROW * 128 * 4;
constexpr size_t OFF_GATE = OFF_IDX + SZ_IDX;
constexpr size_t OFF_PU = OFF_GATE + SZ_IDX, SZ_PU = (size_t)16384 * D * 2;
constexpr size_t OFF_PV = OFF_PU + SZ_PU;
constexpr size_t OFF_PSC = OFF_PV + SZ_PU;
static_assert(OFF_PSC + 2 * 16384 * 4 <= SZ_S, "alias overflow");
constexpr size_t PT_U = 0, PT_V = (size_t)16384 * D, PT_SC = 2 * (size_t)16384 * D, SZ_PT = PT_SC + 2 * 16384 * 4;

DI int otid() { int t = threadIdx.x; asm volatile("" : "+v"(t)); return t; }
DI int obid() { int t = blockIdx.x; asm volatile("" : "+s"(t)); return t; }
DI float bf2f(u16 h) { return __uint_as_float(((u32)h) << 16); }
DI u16 f2bf(float x) { return __builtin_bit_cast(u16, (__bf16)x); }
typedef __attribute__((ext_vector_type(2))) float f32x2v;
typedef __attribute__((ext_vector_type(2))) __bf16 bf16x2v;
DI u32 pack2(float a, float b) { f32x2v v = {a, b}; return __builtin_bit_cast(u32, __builtin_convertvector(v, bf16x2v)); }
DI float wave_sum(float v) {
#pragma unroll
  for (int o = 32; o > 0; o >>= 1) v += __shfl_xor(v, o);
  return v;
}
DI int crow(int i, int h) { return (i & 3) + 8 * (i >> 2) + 4 * h; }
DI int perm16(int k) {
  int kk = k & 15;
  return (k & ~15) | (((kk >> 2) & 1) << 3) | ((kk >> 3) << 2) | (kk & 3);
}
DI bf16x8 pack_frag(const f32x16& x, int s) {
  union { bf16x8 v; u32 u[4]; } r;
#pragma unroll
  for (int j = 0; j < 4; j++) r.u[j] = pack2(x[8 * s + 2 * j], x[8 * s + 2 * j + 1]);
  return r.v;
}
#define MFMA32(a, b, c) __builtin_amdgcn_mfma_f32_32x32x16_bf16((a), (b), (c), 0, 0, 0)

DI const float* ada_ptr(const Params& p, int layer, int r, int j) { return p.ada + ((size_t)(layer * 5 + r) * 6 + j) * D; }
DI int row_batch(int r) { return r < NLAT ? (r >> 13) : 4; }

DI void weight_convert(const Params& p, int l, int vbid, int vgrid) {
  const size_t gtid = (size_t)vbid * 256 + otid(), gsz = (size_t)vgrid * 256;
  for (size_t i = gtid; i < (size_t)128 * DINP; i += gsz) {
    int n = i % DINP; int k8 = i / DINP;
    u32 o[4] = {0, 0, 0, 0};
    if (n < DIN) {
      const float* s = p.w_in + ((size_t)l * D + k8 * 8) * DIN + n;
#pragma unroll
      for (int j = 0; j < 4; j++) o[j] = pack2(s[(size_t)(2 * j) * DIN], s[(size_t)(2 * j + 1) * DIN]);
    }
    *(uint4*)(p.wt_in + ((size_t)l * DINP + n) * D + k8 * 8) = make_uint4(o[0], o[1], o[2], o[3]);
  }
  for (size_t i = gtid; i < (size_t)128 * 1024; i += gsz) {
    int n = i & 1023; int k8 = i >> 10;
    const float* s = p.w_out + ((size_t)l * D + k8 * 8) * D + n;
    u32 o[4];
#pragma unroll
    for (int j = 0; j < 4; j++) o[j] = pack2(s[(size_t)(2 * j) * D], s[(size_t)(2 * j + 1) * D]);
    *(uint4*)(p.wt_out + ((size_t)l * D + n) * D + k8 * 8) = make_uint4(o[0], o[1], o[2], o[3]);
  }
  for (size_t i = gtid; i < (size_t)128 * 2048; i += gsz) {
    int n = i & 2047; int k8 = i >> 11;
    const float* s = p.wq + ((size_t)l * D + k8 * 8) * 2048 + n;
    u32 o[4];
#pragma unroll
    for (int j = 0; j < 4; j++) o[j] = pack2(s[(size_t)(2 * j) * 2048], s[(size_t)(2 * j + 1) * 2048]);
    *(uint4*)(p.wt_q + ((size_t)l * 2048 + n) * D + k8 * 8) = make_uint4(o[0], o[1], o[2], o[3]);
  }
}

DI void phase0(const Params& p, float* lds) {
  for (int it = obid(); it < 768; it += gridDim.x) {
    int kp = it & 7, nb = (it >> 3) % 24, l = it / 192;
    __syncthreads();
    for (int i = otid(); i < 640; i += 256) {
      int r = i >> 7, k = i & 127;
      float v = (r < 4) ? p.c[r * D + kp * 128 + k] : p.c_ctx[kp * 128 + k];
      lds[i] = v / (1.f + __expf(-v));
    }
    __syncthreads();
    int n = nb * 256 + otid();
    const float* w = p.w_ada + ((size_t)l * D + kp * 128) * 6144 + n;
    float a0 = 0, a1 = 0, a2 = 0, a3 = 0, a4 = 0;
#pragma unroll 8
    for (int k = 0; k < 128; k++) {
      float wv = w[(size_t)k * 6144];
      a0 += lds[k] * wv; a1 += lds[128 + k] * wv; a2 += lds[256 + k] * wv; a3 += lds[384 + k] * wv; a4 += lds[512 + k] * wv;
    }
    float* o = p.ada_part + ((size_t)(kp * 4 + l) * 5) * 6144 + n;
    o[0] = a0; o[6144] = a1; o[2 * 6144] = a2; o[3 * 6144] = a3; o[4 * 6144] = a4;
  }
  weight_convert(p, 0, obid(), gridDim.x);
  const size_t gtid = (size_t)obid() * 256 + otid(), gsz = (size_t)gridDim.x * 256;
  for (size_t i = gtid; i < (size_t)4 * 2 * 128 * 128; i += gsz) p.keysb[i] = f2bf(p.sub_keys[i]);
}

DI void phase0b(const Params& p) {
  const size_t gtid = (size_t)obid() * 256 + otid(), gsz = (size_t)gridDim.x * 256;
  for (size_t i = gtid; i < (size_t)4 * 5 * 6144; i += gsz) {
    int n = i % 6144; int l = i / (5 * 6144);
    float a = p.b_ada[l * 6144 + n];
#pragma unroll
    for (int kp = 0; kp < 8; kp++) a += p.ada_part[(size_t)kp * 4 * 5 * 6144 + i];
    p.ada[i] = a;
  }
}

DI void peer_convert(const Params& p, int layer, int vbid, int vgrid) {
  const int tid = otid(), wave = tid >> 6, lane = tid & 63;
  unsigned char* du = (unsigned char*)(p.PT + PT_U);
  unsigned char* dv = (unsigned char*)(p.PT + PT_V);
  float* su = (float*)(p.PT + PT_SC);
  for (int it = vbid * 4 + wave; it < 2 * 16384; it += vgrid * 4) {
    const int tbl = it >> 14, e = it & 16383;
    const float* src = (tbl ? p.peer_v : p.peer_u) + ((size_t)layer * 16384 + e) * D + lane * 16;
    float4 a = *(const float4*)(src), b = *(const float4*)(src + 4), c = *(const float4*)(src + 8), d = *(const float4*)(src + 12);
    float m = fmaxf(fmaxf(fmaxf(fabsf(a.x), fabsf(a.y)), fmaxf(fabsf(a.z), fabsf(a.w))), fmaxf(fmaxf(fabsf(b.x), fabsf(b.y)), fmaxf(fabsf(b.z), fabsf(b.w))));
    m = fmaxf(m, fmaxf(fmaxf(fmaxf(fabsf(c.x), fabsf(c.y)), fmaxf(fabsf(c.z), fabsf(c.w))), fmaxf(fmaxf(fabsf(d.x), fabsf(d.y)), fmaxf(fabsf(d.z), fabsf(d.w)))));
#pragma unroll
    for (int o = 32; o > 0; o >>= 1) m = fmaxf(m, __shfl_xor(m, o));
    m = fmaxf(m, 1e-30f);
    const float sc = 224.f / m;
    int w0 = __builtin_amdgcn_cvt_pk_fp8_f32(a.x * sc, a.y * sc, 0, false); w0 = __builtin_amdgcn_cvt_pk_fp8_f32(a.z * sc, a.w * sc, w0, true);
    int w1 = __builtin_amdgcn_cvt_pk_fp8_f32(b.x * sc, b.y * sc, 0, false); w1 = __builtin_amdgcn_cvt_pk_fp8_f32(b.z * sc, b.w * sc, w1, true);
    int w2 = __builtin_amdgcn_cvt_pk_fp8_f32(c.x * sc, c.y * sc, 0, false); w2 = __builtin_amdgcn_cvt_pk_fp8_f32(c.z * sc, c.w * sc, w2, true);
    int w3 = __builtin_amdgcn_cvt_pk_fp8_f32(d.x * sc, d.y * sc, 0, false); w3 = __builtin_amdgcn_cvt_pk_fp8_f32(d.z * sc, d.w * sc, w3, true);
    if (tbl == 0) *(int4*)(du + (size_t)e * D + lane * 16) = make_int4(w0, w1, w2, w3);
    else *(int4*)(dv + ((size_t)(lane >> 3) * 16384 + e) * 128 + (lane & 7) * 16) = make_int4(w0, w1, w2, w3);
    if (lane == 0) su[it] = m * (1.f / 224.f);
  }
}

template <int MODE>
DI void lnmod_phase(const Params& p, int layer, int nrows) {
  const int wave = otid() >> 6, lane = otid() & 63;
  const float* XP = (const float*)(p.S + OFF_XP);
  for (int r = obid() * 4 + wave; r < nrows; r += gridDim.x * 4) {
    const float* src;
    if (MODE == 0) src = (r < NLAT) ? p.x + (size_t)r * D : p.ctx + (size_t)(r - NLAT) * D;
    else src = XP + (size_t)r * D;
    const int b = row_batch(r);
    float4 v[4];
#pragma unroll
    for (int c = 0; c < 4; c++) v[c] = *(const float4*)(src + c * 256 + lane * 4);
    float s = 0;
#pragma unroll
    for (int c = 0; c < 4; c++) s += v[c].x + v[c].y + v[c].z + v[c].w;
    float mu = wave_sum(s) * (1.f / D);
    float q = 0;
#pragma unroll
    for (int c = 0; c < 4; c++) {
      v[c].x -= mu; v[c].y -= mu; v[c].z -= mu; v[c].w -= mu;
      q += v[c].x * v[c].x + v[c].y * v[c].y + v[c].z * v[c].z + v[c].w * v[c].w;
    }
    float rstd = rsqrtf(wave_sum(q) * (1.f / D) + EPS);
    if (MODE == 1) {
      const float* gm = p.ln_gamma + (size_t)(layer * 2 + 0) * D;
      const float* bt = p.ln_beta + (size_t)(layer * 2 + 0) * D;
      float s2 = 0;
#pragma unroll
      for (int c = 0; c < 4; c++) {
        int col = c * 256 + lane * 4;
        float4 g = *(const float4*)(gm + col), be = *(const float4*)(bt + col);
        v[c].x = v[c].x * rstd * g.x + be.x; v[c].y = v[c].y * rstd * g.y + be.y;
        v[c].z = v[c].z * rstd * g.z + be.z; v[c].w = v[c].w * rstd * g.w + be.w;
        s2 += v[c].x + v[c].y + v[c].z + v[c].w;
      }
      float mu2 = wave_sum(s2) * (1.f / D);
      float q2 = 0;
#pragma unroll
      for (int c = 0; c < 4; c++) {
        v[c].x -= mu2; v[c].y -= mu2; v[c].z -= mu2; v[c].w -= mu2;
        q2 += v[c].x * v[c].x + v[c].y * v[c].y + v[c].z * v[c].z + v[c].w * v[c].w;
      }
      rstd = rsqrtf(wave_sum(q2) * (1.f / D) + EPS);
    }
    const float* sh = ada_ptr(p, layer, b, MODE == 0 ? 0 : 3);
    const float* sc = ada_ptr(p, layer, b, MODE == 0 ? 1 : 4);
#pragma unroll
    for (int c = 0; c < 4; c++) {
      int col = c * 256 + lane * 4;
      float4 a = *(const float4*)(sh + col), m = *(const float4*)(sc + col);
      float y0 = v[c].x * rstd * (1.f + m.x) + a.x, y1 = v[c].y * rstd * (1.f + m.y) + a.y;
      float y2 = v[c].z * rstd * (1.f + m.z) + a.z, y3 = v[c].w * rstd * (1.f + m.w) + a.w;
      *(uint2*)(p.H + (size_t)r * D + col) = make_uint2(pack2(y0, y1), pack2(y2, y3));
    }
  }
}

constexpr int LDS_STRIDE = 72;
constexpr int CT_STRIDE = 132;
template <int MODE>
DI void gemm_store(const Params& p, int layer, int row, int nt, int n0, int c4, const float4 v, const bool dry) {
  if (MODE == 0) {
          u16* dst;
          if (nt >= 16 && nt < 20) dst = p.G + (size_t)row * D + (n0 - 2048) + c4;
          else if (nt >= 28 && nt < 32) dst = p.G + (size_t)row * D + (n0 - 3584 + 512) + c4;
          else dst = p.U + (size_t)row * DIN + n0 + c4;
          if (dry) dst = (u16*)p.S + (size_t)row * DIN + n0 + c4;
          if (n0 + c4 < DIN) *(uint2*)dst = make_uint2(pack2(v.x, v.y), pack2(v.z, v.w));
        } else if (MODE == 1) {
          float* XP = dry ? (float*)p.U : (float*)(p.S + OFF_XP);
          const float* xo = (layer == 0) ? ((row < NLAT) ? p.x + (size_t)row * D : p.ctx + (size_t)(row - NLAT) * D) : p.X + (size_t)row * D;
          const float4 xv = *(const float4*)(xo + n0 + c4);
          const float4 g1 = *(const float4*)(ada_ptr(p, layer, row_batch(row), 2) + n0 + c4);
          *(float4*)(XP + (size_t)row * D + n0 + c4) =
              make_float4(ALPHA * xv.x + g1.x * v.x, ALPHA * xv.y + g1.y * v.y, ALPHA * xv.z + g1.z * v.z, ALPHA * xv.w + g1.w * v.w);
        } else {
          *(uint2*)((dry ? (u16*)(p.S + OFF_PU) : p.U) + (size_t)row * 2048 + n0 + c4) = make_uint2(pack2(v.x, v.y), pack2(v.z, v.w));
        }
}

template <int MODE>
DI void gemm_phase(const Params& p, int layer, char* smem, const u16* A, const u16* Bt, int Mtiles, int Ntiles, const bool dry) {
  u16* As = (u16*)smem;
  u16* Bs = (u16*)smem + 256 * LDS_STRIDE;
  float* Ct = (float*)smem;
  const int tid = otid(), wave = tid >> 6, lane = tid & 63, r = lane & 31, h = lane >> 5;
  const int wm = wave >> 1, wn = wave & 1;
  const int srow = tid >> 3, sc8 = (tid & 7) * 8;
  const int bid = obid(), xcd = bid & 7, jx = bid >> 3, wpx = (gridDim.x + 7 - xcd) >> 3;
  const int ntiles = Mtiles * Ntiles, nchunks = (ntiles + 63) >> 6;
  for (int ch = xcd; ch < nchunks; ch += 8)
  for (int jj = jx; jj < 64; jj += wpx) {
    const int L = ch * 64 + jj;
    if (L >= ntiles) continue;
    const int mt = (L / (4 * Ntiles)) * 4 + (L & 3), nt = (L >> 2) % Ntiles;
    const u16* Ag = A + ((size_t)mt * 256 + srow) * D + sc8;
    const u16* Bg = Bt + ((size_t)nt * 128 + srow) * D + sc8;
    f32x16 acc[4][2];
#pragma unroll
    for (int i = 0; i < 4; i++)
#pragma unroll
      for (int j = 0; j < 2; j++)
#pragma unroll
        for (int e = 0; e < 16; e++) acc[i][j][e] = 0.f;
    bf16x8 ra0, ra1, ra2, ra3, ra4, ra5, ra6, ra7, rb0, rb1, rb2, rb3;
#define GLOAD(kt_) { const u16* ag = Ag + (kt_) * 64; const u16* bg = Bg + (kt_) * 64; \
      ra0 = *(const bf16x8*)(ag); ra1 = *(const bf16x8*)(ag + 32 * D); ra2 = *(const bf16x8*)(ag + 64 * D); ra3 = *(const bf16x8*)(ag + 96 * D); \
      ra4 = *(const bf16x8*)(ag + 128 * D); ra5 = *(const bf16x8*)(ag + 160 * D); ra6 = *(const bf16x8*)(ag + 192 * D); ra7 = *(const bf16x8*)(ag + 224 * D); \
      rb0 = *(const bf16x8*)(bg); rb1 = *(const bf16x8*)(bg + 32 * D); rb2 = *(const bf16x8*)(bg + 64 * D); rb3 = *(const bf16x8*)(bg + 96 * D); }
#define LSTORE() { u16* ad = As + srow * LDS_STRIDE + sc8; u16* bd = Bs + srow * LDS_STRIDE + sc8; \
      *(bf16x8*)(ad) = ra0; *(bf16x8*)(ad + 32 * LDS_STRIDE) = ra1; *(bf16x8*)(ad + 64 * LDS_STRIDE) = ra2; *(bf16x8*)(ad + 96 * LDS_STRIDE) = ra3; \
      *(bf16x8*)(ad + 128 * LDS_STRIDE) = ra4; *(bf16x8*)(ad + 160 * LDS_STRIDE) = ra5; *(bf16x8*)(ad + 192 * LDS_STRIDE) = ra6; *(bf16x8*)(ad + 224 * LDS_STRIDE) = ra7; \
      *(bf16x8*)(bd) = rb0; *(bf16x8*)(bd + 32 * LDS_STRIDE) = rb1; *(bf16x8*)(bd + 64 * LDS_STRIDE) = rb2; *(bf16x8*)(bd + 96 * LDS_STRIDE) = rb3; }
    GLOAD(0)
    __syncthreads();
    LSTORE()
    __syncthreads();
#pragma unroll 1
    for (int kt = 0; kt < 16; kt++) {
      if (kt + 1 < 16 && !(dry && DRYVAR == 1)) GLOAD(kt + 1)
      const u16* as = As + (wm * 128 + r) * LDS_STRIDE + h * 8;
      const u16* bs = Bs + (wn * 64 + r) * LDS_STRIDE + h * 8;
      if (!(dry && DRYVAR == 2)) {
        bf16x8 af[2][4], b0, b1;
#pragma unroll
        for (int i = 0; i < 4; i++) af[0][i] = *(const bf16x8*)(as + i * 32 * LDS_STRIDE);
        b0 = *(const bf16x8*)(bs); b1 = *(const bf16x8*)(bs + 32 * LDS_STRIDE);
#pragma unroll
        for (int kk = 0; kk < 4; kk++) {
          const int cur = kk & 1, nxt = cur ^ 1;
          if (kk < 3) {
#pragma unroll
            for (int i = 0; i < 4; i++) af[nxt][i] = *(const bf16x8*)(as + i * 32 * LDS_STRIDE + (kk + 1) * 16);
          }
          __builtin_amdgcn_s_setprio(1);
#pragma unroll
          for (int i = 0; i < 4; i++) acc[i][0] = MFMA32(af[cur][i], b0, acc[i][0]);
          if (kk < 3) b0 = *(const bf16x8*)(bs + (kk + 1) * 16);
#pragma unroll
          for (int i = 0; i < 4; i++) acc[i][1] = MFMA32(af[cur][i], b1, acc[i][1]);
          if (kk < 3) b1 = *(const bf16x8*)(bs + 32 * LDS_STRIDE + (kk + 1) * 16);
          __builtin_amdgcn_s_setprio(0);
        }
      }
      __syncthreads();
      if (kt + 1 < 16 && !(dry && DRYVAR == 1)) LSTORE()
      __syncthreads();
    }
#undef GLOAD
#undef LSTORE
    const int m0 = mt * 256, n0 = nt * 128;
    const int c4 = (tid & 31) * 4, rr0 = tid >> 5;
#pragma unroll
    for (int ph = 0; ph < 2; ph++) {
      if (ph) __syncthreads();
#pragma unroll
      for (int ii = 0; ii < 2; ii++)
#pragma unroll
        for (int j = 0; j < 2; j++)
#pragma unroll
          for (int e = 0; e < 16; e++) Ct[(wm * 64 + ii * 32 + crow(e, h)) * CT_STRIDE + wn * 64 + j * 32 + r] = acc[ph * 2 + ii][j][e];
      __syncthreads();
#pragma unroll 2
      for (int q = 0; q < 16; q++) {
        const int rl = rr0 + q * 8, row = m0 + (rl >> 6) * 128 + ph * 64 + (rl & 63);
        const float4 v = *(const float4*)(Ct + rl * CT_STRIDE + c4);
        gemm_store<MODE>(p, layer, row, nt, n0, c4, v, dry);
      }
    }
  }
}

template <int MODE>
DI void gemm_thin(const Params& p, int layer, char* smem, const u16* A, const u16* Bt, int row0, int Mtiles, int Ntiles, const bool dry) {
  u16* As = (u16*)smem;
  u16* Bs = (u16*)smem + 64 * LDS_STRIDE;
  float* Ct = (float*)smem;
  const int tid = otid(), wave = tid >> 6, lane = tid & 63, r = lane & 31, h = lane >> 5;
  const int wm = wave >> 1, wn = wave & 1;
  const int srow = tid >> 3, sc8 = (tid & 7) * 8;
  const int ntiles = Mtiles * Ntiles;
  for (int L = obid(); L < ntiles; L += gridDim.x) {
    const int mt = L / Ntiles, nt = L % Ntiles;
    const u16* Ag = A + ((size_t)row0 + mt * 64 + srow) * D + sc8;
    const u16* Bg = Bt + ((size_t)nt * 128 + srow) * D + sc8;
    f32x16 acc0, acc1;
#pragma unroll
    for (int e = 0; e < 16; e++) { acc0[e] = 0.f; acc1[e] = 0.f; }
    bf16x8 ra0, ra1, rb0, rb1, rb2, rb3;
#define GLOADT(kt_) { const u16* ag = Ag + (kt_) * 64; const u16* bg = Bg + (kt_) * 64; \
      ra0 = *(const bf16x8*)(ag); ra1 = *(const bf16x8*)(ag + 32 * D); \
      rb0 = *(const bf16x8*)(bg); rb1 = *(const bf16x8*)(bg + 32 * D); rb2 = *(const bf16x8*)(bg + 64 * D); rb3 = *(const bf16x8*)(bg + 96 * D); }
#define LSTORET() { u16* ad = As + srow * LDS_STRIDE + sc8; u16* bd = Bs + srow * LDS_STRIDE + sc8; \
      *(bf16x8*)(ad) = ra0; *(bf16x8*)(ad + 32 * LDS_STRIDE) = ra1; \
      *(bf16x8*)(bd) = rb0; *(bf16x8*)(bd + 32 * LDS_STRIDE) = rb1; *(bf16x8*)(bd + 64 * LDS_STRIDE) = rb2; *(bf16x8*)(bd + 96 * LDS_STRIDE) = rb3; }
    GLOADT(0)
    __syncthreads();
    LSTORET()
    __syncthreads();
#pragma unroll 1
    for (int kt = 0; kt < 16; kt++) {
      if (kt + 1 < 16) GLOADT(kt + 1)
      const u16* as = As + (wm * 32 + r) * LDS_STRIDE + h * 8;
      const u16* bs = Bs + (wn * 64 + r) * LDS_STRIDE + h * 8;
#pragma unroll
      for (int kk = 0; kk < 4; kk++) {
        const bf16x8 af = *(const bf16x8*)(as + kk * 16);
        const bf16x8 bf0 = *(const bf16x8*)(bs + kk * 16), bf1 = *(const bf16x8*)(bs + 32 * LDS_STRIDE + kk * 16);
        acc0 = MFMA32(af, bf0, acc0);
        acc1 = MFMA32(af, bf1, acc1);
      }
      __syncthreads();
      if (kt + 1 < 16) LSTORET()
      __syncthreads();
    }
#undef GLOADT
#undef LSTORET
#pragma unroll
    for (int e = 0; e < 16; e++) {
      Ct[(wm * 32 + crow(e, h)) * CT_STRIDE + wn * 64 + r] = acc0[e];
      Ct[(wm * 32 + crow(e, h)) * CT_STRIDE + wn * 64 + 32 + r] = acc1[e];
    }
    __syncthreads();
    const int n0 = nt * 128, c4 = (tid & 31) * 4, rr0 = tid >> 5;
#pragma unroll 2
    for (int q = 0; q < 8; q++) {
      const int rl = rr0 + q * 8, row = row0 + mt * 64 + rl;
      const float4 v = *(const float4*)(Ct + rl * CT_STRIDE + c4);
      gemm_store<MODE>(p, layer, row, nt, n0, c4, v, dry);
    }
  }
}

DI int tokrow(int grp, int b, int pos) {
  if (pos < CTX) return NLAT + b * CTX + pos;
  int pp = pos - CTX;
  return b * SEQ + (grp == 0 ? pp : ((pp & 127) * 64 + (pp >> 7)));
}
DI float log_sigmoid(float z) { return fminf(z, 0.f) - __logf(1.f + __expf(-fabsf(z))); }

template <int DK, int DIR>
DI void prep_k(const Params& p, int layer, int grp, int hb, int blk, int cgi) {
  constexpr int CH = DK / 32;
  const int b = hb >> 2, head = hb & 3, k0 = cgi * CH;
  float lb[CH], log_lb[CH], l1m[CH], wg[CH][16], bias[CH], bacc[CH];
#pragma unroll
  for (int c = 0; c < CH; c++) {
    bacc[c] = 0.f; lb[c] = 0.f; log_lb[c] = 0.f; l1m[c] = 0.f; bias[c] = 0.f;
    if (DK == 128) {
      const float* lbp = p.hg_lb + (size_t)DIR * DEPTH * 512 + head * 128 + k0 + c;
      float e0 = lbp[0], e1 = lbp[512], e2 = lbp[1024], e3 = lbp[1536];
      const float mx = fmaxf(fmaxf(e0, e1), fmaxf(e2, e3));
      e0 = __expf(e0 - mx); e1 = __expf(e1 - mx); e2 = __expf(e2 - mx); e3 = __expf(e3 - mx);
      const float inv = 1.f / (e0 + e1 + e2 + e3);
      float cs = 0.f;
      if (layer >= 1) cs += e1 * inv;
      if (layer >= 2) cs += e2 * inv;
      if (layer >= 3) cs += e3 * inv;
      lb[c] = fminf(fmaxf(cs, 0.f), 1.f - 1e-6f);
      log_lb[c] = __logf(fmaxf(lb[c], 1e-30f));
      l1m[c] = __logf(1.f - lb[c]);
    } else {
#pragma unroll
      for (int rr = 0; rr < 16; rr++) wg[c][rr] = p.w_gk2[((size_t)(layer * 2 + DIR) * 16 + rr) * 256 + head * 64 + k0 + c];
      bias[c] = p.b_gk[(size_t)(layer * 2 + DIR) * 256 + head * 64 + k0 + c];
    }
  }
  const size_t chain = (size_t)DIR * 16 + hb;
  const int pk0 = perm16(k0);
  u16* Qd = (u16*)(p.S + (DK == 128 ? OFF_HQ : OFF_GQ)) + (chain * LPOS + (size_t)blk * 32) * DK + pk0;
  u16* Kd = (u16*)(p.S + (DK == 128 ? OFF_HK : OFF_GK)) + (chain * LPOS + (size_t)blk * 32) * DK + pk0;
  u16* KTd = (u16*)(p.S + (DK == 128 ? OFF_HKT : OFF_GKT)) + ((chain * NBLK + blk) * DK + k0) * 32;
#pragma unroll 1
  for (int s2 = 0; s2 < 2; s2++) {
    const int tg = DIR ? 1 - s2 : s2;
    u16 kt[CH][16];
#pragma unroll
    for (int j2 = 0; j2 < 16; j2++) {
      const int t16 = DIR ? 15 - j2 : j2;
      const int t = tg * 16 + t16;
      const u16* urow = p.U + (size_t)tokrow(grp, b, blk * 32 + t) * DIN;
      float qv[CH], kv[CH], la[CH];
      if (DK == 128) {
        const uint2 zz = *(const uint2*)(urow + 512 * (1 + DIR) + head * 128 + k0);
        const uint2 qq = *(const uint2*)(urow + head * 128 + k0);
        const u32 zw[2] = {zz.x, zz.y}, qw[2] = {qq.x, qq.y};
#pragma unroll
        for (int c = 0; c < CH; c++) {
          const float z = (c & 1) ? __uint_as_float(zw[c >> 1] & 0xffff0000u) : __uint_as_float(zw[c >> 1] << 16);
          qv[c] = (c & 1) ? __uint_as_float(qw[c >> 1] & 0xffff0000u) : __uint_as_float(qw[c >> 1] << 16);
          const float ez = __expf(-fabsf(z));
          const float rc = __frcp_rn(1.f + ez);
          const float sp = (z < 0.f) ? ez * rc : rc;
          const float sn = (z < 0.f) ? rc : ez * rc;
          la[c] = __logf(fmaxf(lb[c], 1e-30f) + (1.f - lb[c]) * sp);
          kv[c] = (1.f - lb[c]) * sn;
        }
      } else {
        const u32 qq = *(const u32*)(urow + 2560 + head * 64 + k0);
        const u32 kq = *(const u32*)(urow + 2816 + head * 64 + k0);
        const uint4* gr = (const uint4*)(urow + 4096 + DIR * 16);
        const uint4 g0 = gr[0], g1 = gr[1];
        const u32 gw[8] = {g0.x, g0.y, g0.z, g0.w, g1.x, g1.y, g1.z, g1.w};
#pragma unroll
        for (int c = 0; c < CH; c++) {
          qv[c] = ((c & 1) ? __uint_as_float(qq & 0xffff0000u) : __uint_as_float(qq << 16)) * 0.125f;
          kv[c] = (c & 1) ? __uint_as_float(kq & 0xffff0000u) : __uint_as_float(kq << 16);
          float d = bias[c];
#pragma unroll
          for (int rr = 0; rr < 8; rr++)
            d += __uint_as_float(gw[rr] << 16) * wg[c][2 * rr] + __uint_as_float(gw[rr] & 0xffff0000u) * wg[c][2 * rr + 1];
          la[c] = (fminf(d, 0.f) - __logf(1.f + __expf(-fabsf(d)))) * (1.f / 16.f);
        }
      }
      float qo[CH], ko[CH];
#pragma unroll
      for (int c = 0; c < CH; c++) {
        bacc[c] += la[c];
        const float eb = __expf(bacc[c]);
        qo[c] = qv[c] * eb;
        ko[c] = kv[c] * __expf(-bacc[c]);
        kt[c][perm16(t16)] = f2bf(ko[c]);
      }
      if (CH == 4) {
        *(uint2*)(Qd + (size_t)t * DK) = make_uint2(pack2(qo[0], qo[1]), pack2(qo[2], qo[3]));
        *(uint2*)(Kd + (size_t)t * DK) = make_uint2(pack2(ko[0], ko[1]), pack2(ko[2], ko[3]));
      } else {
        *(u32*)(Qd + (size_t)t * DK) = pack2(qo[0], qo[1]);
        *(u32*)(Kd + (size_t)t * DK) = pack2(ko[0], ko[1]);
      }
    }
#pragma unroll
    for (int c = 0; c < CH; c++) {
      u16* dst = KTd + c * 32 + tg * 16;
#pragma unroll
      for (int q8 = 0; q8 < 2; q8++) {
        uint4 o;
        o.x = (u32)kt[c][q8 * 8 + 0] | ((u32)kt[c][q8 * 8 + 1] << 16); o.y = (u32)kt[c][q8 * 8 + 2] | ((u32)kt[c][q8 * 8 + 3] << 16);
        o.z = (u32)kt[c][q8 * 8 + 4] | ((u32)kt[c][q8 * 8 + 5] << 16); o.w = (u32)kt[c][q8 * 8 + 6] | ((u32)kt[c][q8 * 8 + 7] << 16);
        *(uint4*)(dst + q8 * 8) = o;
      }
    }
  }
  float* Dd = (float*)(p.S + (DK == 128 ? OFF_HD : OFF_GD)) + (chain * NBLK + blk) * DK + k0;
#pragma unroll
  for (int c = 0; c < CH; c++) Dd[c] = __expf(bacc[c]);
}

DI void prep_phase(const Params& p, int layer) {
  const int tid = otid();
  for (int it = obid(); it < 2 * 16 * (NBLK / 4); it += gridDim.x) {
    const int bg = it % (NBLK / 4), hb = (it / (NBLK / 4)) & 15, grp = it / ((NBLK / 4) * 16);
    const int b = hb >> 2, head = hb & 3;
    {
      const int dir = tid >> 7, blk = bg * 4 + ((tid >> 5) & 3), cgi = tid & 31;
      if (grp == 0) {
        if (dir == 0) prep_k<128, 0>(p, layer, 0, hb, blk, cgi);
        else prep_k<128, 1>(p, layer, 0, hb, blk, cgi);
      } else {
        if (dir == 0) prep_k<64, 0>(p, layer, 1, hb, blk, cgi);
        else prep_k<64, 1>(p, layer, 1, hb, blk, cgi);
      }
    }
    {
      const int vg = tid & 31, tg = tid >> 5;
      const int col = (grp == 0 ? 1536 : 3072) + head * 128 + vg * 4;
      const int pos0 = bg * 128 + tg * 16;
      u16 vt[4][16];
#pragma unroll
      for (int t = 0; t < 16; t++) {
        const uint2 vv = *(const uint2*)(p.U + (size_t)tokrow(grp, b, pos0 + t) * DIN + col);
        vt[0][perm16(t)] = (u16)(vv.x & 0xffffu); vt[1][perm16(t)] = (u16)(vv.x >> 16);
        vt[2][perm16(t)] = (u16)(vv.y & 0xffffu); vt[3][perm16(t)] = (u16)(vv.y >> 16);
      }
#pragma unroll
      for (int c = 0; c < 4; c++) {
        u16* dst = (u16*)(p.S + (grp == 0 ? OFF_HVT : OFF_GVT)) + (((size_t)hb * NBLK + (pos0 >> 5)) * 128 + vg * 4 + c) * 32 + (pos0 & 31);
#pragma unroll
        for (int q8 = 0; q8 < 2; q8++) {
          uint4 o;
          o.x = (u32)vt[c][q8 * 8 + 0] | ((u32)vt[c][q8 * 8 + 1] << 16); o.y = (u32)vt[c][q8 * 8 + 2] | ((u32)vt[c][q8 * 8 + 3] << 16);
          o.z = (u32)vt[c][q8 * 8 + 4] | ((u32)vt[c][q8 * 8 + 5] << 16); o.w = (u32)vt[c][q8 * 8 + 6] | ((u32)vt[c][q8 * 8 + 7] << 16);
          *(uint4*)(dst + q8 * 8) = o;
        }
      }
    }
  }
}

template <int DK>
DI void scan_wg(const Params& p, char* smem, int grp, int dir, int hb) {
  constexpr int NT = DK / 32, NF = DK / 16;
  constexpr int QS = DK + 8;
  constexpr int KTS = 40;
  constexpr int OFF_K = 32 * QS * 2, OFF_KT = 2 * 32 * QS * 2, OFF_D = OFF_KT + DK * KTS * 2, BUFB = OFF_D + DK * 4;
  constexpr int QN = DK / 64;
  constexpr int CPR = DK / 8;
  static_assert(2 * BUFB <= LDS_BYTES, "scan LDS");
  const int tid = otid(), vs = tid >> 6, lane = tid & 63, r = lane & 31, h = lane >> 5;
  const int b = hb >> 2, head = hb & 3;
  const size_t chain = (size_t)dir * 16 + hb;
  const u16* Qb = (const u16*)(p.S + (DK == 128 ? OFF_HQ : OFF_GQ)) + chain * LPOS * DK;
  const u16* Kb = (const u16*)(p.S + (DK == 128 ? OFF_HK : OFF_GK)) + chain * LPOS * DK;
  const u16* KTb = (const u16*)(p.S + (DK == 128 ? OFF_HKT : OFF_GKT)) + chain * NBLK * DK * 32;
  const u16* VTb = (const u16*)(p.S + (DK == 128 ? OFF_HVT : OFF_GVT)) + (size_t)hb * NBLK * 128 * 32 + (vs * 32 + r) * 32 + h * 8;
  const float* Db = (const float*)(p.S + (DK == 128 ? OFF_HD : OFF_GD)) + chain * NBLK * DK;
  u16* Ob = p.U + (size_t)dir * NROW * D + grp * 512 + head * 128 + vs * 32;
  f32x16 S[NT];
#pragma unroll
  for (int kt = 0; kt < NT; kt++)
#pragma unroll
    for (int e = 0; e < 16; e++) S[kt][e] = 0.f;
  bf16x8 sq[QN], sk[QN], skt[QN], vn0, vn1;
  float4 sd = make_float4(0.f, 0.f, 0.f, 0.f);
  auto blk_of = [&](int step) { return dir ? (step < 8 ? 7 - step : 271 - step) : step; };
  auto gload = [&](int step) {
    const size_t pos0 = (size_t)blk_of(step) * 32;
#pragma unroll
    for (int i = 0; i < QN; i++) {
      const int id = tid + i * 256;
      sq[i] = *(const bf16x8*)(Qb + (pos0 + id / CPR) * DK + (id % CPR) * 8);
      sk[i] = *(const bf16x8*)(Kb + (pos0 + id / CPR) * DK + (id % CPR) * 8);
      skt[i] = *(const bf16x8*)(KTb + (size_t)blk_of(step) * DK * 32 + id * 8);
    }
    if (tid < DK / 4) sd = *(const float4*)(Db + (size_t)blk_of(step) * DK + tid * 4);
    vn0 = *(const bf16x8*)(VTb + (size_t)blk_of(step) * 128 * 32);
    vn1 = *(const bf16x8*)(VTb + (size_t)blk_of(step) * 128 * 32 + 16);
  };
  auto lstore = [&](int buf) {
    char* base = smem + buf * BUFB;
#pragma unroll
    for (int i = 0; i < QN; i++) {
      const int id = tid + i * 256;
      *(bf16x8*)(base + ((id / CPR) * QS + (id % CPR) * 8) * 2) = sq[i];
      *(bf16x8*)(base + OFF_K + ((id / CPR) * QS + (id % CPR) * 8) * 2) = sk[i];
      *(bf16x8*)(base + OFF_KT + ((id >> 2) * KTS + (id & 3) * 8) * 2) = skt[i];
    }
    if (tid < DK / 4) *(float4*)(base + OFF_D + tid * 16) = sd;
  };
  __syncthreads();
  gload(0);
  lstore(0);
  bf16x8 vf0 = vn0, vf1 = vn1;
  __syncthreads();
#pragma unroll 1
  for (int step = 0; step < NBLK; step++) {
    const int blk = blk_of(step);
    if (step + 1 < NBLK) gload(step + 1);
    const char* base = smem + (step & 1) * BUFB;
    const u16* Qs = (const u16*)base + r * QS + h * 8;
    const u16* Ks = (const u16*)(base + OFF_K) + r * QS + h * 8;
    const u16* KTs = (const u16*)(base + OFF_KT) + r * KTS + h * 8;
    const float* Ds = (const float*)(base + OFF_D) + 4 * h;
    bf16x8 qf[NF];
    f32x16 P0, P1;
#pragma unroll
    for (int e = 0; e < 16; e++) { P0[e] = 0.f; P1[e] = 0.f; }
#pragma unroll
    for (int f = 0; f < NF; f += 2) {
      qf[f] = *(const bf16x8*)(Qs + f * 16);
      qf[f + 1] = *(const bf16x8*)(Qs + f * 16 + 16);
      P0 = MFMA32(*(const bf16x8*)(Ks + f * 16), qf[f], P0);
      P1 = MFMA32(*(const bf16x8*)(Ks + f * 16 + 16), qf[f + 1], P1);
    }
#pragma unroll
    for (int e = 0; e < 16; e++) {
      const int s = crow(e, h);
      const bool keep = dir ? (s >= r) : (s <= r);
      P0[e] = keep ? P0[e] + P1[e] : 0.f;
    }
    f32x16 oA, oB;
#pragma unroll
    for (int e = 0; e < 16; e++) { oA[e] = 0.f; oB[e] = 0.f; }
    oA = MFMA32(vf0, pack_frag(P0, 0), oA);
    oA = MFMA32(vf1, pack_frag(P0, 1), oA);
#pragma unroll
    for (int kt = 0; kt < NT; kt++) {
      if (kt & 1) {
        oA = MFMA32(pack_frag(S[kt], 0), qf[kt * 2], oA);
        oA = MFMA32(pack_frag(S[kt], 1), qf[kt * 2 + 1], oA);
      } else {
        oB = MFMA32(pack_frag(S[kt], 0), qf[kt * 2], oB);
        oB = MFMA32(pack_frag(S[kt], 1), qf[kt * 2 + 1], oB);
      }
    }
#pragma unroll
    for (int kt = 0; kt < NT; kt++) {
      S[kt] = MFMA32(*(const bf16x8*)(KTs + kt * 32 * KTS), vf0, S[kt]);
      S[kt] = MFMA32(*(const bf16x8*)(KTs + kt * 32 * KTS + 16), vf1, S[kt]);
#pragma unroll
      for (int g = 0; g < 4; g++) {
        const float4 dv = *(const float4*)(Ds + kt * 32 + 8 * g);
        S[kt][4 * g + 0] *= dv.x; S[kt][4 * g + 1] *= dv.y; S[kt][4 * g + 2] *= dv.z; S[kt][4 * g + 3] *= dv.w;
      }
    }
    {
      const int pos0 = blk * 32;
      int rbase, rstride;
      if (pos0 < CTX) { rbase = NLAT + b * CTX + pos0; rstride = 1; }
      else if (grp == 0) { rbase = b * SEQ + pos0 - CTX; rstride = 1; }
      else { const int pp = pos0 - CTX; rbase = b * SEQ + (pp & 127) * 64 + (pp >> 7); rstride = 64; }
      u16* orow = Ob + (size_t)(rbase + r * rstride) * D + 4 * h;
#pragma unroll
      for (int g = 0; g < 4; g++)
        *(uint2*)(orow + 8 * g) = make_uint2(pack2(oA[4 * g] + oB[4 * g], oA[4 * g + 1] + oB[4 * g + 1]),
                                             pack2(oA[4 * g + 2] + oB[4 * g + 2], oA[4 * g + 3] + oB[4 * g + 3]));
    }
    if (step + 1 < NBLK) lstore((step + 1) & 1);
    vf0 = vn0; vf1 = vn1;
    __syncthreads();
  }
}

DI void scan_phase(const Params& p, char* smem, int layer) {
  const int bid = obid(), nscan = gridDim.x > 64 ? 64 : gridDim.x;
  if (bid < nscan) {
    for (int w = bid; w < 64; w += nscan) {
      const int grp = w >> 5, dir = (w >> 4) & 1, hb = w & 15;
      if (grp == 0) scan_wg<128>(p, smem, 0, dir, hb);
      else scan_wg<64>(p, smem, 1, dir, hb);
    }
  }
  if (gridDim.x <= 64 || bid >= 64) {
    const int vbid = gridDim.x <= 64 ? bid : bid - 64, vgrid = gridDim.x <= 64 ? gridDim.x : gridDim.x - 64;
    peer_convert(p, layer, vbid, vgrid);
    if (layer + 1 < DEPTH) weight_convert(p, layer + 1, vbid, vgrid);
  }
}

DI void combine_phase(const Params& p, int layer, int nrows) {
  const int wave = otid() >> 6, lane = otid() & 63;
  const int c0 = lane * 16;
  const float* gain = (c0 < 512 ? p.hg_norm : p.gla_norm) + (size_t)layer * 128 + (c0 & 127);
  float gn[16];
#pragma unroll
  for (int j = 0; j < 16; j++) gn[j] = gain[j];
  for (int r = obid() * 4 + wave; r < nrows; r += gridDim.x * 4) {
    const uint4* of = (const uint4*)(p.U + (size_t)r * D + c0);
    const uint4* ob = (const uint4*)(p.U + (size_t)NROW * D + (size_t)r * D + c0);
    const uint4* gg = (const uint4*)(p.G + (size_t)r * D + c0);
    float o[16], g[16];
#pragma unroll
    for (int c = 0; c < 2; c++) {
      uint4 a = of[c], bq = ob[c], gq = gg[c];
      u32 aw[4] = {a.x, a.y, a.z, a.w}, bw[4] = {bq.x, bq.y, bq.z, bq.w}, gw[4] = {gq.x, gq.y, gq.z, gq.w};
#pragma unroll
      for (int j = 0; j < 4; j++) {
        o[c * 8 + 2 * j] = __uint_as_float(aw[j] << 16) + __uint_as_float(bw[j] << 16);
        o[c * 8 + 2 * j + 1] = __uint_as_float(aw[j] & 0xffff0000u) + __uint_as_float(bw[j] & 0xffff0000u);
        g[c * 8 + 2 * j] = __uint_as_float(gw[j] << 16);
        g[c * 8 + 2 * j + 1] = __uint_as_float(gw[j] & 0xffff0000u);
      }
    }
    float ss = 0;
#pragma unroll
    for (int j = 0; j < 16; j++) ss += o[j] * o[j];
    ss += __shfl_xor(ss, 1); ss += __shfl_xor(ss, 2); ss += __shfl_xor(ss, 4);
    float rs = rsqrtf(ss * (1.f / 128.f) + EPS);
    u32 ow[8];
#pragma unroll
    for (int j = 0; j < 8; j++) {
      float g0 = g[2 * j], g1 = g[2 * j + 1];
      float y0 = o[2 * j] * rs * gn[2 * j] * (g0 / (1.f + __expf(-g0)));
      float y1 = o[2 * j + 1] * rs * gn[2 * j + 1] * (g1 / (1.f + __expf(-g1)));
      ow[j] = pack2(y0, y1);
    }
    uint4* dst = (uint4*)(p.H + (size_t)r * D + c0);
    dst[0] = make_uint4(ow[0], ow[1], ow[2], ow[3]);
    dst[1] = make_uint4(ow[4], ow[5], ow[6], ow[7]);
  }
}

template <bool PAY>
DI void ce(u32& a, u32& b, u32& pa, u32& pb) {
  if (!PAY) { u32 hi = a > b ? a : b, lo = a > b ? b : a; a = hi; b = lo; }
  else { bool c = a >= b; u32 hi = c ? a : b, lo = c ? b : a, ph = c ? pa : pb, pl = c ? pb : pa; a = hi; b = lo; pa = ph; pb = pl; }
}
template <bool PAY>
DI void sort16(u32 (&k)[16], u32 (&q)[16]) {
#pragma unroll
  for (int size = 2; size <= 16; size <<= 1) {
#pragma unroll
    for (int stride = size >> 1; stride > 0; stride >>= 1) {
#pragma unroll
      for (int i = 0; i < 16; i++) {
        int j = i ^ stride;
        if (j > i) {
          if ((i & size) == 0) ce<PAY>(k[i], k[j], q[i], q[j]);
          else ce<PAY>(k[j], k[i], q[j], q[i]);
        }
      }
    }
  }
}
template <bool PAY>
DI void merge16(u32 (&R)[16], u32 (&RP)[16], u32 (&N)[16], u32 (&NP)[16]) {
#pragma unroll
  for (int i = 0; i < 16; i++) {
    bool c = N[15 - i] > R[i];
    R[i] = c ? N[15 - i] : R[i];
    if (PAY) RP[i] = c ? NP[15 - i] : RP[i];
  }
#pragma unroll
  for (int stride = 8; stride > 0; stride >>= 1) {
#pragma unroll
    for (int i = 0; i < 16; i++) {
      int j = i ^ stride;
      if (j > i) ce<PAY>(R[i], R[j], RP[i], RP[j]);
    }
  }
}
DI u32 ord_f(float f) { u32 u = __float_as_uint(f); return (u & 0x80000000u) ? ~u : (u | 0x80000000u); }
DI float unord_f(u32 u) { return __uint_as_float((u & 0x80000000u) ? (u ^ 0x80000000u) : ~u); }

DI void topk_phase(const Params& p, int layer, char* smem, int nrows) {
  const int tid = otid(), wave = tid >> 6, lane = tid & 63, r = lane & 31, h = lane >> 5;
  float* sc = (float*)smem + wave * 4096;
  const u16* Q = p.U;
  const u16* keys = p.keysb + (size_t)layer * 2 * 128 * 128;
  int* IDX = (int*)(p.S + OFF_IDX);
  float* GATE = (float*)(p.S + OFF_GATE);
  const int nunits = (nrows / 64) * 8;
  for (int wu = obid() * 4 + wave; wu < nunits; wu += gridDim.x * 4) {
    const int tok0 = (wu >> 3) * 64, head = wu & 7;
    u32 RA[16], RB[16], dummy[16];
#pragma unroll
    for (int i = 0; i < 16; i++) { RA[i] = 0; RB[i] = 0; dummy[i] = 0; }
    auto do_half = [&](const int half, u32 (&R)[16]) {
      bf16x8 qf[2][8];
#pragma unroll
      for (int nt = 0; nt < 2; nt++) {
        const u16* qp = Q + (size_t)(tok0 + nt * 32 + r) * 2048 + head * 256 + half * 128 + h * 8;
#pragma unroll
        for (int f = 0; f < 8; f++) qf[nt][f] = *(const bf16x8*)(qp + f * 16);
      }
      f32x16 acc0, acc1;
      auto mm = [&](const int kr) {
        const u16* kp = keys + ((size_t)half * 128 + kr * 32 + r) * 128 + h * 8;
#pragma unroll
        for (int e = 0; e < 16; e++) { acc0[e] = 0.f; acc1[e] = 0.f; }
#pragma unroll
        for (int f = 0; f < 8; f++) {
          const bf16x8 af = *(const bf16x8*)(kp + f * 16);
          acc0 = MFMA32(af, qf[0][f], acc0);
          acc1 = MFMA32(af, qf[1][f], acc1);
        }
      };
      auto put = [&](const int buf) {
        float* d = sc + buf * 2048;
#pragma unroll
        for (int e = 0; e < 16; e++) {
          d[crow(e, h) * 64 + r] = acc0[e];
          d[crow(e, h) * 64 + 32 + r] = acc1[e];
        }
      };
      mm(0);
      put(0);
#pragma unroll
      for (int kr = 0; kr < 4; kr++) {
        if (kr < 3) mm(kr + 1);
        __builtin_amdgcn_wave_barrier();
        const float* sp = sc + (kr & 1) * 2048 + lane;
#pragma unroll
        for (int grp = 0; grp < 2; grp++) {
          u32 N[16];
#pragma unroll
          for (int i = 0; i < 16; i++) {
            const float v = sp[(grp * 16 + i) * 64];
            N[i] = (ord_f(v) & 0xFFFFFF80u) | (u32)(127 - (kr * 32 + grp * 16 + i));
          }
          sort16<false>(N, dummy);
          merge16<false>(R, dummy, N, dummy);
        }
        __builtin_amdgcn_wave_barrier();
        if (kr < 3) put((kr + 1) & 1);
      }
    };
    do_half(0, RA);
    do_half(1, RB);
    {
      float v1[16], v2[16]; u32 i1[16], i2[16];
#pragma unroll
      for (int i = 0; i < 16; i++) {
        v1[i] = unord_f(RA[i] & 0xFFFFFF80u); i1[i] = 127 - (RA[i] & 127u);
        v2[i] = unord_f(RB[i] & 0xFFFFFF80u); i2[i] = 127 - (RB[i] & 127u);
      }
      u32 TK[16], TP[16], NK[16], NP[16];
#define CAND(slot, a, bq) { NK[slot] = ord_f(v1[a] + v2[bq]); NP[slot] = i1[a] * 128u + i2[bq]; }
#pragma unroll
      for (int bq = 0; bq < 16; bq++) { TK[bq] = ord_f(v1[0] + v2[bq]); TP[bq] = i1[0] * 128u + i2[bq]; }
      sort16<true>(TK, TP);
#pragma unroll
      for (int bq = 0; bq < 8; bq++) CAND(bq, 1, bq)
#pragma unroll
      for (int bq = 0; bq < 5; bq++) CAND(8 + bq, 2, bq)
#pragma unroll
      for (int bq = 0; bq < 3; bq++) CAND(13 + bq, 4, bq)
      sort16<true>(NK, NP); merge16<true>(TK, TP, NK, NP);
#pragma unroll
      for (int bq = 0; bq < 4; bq++) CAND(bq, 3, bq)
      CAND(4, 5, 0) CAND(5, 5, 1) CAND(6, 6, 0) CAND(7, 6, 1) CAND(8, 7, 0) CAND(9, 7, 1)
      CAND(10, 8, 0) CAND(11, 9, 0) CAND(12, 10, 0) CAND(13, 11, 0) CAND(14, 12, 0) CAND(15, 13, 0)
      sort16<true>(NK, NP); merge16<true>(TK, TP, NK, NP);
      CAND(0, 14, 0) CAND(1, 15, 0)
#pragma unroll
      for (int i = 2; i < 16; i++) { NK[i] = 0; NP[i] = 0; }
      sort16<true>(NK, NP); merge16<true>(TK, TP, NK, NP);
#undef CAND
      const float mx = unord_f(TK[0]);
      float ev[16], sum = 0.f;
#pragma unroll
      for (int i = 0; i < 16; i++) { ev[i] = __expf(unord_f(TK[i]) - mx); sum += ev[i]; }
      const float inv = 1.f / sum;
      u16* ip = (u16*)IDX + (size_t)(tok0 + lane) * 128 + head * 16;
      float* gp = GATE + (size_t)(tok0 + lane) * 128 + head * 16;
#pragma unroll
      for (int c = 0; c < 2; c++)
        *(uint4*)(ip + c * 8) = make_uint4(TP[c * 8] | (TP[c * 8 + 1] << 16), TP[c * 8 + 2] | (TP[c * 8 + 3] << 16),
                                           TP[c * 8 + 4] | (TP[c * 8 + 5] << 16), TP[c * 8 + 6] | (TP[c * 8 + 7] << 16));
#pragma unroll
      for (int c = 0; c < 4; c++)
        *(float4*)(gp + c * 4) = make_float4(ev[c * 4] * inv, ev[c * 4 + 1] * inv, ev[c * 4 + 2] * inv, ev[c * 4 + 3] * inv);
    }
  }
}

DI float row16_sum(float v) {
  v += __int_as_float(__builtin_amdgcn_update_dpp(0, __float_as_int(v), 0x128, 0xf, 0xf, false));
  v += __int_as_float(__builtin_amdgcn_update_dpp(0, __float_as_int(v), 0x124, 0xf, 0xf, false));
  v += __int_as_float(__builtin_amdgcn_update_dpp(0, __float_as_int(v), 0x122, 0xf, 0xf, false));
  v += __int_as_float(__builtin_amdgcn_update_dpp(0, __float_as_int(v), 0x121, 0xf, 0xf, false));
  return v;
}
DI float gelu_tanh(float x) {
  float u = 0.7978845608028654f * (x + 0.044715f * x * x * x);
  float e = __expf(2.f * u);
  float th = 1.f - 2.f / (e + 1.f);
  return 0.5f * x * (1.f + th);
}
DI float dot8(uint4 a, uint4 b, float acc) {
  acc = __builtin_amdgcn_fdot2_f32_bf16(__builtin_bit_cast(bf2, a.x), __builtin_bit_cast(bf2, b.x), acc, false);
  acc = __builtin_amdgcn_fdot2_f32_bf16(__builtin_bit_cast(bf2, a.y), __builtin_bit_cast(bf2, b.y), acc, false);
  acc = __builtin_amdgcn_fdot2_f32_bf16(__builtin_bit_cast(bf2, a.z), __builtin_bit_cast(bf2, b.z), acc, false);
  acc = __builtin_amdgcn_fdot2_f32_bf16(__builtin_bit_cast(bf2, a.w), __builtin_bit_cast(bf2, b.w), acc, false);
  return acc;
}

typedef float f2 __attribute__((ext_vector_type(2)));
DI void expert_dots(const Params& p, int nrows, char* smem) {
  const int tid = otid(), wave = tid >> 6, lane = tid & 63, g = lane >> 4, s = lane & 15;
  const int bid = obid(), x = bid & 7, jx = bid >> 3, wpx = (gridDim.x + 7 - x) >> 3;
  u32* list = (u32*)smem + wave * 128;
  const int* IDX = (const int*)(p.S + OFF_IDX);
  const float* GATE = (const float*)(p.S + OFF_GATE);
  u16* AV16 = (u16*)(p.S + OFF_PU);
  const unsigned char* PU = (const unsigned char*)(p.PT + PT_U) + s * 16;
  const float* PSU = (const float*)(p.PT + PT_SC);
  const float* PSV = PSU + 16384;
  const int tstep = wpx * 4;
  int t = jx * 4 + wave;
  int ni0 = 0, ni1 = 0;
  uint4 nh[8];
  auto prefetch = [&](int tt) {
    { const u32 w2 = ((const u32*)IDX)[(size_t)tt * 64 + lane]; ni0 = (int)(w2 & 0xffffu); ni1 = (int)(w2 >> 16); }
#pragma unroll
    for (int c = 0; c < 4; c++) {
      const u16* hp = p.H + (size_t)tt * D + (c * 16 + s) * 16;
      nh[2 * c] = *(const uint4*)(hp); nh[2 * c + 1] = *(const uint4*)(hp + 8);
    }
  };
  auto dot_row = [&](const int4 (&uu)[4], const f2 (&hf)[32]) {
    const int uw[16] = {uu[0].x, uu[0].y, uu[0].z, uu[0].w, uu[1].x, uu[1].y, uu[1].z, uu[1].w,
                        uu[2].x, uu[2].y, uu[2].z, uu[2].w, uu[3].x, uu[3].y, uu[3].z, uu[3].w};
    f2 acc = {0.f, 0.f}, acc2 = {0.f, 0.f};
#pragma unroll
    for (int j = 0; j < 16; j++) {
      acc = __builtin_elementwise_fma(__builtin_amdgcn_cvt_pk_f32_fp8(uw[j], false), hf[2 * j], acc);
      acc2 = __builtin_elementwise_fma(__builtin_amdgcn_cvt_pk_f32_fp8(uw[j], true), hf[2 * j + 1], acc2);
    }
    return row16_sum((acc.x + acc.y) + (acc2.x + acc2.y));
  };
  if (t < nrows) prefetch(t);
  for (; t < nrows; t += tstep) {
    const int i0 = ni0, i1 = ni1;
    f2 hf[32];
#pragma unroll
    for (int c = 0; c < 4; c++) {
      const u32 hw[8] = {nh[2 * c].x, nh[2 * c].y, nh[2 * c].z, nh[2 * c].w, nh[2 * c + 1].x, nh[2 * c + 1].y, nh[2 * c + 1].z, nh[2 * c + 1].w};
#pragma unroll
      for (int j = 0; j < 8; j++) { hf[c * 8 + j].x = __uint_as_float(hw[j] << 16); hf[c * 8 + j].y = __uint_as_float(hw[j] & 0xffff0000u); }
    }
    if (t + tstep < nrows) prefetch(t + tstep);
    const bool b0 = (i0 >> 11) == x, b1 = (i1 >> 11) == x;
    const unsigned long long m0 = __ballot(b0), m1 = __ballot(b1);
    const int n0 = __popcll(m0);
    const int r0 = __builtin_amdgcn_mbcnt_hi((u32)(m0 >> 32), __builtin_amdgcn_mbcnt_lo((u32)m0, 0u));
    const int r1 = n0 + __builtin_amdgcn_mbcnt_hi((u32)(m1 >> 32), __builtin_amdgcn_mbcnt_lo((u32)m1, 0u));
    const int n = n0 + __popcll(m1);
    __builtin_amdgcn_wave_barrier();
    if (b0) list[r0] = ((u32)(2 * lane) << 16) | (u32)i0;
    if (b1) list[r1] = ((u32)(2 * lane + 1) << 16) | (u32)i1;
    __builtin_amdgcn_wave_barrier();
    for (int cb = 0; cb < n; cb += 64) {
      const int nend = min(n, cb + 64);
      float dk = 0.f;
      for (int base = cb; base < nend; base += 8) {
        const int k0 = base + g, k1 = base + 4 + g;
        const u32 ent0 = list[min(k0, n - 1)], ent1 = list[min(k1, n - 1)];
        const unsigned char* ur0 = PU + (size_t)(ent0 & 0xffffu) * D;
        const unsigned char* ur1 = PU + (size_t)(ent1 & 0xffffu) * D;
        int4 ua[4], ub[4];
        ua[0] = *(const int4*)(ur0); ua[1] = *(const int4*)(ur0 + 256); ua[2] = *(const int4*)(ur0 + 512); ua[3] = *(const int4*)(ur0 + 768);
        ub[0] = *(const int4*)(ur1); ub[1] = *(const int4*)(ur1 + 256); ub[2] = *(const int4*)(ur1 + 512); ub[3] = *(const int4*)(ur1 + 768);
        const float d0 = dot_row(ua, hf);
        const float d1 = dot_row(ub, hf);
        const int it0 = (base - cb) >> 2;
        dk = (s == it0) ? d0 : dk;
        dk = (s == it0 + 1) ? d1 : dk;
      }
      const int kk = cb + 4 * s + g;
      if (kk < nend) {
        const u32 ent = list[kk];
        const int e = (int)(ent & 0xffffu), slot = (int)(ent >> 16);
        AV16[(size_t)t * 128 + slot] = f2bf(GATE[(size_t)t * 128 + slot] * PSV[e] * gelu_tanh(dk * PSU[e]));
      }
    }
  }
}

DI void expert_vsum(const Params& p, int nrows) {
  const int tid = otid(), wave = tid >> 6, lane = tid & 63, g = lane >> 3, s = lane & 7;
  const int bid = obid(), x = bid & 7, jx = bid >> 3, wpx = (gridDim.x + 7 - x) >> 3;
  const u16* IDX = (const u16*)(p.S + OFF_IDX) + g * 16;
  const u16* AV = (const u16*)(p.S + OFF_PU) + g * 16;
  const unsigned char* PV = (const unsigned char*)(p.PT + PT_V) + (size_t)x * 16384 * 128 + s * 16;
  u16* Y = (u16*)((char*)p.U + (size_t)NROW * 2048 * 2);
  const int b5 = (lane >> 5) & 1, b4 = (lane >> 4) & 1, b3 = (lane >> 3) & 1;
  const int tstep = wpx * 4;
  int t = jx * 4 + wave;
  uint4 ni[2], na[2];
  auto prefetch = [&](int tt) {
#pragma unroll
    for (int j = 0; j < 2; j++) { ni[j] = *(const uint4*)(IDX + (size_t)tt * 128 + j * 8); na[j] = *(const uint4*)(AV + (size_t)tt * 128 + j * 8); }
  };
  if (t < nrows) prefetch(t);
  for (; t < nrows; t += tstep) {
    const u32 iw[8] = {ni[0].x, ni[0].y, ni[0].z, ni[0].w, ni[1].x, ni[1].y, ni[1].z, ni[1].w};
    const u32 aw[8] = {na[0].x, na[0].y, na[0].z, na[0].w, na[1].x, na[1].y, na[1].z, na[1].w};
    int ee[16]; float aa[16];
#pragma unroll
    for (int j = 0; j < 8; j++) {
      ee[2 * j] = (int)(iw[j] & 0xffffu); ee[2 * j + 1] = (int)(iw[j] >> 16);
      aa[2 * j] = __uint_as_float(aw[j] << 16); aa[2 * j + 1] = __uint_as_float(aw[j] & 0xffff0000u);
    }
    int4 vv[16];
#pragma unroll
    for (int it = 0; it < 16; it++) vv[it] = *(const int4*)(PV + (size_t)ee[it] * 128);
    if (t + tstep < nrows) prefetch(t + tstep);
    f2 y[8];
#pragma unroll
    for (int i = 0; i < 8; i++) { y[i].x = 0.f; y[i].y = 0.f; }
#pragma unroll
    for (int it = 0; it < 16; it++) {
      const f2 a2 = {aa[it], aa[it]};
      const int vw[4] = {vv[it].x, vv[it].y, vv[it].z, vv[it].w};
#pragma unroll
      for (int j = 0; j < 4; j++) {
        y[2 * j] = __builtin_elementwise_fma(__builtin_amdgcn_cvt_pk_f32_fp8(vw[j], false), a2, y[2 * j]);
        y[2 * j + 1] = __builtin_elementwise_fma(__builtin_amdgcn_cvt_pk_f32_fp8(vw[j], true), a2, y[2 * j + 1]);
      }
    }
    f2 k4[4], k2[2], k1;
#pragma unroll
    for (int i = 0; i < 4; i++) {
      const f2 keep = b5 ? y[4 + i] : y[i], send = b5 ? y[i] : y[4 + i];
      k4[i].x = keep.x + __shfl_xor(send.x, 32); k4[i].y = keep.y + __shfl_xor(send.y, 32);
    }
#pragma unroll
    for (int i = 0; i < 2; i++) {
      const f2 keep = b4 ? k4[2 + i] : k4[i], send = b4 ? k4[i] : k4[2 + i];
      k2[i].x = keep.x + __shfl_xor(send.x, 16); k2[i].y = keep.y + __shfl_xor(send.y, 16);
    }
    {
      const f2 keep = b3 ? k2[1] : k2[0], send = b3 ? k2[0] : k2[1];
      k1.x = keep.x + __shfl_xor(send.x, 8); k1.y = keep.y + __shfl_xor(send.y, 8);
    }
    *(u32*)(Y + (size_t)t * D + x * 128 + s * 16 + b5 * 8 + b4 * 4 + b3 * 2) = pack2(k1.x, k1.y);
  }
}

DI void expert_epilogue(const Params& p, int layer, int nrows) {
  const int tid = otid(), wave = tid >> 6, lane = tid & 63, g = lane >> 5, s = lane & 31;
  const bool last = (layer == DEPTH - 1);
  const u16* Y = (const u16*)((const char*)p.U + (size_t)NROW * 2048 * 2);
  for (int tk = obid() * 4 + wave; tk < nrows; tk += gridDim.x * 4) {
    const int b = row_batch(tk);
    const int col = (g * 32 + s) * 16;
    const float* g2 = ada_ptr(p, layer, b, 5) + col;
    const float* gm = p.ln_gamma + (size_t)(layer * 2 + 1) * D + col;
    const float* bt = p.ln_beta + (size_t)(layer * 2 + 1) * D + col;
    const float* XP = (const float*)(p.S + OFF_XP) + (size_t)tk * D + col;
    float xin[16];
    {
      float s0 = 0.f;
#pragma unroll
      for (int j4 = 0; j4 < 4; j4++) {
        const float4 t4 = *(const float4*)(XP + j4 * 4);
        xin[j4 * 4] = t4.x; xin[j4 * 4 + 1] = t4.y; xin[j4 * 4 + 2] = t4.z; xin[j4 * 4 + 3] = t4.w;
        s0 += t4.x + t4.y + t4.z + t4.w;
      }
      const float m0 = wave_sum(s0) * (1.f / D);
      float q0 = 0.f;
#pragma unroll
      for (int j = 0; j < 16; j++) { xin[j] -= m0; q0 += xin[j] * xin[j]; }
      const float r0 = rsqrtf(wave_sum(q0) * (1.f / D) + EPS);
      const float* gm0 = p.ln_gamma + (size_t)(layer * 2 + 0) * D + col;
      const float* bt0 = p.ln_beta + (size_t)(layer * 2 + 0) * D + col;
#pragma unroll
      for (int j4 = 0; j4 < 4; j4++) {
        const float4 ga = *(const float4*)(gm0 + j4 * 4), be = *(const float4*)(bt0 + j4 * 4);
        xin[j4 * 4] = xin[j4 * 4] * r0 * ga.x + be.x; xin[j4 * 4 + 1] = xin[j4 * 4 + 1] * r0 * ga.y + be.y;
        xin[j4 * 4 + 2] = xin[j4 * 4 + 2] * r0 * ga.z + be.z; xin[j4 * 4 + 3] = xin[j4 * 4 + 3] * r0 * ga.w + be.w;
      }
    }
    float xv[16];
    float sum = 0.f;
    const uint4 yq0 = *(const uint4*)(Y + (size_t)tk * D + col), yq1 = *(const uint4*)(Y + (size_t)tk * D + col + 8);
    const u32 yw[8] = {yq0.x, yq0.y, yq0.z, yq0.w, yq1.x, yq1.y, yq1.z, yq1.w};
#pragma unroll
    for (int j4 = 0; j4 < 4; j4++) {
      const float4 xo = make_float4(xin[j4 * 4], xin[j4 * 4 + 1], xin[j4 * 4 + 2], xin[j4 * 4 + 3]);
      const float4 gg = *(const float4*)(g2 + j4 * 4);
      const float4 yy = make_float4(__uint_as_float(yw[2 * j4] << 16), __uint_as_float(yw[2 * j4] & 0xffff0000u),
                                    __uint_as_float(yw[2 * j4 + 1] << 16), __uint_as_float(yw[2 * j4 + 1] & 0xffff0000u));
      float* o = xv + j4 * 4;
      o[0] = ALPHA * xo.x + gg.x * yy.x; o[1] = ALPHA * xo.y + gg.y * yy.y;
      o[2] = ALPHA * xo.z + gg.z * yy.z; o[3] = ALPHA * xo.w + gg.w * yy.w;
      sum += o[0] + o[1] + o[2] + o[3];
    }
    float mu = wave_sum(sum) * (1.f / D);
    float q = 0.f;
#pragma unroll
    for (int j = 0; j < 16; j++) { xv[j] -= mu; q += xv[j] * xv[j]; }
    float rstd = rsqrtf(wave_sum(q) * (1.f / D) + EPS);
    float* dstx = (last ? p.out : p.X) + (size_t)tk * D + col;
    float s2 = 0.f;
#pragma unroll
    for (int j4 = 0; j4 < 4; j4++) {
      const float4 gmv = *(const float4*)(gm + j4 * 4);
      const float4 btv = *(const float4*)(bt + j4 * 4);
      float* o = xv + j4 * 4;
      o[0] = o[0] * rstd * gmv.x + btv.x; o[1] = o[1] * rstd * gmv.y + btv.y;
      o[2] = o[2] * rstd * gmv.z + btv.z; o[3] = o[3] * rstd * gmv.w + btv.w;
      s2 += o[0] + o[1] + o[2] + o[3];
      *(float4*)(dstx + j4 * 4) = make_float4(o[0], o[1], o[2], o[3]);
    }
    if (!last) {
      float mu2 = wave_sum(s2) * (1.f / D);
      float q2 = 0.f;
#pragma unroll
      for (int j = 0; j < 16; j++) { xv[j] -= mu2; q2 += xv[j] * xv[j]; }
      float rstd2 = rsqrtf(wave_sum(q2) * (1.f / D) + EPS);
      const float* sh = ada_ptr(p, layer + 1, b, 0) + col;
      const float* sc = ada_ptr(p, layer + 1, b, 1) + col;
      u32 ow[8];
#pragma unroll
      for (int j = 0; j < 8; j++) {
        float y0 = xv[2 * j] * rstd2 * (1.f + sc[2 * j]) + sh[2 * j];
        float y1 = xv[2 * j + 1] * rstd2 * (1.f + sc[2 * j + 1]) + sh[2 * j + 1];
        ow[j] = pack2(y0, y1);
      }
      *(uint4*)(p.H + (size_t)tk * D + col) = make_uint4(ow[0], ow[1], ow[2], ow[3]);
      *(uint4*)(p.H + (size_t)tk * D + col + 8) = make_uint4(ow[4], ow[5], ow[6], ow[7]);
    }
  }
}

#define XB_TMO      128
#define XB_XCNT(j)  (256  + 64 * (j))
#define XB_XSUB(j)  (1280 + 64 * (j))
#define XB_XGEN(j)  (2304 + 64 * (j))
#define XB_TOP      3328
#define XB_TOPGEN   3392
#define XCD_BAR_WORDS 3456
#define XB_SPIN_CAP (1u << 18)
#define LAS __attribute__((address_space(3)))

__device__ __forceinline__ unsigned xb_ld(unsigned* p)              { return __hip_atomic_load(p, __ATOMIC_RELAXED, __HIP_MEMORY_SCOPE_AGENT); }
__device__ __forceinline__ unsigned xb_add(unsigned* p, unsigned v) { return __hip_atomic_fetch_add(p, v, __ATOMIC_RELAXED, __HIP_MEMORY_SCOPE_AGENT); }
__device__ __forceinline__ unsigned xb_xcc_id() { return (unsigned)__builtin_amdgcn_s_getreg((3 << 11) | 20) & 0xFu; }
#define XB_SPIN(cond, bar) do { unsigned _sp = 0; while (cond) { __builtin_amdgcn_s_sleep(1); \
    if ((++_sp & 255u) == 0u) { if (xb_ld(&(bar)[XB_TMO])) break; if (_sp > XB_SPIN_CAP) { atomicAdd(&(bar)[XB_TMO], 1u); break; } } } } while (0)

struct XcdBarrier {
    unsigned* bar; unsigned x;
    volatile LAS unsigned* st;
};

__device__ __forceinline__ XcdBarrier xcd_barrier_post(unsigned* bar, volatile LAS unsigned* st) {
    XcdBarrier b; b.bar = bar; b.x = xb_xcc_id(); b.st = st;
    if (threadIdx.x == 0) (void)xb_add(&bar[XB_XCNT(b.x)], 1u);
    return b;
}
__device__ __forceinline__ void xcd_barrier_complete(unsigned* bar, unsigned x, unsigned& nloc, unsigned& nx) {
    const unsigned G = gridDim.x * gridDim.y * gridDim.z;
    unsigned sum, cnt, mine, sp = 0u;
    for (;;) {
        sum = 0u; cnt = 0u; mine = 0u;
#pragma unroll
        for (unsigned j = 0; j < 16; ++j) { const unsigned c = xb_ld(&bar[XB_XCNT(j)]); sum += c; cnt += (c > 0u) ? 1u : 0u; mine = (j == x) ? c : mine; }
        if (sum == G) break;
        __builtin_amdgcn_s_sleep(1);
        if ((++sp & 255u) == 0u) { if (xb_ld(&bar[XB_TMO])) break; if (sp > XB_SPIN_CAP) { atomicAdd(&bar[XB_TMO], 1u); break; } }
    }
    nloc = mine > 0u ? mine : 1u; nx = cnt > 0u ? cnt : 1u;
}

__device__ __forceinline__ void xcd_barrier(const XcdBarrier& b) {
    asm volatile("s_waitcnt vmcnt(0)" ::: "memory");
    __syncthreads();
    if (threadIdx.x == 0) {
        unsigned* bar = b.bar;
        __builtin_amdgcn_s_waitcnt(0);
        unsigned nloc = b.st[0], nx = b.st[1];
        if (nloc == 0u) { xcd_barrier_complete(bar, b.x, nloc, nx); b.st[0] = nloc; b.st[1] = nx; }
        const unsigned old = xb_add(&bar[XB_XSUB(b.x)], 1u);
        const unsigned gen = old / nloc;
        if (old + 1u == (gen + 1u) * nloc) {
            __builtin_amdgcn_fence(__ATOMIC_RELEASE, "agent");
            asm volatile("s_waitcnt vmcnt(0)" ::: "memory");
            const unsigned og = xb_add(&bar[XB_TOP], 1u);
            const unsigned tg = og / nx;
            if (og + 1u == (tg + 1u) * nx) xb_add(&bar[XB_TOPGEN], 1u);
            else XB_SPIN(xb_ld(&bar[XB_TOPGEN]) == tg, bar);
            __builtin_amdgcn_fence(__ATOMIC_ACQUIRE, "agent");
            xb_add(&bar[XB_XGEN(b.x)], 1u);
            asm volatile("s_waitcnt vmcnt(0)" ::: "memory");
        } else {
            XB_SPIN(xb_ld(&bar[XB_XGEN(b.x)]) == gen, bar);
            __builtin_amdgcn_fence(__ATOMIC_ACQUIRE, "agent");
            asm volatile("s_waitcnt vmcnt(0)" ::: "memory");
        }
    }
    __syncthreads();
}


DI void grid_barrier(unsigned* ctr, unsigned& target) {
  asm volatile("s_waitcnt vmcnt(0)" ::: "memory");
  __syncthreads();
  if (threadIdx.x == 0) {
    target += gridDim.x;
    __builtin_amdgcn_fence(__ATOMIC_RELEASE, "agent");
    asm volatile("s_waitcnt vmcnt(0)" ::: "memory");
    __hip_atomic_fetch_add(ctr, 1u, __ATOMIC_RELAXED, __HIP_MEMORY_SCOPE_AGENT);
    while (__hip_atomic_load(ctr, __ATOMIC_RELAXED, __HIP_MEMORY_SCOPE_AGENT) < target) __builtin_amdgcn_s_sleep(1);
    __builtin_amdgcn_fence(__ATOMIC_ACQUIRE, "agent");
    asm volatile("s_waitcnt vmcnt(0)" ::: "memory");
  }
  __syncthreads();
}

__global__ void __launch_bounds__(256, 2) mk_forward(Params p) {
  __shared__ __attribute__((aligned(16))) char smem[LDS_BYTES];
  cg::grid_group grid = cg::this_grid();
  int pc = 0;
#define GSYNC() xcd_barrier(xb)
#define PHASE(body) PHASER(15, body)
#define PHASER(kind, body)                              \
  {                                                     \
    if (pc >= p.ph_lo && pc < p.ph_hi) {                \
      if ((REPMASK >> (kind)) & 1) { const bool dry = true; (void)dry; body; GSYNC(); } \
      { const bool dry = false; (void)dry; body; }      \
      if (pc + 1 < p.ph_hi) GSYNC();                    \
    }                                                   \
    pc++;                                               \
  }
  __shared__ __attribute__((aligned(16))) unsigned xb_words[4];
  if (threadIdx.x == 0) { xb_words[0] = 0u; xb_words[1] = 0u; xb_words[2] = 0u; xb_words[3] = 0u; }
  __syncthreads();
  const XcdBarrier xb = xcd_barrier_post(p.bar, (volatile LAS unsigned*)xb_words);
  if (0 >= p.ph_lo && 0 < p.ph_hi) {
    phase0(p, (float*)smem);
    if (1 < p.ph_hi) grid.sync();
  }
  pc++;
  PHASE(phase0b(p))
  PHASE(lnmod_phase<0>(p, 0, NROW))
  for (int layer = 0; layer < DEPTH; layer++) {
    const bool last = (layer == DEPTH - 1);
    const int nrows = last ? NLAT : NROW;
    PHASER(0, gemm_phase<0>(p, layer, smem, p.H, p.wt_in + (size_t)layer * DINP * D, NROW / 256, DINP / 128, dry))
    PHASER(1, prep_phase(p, layer))
    PHASER(2, scan_phase(p, smem, layer))
    PHASER(3, combine_phase(p, layer, nrows))
    PHASER(4, { gemm_phase<1>(p, layer, smem, p.H, p.wt_out + (size_t)layer * D * D, NLAT / 256, 8, dry);
                 if (nrows > NLAT) gemm_thin<1>(p, layer, smem, p.H, p.wt_out + (size_t)layer * D * D, NLAT, NCTX / 64, 8, dry); })
    PHASER(5, lnmod_phase<1>(p, layer, nrows))
    PHASER(6, { gemm_phase<2>(p, layer, smem, p.H, p.wt_q + (size_t)layer * 2048 * D, NLAT / 256, 16, dry);
                 if (nrows > NLAT) gemm_thin<2>(p, layer, smem, p.H, p.wt_q + (size_t)layer * 2048 * D, NLAT, NCTX / 64, 16, dry); })
    PHASER(7, topk_phase(p, layer, smem, nrows))
    PHASER(8, expert_dots(p, nrows, smem))
    PHASER(9, expert_vsum(p, nrows))
    PHASER(10, expert_epilogue(p, layer, nrows))
  }
#undef PHASE
#undef PHASER
}
constexpr int NPHASES = 3 + 11 * DEPTH;

extern "C" void kernel_launch(void* const* d_in, const int* in_sizes, int n_in, void* d_out, int out_size, void* d_ws,
                              size_t ws_size, hipStream_t stream) {
  Params p{};
  p.x = (const float*)d_in[0]; p.c = (const float*)d_in[1]; p.ctx = (const float*)d_in[2]; p.c_ctx = (const float*)d_in[3];
  p.w_ada = (const float*)d_in[4]; p.b_ada = (const float*)d_in[5]; p.w_in = (const float*)d_in[6];
  p.w_gk2 = (const float*)d_in[7]; p.b_gk = (const float*)d_in[8]; p.hg_lb = (const float*)d_in[9];
  p.hg_norm = (const float*)d_in[10]; p.gla_norm = (const float*)d_in[11]; p.w_out = (const float*)d_in[12];
  p.ln_gamma = (const float*)d_in[13]; p.ln_beta = (const float*)d_in[14]; p.wq = (const float*)d_in[15];
  p.sub_keys = (const float*)d_in[16]; p.peer_u = (const float*)d_in[17]; p.peer_v = (const float*)d_in[18];
  p.out = (float*)d_out;
  char* w = (char*)d_ws;
  size_t off = 0;
  auto take = [&](size_t bytes) { char* q = w + off; off += (bytes + 255) & ~(size_t)255; return q; };
  p.wt_in = (u16*)take((size_t)4 * DINP * D * 2);
  p.wt_out = (u16*)take((size_t)4 * D * D * 2);
  p.wt_q = (u16*)take((size_t)4 * 2048 * D * 2);
  p.keysb = (u16*)take((size_t)4 * 2 * 128 * 128 * 2);
  p.ada_part = (float*)take((size_t)8 * 4 * 5 * 6144 * 4);
  p.ada = (float*)take((size_t)4 * 5 * 6144 * 4);
  p.X = (float*)take((size_t)NROW * D * 4);
  p.H = (u16*)take((size_t)NROW * D * 2);
  p.G = (u16*)take((size_t)NROW * D * 2);
  p.U = (u16*)take((size_t)NROW * DIN * 2);
  p.S = take(SZ_S);
  p.PT = take(SZ_PT);
  p.bar = (unsigned*)take(XCD_BAR_WORDS * 4);
  if (off > ws_size) { fprintf(stderr, "workspace too small: need %zu have %zu\n", off, ws_size); return; }

  static int grid_blocks = 0;
  if (!grid_blocks) {
    int dev = 0, cus = 0, per_cu = 0;
    hipGetDevice(&dev);
    hipDeviceGetAttribute(&cus, hipDeviceAttributeMultiprocessorCount, dev);
    hipOccupancyMaxActiveBlocksPerMultiprocessor(&per_cu, mk_forward, 256, 0);
    if (per_cu > 2) per_cu = 2;
    grid_blocks = cus * per_cu;
  }
#if ONE_LAUNCH
  hipMemsetAsync(p.bar, 0, XCD_BAR_WORDS * 4, stream);
  p.ph_lo = 0; p.ph_hi = NPHASES;
  void* args[] = {&p};
  hipError_t e = hipLaunchCooperativeKernel((void*)mk_forward, dim3(grid_blocks), dim3(256), args, 0, stream);
  if (e != hipSuccess) fprintf(stderr, "cooperative launch failed: %s (grid %d)\n", hipGetErrorString(e), grid_blocks);
#else
  for (int ph = 0; ph < NPHASES; ph++) {
    p.ph_lo = ph; p.ph_hi = ph + 1;
    hipLaunchKernelGGL(mk_forward, dim3(grid_blocks), dim3(256), 0, stream, p);
  }
#endif
}
```

```cpp
#include <hip/hip_runtime.h>
#include <hip/hip_cooperative_groups.h>
#include <cstdio>
namespace cg = cooperative_groups;

#define DI __device__ __forceinline__
typedef unsigned short u16;
typedef unsigned int u32;
typedef __attribute__((ext_vector_type(8))) short bf16x8;
typedef __attribute__((ext_vector_type(16))) float f32x16;
typedef __attribute__((ext_vector_type(2))) __bf16 bf2;

#ifndef REPMASK
#define REPMASK 0
#endif
#ifndef DRYVAR
#define DRYVAR 0
#endif
#ifndef ONE_LAUNCH
#define ONE_LAUNCH 1
#endif

constexpr int D = 1024, NB = 4, SEQ = 8192, DEPTH = 4, CTX = 256;
constexpr int NLAT = NB * SEQ;
constexpr int NCTX = NB * CTX;
constexpr int NROW = NLAT + NCTX;
constexpr int DIN = 4128, DINP = 4224;
constexpr int LPOS = CTX + SEQ;
constexpr int NBLK = LPOS / 32;
constexpr float ALPHA = 1.681792830507429f;
constexpr float EPS = 1e-6f;
constexpr int LDS_BYTES = 73728;

struct Params {
  const float *x, *c, *ctx, *c_ctx, *w_ada, *b_ada, *w_in, *w_gk2, *b_gk, *hg_lb, *hg_norm, *gla_norm,
      *w_out, *ln_gamma, *ln_beta, *wq, *sub_keys, *peer_u, *peer_v;
  float* out;
  u16 *wt_in, *wt_out, *wt_q, *keysb;
  float *ada_part, *ada;
  float* X;
  u16 *H, *G, *U;
  char* S;
  char* PT;
  unsigned* bar;
  int ph_lo, ph_hi;
};

constexpr size_t SZ_HQ = (size_t)2 * 16 * LPOS * 128 * 2;
constexpr size_t SZ_HVT = (size_t)16 * 128 * LPOS * 2;
constexpr size_t SZ_HD = (size_t)2 * 16 * NBLK * 128 * 4;
constexpr size_t SZ_GQ = (size_t)2 * 16 * LPOS * 64 * 2;
constexpr size_t SZ_GD = (size_t)2 * 16 * NBLK * 64 * 4;
constexpr size_t OFF_HQ = 0, OFF_HK = OFF_HQ + SZ_HQ, OFF_HKT = OFF_HK + SZ_HQ, OFF_HVT = OFF_HKT + SZ_HQ,
                 OFF_HD = OFF_HVT + SZ_HVT, OFF_GQ = OFF_HD + SZ_HD, OFF_GK = OFF_GQ + SZ_GQ, OFF_GKT = OFF_GK + SZ_GQ,
                 OFF_GVT = OFF_GKT + SZ_GQ, OFF_GD = OFF_GVT + SZ_HVT, SZ_S = OFF_GD + SZ_GD;
constexpr size_t OFF_XP = 0, SZ_XP = (size_t)NROW * D * 4;
constexpr size_t OFF_IDX = OFF_XP + SZ_XP, SZ_IDX = (size_t)NROW * 128 * 4;
constexpr size_t OFF_GATE = OFF_IDX + SZ_IDX;
constexpr size_t OFF_PU = OFF_GATE + SZ_IDX, SZ_PU = (size_t)16384 * D * 2;
constexpr size_t OFF_PV = OFF_PU + SZ_PU;
constexpr size_t OFF_PSC = OFF_PV + SZ_PU;
static_assert(OFF_PSC + 2 * 16384 * 4 <= SZ_S, "alias overflow");
constexpr size_t PT_U = 0, PT_V = (size_t)16384 * D, PT_SC = 2 * (size_t)16384 * D, SZ_PT = PT_SC + 2 * 16384 * 4;

DI int otid() { int t = threadIdx.x; asm volatile("" : "+v"(t)); return t; }
DI int obid() { int t = blockIdx.x; asm volatile("" : "+s"(t)); return t; }
DI float bf2f(u16 h) { return __uint_as_float(((u32)h) << 16); }
DI u16 f2bf(float x) { return __builtin_bit_cast(u16, (__bf16)x); }
typedef __attribute__((ext_vector_type(2))) float f32x2v;
typedef __attribute__((ext_vector_type(2))) __bf16 bf16x2v;
DI u32 pack2(float a, float b) { f32x2v v = {a, b}; return __builtin_bit_cast(u32, __builtin_convertvector(v, bf16x2v)); }
DI float wave_sum(float v) {
#pragma unroll
  for (int o = 32; o > 0; o >>= 1) v += __shfl_xor(v, o);
  return v;
}
DI int crow(int i, int h) { return (i & 3) + 8 * (i >> 2) + 4 * h; }
DI int perm16(int k) {
  int kk = k & 15;
  return (k & ~15) | (((kk >> 2) & 1) << 3) | ((kk >> 3) << 2) | (kk & 3);
}
DI bf16x8 pack_frag(const f32x16& x, int s) {
  union { bf16x8 v; u32 u[4]; } r;
#pragma unroll
  for (int j = 0; j < 4; j++) r.u[j] = pack2(x[8 * s + 2 * j], x[8 * s + 2 * j + 1]);
  return r.v;
}
#define MFMA32(a, b, c) __builtin_amdgcn_mfma_f32_32x32x16_bf16((a), (b), (c), 0, 0, 0)

DI const float* ada_ptr(const Params& p, int layer, int r, int j) { return p.ada + ((size_t)(layer * 5 + r) * 6 + j) * D; }
DI int row_batch(int r) { return r < NLAT ? (r >> 13) : 4; }

DI void weight_convert(const Params& p, int l, int vbid, int vgrid) {
  const size_t gtid = (size_t)vbid * 256 + otid(), gsz = (size_t)vgrid * 256;
  for (size_t i = gtid; i < (size_t)128 * DINP; i += gsz) {
    int n = i % DINP; int k8 = i / DINP;
    u32 o[4] = {0, 0, 0, 0};
    if (n < DIN) {
      const float* s = p.w_in + ((size_t)l * D + k8 * 8) * DIN + n;
#pragma unroll
      for (int j = 0; j < 4; j++) o[j] = pack2(s[(size_t)(2 * j) * DIN], s[(size_t)(2 * j + 1) * DIN]);
    }
    *(uint4*)(p.wt_in + ((size_t)l * DINP + n) * D + k8 * 8) = make_uint4(o[0], o[1], o[2], o[3]);
  }
  for (size_t i = gtid; i < (size_t)128 * 1024; i += gsz) {
    int n = i & 1023; int k8 = i >> 10;
    const float* s = p.w_out + ((size_t)l * D + k8 * 8) * D + n;
    u32 o[4];
#pragma unroll
    for (int j = 0; j < 4; j++) o[j] = pack2(s[(size_t)(2 * j) * D], s[(size_t)(2 * j + 1) * D]);
    *(uint4*)(p.wt_out + ((size_t)l * D + n) * D + k8 * 8) = make_uint4(o[0], o[1], o[2], o[3]);
  }
  for (size_t i = gtid; i < (size_t)128 * 2048; i += gsz) {
    int n = i & 2047; int k8 = i >> 11;
    const float* s = p.wq + ((size_t)l * D + k8 * 8) * 2048 + n;
    u32 o[4];
#pragma unroll
    for (int j = 0; j < 4; j++) o[j] = pack2(s[(size_t)(2 * j) * 2048], s[(size_t)(2 * j + 1) * 2048]);
    *(uint4*)(p.wt_q + ((size_t)l * 2048 + n) * D + k8 * 8) = make_uint4(o[0], o[1], o[2], o[3]);
  }
}

DI void phase0(const Params& p, float* lds) {
  for (int it = obid(); it < 768; it += gridDim.x) {
    int kp = it & 7, nb = (it >> 3) % 24, l = it / 192;
    __syncthreads();
    for (int i = otid(); i < 640; i += 256) {
      int r = i >> 7, k = i & 127;
      float v = (r < 4) ? p.c[r * D + kp * 128 + k] : p.c_ctx[kp * 128 + k];
      lds[i] = v / (1.f + __expf(-v));
    }
    __syncthreads();
    int n = nb * 256 + otid();
    const float* w = p.w_ada + ((size_t)l * D + kp * 128) * 6144 + n;
    float a0 = 0, a1 = 0, a2 = 0, a3 = 0, a4 = 0;
#pragma unroll 8
    for (int k = 0; k < 128; k++) {
      float wv = w[(size_t)k * 6144];
      a0 += lds[k] * wv; a1 += lds[128 + k] * wv; a2 += lds[256 + k] * wv; a3 += lds[384 + k] * wv; a4 += lds[512 + k] * wv;
    }
    float* o = p.ada_part + ((size_t)(kp * 4 + l) * 5) * 6144 + n;
    o[0] = a0; o[6144] = a1; o[2 * 6144] = a2; o[3 * 6144] = a3; o[4 * 6144] = a4;
  }
  weight_convert(p, 0, obid(), gridDim.x);
  const size_t gtid = (size_t)obid() * 256 + otid(), gsz = (size_t)gridDim.x * 256;
  for (size_t i = gtid; i < (size_t)4 * 2 * 128 * 128; i += gsz) p.keysb[i] = f2bf(p.sub_keys[i]);
}

DI void phase0b(const Params& p) {
  const size_t gtid = (size_t)obid() * 256 + otid(), gsz = (size_t)gridDim.x * 256;
  for (size_t i = gtid; i < (size_t)4 * 5 * 6144; i += gsz) {
    int n = i % 6144; int l = i / (5 * 6144);
    float a = p.b_ada[l * 6144 + n];
#pragma unroll
    for (int kp = 0; kp < 8; kp++) a += p.ada_part[(size_t)kp * 4 * 5 * 6144 + i];
    p.ada[i] = a;
  }
}

DI void peer_convert(const Params& p, int layer, int vbid, int vgrid) {
  const int tid = otid(), wave = tid >> 6, lane = tid & 63;
  unsigned char* du = (unsigned char*)(p.PT + PT_U);
  unsigned char* dv = (unsigned char*)(p.PT + PT_V);
  float* su = (float*)(p.PT + PT_SC);
  for (int it = vbid * 4 + wave; it < 2 * 16384; it += vgrid * 4) {
    const int tbl = it >> 14, e = it & 16383;
    const float* src = (tbl ? p.peer_v : p.peer_u) + ((size_t)layer * 16384 + e) * D + lane * 16;
    float4 a = *(const float4*)(src), b = *(const float4*)(src + 4), c = *(const float4*)(src + 8), d = *(const float4*)(src + 12);
    float m = fmaxf(fmaxf(fmaxf(fabsf(a.x), fabsf(a.y)), fmaxf(fabsf(a.z), fabsf(a.w))), fmaxf(fmaxf(fabsf(b.x), fabsf(b.y)), fmaxf(fabsf(b.z), fabsf(b.w))));
    m = fmaxf(m, fmaxf(fmaxf(fmaxf(fabsf(c.x), fabsf(c.y)), fmaxf(fabsf(c.z), fabsf(c.w))), fmaxf(fmaxf(fabsf(d.x), fabsf(d.y)), fmaxf(fabsf(d.z), fabsf(d.w)))));
#pragma unroll
    for (int o = 32; o > 0; o >>= 1) m = fmaxf(m, __shfl_xor(m, o));
    m = fmaxf(m, 1e-30f);
    const float sc = 224.f / m;
    int w0 = __builtin_amdgcn_cvt_pk_fp8_f32(a.x * sc, a.y * sc, 0, false); w0 = __builtin_amdgcn_cvt_pk_fp8_f32(a.z * sc, a.w * sc, w0, true);
    int w1 = __builtin_amdgcn_cvt_pk_fp8_f32(b.x * sc, b.y * sc, 0, false); w1 = __builtin_amdgcn_cvt_pk_fp8_f32(b.z * sc, b.w * sc, w1, true);
    int w2 = __builtin_amdgcn_cvt_pk_fp8_f32(c.x * sc, c.y * sc, 0, false); w2 = __builtin_amdgcn_cvt_pk_fp8_f32(c.z * sc, c.w * sc, w2, true);
    int w3 = __builtin_amdgcn_cvt_pk_fp8_f32(d.x * sc, d.y * sc, 0, false); w3 = __builtin_amdgcn_cvt_pk_fp8_f32(d.z * sc, d.w * sc, w3, true);
    if (tbl == 0) *(int4*)(du + (size_t)e * D + lane * 16) = make_int4(w0, w1, w2, w3);
    else *(int4*)(dv + ((size_t)(lane >> 3) * 16384 + e) * 128 + (lane & 7) * 16) = make_int4(w0, w1, w2, w3);
    if (lane == 0) su[it] = m * (1.f / 224.f);
  }
}

template <int MODE>
DI void lnmod_phase(const Params& p, int layer, int nrows) {
  const int wave = otid() >> 6, lane = otid() & 63;
  const float* XP = (const float*)(p.S + OFF_XP);
  for (int r = obid() * 4 + wave; r < nrows; r += gridDim.x * 4) {
    const float* src;
    if (MODE == 0) src = (r < NLAT) ? p.x + (size_t)r * D : p.ctx + (size_t)(r - NLAT) * D;
    else src = XP + (size_t)r * D;
    const int b = row_batch(r);
    float4 v[4];
#pragma unroll
    for (int c = 0; c < 4; c++) v[c] = *(const float4*)(src + c * 256 + lane * 4);
    float s = 0;
#pragma unroll
    for (int c = 0; c < 4; c++) s += v[c].x + v[c].y + v[c].z + v[c].w;
    float mu = wave_sum(s) * (1.f / D);
    float q = 0;
#pragma unroll
    for (int c = 0; c < 4; c++) {
      v[c].x -= mu; v[c].y -= mu; v[c].z -= mu; v[c].w -= mu;
      q += v[c].x * v[c].x + v[c].y * v[c].y + v[c].z * v[c].z + v[c].w * v[c].w;
    }
    float rstd = rsqrtf(wave_sum(q) * (1.f / D) + EPS);
    if (MODE == 1) {
      const float* gm = p.ln_gamma + (size_t)(layer * 2 + 0) * D;
      const float* bt = p.ln_beta + (size_t)(layer * 2 + 0) * D;
      float s2 = 0;
#pragma unroll
      for (int c = 0; c < 4; c++) {
        int col = c * 256 + lane * 4;
        float4 g = *(const float4*)(gm + col), be = *(const float4*)(bt + col);
        v[c].x = v[c].x * rstd * g.x + be.x; v[c].y = v[c].y * rstd * g.y + be.y;
        v[c].z = v[c].z * rstd * g.z + be.z; v[c].w = v[c].w * rstd * g.w + be.w;
        s2 += v[c].x + v[c].y + v[c].z + v[c].w;
      }
      float mu2 = wave_sum(s2) * (1.f / D);
      float q2 = 0;
#pragma unroll
      for (int c = 0; c < 4; c++) {
        v[c].x -= mu2; v[c].y -= mu2; v[c].z -= mu2; v[c].w -= mu2;
        q2 += v[c].x * v[c].x + v[c].y * v[c].y + v[c].z * v[c].z + v[c].w * v[c].w;
      }
      rstd = rsqrtf(wave_sum(q2) * (1.f / D) + EPS);
    }
    const float* sh = ada_ptr(p, layer, b, MODE == 0 ? 0 : 3);
    const float* sc = ada_ptr(p, layer, b, MODE == 0 ? 1 : 4);
#pragma unroll
    for (int c = 0; c < 4; c++) {
      int col = c * 256 + lane * 4;
      float4 a = *(const float4*)(sh + col), m = *(const float4*)(sc + col);
      float y0 = v[c].x * rstd * (1.f + m.x) + a.x, y1 = v[c].y * rstd * (1.f + m.y) + a.y;
      float y2 = v[c].z * rstd * (1.f + m.z) + a.z, y3 = v[c].w * rstd * (1.f + m.w) + a.w;
      *(uint2*)(p.H + (size_t)r * D + col) = make_uint2(pack2(y0, y1), pack2(y2, y3));
    }
  }
}

constexpr int LDS_STRIDE = 72;
constexpr int CT_STRIDE = 132;
template <int MODE>
DI void gemm_store(const Params& p, int layer, int row, int nt, int n0, int c4, const float4 v, const bool dry) {
  if (MODE == 0) {
          u16* dst;
          if (nt >= 16 && nt < 20) dst = p.G + (size_t)row * D + (n0 - 2048) + c4;
          else if (nt >= 28 && nt < 32) dst = p.G + (size_t)row * D + (n0 - 3584 + 512) + c4;
          else dst = p.U + (size_t)row * DIN + n0 + c4;
          if (dry) dst = (u16*)p.S + (size_t)row * DIN + n0 + c4;
          if (n0 + c4 < DIN) *(uint2*)dst = make_uint2(pack2(v.x, v.y), pack2(v.z, v.w));
        } else if (MODE == 1) {
          float* XP = dry ? (float*)p.U : (float*)(p.S + OFF_XP);
          const float* xo = (layer == 0) ? ((row < NLAT) ? p.x + (size_t)row * D : p.ctx + (size_t)(row - NLAT) * D) : p.X + (size_t)row * D;
          const float4 xv = *(const float4*)(xo + n0 + c4);
          const float4 g1 = *(const float4*)(ada_ptr(p, layer, row_batch(row), 2) + n0 + c4);
          *(float4*)(XP + (size_t)row * D + n0 + c4) =
              make_float4(ALPHA * xv.x + g1.x * v.x, ALPHA * xv.y + g1.y * v.y, ALPHA * xv.z + g1.z * v.z, ALPHA * xv.w + g1.w * v.w);
        } else {
          *(uint2*)((dry ? (u16*)(p.S + OFF_PU) : p.U) + (size_t)row * 2048 + n0 + c4) = make_uint2(pack2(v.x, v.y), pack2(v.z, v.w));
        }
}

template <int MODE>
DI void gemm_phase(const Params& p, int layer, char* smem, const u16* A, const u16* Bt, int Mtiles, int Ntiles, const bool dry) {
  u16* As = (u16*)smem;
  u16* Bs = (u16*)smem + 256 * LDS_STRIDE;
  float* Ct = (float*)smem;
  const int tid = otid(), wave = tid >> 6, lane = tid & 63, r = lane & 31, h = lane >> 5;
  const int wm = wave >> 1, wn = wave & 1;
  const int srow = tid >> 3, sc8 = (tid & 7) * 8;
  const int bid = obid(), xcd = bid & 7, jx = bid >> 3, wpx = (gridDim.x + 7 - xcd) >> 3;
  const int ntiles = Mtiles * Ntiles, nchunks = (ntiles + 63) >> 6;
  for (int ch = xcd; ch < nchunks; ch += 8)
  for (int jj = jx; jj < 64; jj += wpx) {
    const int L = ch * 64 + jj;
    if (L >= ntiles) continue;
    const int mt = (L / (4 * Ntiles)) * 4 + (L & 3), nt = (L >> 2) % Ntiles;
    const u16* Ag = A + ((size_t)mt * 256 + srow) * D + sc8;
    const u16* Bg = Bt + ((size_t)nt * 128 + srow) * D + sc8;
    f32x16 acc[4][2];
#pragma unroll
    for (int i = 0; i < 4; i++)
#pragma unroll
      for (int j = 0; j < 2; j++)
#pragma unroll
        for (int e = 0; e < 16; e++) acc[i][j][e] = 0.f;
    bf16x8 ra0, ra1, ra2, ra3, ra4, ra5, ra6, ra7, rb0, rb1, rb2, rb3;
#define GLOAD(kt_) { const u16* ag = Ag + (kt_) * 64; const u16* bg = Bg + (kt_) * 64; \
      ra0 = *(const bf16x8*)(ag); ra1 = *(const bf16x8*)(ag + 32 * D); ra2 = *(const bf16x8*)(ag + 64 * D); ra3 = *(const bf16x8*)(ag + 96 * D); \
      ra4 = *(const bf16x8*)(ag + 128 * D); ra5 = *(const bf16x8*)(ag + 160 * D); ra6 = *(const bf16x8*)(ag + 192 * D); ra7 = *(const bf16x8*)(ag + 224 * D); \
      rb0 = *(const bf16x8*)(bg); rb1 = *(const bf16x8*)(bg + 32 * D); rb2 = *(const bf16x8*)(bg + 64 * D); rb3 = *(const bf16x8*)(bg + 96 * D); }
#define LSTORE() { u16* ad = As + srow * LDS_STRIDE + sc8; u16* bd = Bs + srow * LDS_STRIDE + sc8; \
      *(bf16x8*)(ad) = ra0; *(bf16x8*)(ad + 32 * LDS_STRIDE) = ra1; *(bf16x8*)(ad + 64 * LDS_STRIDE) = ra2; *(bf16x8*)(ad + 96 * LDS_STRIDE) = ra3; \
      *(bf16x8*)(ad + 128 * LDS_STRIDE) = ra4; *(bf16x8*)(ad + 160 * LDS_STRIDE) = ra5; *(bf16x8*)(ad + 192 * LDS_STRIDE) = ra6; *(bf16x8*)(ad + 224 * LDS_STRIDE) = ra7; \
      *(bf16x8*)(bd) = rb0; *(bf16x8*)(bd + 32 * LDS_STRIDE) = rb1; *(bf16x8*)(bd + 64 * LDS_STRIDE) = rb2; *(bf16x8*)(bd + 96 * LDS_STRIDE) = rb3; }
    GLOAD(0)
    __syncthreads();
    LSTORE()
    __syncthreads();
#pragma unroll 1
    for (int kt = 0; kt < 16; kt++) {
      if (kt + 1 < 16 && !(dry && DRYVAR == 1)) GLOAD(kt + 1)
      const u16* as = As + (wm * 128 + r) * LDS_STRIDE + h * 8;
      const u16* bs = Bs + (wn * 64 + r) * LDS_STRIDE + h * 8;
      if (!(dry && DRYVAR == 2)) {
        bf16x8 af[2][4], b0, b1;
#pragma unroll
        for (int i = 0; i < 4; i++) af[0][i] = *(const bf16x8*)(as + i * 32 * LDS_STRIDE);
        b0 = *(const bf16x8*)(bs); b1 = *(const bf16x8*)(bs + 32 * LDS_STRIDE);
#pragma unroll
        for (int kk = 0; kk < 4; kk++) {
          const int cur = kk & 1, nxt = cur ^ 1;
          if (kk < 3) {
#pragma unroll
            for (int i = 0; i < 4; i++) af[nxt][i] = *(const bf16x8*)(as + i * 32 * LDS_STRIDE + (kk + 1) * 16);
          }
          __builtin_amdgcn_s_setprio(1);
#pragma unroll
          for (int i = 0; i < 4; i++) acc[i][0] = MFMA32(af[cur][i], b0, acc[i][0]);
          if (kk < 3) b0 = *(const bf16x8*)(bs + (kk + 1) * 16);
#pragma unroll
          for (int i = 0; i < 4; i++) acc[i][1] = MFMA32(af[cur][i], b1, acc[i][1]);
          if (kk < 3) b1 = *(const bf16x8*)(bs + 32 * LDS_STRIDE + (kk + 1) * 16);
          __builtin_amdgcn_s_setprio(0);
        }
      }
      __syncthreads();
      if (kt + 1 < 16 && !(dry && DRYVAR == 1)) LSTORE()
      __syncthreads();
    }
#undef GLOAD
#undef LSTORE
    const int m0 = mt * 256, n0 = nt * 128;
    const int c4 = (tid & 31) * 4, rr0 = tid >> 5;
#pragma unroll
    for (int ph = 0; ph < 2; ph++) {
      if (ph) __syncthreads();
#pragma unroll
      for (int ii = 0; ii < 2; ii++)
#pragma unroll
        for (int j = 0; j < 2; j++)
#pragma unroll
          for (int e = 0; e < 16; e++) Ct[(wm * 64 + ii * 32 + crow(e, h)) * CT_STRIDE + wn * 64 + j * 32 + r] = acc[ph * 2 + ii][j][e];
      __syncthreads();
#pragma unroll 2
      for (int q = 0; q < 16; q++) {
        const int rl = rr0 + q * 8, row = m0 + (rl >> 6) * 128 + ph * 64 + (rl & 63);
        const float4 v = *(const float4*)(Ct + rl * CT_STRIDE + c4);
        gemm_store<MODE>(p, layer, row, nt, n0, c4, v, dry);
      }
    }
  }
}

template <int MODE>
DI void gemm_thin(const Params& p, int layer, char* smem, const u16* A, const u16* Bt, int row0, int Mtiles, int Ntiles, const bool dry) {
  u16* As = (u16*)smem;
  u16* Bs = (u16*)smem + 64 * LDS_STRIDE;
  float* Ct = (float*)smem;
  const int tid = otid(), wave = tid >> 6, lane = tid & 63, r = lane & 31, h = lane >> 5;
  const int wm = wave >> 1, wn = wave & 1;
  const int srow = tid >> 3, sc8 = (tid & 7) * 8;
  const int ntiles = Mtiles * Ntiles;
  for (int L = obid(); L < ntiles; L += gridDim.x) {
    const int mt = L / Ntiles, nt = L % Ntiles;
    const u16* Ag = A + ((size_t)row0 + mt * 64 + srow) * D + sc8;
    const u16* Bg = Bt + ((size_t)nt * 128 + srow) * D + sc8;
    f32x16 acc0, acc1;
#pragma unroll
    for (int e = 0; e < 16; e++) { acc0[e] = 0.f; acc1[e] = 0.f; }
    bf16x8 ra0, ra1, rb0, rb1, rb2, rb3;
#define GLOADT(kt_) { const u16* ag = Ag + (kt_) * 64; const u16* bg = Bg + (kt_) * 64; \
      ra0 = *(const bf16x8*)(ag); ra1 = *(const bf16x8*)(ag + 32 * D); \
      rb0 = *(const bf16x8*)(bg); rb1 = *(const bf16x8*)(bg + 32 * D); rb2 = *(const bf16x8*)(bg + 64 * D); rb3 = *(const bf16x8*)(bg + 96 * D); }
#define LSTORET() { u16* ad = As + srow * LDS_STRIDE + sc8; u16* bd = Bs + srow * LDS_STRIDE + sc8; \
      *(bf16x8*)(ad) = ra0; *(bf16x8*)(ad + 32 * LDS_STRIDE) = ra1; \
      *(bf16x8*)(bd) = rb0; *(bf16x8*)(bd + 32 * LDS_STRIDE) = rb1; *(bf16x8*)(bd + 64 * LDS_STRIDE) = rb2; *(bf16x8*)(bd + 96 * LDS_STRIDE) = rb3; }
    GLOADT(0)
    __syncthreads();
    LSTORET()
    __syncthreads();
#pragma unroll 1
    for (int kt = 0; kt < 16; kt++) {
      if (kt + 1 < 16) GLOADT(kt + 1)
      const u16* as = As + (wm * 32 + r) * LDS_STRIDE + h * 8;
      const u16* bs = Bs + (wn * 64 + r) * LDS_STRIDE + h * 8;
#pragma unroll
      for (int kk = 0; kk < 4; kk++) {
        const bf16x8 af = *(const bf16x8*)(as + kk * 16);
        const bf16x8 bf0 = *(const bf16x8*)(bs + kk * 16), bf1 = *(const bf16x8*)(bs + 32 * LDS_STRIDE + kk * 16);
        acc0 = MFMA32(af, bf0, acc0);
        acc1 = MFMA32(af, bf1, acc1);
      }
      __syncthreads();
      if (kt + 1 < 16) LSTORET()
      __syncthreads();
    }
#undef GLOADT
#undef LSTORET
#pragma unroll
    for (int e = 0; e < 16; e++) {
      Ct[(wm * 32 + crow(e, h)) * CT_STRIDE + wn * 64 + r] = acc0[e];
      Ct[(wm * 32 + crow(e, h)) * CT_STRIDE + wn * 64 + 32 + r] = acc1[e];
    }
    __syncthreads();
    const int n0 = nt * 128, c4 = (tid & 31) * 4, rr0 = tid >> 5;
#pragma unroll 2
    for (int q = 0; q < 8; q++) {
      const int rl = rr0 + q * 8, row = row0 + mt * 64 + rl;
      const float4 v = *(const float4*)(Ct + rl * CT_STRIDE + c4);
      gemm_store<MODE>(p, layer, row, nt, n0, c4, v, dry);
    }
  }
}

DI int tokrow(int grp, int b, int pos) {
  if (pos < CTX) return NLAT + b * CTX + pos;
  int pp = pos - CTX;
  return b * SEQ + (grp == 0 ? pp : ((pp & 127) * 64 + (pp >> 7)));
}
DI float log_sigmoid(float z) { return fminf(z, 0.f) - __logf(1.f + __expf(-fabsf(z))); }

template <int DK, int DIR>
DI void prep_k(const Params& p, int layer, int grp, int hb, int blk, int cgi) {
  constexpr int CH = DK / 32;
  const int b = hb >> 2, head = hb & 3, k0 = cgi * CH;
  float lb[CH], log_lb[CH], l1m[CH], wg[CH][16], bias[CH], bacc[CH];
#pragma unroll
  for (int c = 0; c < CH; c++) {
    bacc[c] = 0.f; lb[c] = 0.f; log_lb[c] = 0.f; l1m[c] = 0.f; bias[c] = 0.f;
    if (DK == 128) {
      const float* lbp = p.hg_lb + (size_t)DIR * DEPTH * 512 + head * 128 + k0 + c;
      float e0 = lbp[0], e1 = lbp[512], e2 = lbp[1024], e3 = lbp[1536];
      const float mx = fmaxf(fmaxf(e0, e1), fmaxf(e2, e3));
      e0 = __expf(e0 - mx); e1 = __expf(e1 - mx); e2 = __expf(e2 - mx); e3 = __expf(e3 - mx);
      const float inv = 1.f / (e0 + e1 + e2 + e3);
      float cs = 0.f;
      if (layer >= 1) cs += e1 * inv;
      if (layer >= 2) cs += e2 * inv;
      if (layer >= 3) cs += e3 * inv;
      lb[c] = fminf(fmaxf(cs, 0.f), 1.f - 1e-6f);
      log_lb[c] = __logf(fmaxf(lb[c], 1e-30f));
      l1m[c] = __logf(1.f - lb[c]);
    } else {
#pragma unroll
      for (int rr = 0; rr < 16; rr++) wg[c][rr] = p.w_gk2[((size_t)(layer * 2 + DIR) * 16 + rr) * 256 + head * 64 + k0 + c];
      bias[c] = p.b_gk[(size_t)(layer * 2 + DIR) * 256 + head * 64 + k0 + c];
    }
  }
  const size_t chain = (size_t)DIR * 16 + hb;
  const int pk0 = perm16(k0);
  u16* Qd = (u16*)(p.S + (DK == 128 ? OFF_HQ : OFF_GQ)) + (chain * LPOS + (size_t)blk * 32) * DK + pk0;
  u16* Kd = (u16*)(p.S + (DK == 128 ? OFF_HK : OFF_GK)) + (chain * LPOS + (size_t)blk * 32) * DK + pk0;
  u16* KTd = (u16*)(p.S + (DK == 128 ? OFF_HKT : OFF_GKT)) + ((chain * NBLK + blk) * DK + k0) * 32;
#pragma unroll 1
  for (int s2 = 0; s2 < 2; s2++) {
    const int tg = DIR ? 1 - s2 : s2;
    u16 kt[CH][16];
#pragma unroll
    for (int j2 = 0; j2 < 16; j2++) {
      const int t16 = DIR ? 15 - j2 : j2;
      const int t = tg * 16 + t16;
      const u16* urow = p.U + (size_t)tokrow(grp, b, blk * 32 + t) * DIN;
      float qv[CH], kv[CH], la[CH];
      if (DK == 128) {
        const uint2 zz = *(const uint2*)(urow + 512 * (1 + DIR) + head * 128 + k0);
        const uint2 qq = *(const uint2*)(urow + head * 128 + k0);
        const u32 zw[2] = {zz.x, zz.y}, qw[2] = {qq.x, qq.y};
#pragma unroll
        for (int c = 0; c < CH; c++) {
          const float z = (c & 1) ? __uint_as_float(zw[c >> 1] & 0xffff0000u) : __uint_as_float(zw[c >> 1] << 16);
          qv[c] = (c & 1) ? __uint_as_float(qw[c >> 1] & 0xffff0000u) : __uint_as_float(qw[c >> 1] << 16);
          const float ez = __expf(-fabsf(z));
          const float rc = __frcp_rn(1.f + ez);
          const float sp = (z < 0.f) ? ez * rc : rc;
          const float sn = (z < 0.f) ? rc : ez * rc;
          la[c] = __logf(fmaxf(lb[c], 1e-30f) + (1.f - lb[c]) * sp);
          kv[c] = (1.f - lb[c]) * sn;
        }
      } else {
        const u32 qq = *(const u32*)(urow + 2560 + head * 64 + k0);
        const u32 kq = *(const u32*)(urow + 2816 + head * 64 + k0);
        const uint4* gr = (const uint4*)(urow + 4096 + DIR * 16);
        const uint4 g0 = gr[0], g1 = gr[1];
        const u32 gw[8] = {g0.x, g0.y, g0.z, g0.w, g1.x, g1.y, g1.z, g1.w};
#pragma unroll
        for (int c = 0; c < CH; c++) {
          qv[c] = ((c & 1) ? __uint_as_float(qq & 0xffff0000u) : __uint_as_float(qq << 16)) * 0.125f;
          kv[c] = (c & 1) ? __uint_as_float(kq & 0xffff0000u) : __uint_as_float(kq << 16);
          float d = bias[c];
#pragma unroll
          for (int rr = 0; rr < 8; rr++)
            d += __uint_as_float(gw[rr] << 16) * wg[c][2 * rr] + __uint_as_float(gw[rr] & 0xffff0000u) * wg[c][2 * rr + 1];
          la[c] = (fminf(d, 0.f) - __logf(1.f + __expf(-fabsf(d)))) * (1.f / 16.f);
        }
      }
      float qo[CH], ko[CH];
#pragma unroll
      for (int c = 0; c < CH; c++) {
        bacc[c] += la[c];
        const float eb = __expf(bacc[c]);
        qo[c] = qv[c] * eb;
        ko[c] = kv[c] * __expf(-bacc[c]);
        kt[c][perm16(t16)] = f2bf(ko[c]);
      }
      if (CH == 4) {
        *(uint2*)(Qd + (size_t)t * DK) = make_uint2(pack2(qo[0], qo[1]), pack2(qo[2], qo[3]));
        *(uint2*)(Kd + (size_t)t * DK) = make_uint2(pack2(ko[0], ko[1]), pack2(ko[2], ko[3]));
      } else {
        *(u32*)(Qd + (size_t)t * DK) = pack2(qo[0], qo[1]);
        *(u32*)(Kd + (size_t)t * DK) = pack2(ko[0], ko[1]);
      }
    }
#pragma unroll
    for (int c = 0; c < CH; c++) {
      u16* dst = KTd + c * 32 + tg * 16;
#pragma unroll
      for (int q8 = 0; q8 < 2; q8++) {
        uint4 o;
        o.x = (u32)kt[c][q8 * 8 + 0] | ((u32)kt[c][q8 * 8 + 1] << 16); o.y = (u32)kt[c][q8 * 8 + 2] | ((u32)kt[c][q8 * 8 + 3] << 16);
        o.z = (u32)kt[c][q8 * 8 + 4] | ((u32)kt[c][q8 * 8 + 5] << 16); o.w = (u32)kt[c][q8 * 8 + 6] | ((u32)kt[c][q8 * 8 + 7] << 16);
        *(uint4*)(dst + q8 * 8) = o;
      }
    }
  }
  float* Dd = (float*)(p.S + (DK == 128 ? OFF_HD : OFF_GD)) + (chain * NBLK + blk) * DK + k0;
#pragma unroll
  for (int c = 0; c < CH; c++) Dd[c] = __expf(bacc[c]);
}

DI void prep_phase(const Params& p, int layer) {
  const int tid = otid();
  for (int it = obid(); it < 2 * 16 * (NBLK / 4); it += gridDim.x) {
    const int bg = it % (NBLK / 4), hb = (it / (NBLK / 4)) & 15, grp = it / ((NBLK / 4) * 16);
    const int b = hb >> 2, head = hb & 3;
    {
      const int dir = tid >> 7, blk = bg * 4 + ((tid >> 5) & 3), cgi = tid & 31;
      if (grp == 0) {
        if (dir == 0) prep_k<128, 0>(p, layer, 0, hb, blk, cgi);
        else prep_k<128, 1>(p, layer, 0, hb, blk, cgi);
      } else {
        if (dir == 0) prep_k<64, 0>(p, layer, 1, hb, blk, cgi);
        else prep_k<64, 1>(p, layer, 1, hb, blk, cgi);
      }
    }
    {
      const int vg = tid & 31, tg = tid >> 5;
      const int col = (grp == 0 ? 1536 : 3072) + head * 128 + vg * 4;
      const int pos0 = bg * 128 + tg * 16;
      u16 vt[4][16];
#pragma unroll
      for (int t = 0; t < 16; t++) {
        const uint2 vv = *(const uint2*)(p.U + (size_t)tokrow(grp, b, pos0 + t) * DIN + col);
        vt[0][perm16(t)] = (u16)(vv.x & 0xffffu); vt[1][perm16(t)] = (u16)(vv.x >> 16);
        vt[2][perm16(t)] = (u16)(vv.y & 0xffffu); vt[3][perm16(t)] = (u16)(vv.y >> 16);
      }
#pragma unroll
      for (int c = 0; c < 4; c++) {
        u16* dst = (u16*)(p.S + (grp == 0 ? OFF_HVT : OFF_GVT)) + (((size_t)hb * NBLK + (pos0 >> 5)) * 128 + vg * 4 + c) * 32 + (pos0 & 31);
#pragma unroll
        for (int q8 = 0; q8 < 2; q8++) {
          uint4 o;
          o.x = (u32)vt[c][q8 * 8 + 0] | ((u32)vt[c][q8 * 8 + 1] << 16); o.y = (u32)vt[c][q8 * 8 + 2] | ((u32)vt[c][q8 * 8 + 3] << 16);
          o.z = (u32)vt[c][q8 * 8 + 4] | ((u32)vt[c][q8 * 8 + 5] << 16); o.w = (u32)vt[c][q8 * 8 + 6] | ((u32)vt[c][q8 * 8 + 7] << 16);
          *(uint4*)(dst + q8 * 8) = o;
        }
      }
    }
  }
}

template <int DK>
DI void scan_wg(const Params& p, char* smem, int grp, int dir, int hb) {
  constexpr int NT = DK / 32, NF = DK / 16;
  constexpr int QS = DK + 8;
  constexpr int KTS = 40;
  constexpr int OFF_K = 32 * QS * 2, OFF_KT = 2 * 32 * QS * 2, OFF_D = OFF_KT + DK * KTS * 2, BUFB = OFF_D + DK * 4;
  constexpr int QN = DK / 64;
  constexpr int CPR = DK / 8;
  static_assert(2 * BUFB <= LDS_BYTES, "scan LDS");
  const int tid = otid(), vs = tid >> 6, lane = tid & 63, r = lane & 31, h = lane >> 5;
  const int b = hb >> 2, head = hb & 3;
  const size_t chain = (size_t)dir * 16 + hb;
  const u16* Qb = (const u16*)(p.S + (DK == 128 ? OFF_HQ : OFF_GQ)) + chain * LPOS * DK;
  const u16* Kb = (const u16*)(p.S + (DK == 128 ? OFF_HK : OFF_GK)) + chain * LPOS * DK;
  const u16* KTb = (const u16*)(p.S + (DK == 128 ? OFF_HKT : OFF_GKT)) + chain * NBLK * DK * 32;
  const u16* VTb = (const u16*)(p.S + (DK == 128 ? OFF_HVT : OFF_GVT)) + (size_t)hb * NBLK * 128 * 32 + (vs * 32 + r) * 32 + h * 8;
  const float* Db = (const float*)(p.S + (DK == 128 ? OFF_HD : OFF_GD)) + chain * NBLK * DK;
  u16* Ob = p.U + (size_t)dir * NROW * D + grp * 512 + head * 128 + vs * 32;
  f32x16 S[NT];
#pragma unroll
  for (int kt = 0; kt < NT; kt++)
#pragma unroll
    for (int e = 0; e < 16; e++) S[kt][e] = 0.f;
  bf16x8 sq[QN], sk[QN], skt[QN], vn0, vn1;
  float4 sd = make_float4(0.f, 0.f, 0.f, 0.f);
  auto blk_of = [&](int step) { return dir ? (step < 8 ? 7 - step : 271 - step) : step; };
  auto gload = [&](int step) {
    const size_t pos0 = (size_t)blk_of(step) * 32;
#pragma unroll
    for (int i = 0; i < QN; i++) {
      const int id = tid + i * 256;
      sq[i] = *(const bf16x8*)(Qb + (pos0 + id / CPR) * DK + (id % CPR) * 8);
      sk[i] = *(const bf16x8*)(Kb + (pos0 + id / CPR) * DK + (id % CPR) * 8);
      skt[i] = *(const bf16x8*)(KTb + (size_t)blk_of(step) * DK * 32 + id * 8);
    }
    if (tid < DK / 4) sd = *(const float4*)(Db + (size_t)blk_of(step) * DK + tid * 4);
    vn0 = *(const bf16x8*)(VTb + (size_t)blk_of(step) * 128 * 32);
    vn1 = *(const bf16x8*)(VTb + (size_t)blk_of(step) * 128 * 32 + 16);
  };
  auto lstore = [&](int buf) {
    char* base = smem + buf * BUFB;
#pragma unroll
    for (int i = 0; i < QN; i++) {
      const int id = tid + i * 256;
      *(bf16x8*)(base + ((id / CPR) * QS + (id % CPR) * 8) * 2) = sq[i];
      *(bf16x8*)(base + OFF_K + ((id / CPR) * QS + (id % CPR) * 8) * 2) = sk[i];
      *(bf16x8*)(base + OFF_KT + ((id >> 2) * KTS + (id & 3) * 8) * 2) = skt[i];
    }
    if (tid < DK / 4) *(float4*)(base + OFF_D + tid * 16) = sd;
  };
  __syncthreads();
  gload(0);
  lstore(0);
  bf16x8 vf0 = vn0, vf1 = vn1;
  __syncthreads();
#pragma unroll 1
  for (int step = 0; step < NBLK; step++) {
    const int blk = blk_of(step);
    if (step + 1 < NBLK) gload(step + 1);
    const char* base = smem + (step & 1) * BUFB;
    const u16* Qs = (const u16*)base + r * QS + h * 8;
    const u16* Ks = (const u16*)(base + OFF_K) + r * QS + h * 8;
    const u16* KTs = (const u16*)(base + OFF_KT) + r * KTS + h * 8;
    const float* Ds = (const float*)(base + OFF_D) + 4 * h;
    bf16x8 qf[NF];
    f32x16 P0, P1;
#pragma unroll
    for (int e = 0; e < 16; e++) { P0[e] = 0.f; P1[e] = 0.f; }
#pragma unroll
    for (int f = 0; f < NF; f += 2) {
      qf[f] = *(const bf16x8*)(Qs + f * 16);
      qf[f + 1] = *(const bf16x8*)(Qs + f * 16 + 16);
      P0 = MFMA32(*(const bf16x8*)(Ks + f * 16), qf[f], P0);
      P1 = MFMA32(*(const bf16x8*)(Ks + f * 16 + 16), qf[f + 1], P1);
    }
#pragma unroll
    for (int e = 0; e < 16; e++) {
      const int s = crow(e, h);
      const bool keep = dir ? (s >= r) : (s <= r);
      P0[e] = keep ? P0[e] + P1[e] : 0.f;
    }
    f32x16 oA, oB;
#pragma unroll
    for (int e = 0; e < 16; e++) { oA[e] = 0.f; oB[e] = 0.f; }
    oA = MFMA32(vf0, pack_frag(P0, 0), oA);
    oA = MFMA32(vf1, pack_frag(P0, 1), oA);
#pragma unroll
    for (int kt = 0; kt < NT; kt++) {
      if (kt & 1) {
        oA = MFMA32(pack_frag(S[kt], 0), qf[kt * 2], oA);
        oA = MFMA32(pack_frag(S[kt], 1), qf[kt * 2 + 1], oA);
      } else {
        oB = MFMA32(pack_frag(S[kt], 0), qf[kt * 2], oB);
        oB = MFMA32(pack_frag(S[kt], 1), qf[kt * 2 + 1], oB);
      }
    }
#pragma unroll
    for (int kt = 0; kt < NT; kt++) {
      S[kt] = MFMA32(*(const bf16x8*)(KTs + kt * 32 * KTS), vf0, S[kt]);
      S[kt] = MFMA32(*(const bf16x8*)(KTs + kt * 32 * KTS + 16), vf1, S[kt]);
#pragma unroll
      for (int g = 0; g < 4; g++) {
        const float4 dv = *(const float4*)(Ds + kt * 32 + 8 * g);
        S[kt][4 * g + 0] *= dv.x; S[kt][4 * g + 1] *= dv.y; S[kt][4 * g + 2] *= dv.z; S[kt][4 * g + 3] *= dv.w;
      }
    }
    {
      const int pos0 = blk * 32;
      int rbase, rstride;
      if (pos0 < CTX) { rbase = NLAT + b * CTX + pos0; rstride = 1; }
      else if (grp == 0) { rbase = b * SEQ + pos0 - CTX; rstride = 1; }
      else { const int pp = pos0 - CTX; rbase = b * SEQ + (pp & 127) * 64 + (pp >> 7); rstride = 64; }
      u16* orow = Ob + (size_t)(rbase + r * rstride) * D + 4 * h;
#pragma unroll
      for (int g = 0; g < 4; g++)
        *(uint2*)(orow + 8 * g) = make_uint2(pack2(oA[4 * g] + oB[4 * g], oA[4 * g + 1] + oB[4 * g + 1]),
                                             pack2(oA[4 * g + 2] + oB[4 * g + 2], oA[4 * g + 3] + oB[4 * g + 3]));
    }
    if (step + 1 < NBLK) lstore((step + 1) & 1);
    vf0 = vn0; vf1 = vn1;
    __syncthreads();
  }
}

DI void scan_phase(const Params& p, char* smem, int layer) {
  const int bid = obid(), nscan = gridDim.x > 64 ? 64 : gridDim.x;
  if (bid < nscan) {
    for (int w = bid; w < 64; w += nscan) {
      const int grp = w >> 5, dir = (w >> 4) & 1, hb = w & 15;
      if (grp == 0) scan_wg<128>(p, smem, 0, dir, hb);
      else scan_wg<64>(p, smem, 1, dir, hb);
    }
  }
  if (gridDim.x <= 64 || bid >= 64) {
    const int vbid = gridDim.x <= 64 ? bid : bid - 64, vgrid = gridDim.x <= 64 ? gridDim.x : gridDim.x - 64;
    peer_convert(p, layer, vbid, vgrid);
    if (layer + 1 < DEPTH) weight_convert(p, layer + 1, vbid, vgrid);
  }
}

DI void combine_phase(const Params& p, int layer, int nrows) {
  const int wave = otid() >> 6, lane = otid() & 63;
  const int c0 = lane * 16;
  const float* gain = (c0 < 512 ? p.hg_norm : p.gla_norm) + (size_t)layer * 128 + (c0 & 127);
  float gn[16];
#pragma unroll
  for (int j = 0; j < 16; j++) gn[j] = gain[j];
  for (int r = obid() * 4 + wave; r < nrows; r += gridDim.x * 4) {
    const uint4* of = (const uint4*)(p.U + (size_t)r * D + c0);
    const uint4* ob = (const uint4*)(p.U + (size_t)NROW * D + (size_t)r * D + c0);
    const uint4* gg = (const uint4*)(p.G + (size_t)r * D + c0);
    float o[16], g[16];
#pragma unroll
    for (int c = 0; c < 2; c++) {
      uint4 a = of[c], bq = ob[c], gq = gg[c];
      u32 aw[4] = {a.x, a.y, a.z, a.w}, bw[4] = {bq.x, bq.y, bq.z, bq.w}, gw[4] = {gq.x, gq.y, gq.z, gq.w};
#pragma unroll
      for (int j = 0; j < 4; j++) {
        o[c * 8 + 2 * j] = __uint_as_float(aw[j] << 16) + __uint_as_float(bw[j] << 16);
        o[c * 8 + 2 * j + 1] = __uint_as_float(aw[j] & 0xffff0000u) + __uint_as_float(bw[j] & 0xffff0000u);
        g[c * 8 + 2 * j] = __uint_as_float(gw[j] << 16);
        g[c * 8 + 2 * j + 1] = __uint_as_float(gw[j] & 0xffff0000u);
      }
    }
    float ss = 0;
#pragma unroll
    for (int j = 0; j < 16; j++) ss += o[j] * o[j];
    ss += __shfl_xor(ss, 1); ss += __shfl_xor(ss, 2); ss += __shfl_xor(ss, 4);
    float rs = rsqrtf(ss * (1.f / 128.f) + EPS);
    u32 ow[8];
#pragma unroll
    for (int j = 0; j < 8; j++) {
      float g0 = g[2 * j], g1 = g[2 * j + 1];
      float y0 = o[2 * j] * rs * gn[2 * j] * (g0 / (1.f + __expf(-g0)));
      float y1 = o[2 * j + 1] * rs * gn[2 * j + 1] * (g1 / (1.f + __expf(-g1)));
      ow[j] = pack2(y0, y1);
    }
    uint4* dst = (uint4*)(p.H + (size_t)r * D + c0);
    dst[0] = make_uint4(ow[0], ow[1], ow[2], ow[3]);
    dst[1] = make_uint4(ow[4], ow[5], ow[6], ow[7]);
  }
}

template <bool PAY>
DI void ce(u32& a, u32& b, u32& pa, u32& pb) {
  if (!PAY) { u32 hi = a > b ? a : b, lo = a > b ? b : a; a = hi; b = lo; }
  else { bool c = a >= b; u32 hi = c ? a : b, lo = c ? b : a, ph = c ? pa : pb, pl = c ? pb : pa; a = hi; b = lo; pa = ph; pb = pl; }
}
template <bool PAY>
DI void sort16(u32 (&k)[16], u32 (&q)[16]) {
#pragma unroll
  for (int size = 2; size <= 16; size <<= 1) {
#pragma unroll
    for (int stride = size >> 1; stride > 0; stride >>= 1) {
#pragma unroll
      for (int i = 0; i < 16; i++) {
        int j = i ^ stride;
        if (j > i) {
          if ((i & size) == 0) ce<PAY>(k[i], k[j], q[i], q[j]);
          else ce<PAY>(k[j], k[i], q[j], q[i]);
        }
      }
    }
  }
}
template <bool PAY>
DI void merge16(u32 (&R)[16], u32 (&RP)[16], u32 (&N)[16], u32 (&NP)[16]) {
#pragma unroll
  for (int i = 0; i < 16; i++) {
    bool c = N[15 - i] > R[i];
    R[i] = c ? N[15 - i] : R[i];
    if (PAY) RP[i] = c ? NP[15 - i] : RP[i];
  }
#pragma unroll
  for (int stride = 8; stride > 0; stride >>= 1) {
#pragma unroll
    for (int i = 0; i < 16; i++) {
      int j = i ^ stride;
      if (j > i) ce<PAY>(R[i], R[j], RP[i], RP[j]);
    }
  }
}
DI u32 ord_f(float f) { u32 u = __float_as_uint(f); return (u & 0x80000000u) ? ~u : (u | 0x80000000u); }
DI float unord_f(u32 u) { return __uint_as_float((u & 0x80000000u) ? (u ^ 0x80000000u) : ~u); }

DI void topk_phase(const Params& p, int layer, char* smem, int nrows) {
  const int tid = otid(), wave = tid >> 6, lane = tid & 63, r = lane & 31, h = lane >> 5;
  float* sc = (float*)smem + wave * 4096;
  const u16* Q = p.U;
  const u16* keys = p.keysb + (size_t)layer * 2 * 128 * 128;
  int* IDX = (int*)(p.S + OFF_IDX);
  float* GATE = (float*)(p.S + OFF_GATE);
  const int nunits = (nrows / 64) * 8;
  for (int wu = obid() * 4 + wave; wu < nunits; wu += gridDim.x * 4) {
    const int tok0 = (wu >> 3) * 64, head = wu & 7;
    u32 RA[16], RB[16], dummy[16];
#pragma unroll
    for (int i = 0; i < 16; i++) { RA[i] = 0; RB[i] = 0; dummy[i] = 0; }
    auto do_half = [&](const int half, u32 (&R)[16]) {
      bf16x8 qf[2][8];
#pragma unroll
      for (int nt = 0; nt < 2; nt++) {
        const u16* qp = Q + (size_t)(tok0 + nt * 32 + r) * 2048 + head * 256 + half * 128 + h * 8;
#pragma unroll
        for (int f = 0; f < 8; f++) qf[nt][f] = *(const bf16x8*)(qp + f * 16);
      }
      f32x16 acc0, acc1;
      auto mm = [&](const int kr) {
        const u16* kp = keys + ((size_t)half * 128 + kr * 32 + r) * 128 + h * 8;
#pragma unroll
        for (int e = 0; e < 16; e++) { acc0[e] = 0.f; acc1[e] = 0.f; }
        bf16x8 afk[8];
#pragma unroll
        for (int f = 0; f < 8; f++) afk[f] = *(const bf16x8*)(kp + f * 16);
        __builtin_amdgcn_s_setprio(1);
#pragma unroll
        for (int f = 0; f < 8; f++) {
          acc0 = MFMA32(afk[f], qf[0][f], acc0);
          acc1 = MFMA32(afk[f], qf[1][f], acc1);
        }
        __builtin_amdgcn_s_setprio(0);
      };
      auto put = [&](const int buf) {
        float* d = sc + buf * 2048;
#pragma unroll
        for (int e = 0; e < 16; e++) {
          d[crow(e, h) * 64 + r] = acc0[e];
          d[crow(e, h) * 64 + 32 + r] = acc1[e];
        }
      };
      mm(0);
      put(0);
#pragma unroll
      for (int kr = 0; kr < 4; kr++) {
        if (kr < 3) mm(kr + 1);
        __builtin_amdgcn_wave_barrier();
        const float* sp = sc + (kr & 1) * 2048 + lane;
#pragma unroll
        for (int grp = 0; grp < 2; grp++) {
          u32 N[16];
#pragma unroll
          for (int i = 0; i < 16; i++) {
            const float v = sp[(grp * 16 + i) * 64];
            N[i] = (ord_f(v) & 0xFFFFFF80u) | (u32)(127 - (kr * 32 + grp * 16 + i));
          }
          sort16<false>(N, dummy);
          merge16<false>(R, dummy, N, dummy);
        }
        __builtin_amdgcn_wave_barrier();
        if (kr < 3) put((kr + 1) & 1);
      }
    };
    do_half(0, RA);
    do_half(1, RB);
    {
      float v1[16], v2[16]; u32 i1[16], i2[16];
#pragma unroll
      for (int i = 0; i < 16; i++) {
        v1[i] = unord_f(RA[i] & 0xFFFFFF80u); i1[i] = 127 - (RA[i] & 127u);
        v2[i] = unord_f(RB[i] & 0xFFFFFF80u); i2[i] = 127 - (RB[i] & 127u);
      }
      u32 TK[16], TP[16], NK[16], NP[16];
#define CAND(slot, a, bq) { NK[slot] = ord_f(v1[a] + v2[bq]); NP[slot] = i1[a] * 128u + i2[bq]; }
#pragma unroll
      for (int bq = 0; bq < 16; bq++) { TK[bq] = ord_f(v1[0] + v2[bq]); TP[bq] = i1[0] * 128u + i2[bq]; }
      sort16<true>(TK, TP);
#pragma unroll
      for (int bq = 0; bq < 8; bq++) CAND(bq, 1, bq)
#pragma unroll
      for (int bq = 0; bq < 5; bq++) CAND(8 + bq, 2, bq)
#pragma unroll
      for (int bq = 0; bq < 3; bq++) CAND(13 + bq, 4, bq)
      sort16<true>(NK, NP); merge16<true>(TK, TP, NK, NP);
#pragma unroll
      for (int bq = 0; bq < 4; bq++) CAND(bq, 3, bq)
      CAND(4, 5, 0) CAND(5, 5, 1) CAND(6, 6, 0) CAND(7, 6, 1) CAND(8, 7, 0) CAND(9, 7, 1)
      CAND(10, 8, 0) CAND(11, 9, 0) CAND(12, 10, 0) CAND(13, 11, 0) CAND(14, 12, 0) CAND(15, 13, 0)
      sort16<true>(NK, NP); merge16<true>(TK, TP, NK, NP);
      CAND(0, 14, 0) CAND(1, 15, 0)
#pragma unroll
      for (int i = 2; i < 16; i++) { NK[i] = 0; NP[i] = 0; }
      sort16<true>(NK, NP); merge16<true>(TK, TP, NK, NP);
#undef CAND
      const float mx = unord_f(TK[0]);
      float ev[16], sum = 0.f;
#pragma unroll
      for (int i = 0; i < 16; i++) { ev[i] = __expf(unord_f(TK[i]) - mx); sum += ev[i]; }
      const float inv = 1.f / sum;
      u16* ip = (u16*)IDX + (size_t)(tok0 + lane) * 128 + head * 16;
      float* gp = GATE + (size_t)(tok0 + lane) * 128 + head * 16;
#pragma unroll
      for (int c = 0; c < 2; c++)
        *(uint4*)(ip + c * 8) = make_uint4(TP[c * 8] | (TP[c * 8 + 1] << 16), TP[c * 8 + 2] | (TP[c * 8 + 3] << 16),
                                           TP[c * 8 + 4] | (TP[c * 8 + 5] << 16), TP[c * 8 + 6] | (TP[c * 8 + 7] << 16));
#pragma unroll
      for (int c = 0; c < 4; c++)
        *(float4*)(gp + c * 4) = make_float4(ev[c * 4] * inv, ev[c * 4 + 1] * inv, ev[c * 4 + 2] * inv, ev[c * 4 + 3] * inv);
    }
  }
}

DI float row16_sum(float v) {
  v += __int_as_float(__builtin_amdgcn_update_dpp(0, __float_as_int(v), 0x128, 0xf, 0xf, false));
  v += __int_as_float(__builtin_amdgcn_update_dpp(0, __float_as_int(v), 0x124, 0xf, 0xf, false));
  v += __int_as_float(__builtin_amdgcn_update_dpp(0, __float_as_int(v), 0x122, 0xf, 0xf, false));
  v += __int_as_float(__builtin_amdgcn_update_dpp(0, __float_as_int(v), 0x121, 0xf, 0xf, false));
  return v;
}
DI float gelu_tanh(float x) {
  float u = 0.7978845608028654f * (x + 0.044715f * x * x * x);
  float e = __expf(2.f * u);
  float th = 1.f - 2.f / (e + 1.f);
  return 0.5f * x * (1.f + th);
}
DI float dot8(uint4 a, uint4 b, float acc) {
  acc = __builtin_amdgcn_fdot2_f32_bf16(__builtin_bit_cast(bf2, a.x), __builtin_bit_cast(bf2, b.x), acc, false);
  acc = __builtin_amdgcn_fdot2_f32_bf16(__builtin_bit_cast(bf2, a.y), __builtin_bit_cast(bf2, b.y), acc, false);
  acc = __builtin_amdgcn_fdot2_f32_bf16(__builtin_bit_cast(bf2, a.z), __builtin_bit_cast(bf2, b.z), acc, false);
  acc = __builtin_amdgcn_fdot2_f32_bf16(__builtin_bit_cast(bf2, a.w), __builtin_bit_cast(bf2, b.w), acc, false);
  return acc;
}

typedef float f2 __attribute__((ext_vector_type(2)));
DI void expert_dots(const Params& p, int nrows, char* smem) {
  const int tid = otid(), wave = tid >> 6, lane = tid & 63, g = lane >> 4, s = lane & 15;
  const int bid = obid(), x = bid & 7, jx = bid >> 3, wpx = (gridDim.x + 7 - x) >> 3;
  u32* list = (u32*)smem + wave * 128;
  const int* IDX = (const int*)(p.S + OFF_IDX);
  const float* GATE = (const float*)(p.S + OFF_GATE);
  u16* AV16 = (u16*)(p.S + OFF_PU);
  const unsigned char* PU = (const unsigned char*)(p.PT + PT_U) + s * 16;
  const float* PSU = (const float*)(p.PT + PT_SC);
  const float* PSV = PSU + 16384;
  const int tstep = wpx * 4;
  int t = jx * 4 + wave;
  int ni0 = 0, ni1 = 0;
  uint4 nh[8];
  auto prefetch = [&](int tt) {
    { const u32 w2 = ((const u32*)IDX)[(size_t)tt * 64 + lane]; ni0 = (int)(w2 & 0xffffu); ni1 = (int)(w2 >> 16); }
#pragma unroll
    for (int c = 0; c < 4; c++) {
      const u16* hp = p.H + (size_t)tt * D + (c * 16 + s) * 16;
      nh[2 * c] = *(const uint4*)(hp); nh[2 * c + 1] = *(const uint4*)(hp + 8);
    }
  };
  auto dot_row = [&](const int4 (&uu)[4], const f2 (&hf)[32]) {
    const int uw[16] = {uu[0].x, uu[0].y, uu[0].z, uu[0].w, uu[1].x, uu[1].y, uu[1].z, uu[1].w,
                        uu[2].x, uu[2].y, uu[2].z, uu[2].w, uu[3].x, uu[3].y, uu[3].z, uu[3].w};
    f2 acc = {0.f, 0.f}, acc2 = {0.f, 0.f};
#pragma unroll
    for (int j = 0; j < 16; j++) {
      acc = __builtin_elementwise_fma(__builtin_amdgcn_cvt_pk_f32_fp8(uw[j], false), hf[2 * j], acc);
      acc2 = __builtin_elementwise_fma(__builtin_amdgcn_cvt_pk_f32_fp8(uw[j], true), hf[2 * j + 1], acc2);
    }
    return row16_sum((acc.x + acc.y) + (acc2.x + acc2.y));
  };
  if (t < nrows) prefetch(t);
  for (; t < nrows; t += tstep) {
    const int i0 = ni0, i1 = ni1;
    f2 hf[32];
#pragma unroll
    for (int c = 0; c < 4; c++) {
      const u32 hw[8] = {nh[2 * c].x, nh[2 * c].y, nh[2 * c].z, nh[2 * c].w, nh[2 * c + 1].x, nh[2 * c + 1].y, nh[2 * c + 1].z, nh[2 * c + 1].w};
#pragma unroll
      for (int j = 0; j < 8; j++) { hf[c * 8 + j].x = __uint_as_float(hw[j] << 16); hf[c * 8 + j].y = __uint_as_float(hw[j] & 0xffff0000u); }
    }
    if (t + tstep < nrows) prefetch(t + tstep);
    const bool b0 = (i0 >> 11) == x, b1 = (i1 >> 11) == x;
    const unsigned long long m0 = __ballot(b0), m1 = __ballot(b1);
    const int n0 = __popcll(m0);
    const int r0 = __builtin_amdgcn_mbcnt_hi((u32)(m0 >> 32), __builtin_amdgcn_mbcnt_lo((u32)m0, 0u));
    const int r1 = n0 + __builtin_amdgcn_mbcnt_hi((u32)(m1 >> 32), __builtin_amdgcn_mbcnt_lo((u32)m1, 0u));
    const int n = n0 + __popcll(m1);
    __builtin_amdgcn_wave_barrier();
    if (b0) list[r0] = ((u32)(2 * lane) << 16) | (u32)i0;
    if (b1) list[r1] = ((u32)(2 * lane + 1) << 16) | (u32)i1;
    __builtin_amdgcn_wave_barrier();
    for (int cb = 0; cb < n; cb += 64) {
      const int nend = min(n, cb + 64);
      float dk = 0.f;
      for (int base = cb; base < nend; base += 8) {
        const int k0 = base + g, k1 = base + 4 + g;
        const u32 ent0 = list[min(k0, n - 1)], ent1 = list[min(k1, n - 1)];
        const unsigned char* ur0 = PU + (size_t)(ent0 & 0xffffu) * D;
        const unsigned char* ur1 = PU + (size_t)(ent1 & 0xffffu) * D;
        int4 ua[4], ub[4];
        ua[0] = *(const int4*)(ur0); ua[1] = *(const int4*)(ur0 + 256); ua[2] = *(const int4*)(ur0 + 512); ua[3] = *(const int4*)(ur0 + 768);
        ub[0] = *(const int4*)(ur1); ub[1] = *(const int4*)(ur1 + 256); ub[2] = *(const int4*)(ur1 + 512); ub[3] = *(const int4*)(ur1 + 768);
        const float d0 = dot_row(ua, hf);
        const float d1 = dot_row(ub, hf);
        const int it0 = (base - cb) >> 2;
        dk = (s == it0) ? d0 : dk;
        dk = (s == it0 + 1) ? d1 : dk;
      }
      const int kk = cb + 4 * s + g;
      if (kk < nend) {
        const u32 ent = list[kk];
        const int e = (int)(ent & 0xffffu), slot = (int)(ent >> 16);
        AV16[(size_t)t * 128 + slot] = f2bf(GATE[(size_t)t * 128 + slot] * PSV[e] * gelu_tanh(dk * PSU[e]));
      }
    }
  }
}

DI void expert_vsum(const Params& p, int nrows) {
  const int tid = otid(), wave = tid >> 6, lane = tid & 63, g = lane >> 3, s = lane & 7;
  const int bid = obid(), x = bid & 7, jx = bid >> 3, wpx = (gridDim.x + 7 - x) >> 3;
  const u16* IDX = (const u16*)(p.S + OFF_IDX) + g * 16;
  const u16* AV = (const u16*)(p.S + OFF_PU) + g * 16;
  const unsigned char* PV = (const unsigned char*)(p.PT + PT_V) + (size_t)x * 16384 * 128 + s * 16;
  u16* Y = (u16*)((char*)p.U + (size_t)NROW * 2048 * 2);
  const int b5 = (lane >> 5) & 1, b4 = (lane >> 4) & 1, b3 = (lane >> 3) & 1;
  const int tstep = wpx * 4;
  int t = jx * 4 + wave;
  uint4 ni[2], na[2];
  auto prefetch = [&](int tt) {
#pragma unroll
    for (int j = 0; j < 2; j++) { ni[j] = *(const uint4*)(IDX + (size_t)tt * 128 + j * 8); na[j] = *(const uint4*)(AV + (size_t)tt * 128 + j * 8); }
  };
  if (t < nrows) prefetch(t);
  for (; t < nrows; t += tstep) {
    const u32 iw[8] = {ni[0].x, ni[0].y, ni[0].z, ni[0].w, ni[1].x, ni[1].y, ni[1].z, ni[1].w};
    const u32 aw[8] = {na[0].x, na[0].y, na[0].z, na[0].w, na[1].x, na[1].y, na[1].z, na[1].w};
    int ee[16]; float aa[16];
#pragma unroll
    for (int j = 0; j < 8; j++) {
      ee[2 * j] = (int)(iw[j] & 0xffffu); ee[2 * j + 1] = (int)(iw[j] >> 16);
      aa[2 * j] = __uint_as_float(aw[j] << 16); aa[2 * j + 1] = __uint_as_float(aw[j] & 0xffff0000u);
    }
    int4 vv[16];
#pragma unroll
    for (int it = 0; it < 16; it++) vv[it] = *(const int4*)(PV + (size_t)ee[it] * 128);
    if (t + tstep < nrows) prefetch(t + tstep);
    f2 y[8];
#pragma unroll
    for (int i = 0; i < 8; i++) { y[i].x = 0.f; y[i].y = 0.f; }
#pragma unroll
    for (int it = 0; it < 16; it++) {
      const f2 a2 = {aa[it], aa[it]};
      const int vw[4] = {vv[it].x, vv[it].y, vv[it].z, vv[it].w};
#pragma unroll
      for (int j = 0; j < 4; j++) {
        y[2 * j] = __builtin_elementwise_fma(__builtin_amdgcn_cvt_pk_f32_fp8(vw[j], false), a2, y[2 * j]);
        y[2 * j + 1] = __builtin_elementwise_fma(__builtin_amdgcn_cvt_pk_f32_fp8(vw[j], true), a2, y[2 * j + 1]);
      }
    }
    f2 k4[4], k2[2], k1;
#pragma unroll
    for (int i = 0; i < 4; i++) {
      const f2 keep = b5 ? y[4 + i] : y[i], send = b5 ? y[i] : y[4 + i];
      k4[i].x = keep.x + __shfl_xor(send.x, 32); k4[i].y = keep.y + __shfl_xor(send.y, 32);
    }
#pragma unroll
    for (int i = 0; i < 2; i++) {
      const f2 keep = b4 ? k4[2 + i] : k4[i], send = b4 ? k4[i] : k4[2 + i];
      k2[i].x = keep.x + __shfl_xor(send.x, 16); k2[i].y = keep.y + __shfl_xor(send.y, 16);
    }
    {
      const f2 keep = b3 ? k2[1] : k2[0], send = b3 ? k2[0] : k2[1];
      k1.x = keep.x + __shfl_xor(send.x, 8); k1.y = keep.y + __shfl_xor(send.y, 8);
    }
    *(u32*)(Y + (size_t)t * D + x * 128 + s * 16 + b5 * 8 + b4 * 4 + b3 * 2) = pack2(k1.x, k1.y);
  }
}

DI void expert_epilogue(const Params& p, int layer, int nrows) {
  const int tid = otid(), wave = tid >> 6, lane = tid & 63, g = lane >> 5, s = lane & 31;
  const bool last = (layer == DEPTH - 1);
  const u16* Y = (const u16*)((const char*)p.U + (size_t)NROW * 2048 * 2);
  for (int tk = obid() * 4 + wave; tk < nrows; tk += gridDim.x * 4) {
    const int b = row_batch(tk);
    const int col = (g * 32 + s) * 16;
    const float* g2 = ada_ptr(p, layer, b, 5) + col;
    const float* gm = p.ln_gamma + (size_t)(layer * 2 + 1) * D + col;
    const float* bt = p.ln_beta + (size_t)(layer * 2 + 1) * D + col;
    const float* XP = (const float*)(p.S + OFF_XP) + (size_t)tk * D + col;
    float xin[16];
    {
      float s0 = 0.f;
#pragma unroll
      for (int j4 = 0; j4 < 4; j4++) {
        const float4 t4 = *(const float4*)(XP + j4 * 4);
        xin[j4 * 4] = t4.x; xin[j4 * 4 + 1] = t4.y; xin[j4 * 4 + 2] = t4.z; xin[j4 * 4 + 3] = t4.w;
        s0 += t4.x + t4.y + t4.z + t4.w;
      }
      const float m0 = wave_sum(s0) * (1.f / D);
      float q0 = 0.f;
#pragma unroll
      for (int j = 0; j < 16; j++) { xin[j] -= m0; q0 += xin[j] * xin[j]; }
      const float r0 = rsqrtf(wave_sum(q0) * (1.f / D) + EPS);
      const float* gm0 = p.ln_gamma + (size_t)(layer * 2 + 0) * D + col;
      const float* bt0 = p.ln_beta + (size_t)(layer * 2 + 0) * D + col;
#pragma unroll
      for (int j4 = 0; j4 < 4; j4++) {
        const float4 ga = *(const float4*)(gm0 + j4 * 4), be = *(const float4*)(bt0 + j4 * 4);
        xin[j4 * 4] = xin[j4 * 4] * r0 * ga.x + be.x; xin[j4 * 4 + 1] = xin[j4 * 4 + 1] * r0 * ga.y + be.y;
        xin[j4 * 4 + 2] = xin[j4 * 4 + 2] * r0 * ga.z + be.z; xin[j4 * 4 + 3] = xin[j4 * 4 + 3] * r0 * ga.w + be.w;
      }
    }
    float xv[16];
    float sum = 0.f;
    const uint4 yq0 = *(const uint4*)(Y + (size_t)tk * D + col), yq1 = *(const uint4*)(Y + (size_t)tk * D + col + 8);
    const u32 yw[8] = {yq0.x, yq0.y, yq0.z, yq0.w, yq1.x, yq1.y, yq1.z, yq1.w};
#pragma unroll
    for (int j4 = 0; j4 < 4; j4++) {
      const float4 xo = make_float4(xin[j4 * 4], xin[j4 * 4 + 1], xin[j4 * 4 + 2], xin[j4 * 4 + 3]);
      const float4 gg = *(const float4*)(g2 + j4 * 4);
      const float4 yy = make_float4(__uint_as_float(yw[2 * j4] << 16), __uint_as_float(yw[2 * j4] & 0xffff0000u),
                                    __uint_as_float(yw[2 * j4 + 1] << 16), __uint_as_float(yw[2 * j4 + 1] & 0xffff0000u));
      float* o = xv + j4 * 4;
      o[0] = ALPHA * xo.x + gg.x * yy.x; o[1] = ALPHA * xo.y + gg.y * yy.y;
      o[2] = ALPHA * xo.z + gg.z * yy.z; o[3] = ALPHA * xo.w + gg.w * yy.w;
      sum += o[0] + o[1] + o[2] + o[3];
    }
    float mu = wave_sum(sum) * (1.f / D);
    float q = 0.f;
#pragma unroll
    for (int j = 0; j < 16; j++) { xv[j] -= mu; q += xv[j] * xv[j]; }
    float rstd = rsqrtf(wave_sum(q) * (1.f / D) + EPS);
    float* dstx = (last ? p.out : p.X) + (size_t)tk * D + col;
    float s2 = 0.f;
#pragma unroll
    for (int j4 = 0; j4 < 4; j4++) {
      const float4 gmv = *(const float4*)(gm + j4 * 4);
      const float4 btv = *(const float4*)(bt + j4 * 4);
      float* o = xv + j4 * 4;
      o[0] = o[0] * rstd * gmv.x + btv.x; o[1] = o[1] * rstd * gmv.y + btv.y;
      o[2] = o[2] * rstd * gmv.z + btv.z; o[3] = o[3] * rstd * gmv.w + btv.w;
      s2 += o[0] + o[1] + o[2] + o[3];
      *(float4*)(dstx + j4 * 4) = make_float4(o[0], o[1], o[2], o[3]);
    }
    if (!last) {
      float mu2 = wave_sum(s2) * (1.f / D);
      float q2 = 0.f;
#pragma unroll
      for (int j = 0; j < 16; j++) { xv[j] -= mu2; q2 += xv[j] * xv[j]; }
      float rstd2 = rsqrtf(wave_sum(q2) * (1.f / D) + EPS);
      const float* sh = ada_ptr(p, layer + 1, b, 0) + col;
      const float* sc = ada_ptr(p, layer + 1, b, 1) + col;
      u32 ow[8];
#pragma unroll
      for (int j = 0; j < 8; j++) {
        float y0 = xv[2 * j] * rstd2 * (1.f + sc[2 * j]) + sh[2 * j];
        float y1 = xv[2 * j + 1] * rstd2 * (1.f + sc[2 * j + 1]) + sh[2 * j + 1];
        ow[j] = pack2(y0, y1);
      }
      *(uint4*)(p.H + (size_t)tk * D + col) = make_uint4(ow[0], ow[1], ow[2], ow[3]);
      *(uint4*)(p.H + (size_t)tk * D + col + 8) = make_uint4(ow[4], ow[5], ow[6], ow[7]);
    }
  }
}

#define XB_TMO      128
#define XB_XCNT(j)  (256  + 64 * (j))
#define XB_XSUB(j)  (1280 + 64 * (j))
#define XB_XGEN(j)  (2304 + 64 * (j))
#define XB_TOP      3328
#define XB_TOPGEN   3392
#define XCD_BAR_WORDS 3456
#define XB_SPIN_CAP (1u << 18)
#define LAS __attribute__((address_space(3)))

__device__ __forceinline__ unsigned xb_ld(unsigned* p)              { return __hip_atomic_load(p, __ATOMIC_RELAXED, __HIP_MEMORY_SCOPE_AGENT); }
__device__ __forceinline__ unsigned xb_add(unsigned* p, unsigned v) { return __hip_atomic_fetch_add(p, v, __ATOMIC_RELAXED, __HIP_MEMORY_SCOPE_AGENT); }
__device__ __forceinline__ unsigned xb_xcc_id() { return (unsigned)__builtin_amdgcn_s_getreg((3 << 11) | 20) & 0xFu; }
#define XB_SPIN(cond, bar) do { unsigned _sp = 0; while (cond) { __builtin_amdgcn_s_sleep(1); \
    if ((++_sp & 255u) == 0u) { if (xb_ld(&(bar)[XB_TMO])) break; if (_sp > XB_SPIN_CAP) { atomicAdd(&(bar)[XB_TMO], 1u); break; } } } } while (0)

struct XcdBarrier {
    unsigned* bar; unsigned x;
    volatile LAS unsigned* st;
};

__device__ __forceinline__ XcdBarrier xcd_barrier_post(unsigned* bar, volatile LAS unsigned* st) {
    XcdBarrier b; b.bar = bar; b.x = xb_xcc_id(); b.st = st;
    if (threadIdx.x == 0) (void)xb_add(&bar[XB_XCNT(b.x)], 1u);
    return b;
}
__device__ __forceinline__ void xcd_barrier_complete(unsigned* bar, unsigned x, unsigned& nloc, unsigned& nx) {
    const unsigned G = gridDim.x * gridDim.y * gridDim.z;
    unsigned sum, cnt, mine, sp = 0u;
    for (;;) {
        sum = 0u; cnt = 0u; mine = 0u;
#pragma unroll
        for (unsigned j = 0; j < 16; ++j) { const unsigned c = xb_ld(&bar[XB_XCNT(j)]); sum += c; cnt += (c > 0u) ? 1u : 0u; mine = (j == x) ? c : mine; }
        if (sum == G) break;
        __builtin_amdgcn_s_sleep(1);
        if ((++sp & 255u) == 0u) { if (xb_ld(&bar[XB_TMO])) break; if (sp > XB_SPIN_CAP) { atomicAdd(&bar[XB_TMO], 1u); break; } }
    }
    nloc = mine > 0u ? mine : 1u; nx = cnt > 0u ? cnt : 1u;
}

__device__ __forceinline__ void xcd_barrier(const XcdBarrier& b) {
    asm volatile("s_waitcnt vmcnt(0)" ::: "memory");
    __syncthreads();
    if (threadIdx.x == 0) {
        unsigned* bar = b.bar;
        __builtin_amdgcn_s_waitcnt(0);
        unsigned nloc = b.st[0], nx = b.st[1];
        if (nloc == 0u) { xcd_barrier_complete(bar, b.x, nloc, nx); b.st[0] = nloc; b.st[1] = nx; }
        const unsigned old = xb_add(&bar[XB_XSUB(b.x)], 1u);
        const unsigned gen = old / nloc;
        if (old + 1u == (gen + 1u) * nloc) {
            __builtin_amdgcn_fence(__ATOMIC_RELEASE, "agent");
            asm volatile("s_waitcnt vmcnt(0)" ::: "memory");
            const unsigned og = xb_add(&bar[XB_TOP], 1u);
            const unsigned tg = og / nx;
            if (og + 1u == (tg + 1u) * nx) xb_add(&bar[XB_TOPGEN], 1u);
            else XB_SPIN(xb_ld(&bar[XB_TOPGEN]) == tg, bar);
            __builtin_amdgcn_fence(__ATOMIC_ACQUIRE, "agent");
            xb_add(&bar[XB_XGEN(b.x)], 1u);
            asm volatile("s_waitcnt vmcnt(0)" ::: "memory");
        } else {
            XB_SPIN(xb_ld(&bar[XB_XGEN(b.x)]) == gen, bar);
            __builtin_amdgcn_fence(__ATOMIC_ACQUIRE, "agent");
            asm volatile("s_waitcnt vmcnt(0)" ::: "memory");
        }
    }
    __syncthreads();
}


DI void grid_barrier(unsigned* ctr, unsigned& target) {
  asm volatile("s_waitcnt vmcnt(0)" ::: "memory");
  __syncthreads();
  if (threadIdx.x == 0) {
    target += gridDim.x;
    __builtin_amdgcn_fence(__ATOMIC_RELEASE, "agent");
    asm volatile("s_waitcnt vmcnt(0)" ::: "memory");
    __hip_atomic_fetch_add(ctr, 1u, __ATOMIC_RELAXED, __HIP_MEMORY_SCOPE_AGENT);
    while (__hip_atomic_load(ctr, __ATOMIC_RELAXED, __HIP_MEMORY_SCOPE_AGENT) < target) __builtin_amdgcn_s_sleep(1);
    __builtin_amdgcn_fence(__ATOMIC_ACQUIRE, "agent");
    asm volatile("s_waitcnt vmcnt(0)" ::: "memory");
  }
  __syncthreads();
}

__global__ void __launch_bounds__(256, 2) mk_forward(Params p) {
  __shared__ __attribute__((aligned(16))) char smem[LDS_BYTES];
  cg::grid_group grid = cg::this_grid();
  int pc = 0;
#define GSYNC() xcd_barrier(xb)
#define PHASE(body) PHASER(15, body)
#define PHASER(kind, body)                              \
  {                                                     \
    if (pc >= p.ph_lo && pc < p.ph_hi) {                \
      if ((REPMASK >> (kind)) & 1) { const bool dry = true; (void)dry; body; GSYNC(); } \
      { const bool dry = false; (void)dry; body; }      \
      if (pc + 1 < p.ph_hi) GSYNC();                    \
    }                                                   \
    pc++;                                               \
  }
  __shared__ __attribute__((aligned(16))) unsigned xb_words[4];
  if (threadIdx.x == 0) { xb_words[0] = 0u; xb_words[1] = 0u; xb_words[2] = 0u; xb_words[3] = 0u; }
  __syncthreads();
  const XcdBarrier xb = xcd_barrier_post(p.bar, (volatile LAS unsigned*)xb_words);
  if (0 >= p.ph_lo && 0 < p.ph_hi) {
    phase0(p, (float*)smem);
    if (1 < p.ph_hi) grid.sync();
  }
  pc++;
  PHASE(phase0b(p))
  PHASE(lnmod_phase<0>(p, 0, NROW))
  for (int layer = 0; layer < DEPTH; layer++) {
    const bool last = (layer == DEPTH - 1);
    const int nrows = last ? NLAT : NROW;
    PHASER(0, gemm_phase<0>(p, layer, smem, p.H, p.wt_in + (size_t)layer * DINP * D, NROW / 256, DINP / 128, dry))
    PHASER(1, prep_phase(p, layer))
    PHASER(2, scan_phase(p, smem, layer))
    PHASER(3, combine_phase(p, layer, nrows))
    PHASER(4, { gemm_phase<1>(p, layer, smem, p.H, p.wt_out + (size_t)layer * D * D, NLAT / 256, 8, dry);
                 if (nrows > NLAT) gemm_thin<1>(p, layer, smem, p.H, p.wt_out + (size_t)layer * D * D, NLAT, NCTX / 64, 8, dry); })
    PHASER(5, lnmod_phase<1>(p, layer, nrows))
    PHASER(6, { gemm_phase<2>(p, layer, smem, p.H, p.wt_q + (size_t)layer * 2048 * D, NLAT / 256, 16, dry);
                 if (nrows > NLAT) gemm_thin<2>(p, layer, smem, p.H, p.wt_q + (size_t)layer * 2048 * D, NLAT, NCTX / 64, 16, dry); })
    PHASER(7, topk_phase(p, layer, smem, nrows))
    PHASER(8, expert_dots(p, nrows, smem))
    PHASER(9, expert_vsum(p, nrows))
    PHASER(10, expert_epilogue(p, layer, nrows))
  }
#undef PHASE
#undef PHASER
}
constexpr int NPHASES = 3 + 11 * DEPTH;

extern "C" void kernel_launch(void* const* d_in, const int* in_sizes, int n_in, void* d_out, int out_size, void* d_ws,
                              size_t ws_size, hipStream_t stream) {
  Params p{};
  p.x = (const float*)d_in[0]; p.c = (const float*)d_in[1]; p.ctx = (const float*)d_in[2]; p.c_ctx = (const float*)d_in[3];
  p.w_ada = (const float*)d_in[4]; p.b_ada = (const float*)d_in[5]; p.w_in = (const float*)d_in[6];
  p.w_gk2 = (const float*)d_in[7]; p.b_gk = (const float*)d_in[8]; p.hg_lb = (const float*)d_in[9];
  p.hg_norm = (const float*)d_in[10]; p.gla_norm = (const float*)d_in[11]; p.w_out = (const float*)d_in[12];
  p.ln_gamma = (const float*)d_in[13]; p.ln_beta = (const float*)d_in[14]; p.wq = (const float*)d_in[15];
  p.sub_keys = (const float*)d_in[16]; p.peer_u = (const float*)d_in[17]; p.peer_v = (const float*)d_in[18];
  p.out = (float*)d_out;
  char* w = (char*)d_ws;
  size_t off = 0;
  auto take = [&](size_t bytes) { char* q = w + off; off += (bytes + 255) & ~(size_t)255; return q; };
  p.wt_in = (u16*)take((size_t)4 * DINP * D * 2);
  p.wt_out = (u16*)take((size_t)4 * D * D * 2);
  p.wt_q = (u16*)take((size_t)4 * 2048 * D * 2);
  p.keysb = (u16*)take((size_t)4 * 2 * 128 * 128 * 2);
  p.ada_part = (float*)take((size_t)8 * 4 * 5 * 6144 * 4);
  p.ada = (float*)take((size_t)4 * 5 * 6144 * 4);
  p.X = (float*)take((size_t)NROW * D * 4);
  p.H = (u16*)take((size_t)NROW * D * 2);
  p.G = (u16*)take((size_t)NROW * D * 2);
  p.U = (u16*)take((size_t)NROW * DIN * 2);
  p.S = take(SZ_S);
  p.PT = take(SZ_PT);
  p.bar = (unsigned*)take(XCD_BAR_WORDS * 4);
  if (off > ws_size) { fprintf(stderr, "workspace too small: need %zu have %zu\n", off, ws_size); return; }

  static int grid_blocks = 0;
  if (!grid_blocks) {
    int dev = 0, cus = 0, per_cu = 0;
    hipGetDevice(&dev);
    hipDeviceGetAttribute(&cus, hipDeviceAttributeMultiprocessorCount, dev);
    hipOccupancyMaxActiveBlocksPerMultiprocessor(&per_cu, mk_forward, 256, 0);
    if (per_cu > 2) per_cu = 2;
    grid_blocks = cus * per_cu;
  }
#if ONE_LAUNCH
  hipMemsetAsync(p.bar, 0, XCD_BAR_WORDS * 4, stream);
  p.ph_lo = 0; p.ph_hi = NPHASES;
  void* args[] = {&p};
  hipError_t e = hipLaunchCooperativeKernel((void*)mk_forward, dim3(grid_blocks), dim3(256), args, 0, stream);
  if (e != hipSuccess) fprintf(stderr, "cooperative launch failed: %s (grid %d)\n", hipGetErrorString(e), grid_blocks);
#else
  for (int ph = 0; ph < NPHASES; ph++) {
    p.ph_lo = ph; p.ph_hi = ph + 1;
    hipLaunchKernelGGL(mk_forward, dim3(grid_blocks), dim3(256), 0, stream, p);
  }
#endif
}
```

```cpp
#include <hip/hip_runtime.h>
#include <hip/hip_cooperative_groups.h>
#include <cstdio>
namespace cg = cooperative_groups;

#define DI __device__ __forceinline__
typedef unsigned short u16;
typedef unsigned int u32;
typedef __attribute__((ext_vector_type(8))) short bf16x8;
typedef __attribute__((ext_vector_type(16))) float f32x16;
typedef __attribute__((ext_vector_type(2))) __bf16 bf2;

#ifndef REPMASK
#define REPMASK 0
#endif
#ifndef DRYVAR
#define DRYVAR 0
#endif
#ifndef ONE_LAUNCH
#define ONE_LAUNCH 1
#endif

constexpr int D = 1024, NB = 4, SEQ = 8192, DEPTH = 4, CTX = 256;
constexpr int NLAT = NB * SEQ;
constexpr int NCTX = NB * CTX;
constexpr int NROW = NLAT + NCTX;
constexpr int DIN = 4128, DINP = 4224;
constexpr int LPOS = CTX + SEQ;
constexpr int NBLK = LPOS / 32;
constexpr float ALPHA = 1.681792830507429f;
constexpr float EPS = 1e-6f;
constexpr int LDS_BYTES = 73728;

struct Params {
  const float *x, *c, *ctx, *c_ctx, *w_ada, *b_ada, *w_in, *w_gk2, *b_gk, *hg_lb, *hg_norm, *gla_norm,
      *w_out, *ln_gamma, *ln_beta, *wq, *sub_keys, *peer_u, *peer_v;
  float* out;
  u16 *wt_in, *wt_out, *wt_q, *keysb;
  float *ada_part, *ada;
  float* X;
  u16 *H, *G, *U;
  char* S;
  char* PT;
  unsigned* bar;
  int ph_lo, ph_hi;
};

constexpr size_t SZ_HQ = (size_t)2 * 16 * LPOS * 128 * 2;
constexpr size_t SZ_HVT = (size_t)16 * 128 * LPOS * 2;
constexpr size_t SZ_HD = (size_t)2 * 16 * NBLK * 128 * 4;
constexpr size_t SZ_GQ = (size_t)2 * 16 * LPOS * 64 * 2;
constexpr size_t SZ_GD = (size_t)2 * 16 * NBLK * 64 * 4;
constexpr size_t OFF_HQ = 0, OFF_HK = OFF_HQ + SZ_HQ, OFF_HKT = OFF_HK + SZ_HQ, OFF_HVT = OFF_HKT + SZ_HQ,
                 OFF_HD = OFF_HVT + SZ_HVT, OFF_GQ = OFF_HD + SZ_HD, OFF_GK = OFF_GQ + SZ_GQ, OFF_GKT = OFF_GK + SZ_GQ,
                 OFF_GVT = OFF_GKT + SZ_GQ, OFF_GD = OFF_GVT + SZ_HVT, SZ_S = OFF_GD + SZ_GD;
constexpr size_t OFF_XP = 0, SZ_XP = (size_t)NROW * D * 4;
constexpr size_t OFF_IDX = OFF_XP + SZ_XP, SZ_IDX = (size_t)NROW * 128 * 4;
constexpr size_t OFF_GATE = OFF_IDX + SZ_IDX;
constexpr size_t OFF_PU = OFF_GATE + SZ_IDX, SZ_PU = (size_t)16384 * D * 2;
constexpr size_t OFF_PV = OFF_PU + SZ_PU;
constexpr size_t OFF_PSC = OFF_PV + SZ_PU;
static_assert(OFF_PSC + 2 * 16384 * 4 <= SZ_S, "alias overflow");
constexpr size_t PT_U = 0, PT_V = (size_t)16384 * D, PT_SC = 2 * (size_t)16384 * D, SZ_PT = PT_SC + 2 * 16384 * 4;

DI int otid() { int t = threadIdx.x; asm volatile("" : "+v"(t)); return t; }
DI int obid() { int t = blockIdx.x; asm volatile("" : "+s"(t)); return t; }
DI float bf2f(u16 h) { return __uint_as_float(((u32)h) << 16); }
DI u16 f2bf(float x) { return __builtin_bit_cast(u16, (__bf16)x); }
typedef __attribute__((ext_vector_type(2))) float f32x2v;
typedef __attribute__((ext_vector_type(2))) __bf16 bf16x2v;
DI u32 pack2(float a, float b) { f32x2v v = {a, b}; return __builtin_bit_cast(u32, __builtin_convertvector(v, bf16x2v)); }
DI float wave_sum(float v) {
#pragma unroll
  for (int o = 32; o > 0; o >>= 1) v += __shfl_xor(v, o);
  return v;
}
DI int crow(int i, int h) { return (i & 3) + 8 * (i >> 2) + 4 * h; }
DI int perm16(int k) {
  int kk = k & 15;
  return (k & ~15) | (((kk >> 2) & 1) << 3) | ((kk >> 3) << 2) | (kk & 3);
}
DI bf16x8 pack_frag(const f32x16& x, int s) {
  union { bf16x8 v; u32 u[4]; } r;
#pragma unroll
  for (int j = 0; j < 4; j++) r.u[j] = pack2(x[8 * s + 2 * j], x[8 * s + 2 * j + 1]);
  return r.v;
}
#define MFMA32(a, b, c) __builtin_amdgcn_mfma_f32_32x32x16_bf16((a), (b), (c), 0, 0, 0)

DI const float* ada_ptr(const Params& p, int layer, int r, int j) { return p.ada + ((size_t)(layer * 5 + r) * 6 + j) * D; }
DI int row_batch(int r) { return r < NLAT ? (r >> 13) : 4; }

DI void weight_convert(const Params& p, int l, int vbid, int vgrid) {
  const size_t gtid = (size_t)vbid * 256 + otid(), gsz = (size_t)vgrid * 256;
  for (size_t i = gtid; i < (size_t)128 * DINP; i += gsz) {
    int n = i % DINP; int k8 = i / DINP;
    u32 o[4] = {0, 0, 0, 0};
    if (n < DIN) {
      const float* s = p.w_in + ((size_t)l * D + k8 * 8) * DIN + n;
#pragma unroll
      for (int j = 0; j < 4; j++) o[j] = pack2(s[(size_t)(2 * j) * DIN], s[(size_t)(2 * j + 1) * DIN]);
    }
    *(uint4*)(p.wt_in + ((size_t)l * DINP + n) * D + k8 * 8) = make_uint4(o[0], o[1], o[2], o[3]);
  }
  for (size_t i = gtid; i < (size_t)128 * 1024; i += gsz) {
    int n = i & 1023; int k8 = i >> 10;
    const float* s = p.w_out + ((size_t)l * D + k8 * 8) * D + n;
    u32 o[4];
#pragma unroll
    for (int j = 0; j < 4; j++) o[j] = pack2(s[(size_t)(2 * j) * D], s[(size_t)(2 * j + 1) * D]);
    *(uint4*)(p.wt_out + ((size_t)l * D + n) * D + k8 * 8) = make_uint4(o[0], o[1], o[2], o[3]);
  }
  for (size_t i = gtid; i < (size_t)128 * 2048; i += gsz) {
    int n = i & 2047; int k8 = i >> 11;
    const float* s = p.wq + ((size_t)l * D + k8 * 8) * 2048 + n;
    u32 o[4];
#pragma unroll
    for (int j = 0; j < 4; j++) o[j] = pack2(s[(size_t)(2 * j) * 2048], s[(size_t)(2 * j + 1) * 2048]);
    *(uint4*)(p.wt_q + ((size_t)l * 2048 + n) * D + k8 * 8) = make_uint4(o[0], o[1], o[2], o[3]);
  }
}

DI void phase0(const Params& p, float* lds) {
  for (int it = obid(); it < 768; it += gridDim.x) {
    int kp = it & 7, nb = (it >> 3) % 24, l = it / 192;
    __syncthreads();
    for (int i = otid(); i < 640; i += 256) {
      int r = i >> 7, k = i & 127;
      float v = (r < 4) ? p.c[r * D + kp * 128 + k] : p.c_ctx[kp * 128 + k];
      lds[i] = v / (1.f + __expf(-v));
    }
    __syncthreads();
    int n = nb * 256 + otid();
    const float* w = p.w_ada + ((size_t)l * D + kp * 128) * 6144 + n;
    float a0 = 0, a1 = 0, a2 = 0, a3 = 0, a4 = 0;
#pragma unroll 8
    for (int k = 0; k < 128; k++) {
      float wv = w[(size_t)k * 6144];
      a0 += lds[k] * wv; a1 += lds[128 + k] * wv; a2 += lds[256 + k] * wv; a3 += lds[384 + k] * wv; a4 += lds[512 + k] * wv;
    }
    float* o = p.ada_part + ((size_t)(kp * 4 + l) * 5) * 6144 + n;
    o[0] = a0; o[6144] = a1; o[2 * 6144] = a2; o[3 * 6144] = a3; o[4 * 6144] = a4;
  }
  weight_convert(p, 0, obid(), gridDim.x);
  const size_t gtid = (size_t)obid() * 256 + otid(), gsz = (size_t)gridDim.x * 256;
  for (size_t i = gtid; i < (size_t)4 * 2 * 128 * 128; i += gsz) p.keysb[i] = f2bf(p.sub_keys[i]);
}

DI void phase0b(const Params& p) {
  const size_t gtid = (size_t)obid() * 256 + otid(), gsz = (size_t)gridDim.x * 256;
  for (size_t i = gtid; i < (size_t)4 * 5 * 6144; i += gsz) {
    int n = i % 6144; int l = i / (5 * 6144);
    float a = p.b_ada[l * 6144 + n];
#pragma unroll
    for (int kp = 0; kp < 8; kp++) a += p.ada_part[(size_t)kp * 4 * 5 * 6144 + i];
    p.ada[i] = a;
  }
}

DI void peer_convert(const Params& p, int layer, int vbid, int vgrid) {
  const int tid = otid(), wave = tid >> 6, lane = tid & 63;
  unsigned char* du = (unsigned char*)(p.PT + PT_U);
  unsigned char* dv = (unsigned char*)(p.PT + PT_V);
  float* su = (float*)(p.PT + PT_SC);
  for (int it = vbid * 4 + wave; it < 2 * 16384; it += vgrid * 4) {
    const int tbl = it >> 14, e = it & 16383;
    const float* src = (tbl ? p.peer_v : p.peer_u) + ((size_t)layer * 16384 + e) * D + lane * 16;
    float4 a = *(const float4*)(src), b = *(const float4*)(src + 4), c = *(const float4*)(src + 8), d = *(const float4*)(src + 12);
    float m = fmaxf(fmaxf(fmaxf(fabsf(a.x), fabsf(a.y)), fmaxf(fabsf(a.z), fabsf(a.w))), fmaxf(fmaxf(fabsf(b.x), fabsf(b.y)), fmaxf(fabsf(b.z), fabsf(b.w))));
    m = fmaxf(m, fmaxf(fmaxf(fmaxf(fabsf(c.x), fabsf(c.y)), fmaxf(fabsf(c.z), fabsf(c.w))), fmaxf(fmaxf(fabsf(d.x), fabsf(d.y)), fmaxf(fabsf(d.z), fabsf(d.w)))));
#pragma unroll
    for (int o = 32; o > 0; o >>= 1) m = fmaxf(m, __shfl_xor(m, o));
    m = fmaxf(m, 1e-30f);
    const float sc = 224.f / m;
    int w0 = __builtin_amdgcn_cvt_pk_fp8_f32(a.x * sc, a.y * sc, 0, false); w0 = __builtin_amdgcn_cvt_pk_fp8_f32(a.z * sc, a.w * sc, w0, true);
    int w1 = __builtin_amdgcn_cvt_pk_fp8_f32(b.x * sc, b.y * sc, 0, false); w1 = __builtin_amdgcn_cvt_pk_fp8_f32(b.z * sc, b.w * sc, w1, true);
    int w2 = __builtin_amdgcn_cvt_pk_fp8_f32(c.x * sc, c.y * sc, 0, false); w2 = __builtin_amdgcn_cvt_pk_fp8_f32(c.z * sc, c.w * sc, w2, true);
    int w3 = __builtin_amdgcn_cvt_pk_fp8_f32(d.x * sc, d.y * sc, 0, false); w3 = __builtin_amdgcn_cvt_pk_fp8_f32(d.z * sc, d.w * sc, w3, true);
    if (tbl == 0) *(int4*)(du + (size_t)e * D + lane * 16) = make_int4(w0, w1, w2, w3);
    else *(int4*)(dv + ((size_t)(lane >> 3) * 16384 + e) * 128 + (lane & 7) * 16) = make_int4(w0, w1, w2, w3);
    if (lane == 0) su[it] = m * (1.f / 224.f);
  }
}

template <int MODE>
DI void lnmod_phase(const Params& p, int layer, int nrows) {
  const int wave = otid() >> 6, lane = otid() & 63;
  const float* XP = (const float*)(p.S + OFF_XP);
  for (int r = obid() * 4 + wave; r < nrows; r += gridDim.x * 4) {
    const float* src;
    if (MODE == 0) src = (r < NLAT) ? p.x + (size_t)r * D : p.ctx + (size_t)(r - NLAT) * D;
    else src = XP + (size_t)r * D;
    const int b = row_batch(r);
    float4 v[4];
#pragma unroll
    for (int c = 0; c < 4; c++) v[c] = *(const float4*)(src + c * 256 + lane * 4);
    float s = 0;
#pragma unroll
    for (int c = 0; c < 4; c++) s += v[c].x + v[c].y + v[c].z + v[c].w;
    float mu = wave_sum(s) * (1.f / D);
    float q = 0;
#pragma unroll
    for (int c = 0; c < 4; c++) {
      v[c].x -= mu; v[c].y -= mu; v[c].z -= mu; v[c].w -= mu;
      q += v[c].x * v[c].x + v[c].y * v[c].y + v[c].z * v[c].z + v[c].w * v[c].w;
    }
    float rstd = rsqrtf(wave_sum(q) * (1.f / D) + EPS);
    if (MODE == 1) {
      const float* gm = p.ln_gamma + (size_t)(layer * 2 + 0) * D;
      const float* bt = p.ln_beta + (size_t)(layer * 2 + 0) * D;
      float s2 = 0;
#pragma unroll
      for (int c = 0; c < 4; c++) {
        int col = c * 256 + lane * 4;
        float4 g = *(const float4*)(gm + col), be = *(const float4*)(bt + col);
        v[c].x = v[c].x * rstd * g.x + be.x; v[c].y = v[c].y * rstd * g.y + be.y;
        v[c].z = v[c].z * rstd * g.z + be.z; v[c].w = v[c].w * rstd * g.w + be.w;
        s2 += v[c].x + v[c].y + v[c].z + v[c].w;
      }
      float mu2 = wave_sum(s2) * (1.f / D);
      float q2 = 0;
#pragma unroll
      for (int c = 0; c < 4; c++) {
        v[c].x -= mu2; v[c].y -= mu2; v[c].z -= mu2; v[c].w -= mu2;
        q2 += v[c].x * v[c].x + v[c].y * v[c].y + v[c].z * v[c].z + v[c].w * v[c].w;
      }
      rstd = rsqrtf(wave_sum(q2) * (1.f / D) + EPS);
    }
    const float* sh = ada_ptr(p, layer, b, MODE == 0 ? 0 : 3);
    const float* sc = ada_ptr(p, layer, b, MODE == 0 ? 1 : 4);
#pragma unroll
    for (int c = 0; c < 4; c++) {
      int col = c * 256 + lane * 4;
      float4 a = *(const float4*)(sh + col), m = *(const float4*)(sc + col);
      float y0 = v[c].x * rstd * (1.f + m.x) + a.x, y1 = v[c].y * rstd * (1.f + m.y) + a.y;
      float y2 = v[c].z * rstd * (1.f + m.z) + a.z, y3 = v[c].w * rstd * (1.f + m.w) + a.w;
      *(uint2*)(p.H + (size_t)r * D + col) = make_uint2(pack2(y0, y1), pack2(y2, y3));
    }
  }
}

constexpr int LDS_STRIDE = 72;
constexpr int CT_STRIDE = 132;
template <int MODE>
DI void gemm_store(const Params& p, int layer, int row, int nt, int n0, int c4, const float4 v, const bool dry) {
  if (MODE == 0) {
          u16* dst;
          if (nt >= 16 && nt < 20) dst = p.G + (size_t)row * D + (n0 - 2048) + c4;
          else if (nt >= 28 && nt < 32) dst = p.G + (size_t)row * D + (n0 - 3584 + 512) + c4;
          else dst = p.U + (size_t)row * DIN + n0 + c4;
          if (dry) dst = (u16*)p.S + (size_t)row * DIN + n0 + c4;
          if (n0 + c4 < DIN) *(uint2*)dst = make_uint2(pack2(v.x, v.y), pack2(v.z, v.w));
        } else if (MODE == 1) {
          float* XP = dry ? (float*)p.U : (float*)(p.S + OFF_XP);
          const float* xo = (layer == 0) ? ((row < NLAT) ? p.x + (size_t)row * D : p.ctx + (size_t)(row - NLAT) * D) : p.X + (size_t)row * D;
          const float4 xv = *(const float4*)(xo + n0 + c4);
          const float4 g1 = *(const float4*)(ada_ptr(p, layer, row_batch(row), 2) + n0 + c4);
          *(float4*)(XP + (size_t)row * D + n0 + c4) =
              make_float4(ALPHA * xv.x + g1.x * v.x, ALPHA * xv.y + g1.y * v.y, ALPHA * xv.z + g1.z * v.z, ALPHA * xv.w + g1.w * v.w);
        } else {
          *(uint2*)((dry ? (u16*)(p.S + OFF_PU) : p.U) + (size_t)row * 2048 + n0 + c4) = make_uint2(pack2(v.x, v.y), pack2(v.z, v.w));
        }
}

template <int MODE>
DI void gemm_phase(const Params& p, int layer, char* smem, const u16* A, const u16* Bt, int Mtiles, int Ntiles, const bool dry) {
  u16* As = (u16*)smem;
  u16* Bs = (u16*)smem + 256 * LDS_STRIDE;
  float* Ct = (float*)smem;
  const int tid = otid(), wave = tid >> 6, lane = tid & 63, r = lane & 31, h = lane >> 5;
  const int wm = wave >> 1, wn = wave & 1;
  const int srow = tid >> 3, sc8 = (tid & 7) * 8;
  const int bid = obid(), xcd = bid & 7, jx = bid >> 3, wpx = (gridDim.x + 7 - xcd) >> 3;
  const int ntiles = Mtiles * Ntiles, nchunks = (ntiles + 63) >> 6;
  for (int ch = xcd; ch < nchunks; ch += 8)
  for (int jj = jx; jj < 64; jj += wpx) {
    const int L = ch * 64 + jj;
    if (L >= ntiles) continue;
    const int mt = (L / (4 * Ntiles)) * 4 + (L & 3), nt = (L >> 2) % Ntiles;
    const u16* Ag = A + ((size_t)mt * 256 + srow) * D + sc8;
    const u16* Bg = Bt + ((size_t)nt * 128 + srow) * D + sc8;
    f32x16 acc[4][2];
#pragma unroll
    for (int i = 0; i < 4; i++)
#pragma unroll
      for (int j = 0; j < 2; j++)
#pragma unroll
        for (int e = 0; e < 16; e++) acc[i][j][e] = 0.f;
    bf16x8 ra0, ra1, ra2, ra3, ra4, ra5, ra6, ra7, rb0, rb1, rb2, rb3;
#define GLOAD(kt_) { const u16* ag = Ag + (kt_) * 64; const u16* bg = Bg + (kt_) * 64; \
      ra0 = *(const bf16x8*)(ag); ra1 = *(const bf16x8*)(ag + 32 * D); ra2 = *(const bf16x8*)(ag + 64 * D); ra3 = *(const bf16x8*)(ag + 96 * D); \
      ra4 = *(const bf16x8*)(ag + 128 * D); ra5 = *(const bf16x8*)(ag + 160 * D); ra6 = *(const bf16x8*)(ag + 192 * D); ra7 = *(const bf16x8*)(ag + 224 * D); \
      rb0 = *(const bf16x8*)(bg); rb1 = *(const bf16x8*)(bg + 32 * D); rb2 = *(const bf16x8*)(bg + 64 * D); rb3 = *(const bf16x8*)(bg + 96 * D); }
#define LSTORE() { u16* ad = As + srow * LDS_STRIDE + sc8; u16* bd = Bs + srow * LDS_STRIDE + sc8; \
      *(bf16x8*)(ad) = ra0; *(bf16x8*)(ad + 32 * LDS_STRIDE) = ra1; *(bf16x8*)(ad + 64 * LDS_STRIDE) = ra2; *(bf16x8*)(ad + 96 * LDS_STRIDE) = ra3; \
      *(bf16x8*)(ad + 128 * LDS_STRIDE) = ra4; *(bf16x8*)(ad + 160 * LDS_STRIDE) = ra5; *(bf16x8*)(ad + 192 * LDS_STRIDE) = ra6; *(bf16x8*)(ad + 224 * LDS_STRIDE) = ra7; \
      *(bf16x8*)(bd) = rb0; *(bf16x8*)(bd + 32 * LDS_STRIDE) = rb1; *(bf16x8*)(bd + 64 * LDS_STRIDE) = rb2; *(bf16x8*)(bd + 96 * LDS_STRIDE) = rb3; }
    GLOAD(0)
    __syncthreads();
    LSTORE()
    __syncthreads();
#pragma unroll 1
    for (int kt = 0; kt < 16; kt++) {
      if (kt + 1 < 16 && !(dry && DRYVAR == 1)) GLOAD(kt + 1)
      const u16* as = As + (wm * 128 + r) * LDS_STRIDE + h * 8;
      const u16* bs = Bs + (wn * 64 + r) * LDS_STRIDE + h * 8;
      if (!(dry && DRYVAR == 2)) {
        bf16x8 af[2][4], b0, b1;
#pragma unroll
        for (int i = 0; i < 4; i++) af[0][i] = *(const bf16x8*)(as + i * 32 * LDS_STRIDE);
        b0 = *(const bf16x8*)(bs); b1 = *(const bf16x8*)(bs + 32 * LDS_STRIDE);
#pragma unroll
        for (int kk = 0; kk < 4; kk++) {
          const int cur = kk & 1, nxt = cur ^ 1;
          if (kk < 3) {
#pragma unroll
            for (int i = 0; i < 4; i++) af[nxt][i] = *(const bf16x8*)(as + i * 32 * LDS_STRIDE + (kk + 1) * 16);
          }
          __builtin_amdgcn_s_setprio(1);
#pragma unroll
          for (int i = 0; i < 4; i++) acc[i][0] = MFMA32(af[cur][i], b0, acc[i][0]);
          if (kk < 3) b0 = *(const bf16x8*)(bs + (kk + 1) * 16);
#pragma unroll
          for (int i = 0; i < 4; i++) acc[i][1] = MFMA32(af[cur][i], b1, acc[i][1]);
          if (kk < 3) b1 = *(const bf16x8*)(bs + 32 * LDS_STRIDE + (kk + 1) * 16);
          __builtin_amdgcn_s_setprio(0);
        }
      }
      __syncthreads();
      if (kt + 1 < 16 && !(dry && DRYVAR == 1)) LSTORE()
      __syncthreads();
    }
#undef GLOAD
#undef LSTORE
    const int m0 = mt * 256, n0 = nt * 128;
    const int c4 = (tid & 31) * 4, rr0 = tid >> 5;
#pragma unroll
    for (int ph = 0; ph < 2; ph++) {
      if (ph) __syncthreads();
#pragma unroll
      for (int ii = 0; ii < 2; ii++)
#pragma unroll
        for (int j = 0; j < 2; j++)
#pragma unroll
          for (int e = 0; e < 16; e++) Ct[(wm * 64 + ii * 32 + crow(e, h)) * CT_STRIDE + wn * 64 + j * 32 + r] = acc[ph * 2 + ii][j][e];
      __syncthreads();
#pragma unroll 2
      for (int q = 0; q < 16; q++) {
        const int rl = rr0 + q * 8, row = m0 + (rl >> 6) * 128 + ph * 64 + (rl & 63);
        const float4 v = *(const float4*)(Ct + rl * CT_STRIDE + c4);
        gemm_store<MODE>(p, layer, row, nt, n0, c4, v, dry);
      }
    }
  }
}

template <int MODE>
DI void gemm_thin(const Params& p, int layer, char* smem, const u16* A, const u16* Bt, int row0, int Mtiles, int Ntiles, const bool dry) {
  u16* As = (u16*)smem;
  u16* Bs = (u16*)smem + 64 * LDS_STRIDE;
  float* Ct = (float*)smem;
  const int tid = otid(), wave = tid >> 6, lane = tid & 63, r = lane & 31, h = lane >> 5;
  const int wm = wave >> 1, wn = wave & 1;
  const int srow = tid >> 3, sc8 = (tid & 7) * 8;
  const int ntiles = Mtiles * Ntiles;
  for (int L = obid(); L < ntiles; L += gridDim.x) {
    const int mt = L / Ntiles, nt = L % Ntiles;
    const u16* Ag = A + ((size_t)row0 + mt * 64 + srow) * D + sc8;
    const u16* Bg = Bt + ((size_t)nt * 128 + srow) * D + sc8;
    f32x16 acc0, acc1;
#pragma unroll
    for (int e = 0; e < 16; e++) { acc0[e] = 0.f; acc1[e] = 0.f; }
    bf16x8 ra0, ra1, rb0, rb1, rb2, rb3;
#define GLOADT(kt_) { const u16* ag = Ag + (kt_) * 64; const u16* bg = Bg + (kt_) * 64; \
      ra0 = *(const bf16x8*)(ag); ra1 = *(const bf16x8*)(ag + 32 * D); \
      rb0 = *(const bf16x8*)(bg); rb1 = *(const bf16x8*)(bg + 32 * D); rb2 = *(const bf16x8*)(bg + 64 * D); rb3 = *(const bf16x8*)(bg + 96 * D); }
#define LSTORET() { u16* ad = As + srow * LDS_STRIDE + sc8; u16* bd = Bs + srow * LDS_STRIDE + sc8; \
      *(bf16x8*)(ad) = ra0; *(bf16x8*)(ad + 32 * LDS_STRIDE) = ra1; \
      *(bf16x8*)(bd) = rb0; *(bf16x8*)(bd + 32 * LDS_STRIDE) = rb1; *(bf16x8*)(bd + 64 * LDS_STRIDE) = rb2; *(bf16x8*)(bd + 96 * LDS_STRIDE) = rb3; }
    GLOADT(0)
    __syncthreads();
    LSTORET()
    __syncthreads();
#pragma unroll 1
    for (int kt = 0; kt < 16; kt++) {
      if (kt + 1 < 16) GLOADT(kt + 1)
      const u16* as = As + (wm * 32 + r) * LDS_STRIDE + h * 8;
      const u16* bs = Bs + (wn * 64 + r) * LDS_STRIDE + h * 8;
#pragma unroll
      for (int kk = 0; kk < 4; kk++) {
        const bf16x8 af = *(const bf16x8*)(as + kk * 16);
        const bf16x8 bf0 = *(const bf16x8*)(bs + kk * 16), bf1 = *(const bf16x8*)(bs + 32 * LDS_STRIDE + kk * 16);
        acc0 = MFMA32(af, bf0, acc0);
        acc1 = MFMA32(af, bf1, acc1);
      }
      __syncthreads();
      if (kt + 1 < 16) LSTORET()
      __syncthreads();
    }
#undef GLOADT
#undef LSTORET
#pragma unroll
    for (int e = 0; e < 16; e++) {
      Ct[(wm * 32 + crow(e, h)) * CT_STRIDE + wn * 64 + r] = acc0[e];
      Ct[(wm * 32 + crow(e, h)) * CT_STRIDE + wn * 64 + 32 + r] = acc1[e];
    }
    __syncthreads();
    const int n0 = nt * 128, c4 = (tid & 31) * 4, rr0 = tid >> 5;
#pragma unroll 2
    for (int q = 0; q < 8; q++) {
      const int rl = rr0 + q * 8, row = row0 + mt * 64 + rl;
      const float4 v = *(const float4*)(Ct + rl * CT_STRIDE + c4);
      gemm_store<MODE>(p, layer, row, nt, n0, c4, v, dry);
    }
  }
}

DI int tokrow(int grp, int b, int pos) {
  if (pos < CTX) return NLAT + b * CTX + pos;
  int pp = pos - CTX;
  return b * SEQ + (grp == 0 ? pp : ((pp & 127) * 64 + (pp >> 7)));
}
DI float log_sigmoid(float z) { return fminf(z, 0.f) - __logf(1.f + __expf(-fabsf(z))); }

template <int DK, int DIR>
DI void prep_k(const Params& p, int layer, int grp, int hb, int blk, int cgi) {
  constexpr int CH = DK / 32;
  const int b = hb >> 2, head = hb & 3, k0 = cgi * CH;
  float lb[CH], log_lb[CH], l1m[CH], wg[CH][16], bias[CH], bacc[CH];
#pragma unroll
  for (int c = 0; c < CH; c++) {
    bacc[c] = 0.f; lb[c] = 0.f; log_lb[c] = 0.f; l1m[c] = 0.f; bias[c] = 0.f;
    if (DK == 128) {
      const float* lbp = p.hg_lb + (size_t)DIR * DEPTH * 512 + head * 128 + k0 + c;
      float e0 = lbp[0], e1 = lbp[512], e2 = lbp[1024], e3 = lbp[1536];
      const float mx = fmaxf(fmaxf(e0, e1), fmaxf(e2, e3));
      e0 = __expf(e0 - mx); e1 = __expf(e1 - mx); e2 = __expf(e2 - mx); e3 = __expf(e3 - mx);
      const float inv = 1.f / (e0 + e1 + e2 + e3);
      float cs = 0.f;
      if (layer >= 1) cs += e1 * inv;
      if (layer >= 2) cs += e2 * inv;
      if (layer >= 3) cs += e3 * inv;
      lb[c] = fminf(fmaxf(cs, 0.f), 1.f - 1e-6f);
      log_lb[c] = __logf(fmaxf(lb[c], 1e-30f));
      l1m[c] = __logf(1.f - lb[c]);
    } else {
#pragma unroll
      for (int rr = 0; rr < 16; rr++) wg[c][rr] = p.w_gk2[((size_t)(layer * 2 + DIR) * 16 + rr) * 256 + head * 64 + k0 + c];
      bias[c] = p.b_gk[(size_t)(layer * 2 + DIR) * 256 + head * 64 + k0 + c];
    }
  }
  const size_t chain = (size_t)DIR * 16 + hb;
  const int pk0 = perm16(k0);
  u16* Qd = (u16*)(p.S + (DK == 128 ? OFF_HQ : OFF_GQ)) + (chain * LPOS + (size_t)blk * 32) * DK + pk0;
  u16* Kd = (u16*)(p.S + (DK == 128 ? OFF_HK : OFF_GK)) + (chain * LPOS + (size_t)blk * 32) * DK + pk0;
  u16* KTd = (u16*)(p.S + (DK == 128 ? OFF_HKT : OFF_GKT)) + ((chain * NBLK + blk) * DK + k0) * 32;
#pragma unroll 1
  for (int s2 = 0; s2 < 2; s2++) {
    const int tg = DIR ? 1 - s2 : s2;
    u16 kt[CH][16];
#pragma unroll
    for (int jb = 0; jb < 2; jb++) {
      uint2 zz[8], qq[8];
      u32 gq[8], gk[8];
      uint4 ga[8], gb[8];
#pragma unroll
      for (int j = 0; j < 8; j++) {
        const int j2 = jb * 8 + j;
        const int t16 = DIR ? 15 - j2 : j2;
        const u16* urow = p.U + (size_t)tokrow(grp, b, blk * 32 + tg * 16 + t16) * DIN;
        if (DK == 128) {
          zz[j] = *(const uint2*)(urow + 512 * (1 + DIR) + head * 128 + k0);
          qq[j] = *(const uint2*)(urow + head * 128 + k0);
        } else {
          gq[j] = *(const u32*)(urow + 2560 + head * 64 + k0);
          gk[j] = *(const u32*)(urow + 2816 + head * 64 + k0);
          const uint4* gr = (const uint4*)(urow + 4096 + DIR * 16);
          ga[j] = gr[0]; gb[j] = gr[1];
        }
      }
#pragma unroll
      for (int j = 0; j < 8; j++) {
        const int j2 = jb * 8 + j;
        const int t16 = DIR ? 15 - j2 : j2;
        const int t = tg * 16 + t16;
        float qv[CH], kv[CH], la[CH];
        if (DK == 128) {
          const u32 zw[2] = {zz[j].x, zz[j].y}, qw[2] = {qq[j].x, qq[j].y};
#pragma unroll
          for (int c = 0; c < CH; c++) {
            const float z = (c & 1) ? __uint_as_float(zw[c >> 1] & 0xffff0000u) : __uint_as_float(zw[c >> 1] << 16);
            qv[c] = (c & 1) ? __uint_as_float(qw[c >> 1] & 0xffff0000u) : __uint_as_float(qw[c >> 1] << 16);
            const float ez = __expf(-fabsf(z));
            const float rc = __frcp_rn(1.f + ez);
            const float sp = (z < 0.f) ? ez * rc : rc;
            const float sn = (z < 0.f) ? rc : ez * rc;
            la[c] = __logf(fmaxf(lb[c], 1e-30f) + (1.f - lb[c]) * sp);
            kv[c] = (1.f - lb[c]) * sn;
          }
        } else {
          const u32 gw[8] = {ga[j].x, ga[j].y, ga[j].z, ga[j].w, gb[j].x, gb[j].y, gb[j].z, gb[j].w};
#pragma unroll
          for (int c = 0; c < CH; c++) {
            qv[c] = ((c & 1) ? __uint_as_float(gq[j] & 0xffff0000u) : __uint_as_float(gq[j] << 16)) * 0.125f;
            kv[c] = (c & 1) ? __uint_as_float(gk[j] & 0xffff0000u) : __uint_as_float(gk[j] << 16);
            float d = bias[c];
#pragma unroll
            for (int rr = 0; rr < 8; rr++)
              d += __uint_as_float(gw[rr] << 16) * wg[c][2 * rr] + __uint_as_float(gw[rr] & 0xffff0000u) * wg[c][2 * rr + 1];
            la[c] = (fminf(d, 0.f) - __logf(1.f + __expf(-fabsf(d)))) * (1.f / 16.f);
          }
        }
        float qo[CH], ko[CH];
#pragma unroll
        for (int c = 0; c < CH; c++) {
          bacc[c] += la[c];
          const float eb = __expf(bacc[c]);
          qo[c] = qv[c] * eb;
          ko[c] = kv[c] * __expf(-bacc[c]);
          kt[c][perm16(t16)] = f2bf(ko[c]);
        }
        if (CH == 4) {
          *(uint2*)(Qd + (size_t)t * DK) = make_uint2(pack2(qo[0], qo[1]), pack2(qo[2], qo[3]));
          *(uint2*)(Kd + (size_t)t * DK) = make_uint2(pack2(ko[0], ko[1]), pack2(ko[2], ko[3]));
        } else {
          *(u32*)(Qd + (size_t)t * DK) = pack2(qo[0], qo[1]);
          *(u32*)(Kd + (size_t)t * DK) = pack2(ko[0], ko[1]);
        }
      }
    }
#pragma unroll
    for (int c = 0; c < CH; c++) {
      u16* dst = KTd + c * 32 + tg * 16;
#pragma unroll
      for (int q8 = 0; q8 < 2; q8++) {
        uint4 o;
        o.x = (u32)kt[c][q8 * 8 + 0] | ((u32)kt[c][q8 * 8 + 1] << 16); o.y = (u32)kt[c][q8 * 8 + 2] | ((u32)kt[c][q8 * 8 + 3] << 16);
        o.z = (u32)kt[c][q8 * 8 + 4] | ((u32)kt[c][q8 * 8 + 5] << 16); o.w = (u32)kt[c][q8 * 8 + 6] | ((u32)kt[c][q8 * 8 + 7] << 16);
        *(uint4*)(dst + q8 * 8) = o;
      }
    }
  }
  float* Dd = (float*)(p.S + (DK == 128 ? OFF_HD : OFF_GD)) + (chain * NBLK + blk) * DK + k0;
#pragma unroll
  for (int c = 0; c < CH; c++) Dd[c] = __expf(bacc[c]);
}

DI void prep_phase(const Params& p, int layer) {
  const int tid = otid();
  for (int it = obid(); it < 2 * 16 * (NBLK / 4); it += gridDim.x) {
    const int bg = it % (NBLK / 4), hb = (it / (NBLK / 4)) & 15, grp = it / ((NBLK / 4) * 16);
    const int b = hb >> 2, head = hb & 3;
    {
      const int dir = tid >> 7, blk = bg * 4 + ((tid >> 5) & 3), cgi = tid & 31;
      if (grp == 0) {
        if (dir == 0) prep_k<128, 0>(p, layer, 0, hb, blk, cgi);
        else prep_k<128, 1>(p, layer, 0, hb, blk, cgi);
      } else {
        if (dir == 0) prep_k<64, 0>(p, layer, 1, hb, blk, cgi);
        else prep_k<64, 1>(p, layer, 1, hb, blk, cgi);
      }
    }
    {
      const int vg = tid & 31, tg = tid >> 5;
      const int col = (grp == 0 ? 1536 : 3072) + head * 128 + vg * 4;
      const int pos0 = bg * 128 + tg * 16;
      u16 vt[4][16];
#pragma unroll
      for (int t = 0; t < 16; t++) {
        const uint2 vv = *(const uint2*)(p.U + (size_t)tokrow(grp, b, pos0 + t) * DIN + col);
        vt[0][perm16(t)] = (u16)(vv.x & 0xffffu); vt[1][perm16(t)] = (u16)(vv.x >> 16);
        vt[2][perm16(t)] = (u16)(vv.y & 0xffffu); vt[3][perm16(t)] = (u16)(vv.y >> 16);
      }
#pragma unroll
      for (int c = 0; c < 4; c++) {
        u16* dst = (u16*)(p.S + (grp == 0 ? OFF_HVT : OFF_GVT)) + (((size_t)hb * NBLK + (pos0 >> 5)) * 128 + vg * 4 + c) * 32 + (pos0 & 31);
#pragma unroll
        for (int q8 = 0; q8 < 2; q8++) {
          uint4 o;
          o.x = (u32)vt[c][q8 * 8 + 0] | ((u32)vt[c][q8 * 8 + 1] << 16); o.y = (u32)vt[c][q8 * 8 + 2] | ((u32)vt[c][q8 * 8 + 3] << 16);
          o.z = (u32)vt[c][q8 * 8 + 4] | ((u32)vt[c][q8 * 8 + 5] << 16); o.w = (u32)vt[c][q8 * 8 + 6] | ((u32)vt[c][q8 * 8 + 7] << 16);
          *(uint4*)(dst + q8 * 8) = o;
        }
      }
    }
  }
}

template <int DK>
DI void scan_wg(const Params& p, char* smem, int grp, int dir, int hb) {
  constexpr int NT = DK / 32, NF = DK / 16;
  constexpr int QS = DK + 8;
  constexpr int KTS = 40;
  constexpr int OFF_K = 32 * QS * 2, OFF_KT = 2 * 32 * QS * 2, OFF_D = OFF_KT + DK * KTS * 2, BUFB = OFF_D + DK * 4;
  constexpr int QN = DK / 64;
  constexpr int CPR = DK / 8;
  static_assert(2 * BUFB <= LDS_BYTES, "scan LDS");
  const int tid = otid(), vs = tid >> 6, lane = tid & 63, r = lane & 31, h = lane >> 5;
  const int b = hb >> 2, head = hb & 3;
  const size_t chain = (size_t)dir * 16 + hb;
  const u16* Qb = (const u16*)(p.S + (DK == 128 ? OFF_HQ : OFF_GQ)) + chain * LPOS * DK;
  const u16* Kb = (const u16*)(p.S + (DK == 128 ? OFF_HK : OFF_GK)) + chain * LPOS * DK;
  const u16* KTb = (const u16*)(p.S + (DK == 128 ? OFF_HKT : OFF_GKT)) + chain * NBLK * DK * 32;
  const u16* VTb = (const u16*)(p.S + (DK == 128 ? OFF_HVT : OFF_GVT)) + (size_t)hb * NBLK * 128 * 32 + (vs * 32 + r) * 32 + h * 8;
  const float* Db = (const float*)(p.S + (DK == 128 ? OFF_HD : OFF_GD)) + chain * NBLK * DK;
  u16* Ob = p.U + (size_t)dir * NROW * D + grp * 512 + head * 128 + vs * 32;
  f32x16 S[NT];
#pragma unroll
  for (int kt = 0; kt < NT; kt++)
#pragma unroll
    for (int e = 0; e < 16; e++) S[kt][e] = 0.f;
  bf16x8 sq[QN], sk[QN], skt[QN], vn0, vn1;
  float4 sd = make_float4(0.f, 0.f, 0.f, 0.f);
  auto blk_of = [&](int step) { return dir ? (step < 8 ? 7 - step : 271 - step) : step; };
  auto gload = [&](int step) {
    const size_t pos0 = (size_t)blk_of(step) * 32;
#pragma unroll
    for (int i = 0; i < QN; i++) {
      const int id = tid + i * 256;
      sq[i] = *(const bf16x8*)(Qb + (pos0 + id / CPR) * DK + (id % CPR) * 8);
      sk[i] = *(const bf16x8*)(Kb + (pos0 + id / CPR) * DK + (id % CPR) * 8);
      skt[i] = *(const bf16x8*)(KTb + (size_t)blk_of(step) * DK * 32 + id * 8);
    }
    if (tid < DK / 4) sd = *(const float4*)(Db + (size_t)blk_of(step) * DK + tid * 4);
    vn0 = *(const bf16x8*)(VTb + (size_t)blk_of(step) * 128 * 32);
    vn1 = *(const bf16x8*)(VTb + (size_t)blk_of(step) * 128 * 32 + 16);
  };
  auto lstore = [&](int buf) {
    char* base = smem + buf * BUFB;
#pragma unroll
    for (int i = 0; i < QN; i++) {
      const int id = tid + i * 256;
      *(bf16x8*)(base + ((id / CPR) * QS + (id % CPR) * 8) * 2) = sq[i];
      *(bf16x8*)(base + OFF_K + ((id / CPR) * QS + (id % CPR) * 8) * 2) = sk[i];
      *(bf16x8*)(base + OFF_KT + ((id >> 2) * KTS + (id & 3) * 8) * 2) = skt[i];
    }
    if (tid < DK / 4) *(float4*)(base + OFF_D + tid * 16) = sd;
  };
  __syncthreads();
  gload(0);
  lstore(0);
  bf16x8 vf0 = vn0, vf1 = vn1;
  __syncthreads();
#pragma unroll 1
  for (int step = 0; step < NBLK; step++) {
    const int blk = blk_of(step);
    if (step + 1 < NBLK) gload(step + 1);
    const char* base = smem + (step & 1) * BUFB;
    const u16* Qs = (const u16*)base + r * QS + h * 8;
    const u16* Ks = (const u16*)(base + OFF_K) + r * QS + h * 8;
    const u16* KTs = (const u16*)(base + OFF_KT) + r * KTS + h * 8;
    const float* Ds = (const float*)(base + OFF_D) + 4 * h;
    bf16x8 qf[NF];
    f32x16 P0, P1;
#pragma unroll
    for (int e = 0; e < 16; e++) { P0[e] = 0.f; P1[e] = 0.f; }
#pragma unroll
    for (int f = 0; f < NF; f += 2) {
      qf[f] = *(const bf16x8*)(Qs + f * 16);
      qf[f + 1] = *(const bf16x8*)(Qs + f * 16 + 16);
      P0 = MFMA32(*(const bf16x8*)(Ks + f * 16), qf[f], P0);
      P1 = MFMA32(*(const bf16x8*)(Ks + f * 16 + 16), qf[f + 1], P1);
    }
#pragma unroll
    for (int e = 0; e < 16; e++) {
      const int s = crow(e, h);
      const bool keep = dir ? (s >= r) : (s <= r);
      P0[e] = keep ? P0[e] + P1[e] : 0.f;
    }
    f32x16 oA, oB;
#pragma unroll
    for (int e = 0; e < 16; e++) { oA[e] = 0.f; oB[e] = 0.f; }
    oA = MFMA32(vf0, pack_frag(P0, 0), oA);
    oA = MFMA32(vf1, pack_frag(P0, 1), oA);
#pragma unroll
    for (int kt = 0; kt < NT; kt++) {
      if (kt & 1) {
        oA = MFMA32(pack_frag(S[kt], 0), qf[kt * 2], oA);
        oA = MFMA32(pack_frag(S[kt], 1), qf[kt * 2 + 1], oA);
      } else {
        oB = MFMA32(pack_frag(S[kt], 0), qf[kt * 2], oB);
        oB = MFMA32(pack_frag(S[kt], 1), qf[kt * 2 + 1], oB);
      }
    }
#pragma unroll
    for (int kt = 0; kt < NT; kt++) {
      S[kt] = MFMA32(*(const bf16x8*)(KTs + kt * 32 * KTS), vf0, S[kt]);
      S[kt] = MFMA32(*(const bf16x8*)(KTs + kt * 32 * KTS + 16), vf1, S[kt]);
#pragma unroll
      for (int g = 0; g < 4; g++) {
        const float4 dv = *(const float4*)(Ds + kt * 32 + 8 * g);
        S[kt][4 * g + 0] *= dv.x; S[kt][4 * g + 1] *= dv.y; S[kt][4 * g + 2] *= dv.z; S[kt][4 * g + 3] *= dv.w;
      }
    }
    {
      const int pos0 = blk * 32;
      int rbase, rstride;
      if (pos0 < CTX) { rbase = NLAT + b * CTX + pos0; rstride = 1; }
      else if (grp == 0) { rbase = b * SEQ + pos0 - CTX; rstride = 1; }
      else { const int pp = pos0 - CTX; rbase = b * SEQ + (pp & 127) * 64 + (pp >> 7); rstride = 64; }
      u16* orow = Ob + (size_t)(rbase + r * rstride) * D + 4 * h;
#pragma unroll
      for (int g = 0; g < 4; g++)
        *(uint2*)(orow + 8 * g) = make_uint2(pack2(oA[4 * g] + oB[4 * g], oA[4 * g + 1] + oB[4 * g + 1]),
                                             pack2(oA[4 * g + 2] + oB[4 * g + 2], oA[4 * g + 3] + oB[4 * g + 3]));
    }
    if (step + 1 < NBLK) lstore((step + 1) & 1);
    vf0 = vn0; vf1 = vn1;
    __syncthreads();
  }
}

DI void scan_phase(const Params& p, char* smem, int layer) {
  const int bid = obid(), nscan = gridDim.x > 64 ? 64 : gridDim.x;
  if (bid < nscan) {
    for (int w = bid; w < 64; w += nscan) {
      const int grp = w >> 5, dir = (w >> 4) & 1, hb = w & 15;
      if (grp == 0) scan_wg<128>(p, smem, 0, dir, hb);
      else scan_wg<64>(p, smem, 1, dir, hb);
    }
  }
  if (gridDim.x <= 64 || bid >= 64) {
    const int vbid = gridDim.x <= 64 ? bid : bid - 64, vgrid = gridDim.x <= 64 ? gridDim.x : gridDim.x - 64;
    peer_convert(p, layer, vbid, vgrid);
    if (layer + 1 < DEPTH) weight_convert(p, layer + 1, vbid, vgrid);
  }
}

DI void combine_phase(const Params& p, int layer, int nrows) {
  const int wave = otid() >> 6, lane = otid() & 63;
  const int c0 = lane * 16;
  const float* gain = (c0 < 512 ? p.hg_norm : p.gla_norm) + (size_t)layer * 128 + (c0 & 127);
  float gn[16];
#pragma unroll
  for (int j = 0; j < 16; j++) gn[j] = gain[j];
  for (int r = obid() * 4 + wave; r < nrows; r += gridDim.x * 4) {
    const uint4* of = (const uint4*)(p.U + (size_t)r * D + c0);
    const uint4* ob = (const uint4*)(p.U + (size_t)NROW * D + (size_t)r * D + c0);
    const uint4* gg = (const uint4*)(p.G + (size_t)r * D + c0);
    float o[16], g[16];
#pragma unroll
    for (int c = 0; c < 2; c++) {
      uint4 a = of[c], bq = ob[c], gq = gg[c];
      u32 aw[4] = {a.x, a.y, a.z, a.w}, bw[4] = {bq.x, bq.y, bq.z, bq.w}, gw[4] = {gq.x, gq.y, gq.z, gq.w};
#pragma unroll
      for (int j = 0; j < 4; j++) {
        o[c * 8 + 2 * j] = __uint_as_float(aw[j] << 16) + __uint_as_float(bw[j] << 16);
        o[c * 8 + 2 * j + 1] = __uint_as_float(aw[j] & 0xffff0000u) + __uint_as_float(bw[j] & 0xffff0000u);
        g[c * 8 + 2 * j] = __uint_as_float(gw[j] << 16);
        g[c * 8 + 2 * j + 1] = __uint_as_float(gw[j] & 0xffff0000u);
      }
    }
    float ss = 0;
#pragma unroll
    for (int j = 0; j < 16; j++) ss += o[j] * o[j];
    ss += __shfl_xor(ss, 1); ss += __shfl_xor(ss, 2); ss += __shfl_xor(ss, 4);
    float rs = rsqrtf(ss * (1.f / 128.f) + EPS);
    u32 ow[8];
#pragma unroll
    for (int j = 0; j < 8; j++) {
      float g0 = g[2 * j], g1 = g[2 * j + 1];
      float y0 = o[2 * j] * rs * gn[2 * j] * (g0 / (1.f + __expf(-g0)));
      float y1 = o[2 * j + 1] * rs * gn[2 * j + 1] * (g1 / (1.f + __expf(-g1)));
      ow[j] = pack2(y0, y1);
    }
    uint4* dst = (uint4*)(p.H + (size_t)r * D + c0);
    dst[0] = make_uint4(ow[0], ow[1], ow[2], ow[3]);
    dst[1] = make_uint4(ow[4], ow[5], ow[6], ow[7]);
  }
}

template <bool PAY>
DI void ce(u32& a, u32& b, u32& pa, u32& pb) {
  if (!PAY) { u32 hi = a > b ? a : b, lo = a > b ? b : a; a = hi; b = lo; }
  else { bool c = a >= b; u32 hi = c ? a : b, lo = c ? b : a, ph = c ? pa : pb, pl = c ? pb : pa; a = hi; b = lo; pa = ph; pb = pl; }
}
template <bool PAY>
DI void sort16(u32 (&k)[16], u32 (&q)[16]) {
#pragma unroll
  for (int size = 2; size <= 16; size <<= 1) {
#pragma unroll
    for (int stride = size >> 1; stride > 0; stride >>= 1) {
#pragma unroll
      for (int i = 0; i < 16; i++) {
        int j = i ^ stride;
        if (j > i) {
          if ((i & size) == 0) ce<PAY>(k[i], k[j], q[i], q[j]);
          else ce<PAY>(k[j], k[i], q[j], q[i]);
        }
      }
    }
  }
}
template <bool PAY>
DI void merge16(u32 (&R)[16], u32 (&RP)[16], u32 (&N)[16], u32 (&NP)[16]) {
#pragma unroll
  for (int i = 0; i < 16; i++) {
    bool c = N[15 - i] > R[i];
    R[i] = c ? N[15 - i] : R[i];
    if (PAY) RP[i] = c ? NP[15 - i] : RP[i];
  }
#pragma unroll
  for (int stride = 8; stride > 0; stride >>= 1) {
#pragma unroll
    for (int i = 0; i < 16; i++) {
      int j = i ^ stride;
      if (j > i) ce<PAY>(R[i], R[j], RP[i], RP[j]);
    }
  }
}
DI u32 ord_f(float f) { u32 u = __float_as_uint(f); return (u & 0x80000000u) ? ~u : (u | 0x80000000u); }
DI float unord_f(u32 u) { return __uint_as_float((u & 0x80000000u) ? (u ^ 0x80000000u) : ~u); }

DI void topk_phase(const Params& p, int layer, char* smem, int nrows) {
  const int tid = otid(), wave = tid >> 6, lane = tid & 63, r = lane & 31, h = lane >> 5;
  float* sc = (float*)smem + wave * 4096;
  const u16* Q = p.U;
  const u16* keys = p.keysb + (size_t)layer * 2 * 128 * 128;
  int* IDX = (int*)(p.S + OFF_IDX);
  float* GATE = (float*)(p.S + OFF_GATE);
  const int nunits = (nrows / 64) * 8;
  for (int wu = obid() * 4 + wave; wu < nunits; wu += gridDim.x * 4) {
    const int tok0 = (wu >> 3) * 64, head = wu & 7;
    u32 RA[16], RB[16], dummy[16];
#pragma unroll
    for (int i = 0; i < 16; i++) { RA[i] = 0; RB[i] = 0; dummy[i] = 0; }
    auto do_half = [&](const int half, u32 (&R)[16]) {
      bf16x8 qf[2][8];
#pragma unroll
      for (int nt = 0; nt < 2; nt++) {
        const u16* qp = Q + (size_t)(tok0 + nt * 32 + r) * 2048 + head * 256 + half * 128 + h * 8;
#pragma unroll
        for (int f = 0; f < 8; f++) qf[nt][f] = *(const bf16x8*)(qp + f * 16);
      }
      f32x16 acc0, acc1;
      auto mm = [&](const int kr) {
        const u16* kp = keys + ((size_t)half * 128 + kr * 32 + r) * 128 + h * 8;
#pragma unroll
        for (int e = 0; e < 16; e++) { acc0[e] = 0.f; acc1[e] = 0.f; }
        bf16x8 afk[8];
#pragma unroll
        for (int f = 0; f < 8; f++) afk[f] = *(const bf16x8*)(kp + f * 16);
        __builtin_amdgcn_s_setprio(1);
#pragma unroll
        for (int f = 0; f < 8; f++) {
          acc0 = MFMA32(afk[f], qf[0][f], acc0);
          acc1 = MFMA32(afk[f], qf[1][f], acc1);
        }
        __builtin_amdgcn_s_setprio(0);
      };
      auto put = [&](const int buf) {
        float* d = sc + buf * 2048;
#pragma unroll
        for (int e = 0; e < 16; e++) {
          d[crow(e, h) * 64 + r] = acc0[e];
          d[crow(e, h) * 64 + 32 + r] = acc1[e];
        }
      };
      mm(0);
      put(0);
#pragma unroll
      for (int kr = 0; kr < 4; kr++) {
        if (kr < 3) mm(kr + 1);
        __builtin_amdgcn_wave_barrier();
        const float* sp = sc + (kr & 1) * 2048 + lane;
#pragma unroll
        for (int grp = 0; grp < 2; grp++) {
          u32 N[16];
#pragma unroll
          for (int i = 0; i < 16; i++) {
            const float v = sp[(grp * 16 + i) * 64];
            N[i] = (ord_f(v) & 0xFFFFFF80u) | (u32)(127 - (kr * 32 + grp * 16 + i));
          }
          sort16<false>(N, dummy);
          merge16<false>(R, dummy, N, dummy);
        }
        __builtin_amdgcn_wave_barrier();
        if (kr < 3) put((kr + 1) & 1);
      }
    };
    do_half(0, RA);
    do_half(1, RB);
    {
      float v1[16], v2[16]; u32 i1[16], i2[16];
#pragma unroll
      for (int i = 0; i < 16; i++) {
        v1[i] = unord_f(RA[i] & 0xFFFFFF80u); i1[i] = 127 - (RA[i] & 127u);
        v2[i] = unord_f(RB[i] & 0xFFFFFF80u); i2[i] = 127 - (RB[i] & 127u);
      }
      u32 TK[16], TP[16], NK[16], NP[16];
#define CAND(slot, a, bq) { NK[slot] = ord_f(v1[a] + v2[bq]); NP[slot] = i1[a] * 128u + i2[bq]; }
#pragma unroll
      for (int bq = 0; bq < 16; bq++) { TK[bq] = ord_f(v1[0] + v2[bq]); TP[bq] = i1[0] * 128u + i2[bq]; }
      sort16<true>(TK, TP);
#pragma unroll
      for (int bq = 0; bq < 8; bq++) CAND(bq, 1, bq)
#pragma unroll
      for (int bq = 0; bq < 5; bq++) CAND(8 + bq, 2, bq)
#pragma unroll
      for (int bq = 0; bq < 3; bq++) CAND(13 + bq, 4, bq)
      sort16<true>(NK, NP); merge16<true>(TK, TP, NK, NP);
#pragma unroll
      for (int bq = 0; bq < 4; bq++) CAND(bq, 3, bq)
      CAND(4, 5, 0) CAND(5, 5, 1) CAND(6, 6, 0) CAND(7, 6, 1) CAND(8, 7, 0) CAND(9, 7, 1)
      CAND(10, 8, 0) CAND(11, 9, 0) CAND(12, 10, 0) CAND(13, 11, 0) CAND(14, 12, 0) CAND(15, 13, 0)
      sort16<true>(NK, NP); merge16<true>(TK, TP, NK, NP);
      CAND(0, 14, 0) CAND(1, 15, 0)
#pragma unroll
      for (int i = 2; i < 16; i++) { NK[i] = 0; NP[i] = 0; }
      sort16<true>(NK, NP); merge16<true>(TK, TP, NK, NP);
#undef CAND
      const float mx = unord_f(TK[0]);
      float ev[16], sum = 0.f;
#pragma unroll
      for (int i = 0; i < 16; i++) { ev[i] = __expf(unord_f(TK[i]) - mx); sum += ev[i]; }
      const float inv = 1.f / sum;
      u16* ip = (u16*)IDX + (size_t)(tok0 + lane) * 128 + head * 16;
      float* gp = GATE + (size_t)(tok0 + lane) * 128 + head * 16;
#pragma unroll
      for (int c = 0; c < 2; c++)
        *(uint4*)(ip + c * 8) = make_uint4(TP[c * 8] | (TP[c * 8 + 1] << 16), TP[c * 8 + 2] | (TP[c * 8 + 3] << 16),
                                           TP[c * 8 + 4] | (TP[c * 8 + 5] << 16), TP[c * 8 + 6] | (TP[c * 8 + 7] << 16));
#pragma unroll
      for (int c = 0; c < 4; c++)
        *(float4*)(gp + c * 4) = make_float4(ev[c * 4] * inv, ev[c * 4 + 1] * inv, ev[c * 4 + 2] * inv, ev[c * 4 + 3] * inv);
    }
  }
}

DI float row16_sum(float v) {
  v += __int_as_float(__builtin_amdgcn_update_dpp(0, __float_as_int(v), 0x128, 0xf, 0xf, false));
  v += __int_as_float(__builtin_amdgcn_update_dpp(0, __float_as_int(v), 0x124, 0xf, 0xf, false));
  v += __int_as_float(__builtin_amdgcn_update_dpp(0, __float_as_int(v), 0x122, 0xf, 0xf, false));
  v += __int_as_float(__builtin_amdgcn_update_dpp(0, __float_as_int(v), 0x121, 0xf, 0xf, false));
  return v;
}
DI float gelu_tanh(float x) {
  float u = 0.7978845608028654f * (x + 0.044715f * x * x * x);
  float e = __expf(2.f * u);
  float th = 1.f - 2.f / (e + 1.f);
  return 0.5f * x * (1.f + th);
}
DI float dot8(uint4 a, uint4 b, float acc) {
  acc = __builtin_amdgcn_fdot2_f32_bf16(__builtin_bit_cast(bf2, a.x), __builtin_bit_cast(bf2, b.x), acc, false);
  acc = __builtin_amdgcn_fdot2_f32_bf16(__builtin_bit_cast(bf2, a.y), __builtin_bit_cast(bf2, b.y), acc, false);
  acc = __builtin_amdgcn_fdot2_f32_bf16(__builtin_bit_cast(bf2, a.z), __builtin_bit_cast(bf2, b.z), acc, false);
  acc = __builtin_amdgcn_fdot2_f32_bf16(__builtin_bit_cast(bf2, a.w), __builtin_bit_cast(bf2, b.w), acc, false);
  return acc;
}

typedef float f2 __attribute__((ext_vector_type(2)));
DI void expert_dots(const Params& p, int nrows, char* smem) {
  const int tid = otid(), wave = tid >> 6, lane = tid & 63, g = lane >> 4, s = lane & 15;
  const int bid = obid(), x = bid & 7, jx = bid >> 3, wpx = (gridDim.x + 7 - x) >> 3;
  u32* list = (u32*)smem + wave * 128;
  const int* IDX = (const int*)(p.S + OFF_IDX);
  const float* GATE = (const float*)(p.S + OFF_GATE);
  u16* AV16 = (u16*)(p.S + OFF_PU);
  const unsigned char* PU = (const unsigned char*)(p.PT + PT_U) + s * 16;
  const float* PSU = (const float*)(p.PT + PT_SC);
  const float* PSV = PSU + 16384;
  const int tstep = wpx * 4;
  int t = jx * 4 + wave;
  int ni0 = 0, ni1 = 0;
  uint4 nh[8];
  auto prefetch = [&](int tt) {
    { const u32 w2 = ((const u32*)IDX)[(size_t)tt * 64 + lane]; ni0 = (int)(w2 & 0xffffu); ni1 = (int)(w2 >> 16); }
#pragma unroll
    for (int c = 0; c < 4; c++) {
      const u16* hp = p.H + (size_t)tt * D + (c * 16 + s) * 16;
      nh[2 * c] = *(const uint4*)(hp); nh[2 * c + 1] = *(const uint4*)(hp + 8);
    }
  };
  auto dot_row = [&](const int4 (&uu)[4], const f2 (&hf)[32]) {
    const int uw[16] = {uu[0].x, uu[0].y, uu[0].z, uu[0].w, uu[1].x, uu[1].y, uu[1].z, uu[1].w,
                        uu[2].x, uu[2].y, uu[2].z, uu[2].w, uu[3].x, uu[3].y, uu[3].z, uu[3].w};
    f2 acc = {0.f, 0.f}, acc2 = {0.f, 0.f};
#pragma unroll
    for (int j = 0; j < 16; j++) {
      acc = __builtin_elementwise_fma(__builtin_amdgcn_cvt_pk_f32_fp8(uw[j], false), hf[2 * j], acc);
      acc2 = __builtin_elementwise_fma(__builtin_amdgcn_cvt_pk_f32_fp8(uw[j], true), hf[2 * j + 1], acc2);
    }
    return row16_sum((acc.x + acc.y) + (acc2.x + acc2.y));
  };
  if (t < nrows) prefetch(t);
  for (; t < nrows; t += tstep) {
    const int i0 = ni0, i1 = ni1;
    f2 hf[32];
#pragma unroll
    for (int c = 0; c < 4; c++) {
      const u32 hw[8] = {nh[2 * c].x, nh[2 * c].y, nh[2 * c].z, nh[2 * c].w, nh[2 * c + 1].x, nh[2 * c + 1].y, nh[2 * c + 1].z, nh[2 * c + 1].w};
#pragma unroll
      for (int j = 0; j < 8; j++) { hf[c * 8 + j].x = __uint_as_float(hw[j] << 16); hf[c * 8 + j].y = __uint_as_float(hw[j] & 0xffff0000u); }
    }
    if (t + tstep < nrows) prefetch(t + tstep);
    const bool b0 = (i0 >> 11) == x, b1 = (i1 >> 11) == x;
    const unsigned long long m0 = __ballot(b0), m1 = __ballot(b1);
    const int n0 = __popcll(m0);
    const int r0 = __builtin_amdgcn_mbcnt_hi((u32)(m0 >> 32), __builtin_amdgcn_mbcnt_lo((u32)m0, 0u));
    const int r1 = n0 + __builtin_amdgcn_mbcnt_hi((u32)(m1 >> 32), __builtin_amdgcn_mbcnt_lo((u32)m1, 0u));
    const int n = n0 + __popcll(m1);
    __builtin_amdgcn_wave_barrier();
    if (b0) list[r0] = ((u32)(2 * lane) << 16) | (u32)i0;
    if (b1) list[r1] = ((u32)(2 * lane + 1) << 16) | (u32)i1;
    __builtin_amdgcn_wave_barrier();
    for (int cb = 0; cb < n; cb += 64) {
      const int nend = min(n, cb + 64);
      float dk = 0.f;
      for (int base = cb; base < nend; base += 8) {
        const int k0 = base + g, k1 = base + 4 + g;
        const u32 ent0 = list[min(k0, n - 1)], ent1 = list[min(k1, n - 1)];
        const unsigned char* ur0 = PU + (size_t)(ent0 & 0xffffu) * D;
        const unsigned char* ur1 = PU + (size_t)(ent1 & 0xffffu) * D;
        int4 ua[4], ub[4];
        ua[0] = *(const int4*)(ur0); ua[1] = *(const int4*)(ur0 + 256); ua[2] = *(const int4*)(ur0 + 512); ua[3] = *(const int4*)(ur0 + 768);
        ub[0] = *(const int4*)(ur1); ub[1] = *(const int4*)(ur1 + 256); ub[2] = *(const int4*)(ur1 + 512); ub[3] = *(const int4*)(ur1 + 768);
        const float d0 = dot_row(ua, hf);
        const float d1 = dot_row(ub, hf);
        const int it0 = (base - cb) >> 2;
        dk = (s == it0) ? d0 : dk;
        dk = (s == it0 + 1) ? d1 : dk;
      }
      const int kk = cb + 4 * s + g;
      if (kk < nend) {
        const u32 ent = list[kk];
        const int e = (int)(ent & 0xffffu), slot = (int)(ent >> 16);
        AV16[(size_t)t * 128 + slot] = f2bf(GATE[(size_t)t * 128 + slot] * PSV[e] * gelu_tanh(dk * PSU[e]));
      }
    }
  }
}

DI void expert_vsum(const Params& p, int nrows) {
  const int tid = otid(), wave = tid >> 6, lane = tid & 63, g = lane >> 3, s = lane & 7;
  const int bid = obid(), x = bid & 7, jx = bid >> 3, wpx = (gridDim.x + 7 - x) >> 3;
  const u16* IDX = (const u16*)(p.S + OFF_IDX) + g * 16;
  const u16* AV = (const u16*)(p.S + OFF_PU) + g * 16;
  const unsigned char* PV = (const unsigned char*)(p.PT + PT_V) + (size_t)x * 16384 * 128 + s * 16;
  u16* Y = (u16*)((char*)p.U + (size_t)NROW * 2048 * 2);
  const int b5 = (lane >> 5) & 1, b4 = (lane >> 4) & 1, b3 = (lane >> 3) & 1;
  const int tstep = wpx * 4;
  int t = jx * 4 + wave;
  uint4 ni[2], na[2];
  auto prefetch = [&](int tt) {
#pragma unroll
    for (int j = 0; j < 2; j++) { ni[j] = *(const uint4*)(IDX + (size_t)tt * 128 + j * 8); na[j] = *(const uint4*)(AV + (size_t)tt * 128 + j * 8); }
  };
  if (t < nrows) prefetch(t);
  for (; t < nrows; t += tstep) {
    const u32 iw[8] = {ni[0].x, ni[0].y, ni[0].z, ni[0].w, ni[1].x, ni[1].y, ni[1].z, ni[1].w};
    const u32 aw[8] = {na[0].x, na[0].y, na[0].z, na[0].w, na[1].x, na[1].y, na[1].z, na[1].w};
    int ee[16]; float aa[16];
#pragma unroll
    for (int j = 0; j < 8; j++) {
      ee[2 * j] = (int)(iw[j] & 0xffffu); ee[2 * j + 1] = (int)(iw[j] >> 16);
      aa[2 * j] = __uint_as_float(aw[j] << 16); aa[2 * j + 1] = __uint_as_float(aw[j] & 0xffff0000u);
    }
    int4 vv[16];
#pragma unroll
    for (int it = 0; it < 16; it++) vv[it] = *(const int4*)(PV + (size_t)ee[it] * 128);
    if (t + tstep < nrows) prefetch(t + tstep);
    f2 y[8];
#pragma unroll
    for (int i = 0; i < 8; i++) { y[i].x = 0.f; y[i].y = 0.f; }
#pragma unroll
    for (int it = 0; it < 16; it++) {
      const f2 a2 = {aa[it], aa[it]};
      const int vw[4] = {vv[it].x, vv[it].y, vv[it].z, vv[it].w};
#pragma unroll
      for (int j = 0; j < 4; j++) {
        y[2 * j] = __builtin_elementwise_fma(__builtin_amdgcn_cvt_pk_f32_fp8(vw[j], false), a2, y[2 * j]);
        y[2 * j + 1] = __builtin_elementwise_fma(__builtin_amdgcn_cvt_pk_f32_fp8(vw[j], true), a2, y[2 * j + 1]);
      }
    }
    f2 k4[4], k2[2], k1;
#pragma unroll
    for (int i = 0; i < 4; i++) {
      const f2 keep = b5 ? y[4 + i] : y[i], send = b5 ? y[i] : y[4 + i];
      k4[i].x = keep.x + __shfl_xor(send.x, 32); k4[i].y = keep.y + __shfl_xor(send.y, 32);
    }
#pragma unroll
    for (int i = 0; i < 2; i++) {
      const f2 keep = b4 ? k4[2 + i] : k4[i], send = b4 ? k4[i] : k4[2 + i];
      k2[i].x = keep.x + __shfl_xor(send.x, 16); k2[i].y = keep.y + __shfl_xor(send.y, 16);
    }
    {
      const f2 keep = b3 ? k2[1] : k2[0], send = b3 ? k2[0] : k2[1];
      k1.x = keep.x + __shfl_xor(send.x, 8); k1.y = keep.y + __shfl_xor(send.y, 8);
    }
    *(u32*)(Y + (size_t)t * D + x * 128 + s * 16 + b5 * 8 + b4 * 4 + b3 * 2) = pack2(k1.x, k1.y);
  }
}

DI void expert_epilogue(const Params& p, int layer, int nrows) {
  const int tid = otid(), wave = tid >> 6, lane = tid & 63, g = lane >> 5, s = lane & 31;
  const bool last = (layer == DEPTH - 1);
  const u16* Y = (const u16*)((const char*)p.U + (size_t)NROW * 2048 * 2);
  for (int tk = obid() * 4 + wave; tk < nrows; tk += gridDim.x * 4) {
    const int b = row_batch(tk);
    const int col = (g * 32 + s) * 16;
    const float* g2 = ada_ptr(p, layer, b, 5) + col;
    const float* gm = p.ln_gamma + (size_t)(layer * 2 + 1) * D + col;
    const float* bt = p.ln_beta + (size_t)(layer * 2 + 1) * D + col;
    const float* XP = (const float*)(p.S + OFF_XP) + (size_t)tk * D + col;
    float xin[16];
    {
      float s0 = 0.f;
#pragma unroll
      for (int j4 = 0; j4 < 4; j4++) {
        const float4 t4 = *(const float4*)(XP + j4 * 4);
        xin[j4 * 4] = t4.x; xin[j4 * 4 + 1] = t4.y; xin[j4 * 4 + 2] = t4.z; xin[j4 * 4 + 3] = t4.w;
        s0 += t4.x + t4.y + t4.z + t4.w;
      }
      const float m0 = wave_sum(s0) * (1.f / D);
      float q0 = 0.f;
#pragma unroll
      for (int j = 0; j < 16; j++) { xin[j] -= m0; q0 += xin[j] * xin[j]; }
      const float r0 = rsqrtf(wave_sum(q0) * (1.f / D) + EPS);
      const float* gm0 = p.ln_gamma + (size_t)(layer * 2 + 0) * D + col;
      const float* bt0 = p.ln_beta + (size_t)(layer * 2 + 0) * D + col;
#pragma unroll
      for (int j4 = 0; j4 < 4; j4++) {
        const float4 ga = *(const float4*)(gm0 + j4 * 4), be = *(const float4*)(bt0 + j4 * 4);
        xin[j4 * 4] = xin[j4 * 4] * r0 * ga.x + be.x; xin[j4 * 4 + 1] = xin[j4 * 4 + 1] * r0 * ga.y + be.y;
        xin[j4 * 4 + 2] = xin[j4 * 4 + 2] * r0 * ga.z + be.z; xin[j4 * 4 + 3] = xin[j4 * 4 + 3] * r0 * ga.w + be.w;
      }
    }
    float xv[16];
    float sum = 0.f;
    const uint4 yq0 = *(const uint4*)(Y + (size_t)tk * D + col), yq1 = *(const uint4*)(Y + (size_t)tk * D + col + 8);
    const u32 yw[8] = {yq0.x, yq0.y, yq0.z, yq0.w, yq1.x, yq1.y, yq1.z, yq1.w};
#pragma unroll
    for (int j4 = 0; j4 < 4; j4++) {
      const float4 xo = make_float4(xin[j4 * 4], xin[j4 * 4 + 1], xin[j4 * 4 + 2], xin[j4 * 4 + 3]);
      const float4 gg = *(const float4*)(g2 + j4 * 4);
      const float4 yy = make_float4(__uint_as_float(yw[2 * j4] << 16), __uint_as_float(yw[2 * j4] & 0xffff0000u),
                                    __uint_as_float(yw[2 * j4 + 1] << 16), __uint_as_float(yw[2 * j4 + 1] & 0xffff0000u));
      float* o = xv + j4 * 4;
      o[0] = ALPHA * xo.x + gg.x * yy.x; o[1] = ALPHA * xo.y + gg.y * yy.y;
      o[2] = ALPHA * xo.z + gg.z * yy.z; o[3] = ALPHA * xo.w + gg.w * yy.w;
      sum += o[0] + o[1] + o[2] + o[3];
    }
    float mu = wave_sum(sum) * (1.f / D);
    float q = 0.f;
#pragma unroll
    for (int j = 0; j < 16; j++) { xv[j] -= mu; q += xv[j] * xv[j]; }
    float rstd = rsqrtf(wave_sum(q) * (1.f / D) + EPS);
    float* dstx = (last ? p.out : p.X) + (size_t)tk * D + col;
    float s2 = 0.f;
#pragma unroll
    for (int j4 = 0; j4 < 4; j4++) {
      const float4 gmv = *(const float4*)(gm + j4 * 4);
      const float4 btv = *(const float4*)(bt + j4 * 4);
      float* o = xv + j4 * 4;
      o[0] = o[0] * rstd * gmv.x + btv.x; o[1] = o[1] * rstd * gmv.y + btv.y;
      o[2] = o[2] * rstd * gmv.z + btv.z; o[3] = o[3] * rstd * gmv.w + btv.w;
      s2 += o[0] + o[1] + o[2] + o[3];
      *(float4*)(dstx + j4 * 4) = make_float4(o[0], o[1], o[2], o[3]);
    }
    if (!last) {
      float mu2 = wave_sum(s2) * (1.f / D);
      float q2 = 0.f;
#pragma unroll
      for (int j = 0; j < 16; j++) { xv[j] -= mu2; q2 += xv[j] * xv[j]; }
      float rstd2 = rsqrtf(wave_sum(q2) * (1.f / D) + EPS);
      const float* sh = ada_ptr(p, layer + 1, b, 0) + col;
      const float* sc = ada_ptr(p, layer + 1, b, 1) + col;
      u32 ow[8];
#pragma unroll
      for (int j = 0; j < 8; j++) {
        float y0 = xv[2 * j] * rstd2 * (1.f + sc[2 * j]) + sh[2 * j];
        float y1 = xv[2 * j + 1] * rstd2 * (1.f + sc[2 * j + 1]) + sh[2 * j + 1];
        ow[j] = pack2(y0, y1);
      }
      *(uint4*)(p.H + (size_t)tk * D + col) = make_uint4(ow[0], ow[1], ow[2], ow[3]);
      *(uint4*)(p.H + (size_t)tk * D + col + 8) = make_uint4(ow[4], ow[5], ow[6], ow[7]);
    }
  }
}

#define XB_TMO      128
#define XB_XCNT(j)  (256  + 64 * (j))
#define XB_XSUB(j)  (1280 + 64 * (j))
#define XB_XGEN(j)  (2304 + 64 * (j))
#define XB_TOP      3328
#define XB_TOPGEN   3392
#define XCD_BAR_WORDS 3456
#define XB_SPIN_CAP (1u << 18)
#define LAS __attribute__((address_space(3)))

__device__ __forceinline__ unsigned xb_ld(unsigned* p)              { return __hip_atomic_load(p, __ATOMIC_RELAXED, __HIP_MEMORY_SCOPE_AGENT); }
__device__ __forceinline__ unsigned xb_add(unsigned* p, unsigned v) { return __hip_atomic_fetch_add(p, v, __ATOMIC_RELAXED, __HIP_MEMORY_SCOPE_AGENT); }
__device__ __forceinline__ unsigned xb_xcc_id() { return (unsigned)__builtin_amdgcn_s_getreg((3 << 11) | 20) & 0xFu; }
#define XB_SPIN(cond, bar) do { unsigned _sp = 0; while (cond) { __builtin_amdgcn_s_sleep(1); \
    if ((++_sp & 255u) == 0u) { if (xb_ld(&(bar)[XB_TMO])) break; if (_sp > XB_SPIN_CAP) { atomicAdd(&(bar)[XB_TMO], 1u); break; } } } } while (0)

struct XcdBarrier {
    unsigned* bar; unsigned x;
    volatile LAS unsigned* st;
};

__device__ __forceinline__ XcdBarrier xcd_barrier_post(unsigned* bar, volatile LAS unsigned* st) {
    XcdBarrier b; b.bar = bar; b.x = xb_xcc_id(); b.st = st;
    if (threadIdx.x == 0) (void)xb_add(&bar[XB_XCNT(b.x)], 1u);
    return b;
}
__device__ __forceinline__ void xcd_barrier_complete(unsigned* bar, unsigned x, unsigned& nloc, unsigned& nx) {
    const unsigned G = gridDim.x * gridDim.y * gridDim.z;
    unsigned sum, cnt, mine, sp = 0u;
    for (;;) {
        sum = 0u; cnt = 0u; mine = 0u;
#pragma unroll
        for (unsigned j = 0; j < 16; ++j) { const unsigned c = xb_ld(&bar[XB_XCNT(j)]); sum += c; cnt += (c > 0u) ? 1u : 0u; mine = (j == x) ? c : mine; }
        if (sum == G) break;
        __builtin_amdgcn_s_sleep(1);
        if ((++sp & 255u) == 0u) { if (xb_ld(&bar[XB_TMO])) break; if (sp > XB_SPIN_CAP) { atomicAdd(&bar[XB_TMO], 1u); break; } }
    }
    nloc = mine > 0u ? mine : 1u; nx = cnt > 0u ? cnt : 1u;
}

__device__ __forceinline__ void xcd_barrier(const XcdBarrier& b) {
    asm volatile("s_waitcnt vmcnt(0)" ::: "memory");
    __syncthreads();
    if (threadIdx.x == 0) {
        unsigned* bar = b.bar;
        __builtin_amdgcn_s_waitcnt(0);
        unsigned nloc = b.st[0], nx = b.st[1];
        if (nloc == 0u) { xcd_barrier_complete(bar, b.x, nloc, nx); b.st[0] = nloc; b.st[1] = nx; }
        const unsigned old = xb_add(&bar[XB_XSUB(b.x)], 1u);
        const unsigned gen = old / nloc;
        if (old + 1u == (gen + 1u) * nloc) {
            __builtin_amdgcn_fence(__ATOMIC_RELEASE, "agent");
            asm volatile("s_waitcnt vmcnt(0)" ::: "memory");
            const unsigned og = xb_add(&bar[XB_TOP], 1u);
            const unsigned tg = og / nx;
            if (og + 1u == (tg + 1u) * nx) xb_add(&bar[XB_TOPGEN], 1u);
            else XB_SPIN(xb_ld(&bar[XB_TOPGEN]) == tg, bar);
            __builtin_amdgcn_fence(__ATOMIC_ACQUIRE, "agent");
            xb_add(&bar[XB_XGEN(b.x)], 1u);
            asm volatile("s_waitcnt vmcnt(0)" ::: "memory");
        } else {
            XB_SPIN(xb_ld(&bar[XB_XGEN(b.x)]) == gen, bar);
            __builtin_amdgcn_fence(__ATOMIC_ACQUIRE, "agent");
            asm volatile("s_waitcnt vmcnt(0)" ::: "memory");
        }
    }
    __syncthreads();
}


DI void grid_barrier(unsigned* ctr, unsigned& target) {
  asm volatile("s_waitcnt vmcnt(0)" ::: "memory");
  __syncthreads();
  if (threadIdx.x == 0) {
    target += gridDim.x;
    __builtin_amdgcn_fence(__ATOMIC_RELEASE, "agent");
    asm volatile("s_waitcnt vmcnt(0)" ::: "memory");
    __hip_atomic_fetch_add(ctr, 1u, __ATOMIC_RELAXED, __HIP_MEMORY_SCOPE_AGENT);
    while (__hip_atomic_load(ctr, __ATOMIC_RELAXED, __HIP_MEMORY_SCOPE_AGENT) < target) __builtin_amdgcn_s_sleep(1);
    __builtin_amdgcn_fence(__ATOMIC_ACQUIRE, "agent");
    asm volatile("s_waitcnt vmcnt(0)" ::: "memory");
  }
  __syncthreads();
}

__global__ void __launch_bounds__(256, 2) mk_forward(Params p) {
  __shared__ __attribute__((aligned(16))) char smem[LDS_BYTES];
  cg::grid_group grid = cg::this_grid();
  int pc = 0;
#define GSYNC() xcd_barrier(xb)
#define PHASE(body) PHASER(15, body)
#define PHASER(kind, body)                              \
  {                                                     \
    if (pc >= p.ph_lo && pc < p.ph_hi) {                \
      if ((REPMASK >> (kind)) & 1) { const bool dry = true; (void)dry; body; GSYNC(); } \
      { const bool dry = false; (void)dry; body; }      \
      if (pc + 1 < p.ph_hi) GSYNC();                    \
    }                                                   \
    pc++;                                               \
  }
  __shared__ __attribute__((aligned(16))) unsigned xb_words[4];
  if (threadIdx.x == 0) { xb_words[0] = 0u; xb_words[1] = 0u; xb_words[2] = 0u; xb_words[3] = 0u; }
  __syncthreads();
  const XcdBarrier xb = xcd_barrier_post(p.bar, (volatile LAS unsigned*)xb_words);
  if (0 >= p.ph_lo && 0 < p.ph_hi) {
    phase0(p, (float*)smem);
    if (1 < p.ph_hi) grid.sync();
  }
  pc++;
  PHASE(phase0b(p))
  PHASE(lnmod_phase<0>(p, 0, NROW))
  for (int layer = 0; layer < DEPTH; layer++) {
    const bool last = (layer == DEPTH - 1);
    const int nrows = last ? NLAT : NROW;
    PHASER(0, gemm_phase<0>(p, layer, smem, p.H, p.wt_in + (size_t)layer * DINP * D, NROW / 256, DINP / 128, dry))
    PHASER(1, prep_phase(p, layer))
    PHASER(2, scan_phase(p, smem, layer))
    PHASER(3, combine_phase(p, layer, nrows))
    PHASER(4, { gemm_phase<1>(p, layer, smem, p.H, p.wt_out + (size_t)layer * D * D, NLAT / 256, 8, dry);
                 if (nrows > NLAT) gemm_thin<1>(p, layer, smem, p.H, p.wt_out + (size_t)layer * D * D, NLAT, NCTX / 64, 8, dry); })
    PHASER(5, lnmod_phase<1>(p, layer, nrows))
    PHASER(6, { gemm_phase<2>(p, layer, smem, p.H, p.wt_q + (size_t)layer * 2048 * D, NLAT / 256, 16, dry);
                 if (nrows > NLAT) gemm_thin<2>(p, layer, smem, p.H, p.wt_q + (size_t)layer * 2048 * D, NLAT, NCTX / 64, 16, dry); })
    PHASER(7, topk_phase(p, layer, smem, nrows))
    PHASER(8, expert_dots(p, nrows, smem))
    PHASER(9, expert_vsum(p, nrows))
    PHASER(10, expert_epilogue(p, layer, nrows))
  }
#undef PHASE
#undef PHASER
}
constexpr int NPHASES = 3 + 11 * DEPTH;

extern "C" void kernel_launch(void* const* d_in, const int* in_sizes, int n_in, void* d_out, int out_size, void* d_ws,
                              size_t ws_size, hipStream_t stream) {
  Params p{};
  p.x = (const float*)d_in[0]; p.c = (const float*)d_in[1]; p.ctx = (const float*)d_in[2]; p.c_ctx = (const float*)d_in[3];
  p.w_ada = (const float*)d_in[4]; p.b_ada = (const float*)d_in[5]; p.w_in = (const float*)d_in[6];
  p.w_gk2 = (const float*)d_in[7]; p.b_gk = (const float*)d_in[8]; p.hg_lb = (const float*)d_in[9];
  p.hg_norm = (const float*)d_in[10]; p.gla_norm = (const float*)d_in[11]; p.w_out = (const float*)d_in[12];
  p.ln_gamma = (const float*)d_in[13]; p.ln_beta = (const float*)d_in[14]; p.wq = (const float*)d_in[15];
  p.sub_keys = (const float*)d_in[16]; p.peer_u = (const float*)d_in[17]; p.peer_v = (const float*)d_in[18];
  p.out = (float*)d_out;
  char* w = (char*)d_ws;
  size_t off = 0;
  auto take = [&](size_t bytes) { char* q = w + off; off += (bytes + 255) & ~(size_t)255; return q; };
  p.wt_in = (u16*)take((size_t)4 * DINP * D * 2);
  p.wt_out = (u16*)take((size_t)4 * D * D * 2);
  p.wt_q = (u16*)take((size_t)4 * 2048 * D * 2);
  p.keysb = (u16*)take((size_t)4 * 2 * 128 * 128 * 2);
  p.ada_part = (float*)take((size_t)8 * 4 * 5 * 6144 * 4);
  p.ada = (float*)take((size_t)4 * 5 * 6144 * 4);
  p.X = (float*)take((size_t)NROW * D * 4);
  p.H = (u16*)take((size_t)NROW * D * 2);
  p.G = (u16*)take((size_t)NROW * D * 2);
  p.U = (u16*)take((size_t)NROW * DIN * 2);
  p.S = take(SZ_S);
  p.PT = take(SZ_PT);
  p.bar = (unsigned*)take(XCD_BAR_WORDS * 4);
  if (off > ws_size) { fprintf(stderr, "workspace too small: need %zu have %zu\n", off, ws_size); return; }

  static int grid_blocks = 0;
  if (!grid_blocks) {
    int dev = 0, cus = 0, per_cu = 0;
    hipGetDevice(&dev);
    hipDeviceGetAttribute(&cus, hipDeviceAttributeMultiprocessorCount, dev);
    hipOccupancyMaxActiveBlocksPerMultiprocessor(&per_cu, mk_forward, 256, 0);
    if (per_cu > 2) per_cu = 2;
    grid_blocks = cus * per_cu;
  }
#if ONE_LAUNCH
  hipMemsetAsync(p.bar, 0, XCD_BAR_WORDS * 4, stream);
  p.ph_lo = 0; p.ph_hi = NPHASES;
  void* args[] = {&p};
  hipError_t e = hipLaunchCooperativeKernel((void*)mk_forward, dim3(grid_blocks), dim3(256), args, 0, stream);
  if (e != hipSuccess) fprintf(stderr, "cooperative launch failed: %s (grid %d)\n", hipGetErrorString(e), grid_blocks);
#else
  for (int ph = 0; ph < NPHASES; ph++) {
    p.ph_lo = ph; p.ph_hi = ph + 1;
    hipLaunchKernelGGL(mk_forward, dim3(grid_blocks), dim3(256), 0, stream, p);
  }
#endif
}
```

```cpp
#include <hip/hip_runtime.h>
#include <hip/hip_cooperative_groups.h>
#include <cstdio>
namespace cg = cooperative_groups;

#define DI __device__ __forceinline__
typedef unsigned short u16;
typedef unsigned int u32;
typedef __attribute__((ext_vector_type(8))) short bf16x8;
typedef __attribute__((ext_vector_type(16))) float f32x16;
typedef __attribute__((ext_vector_type(2))) __bf16 bf2;

#ifndef REPMASK
#define REPMASK 0
#endif
#ifndef DRYVAR
#define DRYVAR 0
#endif
#ifndef ONE_LAUNCH
#define ONE_LAUNCH 1
#endif

constexpr int D = 1024, NB = 4, SEQ = 8192, DEPTH = 4, CTX = 256;
constexpr int NLAT = NB * SEQ;
constexpr int NCTX = NB * CTX;
constexpr int NROW = NLAT + NCTX;
constexpr int DIN = 4128, DINP = 4224;
constexpr int LPOS = CTX + SEQ;
constexpr int NBLK = LPOS / 32;
constexpr float ALPHA = 1.681792830507429f;
constexpr float EPS = 1e-6f;
constexpr int LDS_BYTES = 73728;

struct Params {
  const float *x, *c, *ctx, *c_ctx, *w_ada, *b_ada, *w_in, *w_gk2, *b_gk, *hg_lb, *hg_norm, *gla_norm,
      *w_out, *ln_gamma, *ln_beta, *wq, *sub_keys, *peer_u, *peer_v;
  float* out;
  u16 *wt_in, *wt_out, *wt_q, *keysb;
  float *ada_part, *ada;
  float* X;
  u16 *H, *G, *U;
  char* S;
  char* PT;
  unsigned* bar;
  int ph_lo, ph_hi;
};

constexpr size_t SZ_HQ = (size_t)2 * 16 * LPOS * 128 * 2;
constexpr size_t SZ_HVT = (size_t)16 * 128 * LPOS * 2;
constexpr size_t SZ_HD = (size_t)2 * 16 * NBLK * 128 * 4;
constexpr size_t SZ_GQ = (size_t)2 * 16 * LPOS * 64 * 2;
constexpr size_t SZ_GD = (size_t)2 * 16 * NBLK * 64 * 4;
constexpr size_t OFF_HQ = 0, OFF_HK = OFF_HQ + SZ_HQ, OFF_HKT = OFF_HK + SZ_HQ, OFF_HVT = OFF_HKT + SZ_HQ,
                 OFF_HD = OFF_HVT + SZ_HVT, OFF_GQ = OFF_HD + SZ_HD, OFF_GK = OFF_GQ + SZ_GQ, OFF_GKT = OFF_GK + SZ_GQ,
                 OFF_GVT = OFF_GKT + SZ_GQ, OFF_GD = OFF_GVT + SZ_HVT, SZ_S = OFF_GD + SZ_GD;
constexpr size_t OFF_XP = 0, SZ_XP = (size_t)NROW * D * 4;
constexpr size_t OFF_IDX = OFF_XP + SZ_XP, SZ_IDX = (size_t)NROW * 128 * 4;
constexpr size_t OFF_GATE = OFF_IDX + SZ_IDX;
constexpr size_t OFF_PU = OFF_GATE + SZ_IDX, SZ_PU = (size_t)16384 * D * 2;
constexpr size_t OFF_PV = OFF_PU + SZ_PU;
constexpr size_t OFF_PSC = OFF_PV + SZ_PU;
static_assert(OFF_PSC + 2 * 16384 * 4 <= SZ_S, "alias overflow");
constexpr size_t PT_U = 0, PT_V = (size_t)16384 * D, PT_SC = 2 * (size_t)16384 * D, SZ_PT = PT_SC + 2 * 16384 * 4;

DI int otid() { int t = threadIdx.x; asm volatile("" : "+v"(t)); return t; }
DI int obid() { int t = blockIdx.x; asm volatile("" : "+s"(t)); return t; }
DI float bf2f(u16 h) { return __uint_as_float(((u32)h) << 16); }
DI u16 f2bf(float x) { return __builtin_bit_cast(u16, (__bf16)x); }
typedef __attribute__((ext_vector_type(2))) float f32x2v;
typedef __attribute__((ext_vector_type(2))) __bf16 bf16x2v;
DI u32 pack2(float a, float b) { f32x2v v = {a, b}; return __builtin_bit_cast(u32, __builtin_convertvector(v, bf16x2v)); }
DI float wave_sum(float v) {
#pragma unroll
  for (int o = 32; o > 0; o >>= 1) v += __shfl_xor(v, o);
  return v;
}
DI int crow(int i, int h) { return (i & 3) + 8 * (i >> 2) + 4 * h; }
DI int perm16(int k) {
  int kk = k & 15;
  return (k & ~15) | (((kk >> 2) & 1) << 3) | ((kk >> 3) << 2) | (kk & 3);
}
DI bf16x8 pack_frag(const f32x16& x, int s) {
  union { bf16x8 v; u32 u[4]; } r;
#pragma unroll
  for (int j = 0; j < 4; j++) r.u[j] = pack2(x[8 * s + 2 * j], x[8 * s + 2 * j + 1]);
  return r.v;
}
#define MFMA32(a, b, c) __builtin_amdgcn_mfma_f32_32x32x16_bf16((a), (b), (c), 0, 0, 0)

DI const float* ada_ptr(const Params& p, int layer, int r, int j) { return p.ada + ((size_t)(layer * 5 + r) * 6 + j) * D; }
DI int row_batch(int r) { return r < NLAT ? (r >> 13) : 4; }

DI void weight_convert(const Params& p, int l, int vbid, int vgrid) {
  const size_t gtid = (size_t)vbid * 256 + otid(), gsz = (size_t)vgrid * 256;
  for (size_t i = gtid; i < (size_t)128 * DINP; i += gsz) {
    int n = i % DINP; int k8 = i / DINP;
    u32 o[4] = {0, 0, 0, 0};
    if (n < DIN) {
      const float* s = p.w_in + ((size_t)l * D + k8 * 8) * DIN + n;
#pragma unroll
      for (int j = 0; j < 4; j++) o[j] = pack2(s[(size_t)(2 * j) * DIN], s[(size_t)(2 * j + 1) * DIN]);
    }
    *(uint4*)(p.wt_in + ((size_t)l * DINP + n) * D + k8 * 8) = make_uint4(o[0], o[1], o[2], o[3]);
  }
  for (size_t i = gtid; i < (size_t)128 * 1024; i += gsz) {
    int n = i & 1023; int k8 = i >> 10;
    const float* s = p.w_out + ((size_t)l * D + k8 * 8) * D + n;
    u32 o[4];
#pragma unroll
    for (int j = 0; j < 4; j++) o[j] = pack2(s[(size_t)(2 * j) * D], s[(size_t)(2 * j + 1) * D]);
    *(uint4*)(p.wt_out + ((size_t)l * D + n) * D + k8 * 8) = make_uint4(o[0], o[1], o[2], o[3]);
  }
  for (size_t i = gtid; i < (size_t)128 * 2048; i += gsz) {
    int n = i & 2047; int k8 = i >> 11;
    const float* s = p.wq + ((size_t)l * D + k8 * 8) * 2048 + n;
    u32 o[4];
#pragma unroll
    for (int j = 0; j < 4; j++) o[j] = pack2(s[(size_t)(2 * j) * 2048], s[(size_t)(2 * j + 1) * 2048]);
    *(uint4*)(p.wt_q + ((size_t)l * 2048 + n) * D + k8 * 8) = make_uint4(o[0], o[1], o[2], o[3]);
  }
}

DI void phase0(const Params& p, float* lds) {
  for (int it = obid(); it < 768; it += gridDim.x) {
    int kp = it & 7, nb = (it >> 3) % 24, l = it / 192;
    __syncthreads();
    for (int i = otid(); i < 640; i += 256) {
      int r = i >> 7, k = i & 127;
      float v = (r < 4) ? p.c[r * D + kp * 128 + k] : p.c_ctx[kp * 128 + k];
      lds[i] = v / (1.f + __expf(-v));
    }
    __syncthreads();
    int n = nb * 256 + otid();
    const float* w = p.w_ada + ((size_t)l * D + kp * 128) * 6144 + n;
    float a0 = 0, a1 = 0, a2 = 0, a3 = 0, a4 = 0;
#pragma unroll 8
    for (int k = 0; k < 128; k++) {
      float wv = w[(size_t)k * 6144];
      a0 += lds[k] * wv; a1 += lds[128 + k] * wv; a2 += lds[256 + k] * wv; a3 += lds[384 + k] * wv; a4 += lds[512 + k] * wv;
    }
    float* o = p.ada_part + ((size_t)(kp * 4 + l) * 5) * 6144 + n;
    o[0] = a0; o[6144] = a1; o[2 * 6144] = a2; o[3 * 6144] = a3; o[4 * 6144] = a4;
  }
  weight_convert(p, 0, obid(), gridDim.x);
  const size_t gtid = (size_t)obid() * 256 + otid(), gsz = (size_t)gridDim.x * 256;
  for (size_t i = gtid; i < (size_t)4 * 2 * 128 * 128; i += gsz) p.keysb[i] = f2bf(p.sub_keys[i]);
}

DI void phase0b(const Params& p) {
  const size_t gtid = (size_t)obid() * 256 + otid(), gsz = (size_t)gridDim.x * 256;
  for (size_t i = gtid; i < (size_t)4 * 5 * 6144; i += gsz) {
    int n = i % 6144; int l = i / (5 * 6144);
    float a = p.b_ada[l * 6144 + n];
#pragma unroll
    for (int kp = 0; kp < 8; kp++) a += p.ada_part[(size_t)kp * 4 * 5 * 6144 + i];
    p.ada[i] = a;
  }
}

DI void peer_convert(const Params& p, int layer, int vbid, int vgrid) {
  const int tid = otid(), wave = tid >> 6, lane = tid & 63;
  unsigned char* du = (unsigned char*)(p.PT + PT_U);
  unsigned char* dv = (unsigned char*)(p.PT + PT_V);
  float* su = (float*)(p.PT + PT_SC);
  for (int it = vbid * 4 + wave; it < 2 * 16384; it += vgrid * 4) {
    const int tbl = it >> 14, e = it & 16383;
    const float* src = (tbl ? p.peer_v : p.peer_u) + ((size_t)layer * 16384 + e) * D + lane * 16;
    float4 a = *(const float4*)(src), b = *(const float4*)(src + 4), c = *(const float4*)(src + 8), d = *(const float4*)(src + 12);
    float m = fmaxf(fmaxf(fmaxf(fabsf(a.x), fabsf(a.y)), fmaxf(fabsf(a.z), fabsf(a.w))), fmaxf(fmaxf(fabsf(b.x), fabsf(b.y)), fmaxf(fabsf(b.z), fabsf(b.w))));
    m = fmaxf(m, fmaxf(fmaxf(fmaxf(fabsf(c.x), fabsf(c.y)), fmaxf(fabsf(c.z), fabsf(c.w))), fmaxf(fmaxf(fabsf(d.x), fabsf(d.y)), fmaxf(fabsf(d.z), fabsf(d.w)))));
#pragma unroll
    for (int o = 32; o > 0; o >>= 1) m = fmaxf(m, __shfl_xor(m, o));
    m = fmaxf(m, 1e-30f);
    const float sc = 224.f / m;
    int w0 = __builtin_amdgcn_cvt_pk_fp8_f32(a.x * sc, a.y * sc, 0, false); w0 = __builtin_amdgcn_cvt_pk_fp8_f32(a.z * sc, a.w * sc, w0, true);
    int w1 = __builtin_amdgcn_cvt_pk_fp8_f32(b.x * sc, b.y * sc, 0, false); w1 = __builtin_amdgcn_cvt_pk_fp8_f32(b.z * sc, b.w * sc, w1, true);
    int w2 = __builtin_amdgcn_cvt_pk_fp8_f32(c.x * sc, c.y * sc, 0, false); w2 = __builtin_amdgcn_cvt_pk_fp8_f32(c.z * sc, c.w * sc, w2, true);
    int w3 = __builtin_amdgcn_cvt_pk_fp8_f32(d.x * sc, d.y * sc, 0, false); w3 = __builtin_amdgcn_cvt_pk_fp8_f32(d.z * sc, d.w * sc, w3, true);
    if (tbl == 0) *(int4*)(du + (size_t)e * D + lane * 16) = make_int4(w0, w1, w2, w3);
    else *(int4*)(dv + ((size_t)(lane >> 3) * 16384 + e) * 128 + (lane & 7) * 16) = make_int4(w0, w1, w2, w3);
    if (lane == 0) su[it] = m * (1.f / 224.f);
  }
}

template <int MODE>
DI void lnmod_phase(const Params& p, int layer, int nrows) {
  const int wave = otid() >> 6, lane = otid() & 63;
  const float* XP = (const float*)(p.S + OFF_XP);
  for (int r = obid() * 4 + wave; r < nrows; r += gridDim.x * 4) {
    const float* src;
    if (MODE == 0) src = (r < NLAT) ? p.x + (size_t)r * D : p.ctx + (size_t)(r - NLAT) * D;
    else src = XP + (size_t)r * D;
    const int b = row_batch(r);
    float4 v[4];
#pragma unroll
    for (int c = 0; c < 4; c++) v[c] = *(const float4*)(src + c * 256 + lane * 4);
    float s = 0;
#pragma unroll
    for (int c = 0; c < 4; c++) s += v[c].x + v[c].y + v[c].z + v[c].w;
    float mu = wave_sum(s) * (1.f / D);
    float q = 0;
#pragma unroll
    for (int c = 0; c < 4; c++) {
      v[c].x -= mu; v[c].y -= mu; v[c].z -= mu; v[c].w -= mu;
      q += v[c].x * v[c].x + v[c].y * v[c].y + v[c].z * v[c].z + v[c].w * v[c].w;
    }
    float rstd = rsqrtf(wave_sum(q) * (1.f / D) + EPS);
    if (MODE == 1) {
      const float* gm = p.ln_gamma + (size_t)(layer * 2 + 0) * D;
      const float* bt = p.ln_beta + (size_t)(layer * 2 + 0) * D;
      float s2 = 0;
#pragma unroll
      for (int c = 0; c < 4; c++) {
        int col = c * 256 + lane * 4;
        float4 g = *(const float4*)(gm + col), be = *(const float4*)(bt + col);
        v[c].x = v[c].x * rstd * g.x + be.x; v[c].y = v[c].y * rstd * g.y + be.y;
        v[c].z = v[c].z * rstd * g.z + be.z; v[c].w = v[c].w * rstd * g.w + be.w;
        s2 += v[c].x + v[c].y + v[c].z + v[c].w;
      }
      float mu2 = wave_sum(s2) * (1.f / D);
      float q2 = 0;
#pragma unroll
      for (int c = 0; c < 4; c++) {
        v[c].x -= mu2; v[c].y -= mu2; v[c].z -= mu2; v[c].w -= mu2;
        q2 += v[c].x * v[c].x + v[c].y * v[c].y + v[c].z * v[c].z + v[c].w * v[c].w;
      }
      rstd = rsqrtf(wave_sum(q2) * (1.f / D) + EPS);
    }
    const float* sh = ada_ptr(p, layer, b, MODE == 0 ? 0 : 3);
    const float* sc = ada_ptr(p, layer, b, MODE == 0 ? 1 : 4);
#pragma unroll
    for (int c = 0; c < 4; c++) {
      int col = c * 256 + lane * 4;
      float4 a = *(const float4*)(sh + col), m = *(const float4*)(sc + col);
      float y0 = v[c].x * rstd * (1.f + m.x) + a.x, y1 = v[c].y * rstd * (1.f + m.y) + a.y;
      float y2 = v[c].z * rstd * (1.f + m.z) + a.z, y3 = v[c].w * rstd * (1.f + m.w) + a.w;
      *(uint2*)(p.H + (size_t)r * D + col) = make_uint2(pack2(y0, y1), pack2(y2, y3));
    }
  }
}

constexpr int LDS_STRIDE = 72;
constexpr int CT_STRIDE = 132;
template <int MODE>
DI void gemm_store(const Params& p, int layer, int row, int nt, int n0, int c4, const float4 v, const bool dry) {
  if (MODE == 0) {
          u16* dst;
          if (nt >= 16 && nt < 20) dst = p.G + (size_t)row * D + (n0 - 2048) + c4;
          else if (nt >= 28 && nt < 32) dst = p.G + (size_t)row * D + (n0 - 3584 + 512) + c4;
          else dst = p.U + (size_t)row * DIN + n0 + c4;
          if (dry) dst = (u16*)p.S + (size_t)row * DIN + n0 + c4;
          if (n0 + c4 < DIN) *(uint2*)dst = make_uint2(pack2(v.x, v.y), pack2(v.z, v.w));
        } else if (MODE == 1) {
          float* XP = dry ? (float*)p.U : (float*)(p.S + OFF_XP);
          const float* xo = (layer == 0) ? ((row < NLAT) ? p.x + (size_t)row * D : p.ctx + (size_t)(row - NLAT) * D) : p.X + (size_t)row * D;
          const float4 xv = *(const float4*)(xo + n0 + c4);
          const float4 g1 = *(const float4*)(ada_ptr(p, layer, row_batch(row), 2) + n0 + c4);
          *(float4*)(XP + (size_t)row * D + n0 + c4) =
              make_float4(ALPHA * xv.x + g1.x * v.x, ALPHA * xv.y + g1.y * v.y, ALPHA * xv.z + g1.z * v.z, ALPHA * xv.w + g1.w * v.w);
        } else {
          *(uint2*)((dry ? (u16*)(p.S + OFF_PU) : p.U) + (size_t)row * 2048 + n0 + c4) = make_uint2(pack2(v.x, v.y), pack2(v.z, v.w));
        }
}

template <int MODE>
DI void gemm_phase(const Params& p, int layer, char* smem, const u16* A, const u16* Bt, int Mtiles, int Ntiles, const bool dry) {
  u16* As = (u16*)smem;
  u16* Bs = (u16*)smem + 256 * LDS_STRIDE;
  float* Ct = (float*)smem;
  const int tid = otid(), wave = tid >> 6, lane = tid & 63, r = lane & 31, h = lane >> 5;
  const int wm = wave >> 1, wn = wave & 1;
  const int srow = tid >> 3, sc8 = (tid & 7) * 8;
  const int bid = obid(), xcd = bid & 7, jx = bid >> 3, wpx = (gridDim.x + 7 - xcd) >> 3;
  const int ntiles = Mtiles * Ntiles, nchunks = (ntiles + 63) >> 6;
  for (int ch = xcd; ch < nchunks; ch += 8)
  for (int jj = jx; jj < 64; jj += wpx) {
    const int L = ch * 64 + jj;
    if (L >= ntiles) continue;
    const int mt = (L / (4 * Ntiles)) * 4 + (L & 3), nt = (L >> 2) % Ntiles;
    const u16* Ag = A + ((size_t)mt * 256 + srow) * D + sc8;
    const u16* Bg = Bt + ((size_t)nt * 128 + srow) * D + sc8;
    f32x16 acc[4][2];
#pragma unroll
    for (int i = 0; i < 4; i++)
#pragma unroll
      for (int j = 0; j < 2; j++)
#pragma unroll
        for (int e = 0; e < 16; e++) acc[i][j][e] = 0.f;
    bf16x8 ra0, ra1, ra2, ra3, ra4, ra5, ra6, ra7, rb0, rb1, rb2, rb3;
#define GLOAD(kt_) { const u16* ag = Ag + (kt_) * 64; const u16* bg = Bg + (kt_) * 64; \
      ra0 = *(const bf16x8*)(ag); ra1 = *(const bf16x8*)(ag + 32 * D); ra2 = *(const bf16x8*)(ag + 64 * D); ra3 = *(const bf16x8*)(ag + 96 * D); \
      ra4 = *(const bf16x8*)(ag + 128 * D); ra5 = *(const bf16x8*)(ag + 160 * D); ra6 = *(const bf16x8*)(ag + 192 * D); ra7 = *(const bf16x8*)(ag + 224 * D); \
      rb0 = *(const bf16x8*)(bg); rb1 = *(const bf16x8*)(bg + 32 * D); rb2 = *(const bf16x8*)(bg + 64 * D); rb3 = *(const bf16x8*)(bg + 96 * D); }
#define LSTORE() { u16* ad = As + srow * LDS_STRIDE + sc8; u16* bd = Bs + srow * LDS_STRIDE + sc8; \
      *(bf16x8*)(ad) = ra0; *(bf16x8*)(ad + 32 * LDS_STRIDE) = ra1; *(bf16x8*)(ad + 64 * LDS_STRIDE) = ra2; *(bf16x8*)(ad + 96 * LDS_STRIDE) = ra3; \
      *(bf16x8*)(ad + 128 * LDS_STRIDE) = ra4; *(bf16x8*)(ad + 160 * LDS_STRIDE) = ra5; *(bf16x8*)(ad + 192 * LDS_STRIDE) = ra6; *(bf16x8*)(ad + 224 * LDS_STRIDE) = ra7; \
      *(bf16x8*)(bd) = rb0; *(bf16x8*)(bd + 32 * LDS_STRIDE) = rb1; *(bf16x8*)(bd + 64 * LDS_STRIDE) = rb2; *(bf16x8*)(bd + 96 * LDS_STRIDE) = rb3; }
    GLOAD(0)
    __syncthreads();
    LSTORE()
    __syncthreads();
#pragma unroll 1
    for (int kt = 0; kt < 16; kt++) {
      if (kt + 1 < 16 && !(dry && DRYVAR == 1)) GLOAD(kt + 1)
      const u16* as = As + (wm * 128 + r) * LDS_STRIDE + h * 8;
      const u16* bs = Bs + (wn * 64 + r) * LDS_STRIDE + h * 8;
      if (!(dry && DRYVAR == 2)) {
        bf16x8 af[2][4], b0, b1;
#pragma unroll
        for (int i = 0; i < 4; i++) af[0][i] = *(const bf16x8*)(as + i * 32 * LDS_STRIDE);
        b0 = *(const bf16x8*)(bs); b1 = *(const bf16x8*)(bs + 32 * LDS_STRIDE);
#pragma unroll
        for (int kk = 0; kk < 4; kk++) {
          const int cur = kk & 1, nxt = cur ^ 1;
          if (kk < 3) {
#pragma unroll
            for (int i = 0; i < 4; i++) af[nxt][i] = *(const bf16x8*)(as + i * 32 * LDS_STRIDE + (kk + 1) * 16);
          }
          __builtin_amdgcn_s_setprio(1);
#pragma unroll
          for (int i = 0; i < 4; i++) acc[i][0] = MFMA32(af[cur][i], b0, acc[i][0]);
          if (kk < 3) b0 = *(const bf16x8*)(bs + (kk + 1) * 16);
#pragma unroll
          for (int i = 0; i < 4; i++) acc[i][1] = MFMA32(af[cur][i], b1, acc[i][1]);
          if (kk < 3) b1 = *(const bf16x8*)(bs + 32 * LDS_STRIDE + (kk + 1) * 16);
          __builtin_amdgcn_s_setprio(0);
        }
      }
      __syncthreads();
      if (kt + 1 < 16 && !(dry && DRYVAR == 1)) LSTORE()
      __syncthreads();
    }
#undef GLOAD
#undef LSTORE
    const int m0 = mt * 256, n0 = nt * 128;
    const int c4 = (tid & 31) * 4, rr0 = tid >> 5;
#pragma unroll
    for (int ph = 0; ph < 2; ph++) {
      if (ph) __syncthreads();
#pragma unroll
      for (int ii = 0; ii < 2; ii++)
#pragma unroll
        for (int j = 0; j < 2; j++)
#pragma unroll
          for (int e = 0; e < 16; e++) Ct[(wm * 64 + ii * 32 + crow(e, h)) * CT_STRIDE + wn * 64 + j * 32 + r] = acc[ph * 2 + ii][j][e];
      __syncthreads();
      if (MODE == 1) {
        const float4 g1 = *(const float4*)(ada_ptr(p, layer, row_batch(m0), 2) + n0 + c4);
        float* XP = dry ? (float*)p.U : (float*)(p.S + OFF_XP);
#pragma unroll 1
        for (int q0 = 0; q0 < 16; q0 += 2) {
          float4 xv[2], cv[2];
#pragma unroll
          for (int j = 0; j < 2; j++) {
            const int rl = rr0 + (q0 + j) * 8, row = m0 + (rl >> 6) * 128 + ph * 64 + (rl & 63);
            const float* xo = (layer == 0) ? ((row < NLAT) ? p.x + (size_t)row * D : p.ctx + (size_t)(row - NLAT) * D) : p.X + (size_t)row * D;
            xv[j] = *(const float4*)(xo + n0 + c4);
            cv[j] = *(const float4*)(Ct + rl * CT_STRIDE + c4);
          }
#pragma unroll
          for (int j = 0; j < 2; j++) {
            const int rl = rr0 + (q0 + j) * 8, row = m0 + (rl >> 6) * 128 + ph * 64 + (rl & 63);
            *(float4*)(XP + (size_t)row * D + n0 + c4) = make_float4(ALPHA * xv[j].x + g1.x * cv[j].x, ALPHA * xv[j].y + g1.y * cv[j].y,
                                                                     ALPHA * xv[j].z + g1.z * cv[j].z, ALPHA * xv[j].w + g1.w * cv[j].w);
          }
        }
      } else {
#pragma unroll 2
        for (int q = 0; q < 16; q++) {
          const int rl = rr0 + q * 8, row = m0 + (rl >> 6) * 128 + ph * 64 + (rl & 63);
          const float4 v = *(const float4*)(Ct + rl * CT_STRIDE + c4);
          gemm_store<MODE>(p, layer, row, nt, n0, c4, v, dry);
        }
      }
    }
  }
}

template <int MODE>
DI void gemm_thin(const Params& p, int layer, char* smem, const u16* A, const u16* Bt, int row0, int Mtiles, int Ntiles, const bool dry) {
  u16* As = (u16*)smem;
  u16* Bs = (u16*)smem + 64 * LDS_STRIDE;
  float* Ct = (float*)smem;
  const int tid = otid(), wave = tid >> 6, lane = tid & 63, r = lane & 31, h = lane >> 5;
  const int wm = wave >> 1, wn = wave & 1;
  const int srow = tid >> 3, sc8 = (tid & 7) * 8;
  const int ntiles = Mtiles * Ntiles;
  for (int L = obid(); L < ntiles; L += gridDim.x) {
    const int mt = L / Ntiles, nt = L % Ntiles;
    const u16* Ag = A + ((size_t)row0 + mt * 64 + srow) * D + sc8;
    const u16* Bg = Bt + ((size_t)nt * 128 + srow) * D + sc8;
    f32x16 acc0, acc1;
#pragma unroll
    for (int e = 0; e < 16; e++) { acc0[e] = 0.f; acc1[e] = 0.f; }
    bf16x8 ra0, ra1, rb0, rb1, rb2, rb3;
#define GLOADT(kt_) { const u16* ag = Ag + (kt_) * 64; const u16* bg = Bg + (kt_) * 64; \
      ra0 = *(const bf16x8*)(ag); ra1 = *(const bf16x8*)(ag + 32 * D); \
      rb0 = *(const bf16x8*)(bg); rb1 = *(const bf16x8*)(bg + 32 * D); rb2 = *(const bf16x8*)(bg + 64 * D); rb3 = *(const bf16x8*)(bg + 96 * D); }
#define LSTORET() { u16* ad = As + srow * LDS_STRIDE + sc8; u16* bd = Bs + srow * LDS_STRIDE + sc8; \
      *(bf16x8*)(ad) = ra0; *(bf16x8*)(ad + 32 * LDS_STRIDE) = ra1; \
      *(bf16x8*)(bd) = rb0; *(bf16x8*)(bd + 32 * LDS_STRIDE) = rb1; *(bf16x8*)(bd + 64 * LDS_STRIDE) = rb2; *(bf16x8*)(bd + 96 * LDS_STRIDE) = rb3; }
    GLOADT(0)
    __syncthreads();
    LSTORET()
    __syncthreads();
#pragma unroll 1
    for (int kt = 0; kt < 16; kt++) {
      if (kt + 1 < 16) GLOADT(kt + 1)
      const u16* as = As + (wm * 32 + r) * LDS_STRIDE + h * 8;
      const u16* bs = Bs + (wn * 64 + r) * LDS_STRIDE + h * 8;
#pragma unroll
      for (int kk = 0; kk < 4; kk++) {
        const bf16x8 af = *(const bf16x8*)(as + kk * 16);
        const bf16x8 bf0 = *(const bf16x8*)(bs + kk * 16), bf1 = *(const bf16x8*)(bs + 32 * LDS_STRIDE + kk * 16);
        acc0 = MFMA32(af, bf0, acc0);
        acc1 = MFMA32(af, bf1, acc1);
      }
      __syncthreads();
      if (kt + 1 < 16) LSTORET()
      __syncthreads();
    }
#undef GLOADT
#undef LSTORET
#pragma unroll
    for (int e = 0; e < 16; e++) {
      Ct[(wm * 32 + crow(e, h)) * CT_STRIDE + wn * 64 + r] = acc0[e];
      Ct[(wm * 32 + crow(e, h)) * CT_STRIDE + wn * 64 + 32 + r] = acc1[e];
    }
    __syncthreads();
    const int n0 = nt * 128, c4 = (tid & 31) * 4, rr0 = tid >> 5;
#pragma unroll 2
    for (int q = 0; q < 8; q++) {
      const int rl = rr0 + q * 8, row = row0 + mt * 64 + rl;
      const float4 v = *(const float4*)(Ct + rl * CT_STRIDE + c4);
      gemm_store<MODE>(p, layer, row, nt, n0, c4, v, dry);
    }
  }
}

DI int tokrow(int grp, int b, int pos) {
  if (pos < CTX) return NLAT + b * CTX + pos;
  int pp = pos - CTX;
  return b * SEQ + (grp == 0 ? pp : ((pp & 127) * 64 + (pp >> 7)));
}
DI float log_sigmoid(float z) { return fminf(z, 0.f) - __logf(1.f + __expf(-fabsf(z))); }

template <int DK, int DIR>
DI void prep_k(const Params& p, int layer, int grp, int hb, int blk, int cgi) {
  constexpr int CH = DK / 32;
  const int b = hb >> 2, head = hb & 3, k0 = cgi * CH;
  float lb[CH], log_lb[CH], l1m[CH], wg[CH][16], bias[CH], bacc[CH];
#pragma unroll
  for (int c = 0; c < CH; c++) {
    bacc[c] = 0.f; lb[c] = 0.f; log_lb[c] = 0.f; l1m[c] = 0.f; bias[c] = 0.f;
    if (DK == 128) {
      const float* lbp = p.hg_lb + (size_t)DIR * DEPTH * 512 + head * 128 + k0 + c;
      float e0 = lbp[0], e1 = lbp[512], e2 = lbp[1024], e3 = lbp[1536];
      const float mx = fmaxf(fmaxf(e0, e1), fmaxf(e2, e3));
      e0 = __expf(e0 - mx); e1 = __expf(e1 - mx); e2 = __expf(e2 - mx); e3 = __expf(e3 - mx);
      const float inv = 1.f / (e0 + e1 + e2 + e3);
      float cs = 0.f;
      if (layer >= 1) cs += e1 * inv;
      if (layer >= 2) cs += e2 * inv;
      if (layer >= 3) cs += e3 * inv;
      lb[c] = fminf(fmaxf(cs, 0.f), 1.f - 1e-6f);
      log_lb[c] = __logf(fmaxf(lb[c], 1e-30f));
      l1m[c] = __logf(1.f - lb[c]);
    } else {
#pragma unroll
      for (int rr = 0; rr < 16; rr++) wg[c][rr] = p.w_gk2[((size_t)(layer * 2 + DIR) * 16 + rr) * 256 + head * 64 + k0 + c];
      bias[c] = p.b_gk[(size_t)(layer * 2 + DIR) * 256 + head * 64 + k0 + c];
    }
  }
  const size_t chain = (size_t)DIR * 16 + hb;
  const int pk0 = perm16(k0);
  u16* Qd = (u16*)(p.S + (DK == 128 ? OFF_HQ : OFF_GQ)) + (chain * LPOS + (size_t)blk * 32) * DK + pk0;
  u16* Kd = (u16*)(p.S + (DK == 128 ? OFF_HK : OFF_GK)) + (chain * LPOS + (size_t)blk * 32) * DK + pk0;
  u16* KTd = (u16*)(p.S + (DK == 128 ? OFF_HKT : OFF_GKT)) + ((chain * NBLK + blk) * DK + k0) * 32;
#pragma unroll 1
  for (int s2 = 0; s2 < 2; s2++) {
    const int tg = DIR ? 1 - s2 : s2;
    u16 kt[CH][16];
#pragma unroll
    for (int jb = 0; jb < 2; jb++) {
      uint2 zz[8], qq[8];
      u32 gq[8], gk[8];
      uint4 ga[8], gb[8];
#pragma unroll
      for (int j = 0; j < 8; j++) {
        const int j2 = jb * 8 + j;
        const int t16 = DIR ? 15 - j2 : j2;
        const u16* urow = p.U + (size_t)tokrow(grp, b, blk * 32 + tg * 16 + t16) * DIN;
        if (DK == 128) {
          zz[j] = *(const uint2*)(urow + 512 * (1 + DIR) + head * 128 + k0);
          qq[j] = *(const uint2*)(urow + head * 128 + k0);
        } else {
          gq[j] = *(const u32*)(urow + 2560 + head * 64 + k0);
          gk[j] = *(const u32*)(urow + 2816 + head * 64 + k0);
          const uint4* gr = (const uint4*)(urow + 4096 + DIR * 16);
          ga[j] = gr[0]; gb[j] = gr[1];
        }
      }
#pragma unroll
      for (int j = 0; j < 8; j++) {
        const int j2 = jb * 8 + j;
        const int t16 = DIR ? 15 - j2 : j2;
        const int t = tg * 16 + t16;
        float qv[CH], kv[CH], la[CH];
        if (DK == 128) {
          const u32 zw[2] = {zz[j].x, zz[j].y}, qw[2] = {qq[j].x, qq[j].y};
#pragma unroll
          for (int c = 0; c < CH; c++) {
            const float z = (c & 1) ? __uint_as_float(zw[c >> 1] & 0xffff0000u) : __uint_as_float(zw[c >> 1] << 16);
            qv[c] = (c & 1) ? __uint_as_float(qw[c >> 1] & 0xffff0000u) : __uint_as_float(qw[c >> 1] << 16);
            const float ez = __expf(-fabsf(z));
            const float rc = __frcp_rn(1.f + ez);
            const float sp = (z < 0.f) ? ez * rc : rc;
            const float sn = (z < 0.f) ? rc : ez * rc;
            la[c] = __logf(fmaxf(lb[c], 1e-30f) + (1.f - lb[c]) * sp);
            kv[c] = (1.f - lb[c]) * sn;
          }
        } else {
          const u32 gw[8] = {ga[j].x, ga[j].y, ga[j].z, ga[j].w, gb[j].x, gb[j].y, gb[j].z, gb[j].w};
#pragma unroll
          for (int c = 0; c < CH; c++) {
            qv[c] = ((c & 1) ? __uint_as_float(gq[j] & 0xffff0000u) : __uint_as_float(gq[j] << 16)) * 0.125f;
            kv[c] = (c & 1) ? __uint_as_float(gk[j] & 0xffff0000u) : __uint_as_float(gk[j] << 16);
            float d = bias[c];
#pragma unroll
            for (int rr = 0; rr < 8; rr++)
              d += __uint_as_float(gw[rr] << 16) * wg[c][2 * rr] + __uint_as_float(gw[rr] & 0xffff0000u) * wg[c][2 * rr + 1];
            la[c] = (fminf(d, 0.f) - __logf(1.f + __expf(-fabsf(d)))) * (1.f / 16.f);
          }
        }
        float qo[CH], ko[CH];
#pragma unroll
        for (int c = 0; c < CH; c++) {
          bacc[c] += la[c];
          const float eb = __expf(bacc[c]);
          qo[c] = qv[c] * eb;
          ko[c] = kv[c] * __expf(-bacc[c]);
          kt[c][perm16(t16)] = f2bf(ko[c]);
        }
        if (CH == 4) {
          *(uint2*)(Qd + (size_t)t * DK) = make_uint2(pack2(qo[0], qo[1]), pack2(qo[2], qo[3]));
          *(uint2*)(Kd + (size_t)t * DK) = make_uint2(pack2(ko[0], ko[1]), pack2(ko[2], ko[3]));
        } else {
          *(u32*)(Qd + (size_t)t * DK) = pack2(qo[0], qo[1]);
          *(u32*)(Kd + (size_t)t * DK) = pack2(ko[0], ko[1]);
        }
      }
    }
#pragma unroll
    for (int c = 0; c < CH; c++) {
      u16* dst = KTd + c * 32 + tg * 16;
#pragma unroll
      for (int q8 = 0; q8 < 2; q8++) {
        uint4 o;
        o.x = (u32)kt[c][q8 * 8 + 0] | ((u32)kt[c][q8 * 8 + 1] << 16); o.y = (u32)kt[c][q8 * 8 + 2] | ((u32)kt[c][q8 * 8 + 3] << 16);
        o.z = (u32)kt[c][q8 * 8 + 4] | ((u32)kt[c][q8 * 8 + 5] << 16); o.w = (u32)kt[c][q8 * 8 + 6] | ((u32)kt[c][q8 * 8 + 7] << 16);
        *(uint4*)(dst + q8 * 8) = o;
      }
    }
  }
  float* Dd = (float*)(p.S + (DK == 128 ? OFF_HD : OFF_GD)) + (chain * NBLK + blk) * DK + k0;
#pragma unroll
  for (int c = 0; c < CH; c++) Dd[c] = __expf(bacc[c]);
}

DI void prep_phase(const Params& p, int layer) {
  const int tid = otid();
  for (int it = obid(); it < 2 * 16 * (NBLK / 4); it += gridDim.x) {
    const int bg = it % (NBLK / 4), hb = (it / (NBLK / 4)) & 15, grp = it / ((NBLK / 4) * 16);
    const int b = hb >> 2, head = hb & 3;
    {
      const int dir = tid >> 7, blk = bg * 4 + ((tid >> 5) & 3), cgi = tid & 31;
      if (grp == 0) {
        if (dir == 0) prep_k<128, 0>(p, layer, 0, hb, blk, cgi);
        else prep_k<128, 1>(p, layer, 0, hb, blk, cgi);
      } else {
        if (dir == 0) prep_k<64, 0>(p, layer, 1, hb, blk, cgi);
        else prep_k<64, 1>(p, layer, 1, hb, blk, cgi);
      }
    }
    {
      const int vg = tid & 31, tg = tid >> 5;
      const int col = (grp == 0 ? 1536 : 3072) + head * 128 + vg * 4;
      const int pos0 = bg * 128 + tg * 16;
      u16 vt[4][16];
#pragma unroll
      for (int t = 0; t < 16; t++) {
        const uint2 vv = *(const uint2*)(p.U + (size_t)tokrow(grp, b, pos0 + t) * DIN + col);
        vt[0][perm16(t)] = (u16)(vv.x & 0xffffu); vt[1][perm16(t)] = (u16)(vv.x >> 16);
        vt[2][perm16(t)] = (u16)(vv.y & 0xffffu); vt[3][perm16(t)] = (u16)(vv.y >> 16);
      }
#pragma unroll
      for (int c = 0; c < 4; c++) {
        u16* dst = (u16*)(p.S + (grp == 0 ? OFF_HVT : OFF_GVT)) + (((size_t)hb * NBLK + (pos0 >> 5)) * 128 + vg * 4 + c) * 32 + (pos0 & 31);
#pragma unroll
        for (int q8 = 0; q8 < 2; q8++) {
          uint4 o;
          o.x = (u32)vt[c][q8 * 8 + 0] | ((u32)vt[c][q8 * 8 + 1] << 16); o.y = (u32)vt[c][q8 * 8 + 2] | ((u32)vt[c][q8 * 8 + 3] << 16);
          o.z = (u32)vt[c][q8 * 8 + 4] | ((u32)vt[c][q8 * 8 + 5] << 16); o.w = (u32)vt[c][q8 * 8 + 6] | ((u32)vt[c][q8 * 8 + 7] << 16);
          *(uint4*)(dst + q8 * 8) = o;
        }
      }
    }
  }
}

template <int DK>
DI void scan_wg(const Params& p, char* smem, int grp, int dir, int hb) {
  constexpr int NT = DK / 32, NF = DK / 16;
  constexpr int QS = DK + 8;
  constexpr int KTS = 40;
  constexpr int OFF_K = 32 * QS * 2, OFF_KT = 2 * 32 * QS * 2, OFF_D = OFF_KT + DK * KTS * 2, BUFB = OFF_D + DK * 4;
  constexpr int QN = DK / 64;
  constexpr int CPR = DK / 8;
  static_assert(2 * BUFB <= LDS_BYTES, "scan LDS");
  const int tid = otid(), vs = tid >> 6, lane = tid & 63, r = lane & 31, h = lane >> 5;
  const int b = hb >> 2, head = hb & 3;
  const size_t chain = (size_t)dir * 16 + hb;
  const u16* Qb = (const u16*)(p.S + (DK == 128 ? OFF_HQ : OFF_GQ)) + chain * LPOS * DK;
  const u16* Kb = (const u16*)(p.S + (DK == 128 ? OFF_HK : OFF_GK)) + chain * LPOS * DK;
  const u16* KTb = (const u16*)(p.S + (DK == 128 ? OFF_HKT : OFF_GKT)) + chain * NBLK * DK * 32;
  const u16* VTb = (const u16*)(p.S + (DK == 128 ? OFF_HVT : OFF_GVT)) + (size_t)hb * NBLK * 128 * 32 + (vs * 32 + r) * 32 + h * 8;
  const float* Db = (const float*)(p.S + (DK == 128 ? OFF_HD : OFF_GD)) + chain * NBLK * DK;
  u16* Ob = p.U + (size_t)dir * NROW * D + grp * 512 + head * 128 + vs * 32;
  f32x16 S[NT];
#pragma unroll
  for (int kt = 0; kt < NT; kt++)
#pragma unroll
    for (int e = 0; e < 16; e++) S[kt][e] = 0.f;
  bf16x8 sq[QN], sk[QN], skt[QN], vn0, vn1;
  float4 sd = make_float4(0.f, 0.f, 0.f, 0.f);
  auto blk_of = [&](int step) { return dir ? (step < 8 ? 7 - step : 271 - step) : step; };
  auto gload = [&](int step) {
    const size_t pos0 = (size_t)blk_of(step) * 32;
#pragma unroll
    for (int i = 0; i < QN; i++) {
      const int id = tid + i * 256;
      sq[i] = *(const bf16x8*)(Qb + (pos0 + id / CPR) * DK + (id % CPR) * 8);
      sk[i] = *(const bf16x8*)(Kb + (pos0 + id / CPR) * DK + (id % CPR) * 8);
      skt[i] = *(const bf16x8*)(KTb + (size_t)blk_of(step) * DK * 32 + id * 8);
    }
    if (tid < DK / 4) sd = *(const float4*)(Db + (size_t)blk_of(step) * DK + tid * 4);
    vn0 = *(const bf16x8*)(VTb + (size_t)blk_of(step) * 128 * 32);
    vn1 = *(const bf16x8*)(VTb + (size_t)blk_of(step) * 128 * 32 + 16);
  };
  auto lstore = [&](int buf) {
    char* base = smem + buf * BUFB;
#pragma unroll
    for (int i = 0; i < QN; i++) {
      const int id = tid + i * 256;
      *(bf16x8*)(base + ((id / CPR) * QS + (id % CPR) * 8) * 2) = sq[i];
      *(bf16x8*)(base + OFF_K + ((id / CPR) * QS + (id % CPR) * 8) * 2) = sk[i];
      *(bf16x8*)(base + OFF_KT + ((id >> 2) * KTS + (id & 3) * 8) * 2) = skt[i];
    }
    if (tid < DK / 4) *(float4*)(base + OFF_D + tid * 16) = sd;
  };
  __syncthreads();
  gload(0);
  lstore(0);
  bf16x8 vf0 = vn0, vf1 = vn1;
  __syncthreads();
#pragma unroll 1
  for (int step = 0; step < NBLK; step++) {
    const int blk = blk_of(step);
    if (step + 1 < NBLK) gload(step + 1);
    const char* base = smem + (step & 1) * BUFB;
    const u16* Qs = (const u16*)base + r * QS + h * 8;
    const u16* Ks = (const u16*)(base + OFF_K) + r * QS + h * 8;
    const u16* KTs = (const u16*)(base + OFF_KT) + r * KTS + h * 8;
    const float* Ds = (const float*)(base + OFF_D) + 4 * h;
    bf16x8 qf[NF];
    f32x16 P0, P1;
#pragma unroll
    for (int e = 0; e < 16; e++) { P0[e] = 0.f; P1[e] = 0.f; }
#pragma unroll
    for (int f = 0; f < NF; f += 2) {
      qf[f] = *(const bf16x8*)(Qs + f * 16);
      qf[f + 1] = *(const bf16x8*)(Qs + f * 16 + 16);
      P0 = MFMA32(*(const bf16x8*)(Ks + f * 16), qf[f], P0);
      P1 = MFMA32(*(const bf16x8*)(Ks + f * 16 + 16), qf[f + 1], P1);
    }
#pragma unroll
    for (int e = 0; e < 16; e++) {
      const int s = crow(e, h);
      const bool keep = dir ? (s >= r) : (s <= r);
      P0[e] = keep ? P0[e] + P1[e] : 0.f;
    }
    f32x16 oA, oB;
#pragma unroll
    for (int e = 0; e < 16; e++) { oA[e] = 0.f; oB[e] = 0.f; }
    oA = MFMA32(vf0, pack_frag(P0, 0), oA);
    oA = MFMA32(vf1, pack_frag(P0, 1), oA);
#pragma unroll
    for (int kt = 0; kt < NT; kt++) {
      if (kt & 1) {
        oA = MFMA32(pack_frag(S[kt], 0), qf[kt * 2], oA);
        oA = MFMA32(pack_frag(S[kt], 1), qf[kt * 2 + 1], oA);
      } else {
        oB = MFMA32(pack_frag(S[kt], 0), qf[kt * 2], oB);
        oB = MFMA32(pack_frag(S[kt], 1), qf[kt * 2 + 1], oB);
      }
    }
#pragma unroll
    for (int kt = 0; kt < NT; kt++) {
      S[kt] = MFMA32(*(const bf16x8*)(KTs + kt * 32 * KTS), vf0, S[kt]);
      S[kt] = MFMA32(*(const bf16x8*)(KTs + kt * 32 * KTS + 16), vf1, S[kt]);
#pragma unroll
      for (int g = 0; g < 4; g++) {
        const float4 dv = *(const float4*)(Ds + kt * 32 + 8 * g);
        S[kt][4 * g + 0] *= dv.x; S[kt][4 * g + 1] *= dv.y; S[kt][4 * g + 2] *= dv.z; S[kt][4 * g + 3] *= dv.w;
      }
    }
    {
      const int pos0 = blk * 32;
      int rbase, rstride;
      if (pos0 < CTX) { rbase = NLAT + b * CTX + pos0; rstride = 1; }
      else if (grp == 0) { rbase = b * SEQ + pos0 - CTX; rstride = 1; }
      else { const int pp = pos0 - CTX; rbase = b * SEQ + (pp & 127) * 64 + (pp >> 7); rstride = 64; }
      u16* orow = Ob + (size_t)(rbase + r * rstride) * D + 4 * h;
#pragma unroll
      for (int g = 0; g < 4; g++)
        *(uint2*)(orow + 8 * g) = make_uint2(pack2(oA[4 * g] + oB[4 * g], oA[4 * g + 1] + oB[4 * g + 1]),
                                             pack2(oA[4 * g + 2] + oB[4 * g + 2], oA[4 * g + 3] + oB[4 * g + 3]));
    }
    if (step + 1 < NBLK) lstore((step + 1) & 1);
    vf0 = vn0; vf1 = vn1;
    __syncthreads();
  }
}

DI void scan_phase(const Params& p, char* smem, int layer) {
  const int bid = obid(), nscan = gridDim.x > 64 ? 64 : gridDim.x;
  if (bid < nscan) {
    for (int w = bid; w < 64; w += nscan) {
      const int grp = w >> 5, dir = (w >> 4) & 1, hb = w & 15;
      if (grp == 0) scan_wg<128>(p, smem, 0, dir, hb);
      else scan_wg<64>(p, smem, 1, dir, hb);
    }
  }
  if (gridDim.x <= 64 || bid >= 64) {
    const int vbid = gridDim.x <= 64 ? bid : bid - 64, vgrid = gridDim.x <= 64 ? gridDim.x : gridDim.x - 64;
    peer_convert(p, layer, vbid, vgrid);
    if (layer + 1 < DEPTH) weight_convert(p, layer + 1, vbid, vgrid);
  }
}

DI void combine_phase(const Params& p, int layer, int nrows) {
  const int wave = otid() >> 6, lane = otid() & 63;
  const int c0 = lane * 16;
  const float* gain = (c0 < 512 ? p.hg_norm : p.gla_norm) + (size_t)layer * 128 + (c0 & 127);
  float gn[16];
#pragma unroll
  for (int j = 0; j < 16; j++) gn[j] = gain[j];
  for (int r = obid() * 4 + wave; r < nrows; r += gridDim.x * 4) {
    const uint4* of = (const uint4*)(p.U + (size_t)r * D + c0);
    const uint4* ob = (const uint4*)(p.U + (size_t)NROW * D + (size_t)r * D + c0);
    const uint4* gg = (const uint4*)(p.G + (size_t)r * D + c0);
    float o[16], g[16];
#pragma unroll
    for (int c = 0; c < 2; c++) {
      uint4 a = of[c], bq = ob[c], gq = gg[c];
      u32 aw[4] = {a.x, a.y, a.z, a.w}, bw[4] = {bq.x, bq.y, bq.z, bq.w}, gw[4] = {gq.x, gq.y, gq.z, gq.w};
#pragma unroll
      for (int j = 0; j < 4; j++) {
        o[c * 8 + 2 * j] = __uint_as_float(aw[j] << 16) + __uint_as_float(bw[j] << 16);
        o[c * 8 + 2 * j + 1] = __uint_as_float(aw[j] & 0xffff0000u) + __uint_as_float(bw[j] & 0xffff0000u);
        g[c * 8 + 2 * j] = __uint_as_float(gw[j] << 16);
        g[c * 8 + 2 * j + 1] = __uint_as_float(gw[j] & 0xffff0000u);
      }
    }
    float ss = 0;
#pragma unroll
    for (int j = 0; j < 16; j++) ss += o[j] * o[j];
    ss += __shfl_xor(ss, 1); ss += __shfl_xor(ss, 2); ss += __shfl_xor(ss, 4);
    float rs = rsqrtf(ss * (1.f / 128.f) + EPS);
    u32 ow[8];
#pragma unroll
    for (int j = 0; j < 8; j++) {
      float g0 = g[2 * j], g1 = g[2 * j + 1];
      float y0 = o[2 * j] * rs * gn[2 * j] * (g0 / (1.f + __expf(-g0)));
      float y1 = o[2 * j + 1] * rs * gn[2 * j + 1] * (g1 / (1.f + __expf(-g1)));
      ow[j] = pack2(y0, y1);
    }
    uint4* dst = (uint4*)(p.H + (size_t)r * D + c0);
    dst[0] = make_uint4(ow[0], ow[1], ow[2], ow[3]);
    dst[1] = make_uint4(ow[4], ow[5], ow[6], ow[7]);
  }
}

template <bool PAY>
DI void ce(u32& a, u32& b, u32& pa, u32& pb) {
  if (!PAY) { u32 hi = a > b ? a : b, lo = a > b ? b : a; a = hi; b = lo; }
  else { bool c = a >= b; u32 hi = c ? a : b, lo = c ? b : a, ph = c ? pa : pb, pl = c ? pb : pa; a = hi; b = lo; pa = ph; pb = pl; }
}
template <bool PAY>
DI void sort16(u32 (&k)[16], u32 (&q)[16]) {
#pragma unroll
  for (int size = 2; size <= 16; size <<= 1) {
#pragma unroll
    for (int stride = size >> 1; stride > 0; stride >>= 1) {
#pragma unroll
      for (int i = 0; i < 16; i++) {
        int j = i ^ stride;
        if (j > i) {
          if ((i & size) == 0) ce<PAY>(k[i], k[j], q[i], q[j]);
          else ce<PAY>(k[j], k[i], q[j], q[i]);
        }
      }
    }
  }
}
template <bool PAY>
DI void merge16(u32 (&R)[16], u32 (&RP)[16], u32 (&N)[16], u32 (&NP)[16]) {
#pragma unroll
  for (int i = 0; i < 16; i++) {
    bool c = N[15 - i] > R[i];
    R[i] = c ? N[15 - i] : R[i];
    if (PAY) RP[i] = c ? NP[15 - i] : RP[i];
  }
#pragma unroll
  for (int stride = 8; stride > 0; stride >>= 1) {
#pragma unroll
    for (int i = 0; i < 16; i++) {
      int j = i ^ stride;
      if (j > i) ce<PAY>(R[i], R[j], RP[i], RP[j]);
    }
  }
}
DI u32 ord_f(float f) { u32 u = __float_as_uint(f); return (u & 0x80000000u) ? ~u : (u | 0x80000000u); }
DI float unord_f(u32 u) { return __uint_as_float((u & 0x80000000u) ? (u ^ 0x80000000u) : ~u); }

DI void topk_phase(const Params& p, int layer, char* smem, int nrows) {
  const int tid = otid(), wave = tid >> 6, lane = tid & 63, r = lane & 31, h = lane >> 5;
  float* sc = (float*)smem + wave * 4096;
  const u16* Q = p.U;
  const u16* keys = p.keysb + (size_t)layer * 2 * 128 * 128;
  int* IDX = (int*)(p.S + OFF_IDX);
  float* GATE = (float*)(p.S + OFF_GATE);
  const int nunits = (nrows / 64) * 8;
  for (int wu = obid() * 4 + wave; wu < nunits; wu += gridDim.x * 4) {
    const int tok0 = (wu >> 3) * 64, head = wu & 7;
    u32 RA[16], RB[16], dummy[16];
#pragma unroll
    for (int i = 0; i < 16; i++) { RA[i] = 0; RB[i] = 0; dummy[i] = 0; }
    auto do_half = [&](const int half, u32 (&R)[16]) {
      bf16x8 qf[2][8];
#pragma unroll
      for (int nt = 0; nt < 2; nt++) {
        const u16* qp = Q + (size_t)(tok0 + nt * 32 + r) * 2048 + head * 256 + half * 128 + h * 8;
#pragma unroll
        for (int f = 0; f < 8; f++) qf[nt][f] = *(const bf16x8*)(qp + f * 16);
      }
      f32x16 acc0, acc1;
      auto mm = [&](const int kr) {
        const u16* kp = keys + ((size_t)half * 128 + kr * 32 + r) * 128 + h * 8;
#pragma unroll
        for (int e = 0; e < 16; e++) { acc0[e] = 0.f; acc1[e] = 0.f; }
        bf16x8 afk[8];
#pragma unroll
        for (int f = 0; f < 8; f++) afk[f] = *(const bf16x8*)(kp + f * 16);
        __builtin_amdgcn_s_setprio(1);
#pragma unroll
        for (int f = 0; f < 8; f++) {
          acc0 = MFMA32(afk[f], qf[0][f], acc0);
          acc1 = MFMA32(afk[f], qf[1][f], acc1);
        }
        __builtin_amdgcn_s_setprio(0);
      };
      auto put = [&](const int buf) {
        float* d = sc + buf * 2048;
#pragma unroll
        for (int e = 0; e < 16; e++) {
          d[crow(e, h) * 64 + r] = acc0[e];
          d[crow(e, h) * 64 + 32 + r] = acc1[e];
        }
      };
      mm(0);
      put(0);
#pragma unroll
      for (int kr = 0; kr < 4; kr++) {
        if (kr < 3) mm(kr + 1);
        __builtin_amdgcn_wave_barrier();
        const float* sp = sc + (kr & 1) * 2048 + lane;
#pragma unroll
        for (int grp = 0; grp < 2; grp++) {
          u32 N[16];
#pragma unroll
          for (int i = 0; i < 16; i++) {
            const float v = sp[(grp * 16 + i) * 64];
            N[i] = (ord_f(v) & 0xFFFFFF80u) | (u32)(127 - (kr * 32 + grp * 16 + i));
          }
          sort16<false>(N, dummy);
          merge16<false>(R, dummy, N, dummy);
        }
        __builtin_amdgcn_wave_barrier();
        if (kr < 3) put((kr + 1) & 1);
      }
    };
    do_half(0, RA);
    do_half(1, RB);
    {
      float v1[16], v2[16]; u32 i1[16], i2[16];
#pragma unroll
      for (int i = 0; i < 16; i++) {
        v1[i] = unord_f(RA[i] & 0xFFFFFF80u); i1[i] = 127 - (RA[i] & 127u);
        v2[i] = unord_f(RB[i] & 0xFFFFFF80u); i2[i] = 127 - (RB[i] & 127u);
      }
      u32 TK[16], TP[16], NK[16], NP[16];
#define CAND(slot, a, bq) { NK[slot] = ord_f(v1[a] + v2[bq]); NP[slot] = i1[a] * 128u + i2[bq]; }
#pragma unroll
      for (int bq = 0; bq < 16; bq++) { TK[bq] = ord_f(v1[0] + v2[bq]); TP[bq] = i1[0] * 128u + i2[bq]; }
      sort16<true>(TK, TP);
#pragma unroll
      for (int bq = 0; bq < 8; bq++) CAND(bq, 1, bq)
#pragma unroll
      for (int bq = 0; bq < 5; bq++) CAND(8 + bq, 2, bq)
#pragma unroll
      for (int bq = 0; bq < 3; bq++) CAND(13 + bq, 4, bq)
      sort16<true>(NK, NP); merge16<true>(TK, TP, NK, NP);
#pragma unroll
      for (int bq = 0; bq < 4; bq++) CAND(bq, 3, bq)
      CAND(4, 5, 0) CAND(5, 5, 1) CAND(6, 6, 0) CAND(7, 6, 1) CAND(8, 7, 0) CAND(9, 7, 1)
      CAND(10, 8, 0) CAND(11, 9, 0) CAND(12, 10, 0) CAND(13, 11, 0) CAND(14, 12, 0) CAND(15, 13, 0)
      sort16<true>(NK, NP); merge16<true>(TK, TP, NK, NP);
      CAND(0, 14, 0) CAND(1, 15, 0)
#pragma unroll
      for (int i = 2; i < 16; i++) { NK[i] = 0; NP[i] = 0; }
      sort16<true>(NK, NP); merge16<true>(TK, TP, NK, NP);
#undef CAND
      const float mx = unord_f(TK[0]);
      float ev[16], sum = 0.f;
#pragma unroll
      for (int i = 0; i < 16; i++) { ev[i] = __expf(unord_f(TK[i]) - mx); sum += ev[i]; }
      const float inv = 1.f / sum;
      u16* ip = (u16*)IDX + (size_t)(tok0 + lane) * 128 + head * 16;
      float* gp = GATE + (size_t)(tok0 + lane) * 128 + head * 16;
#pragma unroll
      for (int c = 0; c < 2; c++)
        *(uint4*)(ip + c * 8) = make_uint4(TP[c * 8] | (TP[c * 8 + 1] << 16), TP[c * 8 + 2] | (TP[c * 8 + 3] << 16),
                                           TP[c * 8 + 4] | (TP[c * 8 + 5] << 16), TP[c * 8 + 6] | (TP[c * 8 + 7] << 16));
#pragma unroll
      for (int c = 0; c < 4; c++)
        *(float4*)(gp + c * 4) = make_float4(ev[c * 4] * inv, ev[c * 4 + 1] * inv, ev[c * 4 + 2] * inv, ev[c * 4 + 3] * inv);
    }
  }
}

DI float row16_sum(float v) {
  v += __int_as_float(__builtin_amdgcn_update_dpp(0, __float_as_int(v), 0x128, 0xf, 0xf, false));
  v += __int_as_float(__builtin_amdgcn_update_dpp(0, __float_as_int(v), 0x124, 0xf, 0xf, false));
  v += __int_as_float(__builtin_amdgcn_update_dpp(0, __float_as_int(v), 0x122, 0xf, 0xf, false));
  v += __int_as_float(__builtin_amdgcn_update_dpp(0, __float_as_int(v), 0x121, 0xf, 0xf, false));
  return v;
}
DI float gelu_tanh(float x) {
  float u = 0.7978845608028654f * (x + 0.044715f * x * x * x);
  float e = __expf(2.f * u);
  float th = 1.f - 2.f / (e + 1.f);
  return 0.5f * x * (1.f + th);
}
DI float dot8(uint4 a, uint4 b, float acc) {
  acc = __builtin_amdgcn_fdot2_f32_bf16(__builtin_bit_cast(bf2, a.x), __builtin_bit_cast(bf2, b.x), acc, false);
  acc = __builtin_amdgcn_fdot2_f32_bf16(__builtin_bit_cast(bf2, a.y), __builtin_bit_cast(bf2, b.y), acc, false);
  acc = __builtin_amdgcn_fdot2_f32_bf16(__builtin_bit_cast(bf2, a.z), __builtin_bit_cast(bf2, b.z), acc, false);
  acc = __builtin_amdgcn_fdot2_f32_bf16(__builtin_bit_cast(bf2, a.w), __builtin_bit_cast(bf2, b.w), acc, false);
  return acc;
}

typedef float f2 __attribute__((ext_vector_type(2)));
DI void expert_dots(const Params& p, int nrows, char* smem) {
  const int tid = otid(), wave = tid >> 6, lane = tid & 63, g = lane >> 4, s = lane & 15;
  const int bid = obid(), x = bid & 7, jx = bid >> 3, wpx = (gridDim.x + 7 - x) >> 3;
  u32* list = (u32*)smem + wave * 128;
  const int* IDX = (const int*)(p.S + OFF_IDX);
  const float* GATE = (const float*)(p.S + OFF_GATE);
  u16* AV16 = (u16*)(p.S + OFF_PU);
  const unsigned char* PU = (const unsigned char*)(p.PT + PT_U) + s * 16;
  const float* PSU = (const float*)(p.PT + PT_SC);
  const float* PSV = PSU + 16384;
  const int tstep = wpx * 4;
  int t = jx * 4 + wave;
  int ni0 = 0, ni1 = 0;
  uint4 nh[8];
  auto prefetch = [&](int tt) {
    { const u32 w2 = ((const u32*)IDX)[(size_t)tt * 64 + lane]; ni0 = (int)(w2 & 0xffffu); ni1 = (int)(w2 >> 16); }
#pragma unroll
    for (int c = 0; c < 4; c++) {
      const u16* hp = p.H + (size_t)tt * D + (c * 16 + s) * 16;
      nh[2 * c] = *(const uint4*)(hp); nh[2 * c + 1] = *(const uint4*)(hp + 8);
    }
  };
  auto dot_row = [&](const int4 (&uu)[4], const f2 (&hf)[32]) {
    const int uw[16] = {uu[0].x, uu[0].y, uu[0].z, uu[0].w, uu[1].x, uu[1].y, uu[1].z, uu[1].w,
                        uu[2].x, uu[2].y, uu[2].z, uu[2].w, uu[3].x, uu[3].y, uu[3].z, uu[3].w};
    f2 acc = {0.f, 0.f}, acc2 = {0.f, 0.f};
#pragma unroll
    for (int j = 0; j < 16; j++) {
      acc = __builtin_elementwise_fma(__builtin_amdgcn_cvt_pk_f32_fp8(uw[j], false), hf[2 * j], acc);
      acc2 = __builtin_elementwise_fma(__builtin_amdgcn_cvt_pk_f32_fp8(uw[j], true), hf[2 * j + 1], acc2);
    }
    return row16_sum((acc.x + acc.y) + (acc2.x + acc2.y));
  };
  if (t < nrows) prefetch(t);
  for (; t < nrows; t += tstep) {
    const int i0 = ni0, i1 = ni1;
    f2 hf[32];
#pragma unroll
    for (int c = 0; c < 4; c++) {
      const u32 hw[8] = {nh[2 * c].x, nh[2 * c].y, nh[2 * c].z, nh[2 * c].w, nh[2 * c + 1].x, nh[2 * c + 1].y, nh[2 * c + 1].z, nh[2 * c + 1].w};
#pragma unroll
      for (int j = 0; j < 8; j++) { hf[c * 8 + j].x = __uint_as_float(hw[j] << 16); hf[c * 8 + j].y = __uint_as_float(hw[j] & 0xffff0000u); }
    }
    if (t + tstep < nrows) prefetch(t + tstep);
    const bool b0 = (i0 >> 11) == x, b1 = (i1 >> 11) == x;
    const unsigned long long m0 = __ballot(b0), m1 = __ballot(b1);
    const int n0 = __popcll(m0);
    const int r0 = __builtin_amdgcn_mbcnt_hi((u32)(m0 >> 32), __builtin_amdgcn_mbcnt_lo((u32)m0, 0u));
    const int r1 = n0 + __builtin_amdgcn_mbcnt_hi((u32)(m1 >> 32), __builtin_amdgcn_mbcnt_lo((u32)m1, 0u));
    const int n = n0 + __popcll(m1);
    __builtin_amdgcn_wave_barrier();
    if (b0) list[r0] = ((u32)(2 * lane) << 16) | (u32)i0;
    if (b1) list[r1] = ((u32)(2 * lane + 1) << 16) | (u32)i1;
    __builtin_amdgcn_wave_barrier();
    for (int cb = 0; cb < n; cb += 64) {
      const int nend = min(n, cb + 64);
      float dk = 0.f;
      for (int base = cb; base < nend; base += 8) {
        const int k0 = base + g, k1 = base + 4 + g;
        const u32 ent0 = list[min(k0, n - 1)], ent1 = list[min(k1, n - 1)];
        const unsigned char* ur0 = PU + (size_t)(ent0 & 0xffffu) * D;
        const unsigned char* ur1 = PU + (size_t)(ent1 & 0xffffu) * D;
        int4 ua[4], ub[4];
        ua[0] = *(const int4*)(ur0); ua[1] = *(const int4*)(ur0 + 256); ua[2] = *(const int4*)(ur0 + 512); ua[3] = *(const int4*)(ur0 + 768);
        ub[0] = *(const int4*)(ur1); ub[1] = *(const int4*)(ur1 + 256); ub[2] = *(const int4*)(ur1 + 512); ub[3] = *(const int4*)(ur1 + 768);
        const float d0 = dot_row(ua, hf);
        const float d1 = dot_row(ub, hf);
        const int it0 = (base - cb) >> 2;
        dk = (s == it0) ? d0 : dk;
        dk = (s == it0 + 1) ? d1 : dk;
      }
      const int kk = cb + 4 * s + g;
      if (kk < nend) {
        const u32 ent = list[kk];
        const int e = (int)(ent & 0xffffu), slot = (int)(ent >> 16);
        AV16[(size_t)t * 128 + slot] = f2bf(GATE[(size_t)t * 128 + slot] * PSV[e] * gelu_tanh(dk * PSU[e]));
      }
    }
  }
}

DI void expert_vsum(const Params& p, int nrows) {
  const int tid = otid(), wave = tid >> 6, lane = tid & 63, g = lane >> 3, s = lane & 7;
  const int bid = obid(), x = bid & 7, jx = bid >> 3, wpx = (gridDim.x + 7 - x) >> 3;
  const u16* IDX = (const u16*)(p.S + OFF_IDX) + g * 16;
  const u16* AV = (const u16*)(p.S + OFF_PU) + g * 16;
  const unsigned char* PV = (const unsigned char*)(p.PT + PT_V) + (size_t)x * 16384 * 128 + s * 16;
  u16* Y = (u16*)((char*)p.U + (size_t)NROW * 2048 * 2);
  const int b5 = (lane >> 5) & 1, b4 = (lane >> 4) & 1, b3 = (lane >> 3) & 1;
  const int tstep = wpx * 4;
  int t = jx * 4 + wave;
  uint4 ni[2], na[2];
  auto prefetch = [&](int tt) {
#pragma unroll
    for (int j = 0; j < 2; j++) { ni[j] = *(const uint4*)(IDX + (size_t)tt * 128 + j * 8); na[j] = *(const uint4*)(AV + (size_t)tt * 128 + j * 8); }
  };
  if (t < nrows) prefetch(t);
  for (; t < nrows; t += tstep) {
    const u32 iw[8] = {ni[0].x, ni[0].y, ni[0].z, ni[0].w, ni[1].x, ni[1].y, ni[1].z, ni[1].w};
    const u32 aw[8] = {na[0].x, na[0].y, na[0].z, na[0].w, na[1].x, na[1].y, na[1].z, na[1].w};
    int ee[16]; float aa[16];
#pragma unroll
    for (int j = 0; j < 8; j++) {
      ee[2 * j] = (int)(iw[j] & 0xffffu); ee[2 * j + 1] = (int)(iw[j] >> 16);
      aa[2 * j] = __uint_as_float(aw[j] << 16); aa[2 * j + 1] = __uint_as_float(aw[j] & 0xffff0000u);
    }
    int4 vv[16];
#pragma unroll
    for (int it = 0; it < 16; it++) vv[it] = *(const int4*)(PV + (size_t)ee[it] * 128);
    if (t + tstep < nrows) prefetch(t + tstep);
    f2 y[8];
#pragma unroll
    for (int i = 0; i < 8; i++) { y[i].x = 0.f; y[i].y = 0.f; }
#pragma unroll
    for (int it = 0; it < 16; it++) {
      const f2 a2 = {aa[it], aa[it]};
      const int vw[4] = {vv[it].x, vv[it].y, vv[it].z, vv[it].w};
#pragma unroll
      for (int j = 0; j < 4; j++) {
        y[2 * j] = __builtin_elementwise_fma(__builtin_amdgcn_cvt_pk_f32_fp8(vw[j], false), a2, y[2 * j]);
        y[2 * j + 1] = __builtin_elementwise_fma(__builtin_amdgcn_cvt_pk_f32_fp8(vw[j], true), a2, y[2 * j + 1]);
      }
    }
    f2 k4[4], k2[2], k1;
#pragma unroll
    for (int i = 0; i < 4; i++) {
      const f2 keep = b5 ? y[4 + i] : y[i], send = b5 ? y[i] : y[4 + i];
      k4[i].x = keep.x + __shfl_xor(send.x, 32); k4[i].y = keep.y + __shfl_xor(send.y, 32);
    }
#pragma unroll
    for (int i = 0; i < 2; i++) {
      const f2 keep = b4 ? k4[2 + i] : k4[i], send = b4 ? k4[i] : k4[2 + i];
      k2[i].x = keep.x + __shfl_xor(send.x, 16); k2[i].y = keep.y + __shfl_xor(send.y, 16);
    }
    {
      const f2 keep = b3 ? k2[1] : k2[0], send = b3 ? k2[0] : k2[1];
      k1.x = keep.x + __shfl_xor(send.x, 8); k1.y = keep.y + __shfl_xor(send.y, 8);
    }
    *(u32*)(Y + (size_t)t * D + x * 128 + s * 16 + b5 * 8 + b4 * 4 + b3 * 2) = pack2(k1.x, k1.y);
  }
}

DI void expert_epilogue(const Params& p, int layer, int nrows) {
  const int tid = otid(), wave = tid >> 6, lane = tid & 63, g = lane >> 5, s = lane & 31;
  const bool last = (layer == DEPTH - 1);
  const u16* Y = (const u16*)((const char*)p.U + (size_t)NROW * 2048 * 2);
  for (int tk = obid() * 4 + wave; tk < nrows; tk += gridDim.x * 4) {
    const int b = row_batch(tk);
    const int col = (g * 32 + s) * 16;
    const float* g2 = ada_ptr(p, layer, b, 5) + col;
    const float* gm = p.ln_gamma + (size_t)(layer * 2 + 1) * D + col;
    const float* bt = p.ln_beta + (size_t)(layer * 2 + 1) * D + col;
    const float* XP = (const float*)(p.S + OFF_XP) + (size_t)tk * D + col;
    float xin[16];
    {
      float s0 = 0.f;
#pragma unroll
      for (int j4 = 0; j4 < 4; j4++) {
        const float4 t4 = *(const float4*)(XP + j4 * 4);
        xin[j4 * 4] = t4.x; xin[j4 * 4 + 1] = t4.y; xin[j4 * 4 + 2] = t4.z; xin[j4 * 4 + 3] = t4.w;
        s0 += t4.x + t4.y + t4.z + t4.w;
      }
      const float m0 = wave_sum(s0) * (1.f / D);
      float q0 = 0.f;
#pragma unroll
      for (int j = 0; j < 16; j++) { xin[j] -= m0; q0 += xin[j] * xin[j]; }
      const float r0 = rsqrtf(wave_sum(q0) * (1.f / D) + EPS);
      const float* gm0 = p.ln_gamma + (size_t)(layer * 2 + 0) * D + col;
      const float* bt0 = p.ln_beta + (size_t)(layer * 2 + 0) * D + col;
#pragma unroll
      for (int j4 = 0; j4 < 4; j4++) {
        const float4 ga = *(const float4*)(gm0 + j4 * 4), be = *(const float4*)(bt0 + j4 * 4);
        xin[j4 * 4] = xin[j4 * 4] * r0 * ga.x + be.x; xin[j4 * 4 + 1] = xin[j4 * 4 + 1] * r0 * ga.y + be.y;
        xin[j4 * 4 + 2] = xin[j4 * 4 + 2] * r0 * ga.z + be.z; xin[j4 * 4 + 3] = xin[j4 * 4 + 3] * r0 * ga.w + be.w;
      }
    }
    float xv[16];
    float sum = 0.f;
    const uint4 yq0 = *(const uint4*)(Y + (size_t)tk * D + col), yq1 = *(const uint4*)(Y + (size_t)tk * D + col + 8);
    const u32 yw[8] = {yq0.x, yq0.y, yq0.z, yq0.w, yq1.x, yq1.y, yq1.z, yq1.w};
#pragma unroll
    for (int j4 = 0; j4 < 4; j4++) {
      const float4 xo = make_float4(xin[j4 * 4], xin[j4 * 4 + 1], xin[j4 * 4 + 2], xin[j4 * 4 + 3]);
      const float4 gg = *(const float4*)(g2 + j4 * 4);
      const float4 yy = make_float4(__uint_as_float(yw[2 * j4] << 16), __uint_as_float(yw[2 * j4] & 0xffff0000u),
                                    __uint_as_float(yw[2 * j4 + 1] << 16), __uint_as_float(yw[2 * j4 + 1] & 0xffff0000u));
      float* o = xv + j4 * 4;
      o[0] = ALPHA * xo.x + gg.x * yy.x; o[1] = ALPHA * xo.y + gg.y * yy.y;
      o[2] = ALPHA * xo.z + gg.z * yy.z; o[3] = ALPHA * xo.w + gg.w * yy.w;
      sum += o[0] + o[1] + o[2] + o[3];
    }
    float mu = wave_sum(sum) * (1.f / D);
    float q = 0.f;
#pragma unroll
    for (int j = 0; j < 16; j++) { xv[j] -= mu; q += xv[j] * xv[j]; }
    float rstd = rsqrtf(wave_sum(q) * (1.f / D) + EPS);
    float* dstx = (last ? p.out : p.X) + (size_t)tk * D + col;
    float s2 = 0.f;
#pragma unroll
    for (int j4 = 0; j4 < 4; j4++) {
      const float4 gmv = *(const float4*)(gm + j4 * 4);
      const float4 btv = *(const float4*)(bt + j4 * 4);
      float* o = xv + j4 * 4;
      o[0] = o[0] * rstd * gmv.x + btv.x; o[1] = o[1] * rstd * gmv.y + btv.y;
      o[2] = o[2] * rstd * gmv.z + btv.z; o[3] = o[3] * rstd * gmv.w + btv.w;
      s2 += o[0] + o[1] + o[2] + o[3];
      *(float4*)(dstx + j4 * 4) = make_float4(o[0], o[1], o[2], o[3]);
    }
    if (!last) {
      float mu2 = wave_sum(s2) * (1.f / D);
      float q2 = 0.f;
#pragma unroll
      for (int j = 0; j < 16; j++) { xv[j] -= mu2; q2 += xv[j] * xv[j]; }
      float rstd2 = rsqrtf(wave_sum(q2) * (1.f / D) + EPS);
      const float* sh = ada_ptr(p, layer + 1, b, 0) + col;
      const float* sc = ada_ptr(p, layer + 1, b, 1) + col;
      u32 ow[8];
#pragma unroll
      for (int j = 0; j < 8; j++) {
        float y0 = xv[2 * j] * rstd2 * (1.f + sc[2 * j]) + sh[2 * j];
        float y1 = xv[2 * j + 1] * rstd2 * (1.f + sc[2 * j + 1]) + sh[2 * j + 1];
        ow[j] = pack2(y0, y1);
      }
      *(uint4*)(p.H + (size_t)tk * D + col) = make_uint4(ow[0], ow[1], ow[2], ow[3]);
      *(uint4*)(p.H + (size_t)tk * D + col + 8) = make_uint4(ow[4], ow[5], ow[6], ow[7]);
    }
  }
}

#define XB_TMO      128
#define XB_XCNT(j)  (256  + 64 * (j))
#define XB_XSUB(j)  (1280 + 64 * (j))
#define XB_XGEN(j)  (2304 + 64 * (j))
#define XB_TOP      3328
#define XB_TOPGEN   3392
#define XCD_BAR_WORDS 3456
#define XB_SPIN_CAP (1u << 18)
#define LAS __attribute__((address_space(3)))

__device__ __forceinline__ unsigned xb_ld(unsigned* p)              { return __hip_atomic_load(p, __ATOMIC_RELAXED, __HIP_MEMORY_SCOPE_AGENT); }
__device__ __forceinline__ unsigned xb_add(unsigned* p, unsigned v) { return __hip_atomic_fetch_add(p, v, __ATOMIC_RELAXED, __HIP_MEMORY_SCOPE_AGENT); }
__device__ __forceinline__ unsigned xb_xcc_id() { return (unsigned)__builtin_amdgcn_s_getreg((3 << 11) | 20) & 0xFu; }
#define XB_SPIN(cond, bar) do { unsigned _sp = 0; while (cond) { __builtin_amdgcn_s_sleep(1); \
    if ((++_sp & 255u) == 0u) { if (xb_ld(&(bar)[XB_TMO])) break; if (_sp > XB_SPIN_CAP) { atomicAdd(&(bar)[XB_TMO], 1u); break; } } } } while (0)

struct XcdBarrier {
    unsigned* bar; unsigned x;
    volatile LAS unsigned* st;
};

__device__ __forceinline__ XcdBarrier xcd_barrier_post(unsigned* bar, volatile LAS unsigned* st) {
    XcdBarrier b; b.bar = bar; b.x = xb_xcc_id(); b.st = st;
    if (threadIdx.x == 0) (void)xb_add(&bar[XB_XCNT(b.x)], 1u);
    return b;
}
__device__ __forceinline__ void xcd_barrier_complete(unsigned* bar, unsigned x, unsigned& nloc, unsigned& nx) {
    const unsigned G = gridDim.x * gridDim.y * gridDim.z;
    unsigned sum, cnt, mine, sp = 0u;
    for (;;) {
        sum = 0u; cnt = 0u; mine = 0u;
#pragma unroll
        for (unsigned j = 0; j < 16; ++j) { const unsigned c = xb_ld(&bar[XB_XCNT(j)]); sum += c; cnt += (c > 0u) ? 1u : 0u; mine = (j == x) ? c : mine; }
        if (sum == G) break;
        __builtin_amdgcn_s_sleep(1);
        if ((++sp & 255u) == 0u) { if (xb_ld(&bar[XB_TMO])) break; if (sp > XB_SPIN_CAP) { atomicAdd(&bar[XB_TMO], 1u); break; } }
    }
    nloc = mine > 0u ? mine : 1u; nx = cnt > 0u ? cnt : 1u;
}

__device__ __forceinline__ void xcd_barrier(const XcdBarrier& b) {
    asm volatile("s_waitcnt vmcnt(0)" ::: "memory");
    __syncthreads();
    if (threadIdx.x == 0) {
        unsigned* bar = b.bar;
        __builtin_amdgcn_s_waitcnt(0);
        unsigned nloc = b.st[0], nx = b.st[1];
        if (nloc == 0u) { xcd_barrier_complete(bar, b.x, nloc, nx); b.st[0] = nloc; b.st[1] = nx; }
        const unsigned old = xb_add(&bar[XB_XSUB(b.x)], 1u);
        const unsigned gen = old / nloc;
        if (old + 1u == (gen + 1u) * nloc) {
            __builtin_amdgcn_fence(__ATOMIC_RELEASE, "agent");
            asm volatile("s_waitcnt vmcnt(0)" ::: "memory");
            const unsigned og = xb_add(&bar[XB_TOP], 1u);
            const unsigned tg = og / nx;
            if (og + 1u == (tg + 1u) * nx) xb_add(&bar[XB_TOPGEN], 1u);
            else XB_SPIN(xb_ld(&bar[XB_TOPGEN]) == tg, bar);
            __builtin_amdgcn_fence(__ATOMIC_ACQUIRE, "agent");
            xb_add(&bar[XB_XGEN(b.x)], 1u);
            asm volatile("s_waitcnt vmcnt(0)" ::: "memory");
        } else {
            XB_SPIN(xb_ld(&bar[XB_XGEN(b.x)]) == gen, bar);
            __builtin_amdgcn_fence(__ATOMIC_ACQUIRE, "agent");
            asm volatile("s_waitcnt vmcnt(0)" ::: "memory");
        }
    }
    __syncthreads();
}


DI void grid_barrier(unsigned* ctr, unsigned& target) {
  asm volatile("s_waitcnt vmcnt(0)" ::: "memory");
  __syncthreads();
  if (threadIdx.x == 0) {
    target += gridDim.x;
    __builtin_amdgcn_fence(__ATOMIC_RELEASE, "agent");
    asm volatile("s_waitcnt vmcnt(0)" ::: "memory");
    __hip_atomic_fetch_add(ctr, 1u, __ATOMIC_RELAXED, __HIP_MEMORY_SCOPE_AGENT);
    while (__hip_atomic_load(ctr, __ATOMIC_RELAXED, __HIP_MEMORY_SCOPE_AGENT) < target) __builtin_amdgcn_s_sleep(1);
    __builtin_amdgcn_fence(__ATOMIC_ACQUIRE, "agent");
    asm volatile("s_waitcnt vmcnt(0)" ::: "memory");
  }
  __syncthreads();
}

__global__ void __launch_bounds__(256, 2) mk_forward(Params p) {
  __shared__ __attribute__((aligned(16))) char smem[LDS_BYTES];
  cg::grid_group grid = cg::this_grid();
  int pc = 0;
#define GSYNC() xcd_barrier(xb)
#define PHASE(body) PHASER(15, body)
#define PHASER(kind, body)                              \
  {                                                     \
    if (pc >= p.ph_lo && pc < p.ph_hi) {                \
      if ((REPMASK >> (kind)) & 1) { const bool dry = true; (void)dry; body; GSYNC(); } \
      { const bool dry = false; (void)dry; body; }      \
      if (pc + 1 < p.ph_hi) GSYNC();                    \
    }                                                   \
    pc++;                                               \
  }
  __shared__ __attribute__((aligned(16))) unsigned xb_words[4];
  if (threadIdx.x == 0) { xb_words[0] = 0u; xb_words[1] = 0u; xb_words[2] = 0u; xb_words[3] = 0u; }
  __syncthreads();
  const XcdBarrier xb = xcd_barrier_post(p.bar, (volatile LAS unsigned*)xb_words);
  if (0 >= p.ph_lo && 0 < p.ph_hi) {
    phase0(p, (float*)smem);
    if (1 < p.ph_hi) grid.sync();
  }
  pc++;
  PHASE(phase0b(p))
  PHASE(lnmod_phase<0>(p, 0, NROW))
  for (int layer = 0; layer < DEPTH; layer++) {
    const bool last = (layer == DEPTH - 1);
    const int nrows = last ? NLAT : NROW;
    PHASER(0, gemm_phase<0>(p, layer, smem, p.H, p.wt_in + (size_t)layer * DINP * D, NROW / 256, DINP / 128, dry))
    PHASER(1, prep_phase(p, layer))
    PHASER(2, scan_phase(p, smem, layer))
    PHASER(3, combine_phase(p, layer, nrows))
    PHASER(4, { gemm_phase<1>(p, layer, smem, p.H, p.wt_out + (size_t)layer * D * D, NLAT / 256, 8, dry);
                 if (nrows > NLAT) gemm_thin<1>(p, layer, smem, p.H, p.wt_out + (size_t)layer * D * D, NLAT, NCTX / 64, 8, dry); })
    PHASER(5, lnmod_phase<1>(p, layer, nrows))
    PHASER(6, { gemm_phase<2>(p, layer, smem, p.H, p.wt_q + (size_t)layer * 2048 * D, NLAT / 256, 16, dry);
                 if (nrows > NLAT) gemm_thin<2>(p, layer, smem, p.H, p.wt_q + (size_t)layer * 2048 * D, NLAT, NCTX / 64, 16, dry); })
    PHASER(7, topk_phase(p, layer, smem, nrows))
    PHASER(8, expert_dots(p, nrows, smem))
    PHASER(9, expert_vsum(p, nrows))
    PHASER(10, expert_epilogue(p, layer, nrows))
  }
#undef PHASE
#undef PHASER
}
constexpr int NPHASES = 3 + 11 * DEPTH;

extern "C" void kernel_launch(void* const* d_in, const int* in_sizes, int n_in, void* d_out, int out_size, void* d_ws,
                              size_t ws_size, hipStream_t stream) {
  Params p{};
  p.x = (const float*)d_in[0]; p.c = (const float*)d_in[1]; p.ctx = (const float*)d_in[2]; p.c_ctx = (const float*)d_in[3];
  p.w_ada = (const float*)d_in[4]; p.b_ada = (const float*)d_in[5]; p.w_in = (const float*)d_in[6];
  p.w_gk2 = (const float*)d_in[7]; p.b_gk = (const float*)d_in[8]; p.hg_lb = (const float*)d_in[9];
  p.hg_norm = (const float*)d_in[10]; p.gla_norm = (const float*)d_in[11]; p.w_out = (const float*)d_in[12];
  p.ln_gamma = (const float*)d_in[13]; p.ln_beta = (const float*)d_in[14]; p.wq = (const float*)d_in[15];
  p.sub_keys = (const float*)d_in[16]; p.peer_u = (const float*)d_in[17]; p.peer_v = (const float*)d_in[18];
  p.out = (float*)d_out;
  char* w = (char*)d_ws;
  size_t off = 0;
  auto take = [&](size_t bytes) { char* q = w + off; off += (bytes + 255) & ~(size_t)255; return q; };
  p.wt_in = (u16*)take((size_t)4 * DINP * D * 2);
  p.wt_out = (u16*)take((size_t)4 * D * D * 2);
  p.wt_q = (u16*)take((size_t)4 * 2048 * D * 2);
  p.keysb = (u16*)take((size_t)4 * 2 * 128 * 128 * 2);
  p.ada_part = (float*)take((size_t)8 * 4 * 5 * 6144 * 4);
  p.ada = (float*)take((size_t)4 * 5 * 6144 * 4);
  p.X = (float*)take((size_t)NROW * D * 4);
  p.H = (u16*)take((size_t)NROW * D * 2);
  p.G = (u16*)take((size_t)NROW * D * 2);
  p.U = (u16*)take((size_t)NROW * DIN * 2);
  p.S = take(SZ_S);
  p.PT = take(SZ_PT);
  p.bar = (unsigned*)take(XCD_BAR_WORDS * 4);
  if (off > ws_size) { fprintf(stderr, "workspace too small: need %zu have %zu\n", off, ws_size); return; }

  static int grid_blocks = 0;
  if (!grid_blocks) {
    int dev = 0, cus = 0, per_cu = 0;
    hipGetDevice(&dev);
    hipDeviceGetAttribute(&cus, hipDeviceAttributeMultiprocessorCount, dev);
    hipOccupancyMaxActiveBlocksPerMultiprocessor(&per_cu, mk_forward, 256, 0);
    if (per_cu > 2) per_cu = 2;
    grid_blocks = cus * per_cu;
  }
#if ONE_LAUNCH
  hipMemsetAsync(p.bar, 0, XCD_BAR_WORDS * 4, stream);
  p.ph_lo = 0; p.ph_hi = NPHASES;
  void* args[] = {&p};
  hipError_t e = hipLaunchCooperativeKernel((void*)mk_forward, dim3(grid_blocks), dim3(256), args, 0, stream);
  if (e != hipSuccess) fprintf(stderr, "cooperative launch failed: %s (grid %d)\n", hipGetErrorString(e), grid_blocks);
#else
  for (int ph = 0; ph < NPHASES; ph++) {
    p.ph_lo = ph; p.ph_hi = ph + 1;
    hipLaunchKernelGGL(mk_forward, dim3(grid_blocks), dim3(256), 0, stream, p);
  }
#endif
}
```

```cpp
#include <hip/hip_runtime.h>
#include <hip/hip_cooperative_groups.h>
#include <cstdio>
namespace cg = cooperative_groups;

#define DI __device__ __forceinline__
typedef unsigned short u16;
typedef unsigned int u32;
typedef __attribute__((ext_vector_type(8))) short bf16x8;
typedef __attribute__((ext_vector_type(16))) float f32x16;
typedef __attribute__((ext_vector_type(2))) __bf16 bf2;

#ifndef REPMASK
#define REPMASK 0
#endif
#ifndef DRYVAR
#define DRYVAR 0
#endif
#ifndef ONE_LAUNCH
#define ONE_LAUNCH 1
#endif

constexpr int D = 1024, NB = 4, SEQ = 8192, DEPTH = 4, CTX = 256;
constexpr int NLAT = NB * SEQ;
constexpr int NCTX = NB * CTX;
constexpr int NROW = NLAT + NCTX;
constexpr int DIN = 4128, DINP = 4224;
constexpr int LPOS = CTX + SEQ;
constexpr int NBLK = LPOS / 32;
constexpr float ALPHA = 1.681792830507429f;
constexpr float EPS = 1e-6f;
constexpr int LDS_BYTES = 73728;

struct Params {
  const float *x, *c, *ctx, *c_ctx, *w_ada, *b_ada, *w_in, *w_gk2, *b_gk, *hg_lb, *hg_norm, *gla_norm,
      *w_out, *ln_gamma, *ln_beta, *wq, *sub_keys, *peer_u, *peer_v;
  float* out;
  u16 *wt_in, *wt_out, *wt_q, *keysb;
  float *ada_part, *ada;
  float* X;
  u16 *H, *G, *U;
  char* S;
  char* PT;
  unsigned* bar;
  int ph_lo, ph_hi;
};

constexpr size_t SZ_HQ = (size_t)2 * 16 * LPOS * 128 * 2;
constexpr size_t SZ_HVT = (size_t)16 * 128 * LPOS * 2;
constexpr size_t SZ_HD = (size_t)2 * 16 * NBLK * 128 * 4;
constexpr size_t SZ_GQ = (size_t)2 * 16 * LPOS * 64 * 2;
constexpr size_t SZ_GD = (size_t)2 * 16 * NBLK * 64 * 4;
constexpr size_t OFF_HQ = 0, OFF_HK = OFF_HQ + SZ_HQ, OFF_HKT = OFF_HK + SZ_HQ, OFF_HVT = OFF_HKT + SZ_HQ,
                 OFF_HD = OFF_HVT + SZ_HVT, OFF_GQ = OFF_HD + SZ_HD, OFF_GK = OFF_GQ + SZ_GQ, OFF_GKT = OFF_GK + SZ_GQ,
                 OFF_GVT = OFF_GKT + SZ_GQ, OFF_GD = OFF_GVT + SZ_HVT, SZ_S = OFF_GD + SZ_GD;
constexpr size_t OFF_XP = 0, SZ_XP = (size_t)NROW * D * 4;
constexpr size_t OFF_IDX = OFF_XP + SZ_XP, SZ_IDX = (size_t)NROW * 128 * 4;
constexpr size_t OFF_GATE = OFF_IDX + SZ_IDX;
constexpr size_t OFF_PU = OFF_GATE + SZ_IDX, SZ_PU = (size_t)16384 * D * 2;
constexpr size_t OFF_PV = OFF_PU + SZ_PU;
constexpr size_t OFF_PSC = OFF_PV + SZ_PU;
static_assert(OFF_PSC + 2 * 16384 * 4 <= SZ_S, "alias overflow");
constexpr size_t PT_U = 0, PT_V = (size_t)16384 * D, PT_SC = 2 * (size_t)16384 * D, SZ_PT = PT_SC + 2 * 16384 * 4;

DI int otid() { int t = threadIdx.x; asm volatile("" : "+v"(t)); return t; }
DI int obid() { int t = blockIdx.x; asm volatile("" : "+s"(t)); return t; }
DI float bf2f(u16 h) { return __uint_as_float(((u32)h) << 16); }
DI u16 f2bf(float x) { return __builtin_bit_cast(u16, (__bf16)x); }
typedef __attribute__((ext_vector_type(2))) float f32x2v;
typedef __attribute__((ext_vector_type(2))) __bf16 bf16x2v;
DI u32 pack2(float a, float b) { f32x2v v = {a, b}; return __builtin_bit_cast(u32, __builtin_convertvector(v, bf16x2v)); }
DI float wave_sum(float v) {
#pragma unroll
  for (int o = 32; o > 0; o >>= 1) v += __shfl_xor(v, o);
  return v;
}
DI int crow(int i, int h) { return (i & 3) + 8 * (i >> 2) + 4 * h; }
DI int perm16(int k) {
  int kk = k & 15;
  return (k & ~15) | (((kk >> 2) & 1) << 3) | ((kk >> 3) << 2) | (kk & 3);
}
DI bf16x8 pack_frag(const f32x16& x, int s) {
  union { bf16x8 v; u32 u[4]; } r;
#pragma unroll
  for (int j = 0; j < 4; j++) r.u[j] = pack2(x[8 * s + 2 * j], x[8 * s + 2 * j + 1]);
  return r.v;
}
#define MFMA32(a, b, c) __builtin_amdgcn_mfma_f32_32x32x16_bf16((a), (b), (c), 0, 0, 0)

DI const float* ada_ptr(const Params& p, int layer, int r, int j) { return p.ada + ((size_t)(layer * 5 + r) * 6 + j) * D; }
DI int row_batch(int r) { return r < NLAT ? (r >> 13) : 4; }

DI void weight_convert(const Params& p, int l, int vbid, int vgrid) {
  const size_t gtid = (size_t)vbid * 256 + otid(), gsz = (size_t)vgrid * 256;
  for (size_t i = gtid; i < (size_t)128 * DINP; i += gsz) {
    int n = i % DINP; int k8 = i / DINP;
    u32 o[4] = {0, 0, 0, 0};
    if (n < DIN) {
      const float* s = p.w_in + ((size_t)l * D + k8 * 8) * DIN + n;
#pragma unroll
      for (int j = 0; j < 4; j++) o[j] = pack2(s[(size_t)(2 * j) * DIN], s[(size_t)(2 * j + 1) * DIN]);
    }
    *(uint4*)(p.wt_in + ((size_t)l * DINP + n) * D + k8 * 8) = make_uint4(o[0], o[1], o[2], o[3]);
  }
  for (size_t i = gtid; i < (size_t)128 * 1024; i += gsz) {
    int n = i & 1023; int k8 = i >> 10;
    const float* s = p.w_out + ((size_t)l * D + k8 * 8) * D + n;
    u32 o[4];
#pragma unroll
    for (int j = 0; j < 4; j++) o[j] = pack2(s[(size_t)(2 * j) * D], s[(size_t)(2 * j + 1) * D]);
    *(uint4*)(p.wt_out + ((size_t)l * D + n) * D + k8 * 8) = make_uint4(o[0], o[1], o[2], o[3]);
  }
  for (size_t i = gtid; i < (size_t)128 * 2048; i += gsz) {
    int n = i & 2047; int k8 = i >> 11;
    const float* s = p.wq + ((size_t)l * D + k8 * 8) * 2048 + n;
    u32 o[4];
#pragma unroll
    for (int j = 0; j < 4; j++) o[j] = pack2(s[(size_t)(2 * j) * 2048], s[(size_t)(2 * j + 1) * 2048]);
    *(uint4*)(p.wt_q + ((size_t)l * 2048 + n) * D + k8 * 8) = make_uint4(o[0], o[1], o[2], o[3]);
  }
}

DI void phase0(const Params& p, float* lds) {
  for (int it = obid(); it < 768; it += gridDim.x) {
    int kp = it & 7, nb = (it >> 3) % 24, l = it / 192;
    __syncthreads();
    for (int i = otid(); i < 640; i += 256) {
      int r = i >> 7, k = i & 127;
      float v = (r < 4) ? p.c[r * D + kp * 128 + k] : p.c_ctx[kp * 128 + k];
      lds[i] = v / (1.f + __expf(-v));
    }
    __syncthreads();
    int n = nb * 256 + otid();
    const float* w = p.w_ada + ((size_t)l * D + kp * 128) * 6144 + n;
    float a0 = 0, a1 = 0, a2 = 0, a3 = 0, a4 = 0;
#pragma unroll 8
    for (int k = 0; k < 128; k++) {
      float wv = w[(size_t)k * 6144];
      a0 += lds[k] * wv; a1 += lds[128 + k] * wv; a2 += lds[256 + k] * wv; a3 += lds[384 + k] * wv; a4 += lds[512 + k] * wv;
    }
    float* o = p.ada_part + ((size_t)(kp * 4 + l) * 5) * 6144 + n;
    o[0] = a0; o[6144] = a1; o[2 * 6144] = a2; o[3 * 6144] = a3; o[4 * 6144] = a4;
  }
  weight_convert(p, 0, obid(), gridDim.x);
  const size_t gtid = (size_t)obid() * 256 + otid(), gsz = (size_t)gridDim.x * 256;
  for (size_t i = gtid; i < (size_t)4 * 2 * 128 * 128; i += gsz) p.keysb[i] = f2bf(p.sub_keys[i]);
}

DI void phase0b(const Params& p) {
  const size_t gtid = (size_t)obid() * 256 + otid(), gsz = (size_t)gridDim.x * 256;
  for (size_t i = gtid; i < (size_t)4 * 5 * 6144; i += gsz) {
    int n = i % 6144; int l = i / (5 * 6144);
    float a = p.b_ada[l * 6144 + n];
#pragma unroll
    for (int kp = 0; kp < 8; kp++) a += p.ada_part[(size_t)kp * 4 * 5 * 6144 + i];
    p.ada[i] = a;
  }
}

DI void peer_convert(const Params& p, int layer, int vbid, int vgrid) {
  const int tid = otid(), wave = tid >> 6, lane = tid & 63;
  unsigned char* du = (unsigned char*)(p.PT + PT_U);
  unsigned char* dv = (unsigned char*)(p.PT + PT_V);
  float* su = (float*)(p.PT + PT_SC);
  for (int it = vbid * 4 + wave; it < 2 * 16384; it += vgrid * 4) {
    const int tbl = it >> 14, e = it & 16383;
    const float* src = (tbl ? p.peer_v : p.peer_u) + ((size_t)layer * 16384 + e) * D + lane * 16;
    float4 a = *(const float4*)(src), b = *(const float4*)(src + 4), c = *(const float4*)(src + 8), d = *(const float4*)(src + 12);
    float m = fmaxf(fmaxf(fmaxf(fabsf(a.x), fabsf(a.y)), fmaxf(fabsf(a.z), fabsf(a.w))), fmaxf(fmaxf(fabsf(b.x), fabsf(b.y)), fmaxf(fabsf(b.z), fabsf(b.w))));
    m = fmaxf(m, fmaxf(fmaxf(fmaxf(fabsf(c.x), fabsf(c.y)), fmaxf(fabsf(c.z), fabsf(c.w))), fmaxf(fmaxf(fabsf(d.x), fabsf(d.y)), fmaxf(fabsf(d.z), fabsf(d.w)))));
#pragma unroll
    for (int o = 32; o > 0; o >>= 1) m = fmaxf(m, __shfl_xor(m, o));
    m = fmaxf(m, 1e-30f);
    const float sc = 224.f / m;
    int w0 = __builtin_amdgcn_cvt_pk_fp8_f32(a.x * sc, a.y * sc, 0, false); w0 = __builtin_amdgcn_cvt_pk_fp8_f32(a.z * sc, a.w * sc, w0, true);
    int w1 = __builtin_amdgcn_cvt_pk_fp8_f32(b.x * sc, b.y * sc, 0, false); w1 = __builtin_amdgcn_cvt_pk_fp8_f32(b.z * sc, b.w * sc, w1, true);
    int w2 = __builtin_amdgcn_cvt_pk_fp8_f32(c.x * sc, c.y * sc, 0, false); w2 = __builtin_amdgcn_cvt_pk_fp8_f32(c.z * sc, c.w * sc, w2, true);
    int w3 = __builtin_amdgcn_cvt_pk_fp8_f32(d.x * sc, d.y * sc, 0, false); w3 = __builtin_amdgcn_cvt_pk_fp8_f32(d.z * sc, d.w * sc, w3, true);
    if (tbl == 0) *(int4*)(du + (size_t)e * D + lane * 16) = make_int4(w0, w1, w2, w3);
    else *(int4*)(dv + ((size_t)(lane >> 3) * 16384 + e) * 128 + (lane & 7) * 16) = make_int4(w0, w1, w2, w3);
    if (lane == 0) su[it] = m * (1.f / 224.f);
  }
}

template <int MODE>
DI void lnmod_phase(const Params& p, int layer, int nrows) {
  const int wave = otid() >> 6, lane = otid() & 63;
  const float* XP = (const float*)(p.S + OFF_XP);
  for (int r = obid() * 4 + wave; r < nrows; r += gridDim.x * 4) {
    const float* src;
    if (MODE == 0) src = (r < NLAT) ? p.x + (size_t)r * D : p.ctx + (size_t)(r - NLAT) * D;
    else src = XP + (size_t)r * D;
    const int b = row_batch(r);
    float4 v[4];
#pragma unroll
    for (int c = 0; c < 4; c++) v[c] = *(const float4*)(src + c * 256 + lane * 4);
    float s = 0;
#pragma unroll
    for (int c = 0; c < 4; c++) s += v[c].x + v[c].y + v[c].z + v[c].w;
    float mu = wave_sum(s) * (1.f / D);
    float q = 0;
#pragma unroll
    for (int c = 0; c < 4; c++) {
      v[c].x -= mu; v[c].y -= mu; v[c].z -= mu; v[c].w -= mu;
      q += v[c].x * v[c].x + v[c].y * v[c].y + v[c].z * v[c].z + v[c].w * v[c].w;
    }
    float rstd = rsqrtf(wave_sum(q) * (1.f / D) + EPS);
    if (MODE == 1) {
      const float* gm = p.ln_gamma + (size_t)(layer * 2 + 0) * D;
      const float* bt = p.ln_beta + (size_t)(layer * 2 + 0) * D;
      float s2 = 0;
#pragma unroll
      for (int c = 0; c < 4; c++) {
        int col = c * 256 + lane * 4;
        float4 g = *(const float4*)(gm + col), be = *(const float4*)(bt + col);
        v[c].x = v[c].x * rstd * g.x + be.x; v[c].y = v[c].y * rstd * g.y + be.y;
        v[c].z = v[c].z * rstd * g.z + be.z; v[c].w = v[c].w * rstd * g.w + be.w;
        s2 += v[c].x + v[c].y + v[c].z + v[c].w;
      }
      float mu2 = wave_sum(s2) * (1.f / D);
      float q2 = 0;
#pragma unroll
      for (int c = 0; c < 4; c++) {
        v[c].x -= mu2; v[c].y -= mu2; v[c].z -= mu2; v[c].w -= mu2;
        q2 += v[c].x * v[c].x + v[c].y * v[c].y + v[c].z * v[c].z + v[c].w * v[c].w;
      }
      rstd = rsqrtf(wave_sum(q2) * (1.f / D) + EPS);
    }
    const float* sh = ada_ptr(p, layer, b, MODE == 0 ? 0 : 3);
    const float* sc = ada_ptr(p, layer, b, MODE == 0 ? 1 : 4);
    float4 av[4], mv[4];
#pragma unroll
    for (int c = 0; c < 4; c++) { av[c] = *(const float4*)(sh + c * 256 + lane * 4); mv[c] = *(const float4*)(sc + c * 256 + lane * 4); }
#pragma unroll
    for (int c = 0; c < 4; c++) {
      int col = c * 256 + lane * 4;
      float4 a = av[c], m = mv[c];
      float y0 = v[c].x * rstd * (1.f + m.x) + a.x, y1 = v[c].y * rstd * (1.f + m.y) + a.y;
      float y2 = v[c].z * rstd * (1.f + m.z) + a.z, y3 = v[c].w * rstd * (1.f + m.w) + a.w;
      *(uint2*)(p.H + (size_t)r * D + col) = make_uint2(pack2(y0, y1), pack2(y2, y3));
    }
  }
}

constexpr int LDS_STRIDE = 72;
constexpr int CT_STRIDE = 132;
template <int MODE>
DI void gemm_store(const Params& p, int layer, int row, int nt, int n0, int c4, const float4 v, const bool dry) {
  if (MODE == 0) {
          u16* dst;
          if (nt >= 16 && nt < 20) dst = p.G + (size_t)row * D + (n0 - 2048) + c4;
          else if (nt >= 28 && nt < 32) dst = p.G + (size_t)row * D + (n0 - 3584 + 512) + c4;
          else dst = p.U + (size_t)row * DIN + n0 + c4;
          if (dry) dst = (u16*)p.S + (size_t)row * DIN + n0 + c4;
          if (n0 + c4 < DIN) *(uint2*)dst = make_uint2(pack2(v.x, v.y), pack2(v.z, v.w));
        } else if (MODE == 1) {
          float* XP = dry ? (float*)p.U : (float*)(p.S + OFF_XP);
          const float* xo = (layer == 0) ? ((row < NLAT) ? p.x + (size_t)row * D : p.ctx + (size_t)(row - NLAT) * D) : p.X + (size_t)row * D;
          const float4 xv = *(const float4*)(xo + n0 + c4);
          const float4 g1 = *(const float4*)(ada_ptr(p, layer, row_batch(row), 2) + n0 + c4);
          *(float4*)(XP + (size_t)row * D + n0 + c4) =
              make_float4(ALPHA * xv.x + g1.x * v.x, ALPHA * xv.y + g1.y * v.y, ALPHA * xv.z + g1.z * v.z, ALPHA * xv.w + g1.w * v.w);
        } else {
          *(uint2*)((dry ? (u16*)(p.S + OFF_PU) : p.U) + (size_t)row * 2048 + n0 + c4) = make_uint2(pack2(v.x, v.y), pack2(v.z, v.w));
        }
}

template <int MODE>
DI void gemm_phase(const Params& p, int layer, char* smem, const u16* A, const u16* Bt, int Mtiles, int Ntiles, const bool dry) {
  u16* As = (u16*)smem;
  u16* Bs = (u16*)smem + 256 * LDS_STRIDE;
  float* Ct = (float*)smem;
  const int tid = otid(), wave = tid >> 6, lane = tid & 63, r = lane & 31, h = lane >> 5;
  const int wm = wave >> 1, wn = wave & 1;
  const int srow = tid >> 3, sc8 = (tid & 7) * 8;
  const int bid = obid(), xcd = bid & 7, jx = bid >> 3, wpx = (gridDim.x + 7 - xcd) >> 3;
  const int ntiles = Mtiles * Ntiles, nchunks = (ntiles + 63) >> 6;
  for (int ch = xcd; ch < nchunks; ch += 8)
  for (int jj = jx; jj < 64; jj += wpx) {
    const int L = ch * 64 + jj;
    if (L >= ntiles) continue;
    const int mt = (L / (4 * Ntiles)) * 4 + (L & 3), nt = (L >> 2) % Ntiles;
    const u16* Ag = A + ((size_t)mt * 256 + srow) * D + sc8;
    const u16* Bg = Bt + ((size_t)nt * 128 + srow) * D + sc8;
    f32x16 acc[4][2];
#pragma unroll
    for (int i = 0; i < 4; i++)
#pragma unroll
      for (int j = 0; j < 2; j++)
#pragma unroll
        for (int e = 0; e < 16; e++) acc[i][j][e] = 0.f;
    bf16x8 ra0, ra1, ra2, ra3, ra4, ra5, ra6, ra7, rb0, rb1, rb2, rb3;
#define GLOAD(kt_) { const u16* ag = Ag + (kt_) * 64; const u16* bg = Bg + (kt_) * 64; \
      ra0 = *(const bf16x8*)(ag); ra1 = *(const bf16x8*)(ag + 32 * D); ra2 = *(const bf16x8*)(ag + 64 * D); ra3 = *(const bf16x8*)(ag + 96 * D); \
      ra4 = *(const bf16x8*)(ag + 128 * D); ra5 = *(const bf16x8*)(ag + 160 * D); ra6 = *(const bf16x8*)(ag + 192 * D); ra7 = *(const bf16x8*)(ag + 224 * D); \
      rb0 = *(const bf16x8*)(bg); rb1 = *(const bf16x8*)(bg + 32 * D); rb2 = *(const bf16x8*)(bg + 64 * D); rb3 = *(const bf16x8*)(bg + 96 * D); }
#define LSTORE() { u16* ad = As + srow * LDS_STRIDE + sc8; u16* bd = Bs + srow * LDS_STRIDE + sc8; \
      *(bf16x8*)(ad) = ra0; *(bf16x8*)(ad + 32 * LDS_STRIDE) = ra1; *(bf16x8*)(ad + 64 * LDS_STRIDE) = ra2; *(bf16x8*)(ad + 96 * LDS_STRIDE) = ra3; \
      *(bf16x8*)(ad + 128 * LDS_STRIDE) = ra4; *(bf16x8*)(ad + 160 * LDS_STRIDE) = ra5; *(bf16x8*)(ad + 192 * LDS_STRIDE) = ra6; *(bf16x8*)(ad + 224 * LDS_STRIDE) = ra7; \
      *(bf16x8*)(bd) = rb0; *(bf16x8*)(bd + 32 * LDS_STRIDE) = rb1; *(bf16x8*)(bd + 64 * LDS_STRIDE) = rb2; *(bf16x8*)(bd + 96 * LDS_STRIDE) = rb3; }
    GLOAD(0)
    __syncthreads();
    LSTORE()
    __syncthreads();
#pragma unroll 1
    for (int kt = 0; kt < 16; kt++) {
      if (kt + 1 < 16 && !(dry && DRYVAR == 1)) GLOAD(kt + 1)
      const u16* as = As + (wm * 128 + r) * LDS_STRIDE + h * 8;
      const u16* bs = Bs + (wn * 64 + r) * LDS_STRIDE + h * 8;
      if (!(dry && DRYVAR == 2)) {
        bf16x8 af[2][4], b0, b1;
#pragma unroll
        for (int i = 0; i < 4; i++) af[0][i] = *(const bf16x8*)(as + i * 32 * LDS_STRIDE);
        b0 = *(const bf16x8*)(bs); b1 = *(const bf16x8*)(bs + 32 * LDS_STRIDE);
#pragma unroll
        for (int kk = 0; kk < 4; kk++) {
          const int cur = kk & 1, nxt = cur ^ 1;
          if (kk < 3) {
#pragma unroll
            for (int i = 0; i < 4; i++) af[nxt][i] = *(const bf16x8*)(as + i * 32 * LDS_STRIDE + (kk + 1) * 16);
          }
          __builtin_amdgcn_s_setprio(1);
#pragma unroll
          for (int i = 0; i < 4; i++) acc[i][0] = MFMA32(af[cur][i], b0, acc[i][0]);
          if (kk < 3) b0 = *(const bf16x8*)(bs + (kk + 1) * 16);
#pragma unroll
          for (int i = 0; i < 4; i++) acc[i][1] = MFMA32(af[cur][i], b1, acc[i][1]);
          if (kk < 3) b1 = *(const bf16x8*)(bs + 32 * LDS_STRIDE + (kk + 1) * 16);
          __builtin_amdgcn_s_setprio(0);
        }
      }
      __syncthreads();
      if (kt + 1 < 16 && !(dry && DRYVAR == 1)) LSTORE()
      __syncthreads();
    }
#undef GLOAD
#undef LSTORE
    const int m0 = mt * 256, n0 = nt * 128;
    const int c4 = (tid & 31) * 4, rr0 = tid >> 5;
#pragma unroll
    for (int ph = 0; ph < 2; ph++) {
      if (ph) __syncthreads();
#pragma unroll
      for (int ii = 0; ii < 2; ii++)
#pragma unroll
        for (int j = 0; j < 2; j++)
#pragma unroll
          for (int e = 0; e < 16; e++) Ct[(wm * 64 + ii * 32 + crow(e, h)) * CT_STRIDE + wn * 64 + j * 32 + r] = acc[ph * 2 + ii][j][e];
      __syncthreads();
      if (MODE == 1) {
        const float4 g1 = *(const float4*)(ada_ptr(p, layer, row_batch(m0), 2) + n0 + c4);
        float* XP = dry ? (float*)p.U : (float*)(p.S + OFF_XP);
#pragma unroll 1
        for (int q0 = 0; q0 < 16; q0 += 2) {
          float4 xv[2], cv[2];
#pragma unroll
          for (int j = 0; j < 2; j++) {
            const int rl = rr0 + (q0 + j) * 8, row = m0 + (rl >> 6) * 128 + ph * 64 + (rl & 63);
            const float* xo = (layer == 0) ? ((row < NLAT) ? p.x + (size_t)row * D : p.ctx + (size_t)(row - NLAT) * D) : p.X + (size_t)row * D;
            xv[j] = *(const float4*)(xo + n0 + c4);
            cv[j] = *(const float4*)(Ct + rl * CT_STRIDE + c4);
          }
#pragma unroll
          for (int j = 0; j < 2; j++) {
            const int rl = rr0 + (q0 + j) * 8, row = m0 + (rl >> 6) * 128 + ph * 64 + (rl & 63);
            *(float4*)(XP + (size_t)row * D + n0 + c4) = make_float4(ALPHA * xv[j].x + g1.x * cv[j].x, ALPHA * xv[j].y + g1.y * cv[j].y,
                                                                     ALPHA * xv[j].z + g1.z * cv[j].z, ALPHA * xv[j].w + g1.w * cv[j].w);
          }
        }
      } else {
#pragma unroll 2
        for (int q = 0; q < 16; q++) {
          const int rl = rr0 + q * 8, row = m0 + (rl >> 6) * 128 + ph * 64 + (rl & 63);
          const float4 v = *(const float4*)(Ct + rl * CT_STRIDE + c4);
          gemm_store<MODE>(p, layer, row, nt, n0, c4, v, dry);
        }
      }
    }
  }
}

template <int MODE>
DI void gemm_thin(const Params& p, int layer, char* smem, const u16* A, const u16* Bt, int row0, int Mtiles, int Ntiles, const bool dry) {
  u16* As = (u16*)smem;
  u16* Bs = (u16*)smem + 64 * LDS_STRIDE;
  float* Ct = (float*)smem;
  const int tid = otid(), wave = tid >> 6, lane = tid & 63, r = lane & 31, h = lane >> 5;
  const int wm = wave >> 1, wn = wave & 1;
  const int srow = tid >> 3, sc8 = (tid & 7) * 8;
  const int ntiles = Mtiles * Ntiles;
  for (int L = obid(); L < ntiles; L += gridDim.x) {
    const int mt = L / Ntiles, nt = L % Ntiles;
    const u16* Ag = A + ((size_t)row0 + mt * 64 + srow) * D + sc8;
    const u16* Bg = Bt + ((size_t)nt * 128 + srow) * D + sc8;
    f32x16 acc0, acc1;
#pragma unroll
    for (int e = 0; e < 16; e++) { acc0[e] = 0.f; acc1[e] = 0.f; }
    bf16x8 ra0, ra1, rb0, rb1, rb2, rb3;
#define GLOADT(kt_) { const u16* ag = Ag + (kt_) * 64; const u16* bg = Bg + (kt_) * 64; \
      ra0 = *(const bf16x8*)(ag); ra1 = *(const bf16x8*)(ag + 32 * D); \
      rb0 = *(const bf16x8*)(bg); rb1 = *(const bf16x8*)(bg + 32 * D); rb2 = *(const bf16x8*)(bg + 64 * D); rb3 = *(const bf16x8*)(bg + 96 * D); }
#define LSTORET() { u16* ad = As + srow * LDS_STRIDE + sc8; u16* bd = Bs + srow * LDS_STRIDE + sc8; \
      *(bf16x8*)(ad) = ra0; *(bf16x8*)(ad + 32 * LDS_STRIDE) = ra1; \
      *(bf16x8*)(bd) = rb0; *(bf16x8*)(bd + 32 * LDS_STRIDE) = rb1; *(bf16x8*)(bd + 64 * LDS_STRIDE) = rb2; *(bf16x8*)(bd + 96 * LDS_STRIDE) = rb3; }
    GLOADT(0)
    __syncthreads();
    LSTORET()
    __syncthreads();
#pragma unroll 1
    for (int kt = 0; kt < 16; kt++) {
      if (kt + 1 < 16) GLOADT(kt + 1)
      const u16* as = As + (wm * 32 + r) * LDS_STRIDE + h * 8;
      const u16* bs = Bs + (wn * 64 + r) * LDS_STRIDE + h * 8;
#pragma unroll
      for (int kk = 0; kk < 4; kk++) {
        const bf16x8 af = *(const bf16x8*)(as + kk * 16);
        const bf16x8 bf0 = *(const bf16x8*)(bs + kk * 16), bf1 = *(const bf16x8*)(bs + 32 * LDS_STRIDE + kk * 16);
        acc0 = MFMA32(af, bf0, acc0);
        acc1 = MFMA32(af, bf1, acc1);
      }
      __syncthreads();
      if (kt + 1 < 16) LSTORET()
      __syncthreads();
    }
#undef GLOADT
#undef LSTORET
#pragma unroll
    for (int e = 0; e < 16; e++) {
      Ct[(wm * 32 + crow(e, h)) * CT_STRIDE + wn * 64 + r] = acc0[e];
      Ct[(wm * 32 + crow(e, h)) * CT_STRIDE + wn * 64 + 32 + r] = acc1[e];
    }
    __syncthreads();
    const int n0 = nt * 128, c4 = (tid & 31) * 4, rr0 = tid >> 5;
#pragma unroll 2
    for (int q = 0; q < 8; q++) {
      const int rl = rr0 + q * 8, row = row0 + mt * 64 + rl;
      const float4 v = *(const float4*)(Ct + rl * CT_STRIDE + c4);
      gemm_store<MODE>(p, layer, row, nt, n0, c4, v, dry);
    }
  }
}

DI int tokrow(int grp, int b, int pos) {
  if (pos < CTX) return NLAT + b * CTX + pos;
  int pp = pos - CTX;
  return b * SEQ + (grp == 0 ? pp : ((pp & 127) * 64 + (pp >> 7)));
}
DI float log_sigmoid(float z) { return fminf(z, 0.f) - __logf(1.f + __expf(-fabsf(z))); }

template <int DK, int DIR>
DI void prep_k(const Params& p, int layer, int grp, int hb, int blk, int cgi) {
  constexpr int CH = DK / 32;
  const int b = hb >> 2, head = hb & 3, k0 = cgi * CH;
  float lb[CH], log_lb[CH], l1m[CH], wg[CH][16], bias[CH], bacc[CH];
#pragma unroll
  for (int c = 0; c < CH; c++) {
    bacc[c] = 0.f; lb[c] = 0.f; log_lb[c] = 0.f; l1m[c] = 0.f; bias[c] = 0.f;
    if (DK == 128) {
      const float* lbp = p.hg_lb + (size_t)DIR * DEPTH * 512 + head * 128 + k0 + c;
      float e0 = lbp[0], e1 = lbp[512], e2 = lbp[1024], e3 = lbp[1536];
      const float mx = fmaxf(fmaxf(e0, e1), fmaxf(e2, e3));
      e0 = __expf(e0 - mx); e1 = __expf(e1 - mx); e2 = __expf(e2 - mx); e3 = __expf(e3 - mx);
      const float inv = 1.f / (e0 + e1 + e2 + e3);
      float cs = 0.f;
      if (layer >= 1) cs += e1 * inv;
      if (layer >= 2) cs += e2 * inv;
      if (layer >= 3) cs += e3 * inv;
      lb[c] = fminf(fmaxf(cs, 0.f), 1.f - 1e-6f);
      log_lb[c] = __logf(fmaxf(lb[c], 1e-30f));
      l1m[c] = __logf(1.f - lb[c]);
    } else {
#pragma unroll
      for (int rr = 0; rr < 16; rr++) wg[c][rr] = p.w_gk2[((size_t)(layer * 2 + DIR) * 16 + rr) * 256 + head * 64 + k0 + c];
      bias[c] = p.b_gk[(size_t)(layer * 2 + DIR) * 256 + head * 64 + k0 + c];
    }
  }
  const size_t chain = (size_t)DIR * 16 + hb;
  const int pk0 = perm16(k0);
  u16* Qd = (u16*)(p.S + (DK == 128 ? OFF_HQ : OFF_GQ)) + (chain * LPOS + (size_t)blk * 32) * DK + pk0;
  u16* Kd = (u16*)(p.S + (DK == 128 ? OFF_HK : OFF_GK)) + (chain * LPOS + (size_t)blk * 32) * DK + pk0;
  u16* KTd = (u16*)(p.S + (DK == 128 ? OFF_HKT : OFF_GKT)) + ((chain * NBLK + blk) * DK + k0) * 32;
#pragma unroll 1
  for (int s2 = 0; s2 < 2; s2++) {
    const int tg = DIR ? 1 - s2 : s2;
    u16 kt[CH][16];
#pragma unroll
    for (int jb = 0; jb < 2; jb++) {
      uint2 zz[8], qq[8];
      u32 gq[8], gk[8];
      uint4 ga[8], gb[8];
#pragma unroll
      for (int j = 0; j < 8; j++) {
        const int j2 = jb * 8 + j;
        const int t16 = DIR ? 15 - j2 : j2;
        const u16* urow = p.U + (size_t)tokrow(grp, b, blk * 32 + tg * 16 + t16) * DIN;
        if (DK == 128) {
          zz[j] = *(const uint2*)(urow + 512 * (1 + DIR) + head * 128 + k0);
          qq[j] = *(const uint2*)(urow + head * 128 + k0);
        } else {
          gq[j] = *(const u32*)(urow + 2560 + head * 64 + k0);
          gk[j] = *(const u32*)(urow + 2816 + head * 64 + k0);
          const uint4* gr = (const uint4*)(urow + 4096 + DIR * 16);
          ga[j] = gr[0]; gb[j] = gr[1];
        }
      }
#pragma unroll
      for (int j = 0; j < 8; j++) {
        const int j2 = jb * 8 + j;
        const int t16 = DIR ? 15 - j2 : j2;
        const int t = tg * 16 + t16;
        float qv[CH], kv[CH], la[CH];
        if (DK == 128) {
          const u32 zw[2] = {zz[j].x, zz[j].y}, qw[2] = {qq[j].x, qq[j].y};
#pragma unroll
          for (int c = 0; c < CH; c++) {
            const float z = (c & 1) ? __uint_as_float(zw[c >> 1] & 0xffff0000u) : __uint_as_float(zw[c >> 1] << 16);
            qv[c] = (c & 1) ? __uint_as_float(qw[c >> 1] & 0xffff0000u) : __uint_as_float(qw[c >> 1] << 16);
            const float ez = __expf(-fabsf(z));
            const float rc = __frcp_rn(1.f + ez);
            const float sp = (z < 0.f) ? ez * rc : rc;
            const float sn = (z < 0.f) ? rc : ez * rc;
            la[c] = __logf(fmaxf(lb[c], 1e-30f) + (1.f - lb[c]) * sp);
            kv[c] = (1.f - lb[c]) * sn;
          }
        } else {
          const u32 gw[8] = {ga[j].x, ga[j].y, ga[j].z, ga[j].w, gb[j].x, gb[j].y, gb[j].z, gb[j].w};
#pragma unroll
          for (int c = 0; c < CH; c++) {
            qv[c] = ((c & 1) ? __uint_as_float(gq[j] & 0xffff0000u) : __uint_as_float(gq[j] << 16)) * 0.125f;
            kv[c] = (c & 1) ? __uint_as_float(gk[j] & 0xffff0000u) : __uint_as_float(gk[j] << 16);
            float d = bias[c];
#pragma unroll
            for (int rr = 0; rr < 8; rr++)
              d += __uint_as_float(gw[rr] << 16) * wg[c][2 * rr] + __uint_as_float(gw[rr] & 0xffff0000u) * wg[c][2 * rr + 1];
            la[c] = (fminf(d, 0.f) - __logf(1.f + __expf(-fabsf(d)))) * (1.f / 16.f);
          }
        }
        float qo[CH], ko[CH];
#pragma unroll
        for (int c = 0; c < CH; c++) {
          bacc[c] += la[c];
          const float eb = __expf(bacc[c]);
          qo[c] = qv[c] * eb;
          ko[c] = kv[c] * __expf(-bacc[c]);
          kt[c][perm16(t16)] = f2bf(ko[c]);
        }
        if (CH == 4) {
          *(uint2*)(Qd + (size_t)t * DK) = make_uint2(pack2(qo[0], qo[1]), pack2(qo[2], qo[3]));
          *(uint2*)(Kd + (size_t)t * DK) = make_uint2(pack2(ko[0], ko[1]), pack2(ko[2], ko[3]));
        } else {
          *(u32*)(Qd + (size_t)t * DK) = pack2(qo[0], qo[1]);
          *(u32*)(Kd + (size_t)t * DK) = pack2(ko[0], ko[1]);
        }
      }
    }
#pragma unroll
    for (int c = 0; c < CH; c++) {
      u16* dst = KTd + c * 32 + tg * 16;
#pragma unroll
      for (int q8 = 0; q8 < 2; q8++) {
        uint4 o;
        o.x = (u32)kt[c][q8 * 8 + 0] | ((u32)kt[c][q8 * 8 + 1] << 16); o.y = (u32)kt[c][q8 * 8 + 2] | ((u32)kt[c][q8 * 8 + 3] << 16);
        o.z = (u32)kt[c][q8 * 8 + 4] | ((u32)kt[c][q8 * 8 + 5] << 16); o.w = (u32)kt[c][q8 * 8 + 6] | ((u32)kt[c][q8 * 8 + 7] << 16);
        *(uint4*)(dst + q8 * 8) = o;
      }
    }
  }
  float* Dd = (float*)(p.S + (DK == 128 ? OFF_HD : OFF_GD)) + (chain * NBLK + blk) * DK + k0;
#pragma unroll
  for (int c = 0; c < CH; c++) Dd[c] = __expf(bacc[c]);
}

DI void prep_phase(const Params& p, int layer) {
  const int tid = otid();
  for (int it = obid(); it < 2 * 16 * (NBLK / 4); it += gridDim.x) {
    const int bg = it % (NBLK / 4), hb = (it / (NBLK / 4)) & 15, grp = it / ((NBLK / 4) * 16);
    const int b = hb >> 2, head = hb & 3;
    {
      const int dir = tid >> 7, blk = bg * 4 + ((tid >> 5) & 3), cgi = tid & 31;
      if (grp == 0) {
        if (dir == 0) prep_k<128, 0>(p, layer, 0, hb, blk, cgi);
        else prep_k<128, 1>(p, layer, 0, hb, blk, cgi);
      } else {
        if (dir == 0) prep_k<64, 0>(p, layer, 1, hb, blk, cgi);
        else prep_k<64, 1>(p, layer, 1, hb, blk, cgi);
      }
    }
    {
      const int vg = tid & 31, tg = tid >> 5;
      const int col = (grp == 0 ? 1536 : 3072) + head * 128 + vg * 4;
      const int pos0 = bg * 128 + tg * 16;
      u16 vt[4][16];
#pragma unroll
      for (int t = 0; t < 16; t++) {
        const uint2 vv = *(const uint2*)(p.U + (size_t)tokrow(grp, b, pos0 + t) * DIN + col);
        vt[0][perm16(t)] = (u16)(vv.x & 0xffffu); vt[1][perm16(t)] = (u16)(vv.x >> 16);
        vt[2][perm16(t)] = (u16)(vv.y & 0xffffu); vt[3][perm16(t)] = (u16)(vv.y >> 16);
      }
#pragma unroll
      for (int c = 0; c < 4; c++) {
        u16* dst = (u16*)(p.S + (grp == 0 ? OFF_HVT : OFF_GVT)) + (((size_t)hb * NBLK + (pos0 >> 5)) * 128 + vg * 4 + c) * 32 + (pos0 & 31);
#pragma unroll
        for (int q8 = 0; q8 < 2; q8++) {
          uint4 o;
          o.x = (u32)vt[c][q8 * 8 + 0] | ((u32)vt[c][q8 * 8 + 1] << 16); o.y = (u32)vt[c][q8 * 8 + 2] | ((u32)vt[c][q8 * 8 + 3] << 16);
          o.z = (u32)vt[c][q8 * 8 + 4] | ((u32)vt[c][q8 * 8 + 5] << 16); o.w = (u32)vt[c][q8 * 8 + 6] | ((u32)vt[c][q8 * 8 + 7] << 16);
          *(uint4*)(dst + q8 * 8) = o;
        }
      }
    }
  }
}

template <int DK>
DI void scan_wg(const Params& p, char* smem, int grp, int dir, int hb) {
  constexpr int NT = DK / 32, NF = DK / 16;
  constexpr int QS = DK + 8;
  constexpr int KTS = 40;
  constexpr int OFF_K = 32 * QS * 2, OFF_KT = 2 * 32 * QS * 2, OFF_D = OFF_KT + DK * KTS * 2, BUFB = OFF_D + DK * 4;
  constexpr int QN = DK / 64;
  constexpr int CPR = DK / 8;
  static_assert(2 * BUFB <= LDS_BYTES, "scan LDS");
  const int tid = otid(), vs = tid >> 6, lane = tid & 63, r = lane & 31, h = lane >> 5;
  const int b = hb >> 2, head = hb & 3;
  const size_t chain = (size_t)dir * 16 + hb;
  const u16* Qb = (const u16*)(p.S + (DK == 128 ? OFF_HQ : OFF_GQ)) + chain * LPOS * DK;
  const u16* Kb = (const u16*)(p.S + (DK == 128 ? OFF_HK : OFF_GK)) + chain * LPOS * DK;
  const u16* KTb = (const u16*)(p.S + (DK == 128 ? OFF_HKT : OFF_GKT)) + chain * NBLK * DK * 32;
  const u16* VTb = (const u16*)(p.S + (DK == 128 ? OFF_HVT : OFF_GVT)) + (size_t)hb * NBLK * 128 * 32 + (vs * 32 + r) * 32 + h * 8;
  const float* Db = (const float*)(p.S + (DK == 128 ? OFF_HD : OFF_GD)) + chain * NBLK * DK;
  u16* Ob = p.U + (size_t)dir * NROW * D + grp * 512 + head * 128 + vs * 32;
  f32x16 S[NT];
#pragma unroll
  for (int kt = 0; kt < NT; kt++)
#pragma unroll
    for (int e = 0; e < 16; e++) S[kt][e] = 0.f;
  bf16x8 sq[QN], sk[QN], skt[QN], vn0, vn1;
  float4 sd = make_float4(0.f, 0.f, 0.f, 0.f);
  auto blk_of = [&](int step) { return dir ? (step < 8 ? 7 - step : 271 - step) : step; };
  auto gload = [&](int step) {
    const size_t pos0 = (size_t)blk_of(step) * 32;
#pragma unroll
    for (int i = 0; i < QN; i++) {
      const int id = tid + i * 256;
      sq[i] = *(const bf16x8*)(Qb + (pos0 + id / CPR) * DK + (id % CPR) * 8);
      sk[i] = *(const bf16x8*)(Kb + (pos0 + id / CPR) * DK + (id % CPR) * 8);
      skt[i] = *(const bf16x8*)(KTb + (size_t)blk_of(step) * DK * 32 + id * 8);
    }
    if (tid < DK / 4) sd = *(const float4*)(Db + (size_t)blk_of(step) * DK + tid * 4);
    vn0 = *(const bf16x8*)(VTb + (size_t)blk_of(step) * 128 * 32);
    vn1 = *(const bf16x8*)(VTb + (size_t)blk_of(step) * 128 * 32 + 16);
  };
  auto lstore = [&](int buf) {
    char* base = smem + buf * BUFB;
#pragma unroll
    for (int i = 0; i < QN; i++) {
      const int id = tid + i * 256;
      *(bf16x8*)(base + ((id / CPR) * QS + (id % CPR) * 8) * 2) = sq[i];
      *(bf16x8*)(base + OFF_K + ((id / CPR) * QS + (id % CPR) * 8) * 2) = sk[i];
      *(bf16x8*)(base + OFF_KT + ((id >> 2) * KTS + (id & 3) * 8) * 2) = skt[i];
    }
    if (tid < DK / 4) *(float4*)(base + OFF_D + tid * 16) = sd;
  };
  __syncthreads();
  gload(0);
  lstore(0);
  bf16x8 vf0 = vn0, vf1 = vn1;
  __syncthreads();
#pragma unroll 1
  for (int step = 0; step < NBLK; step++) {
    const int blk = blk_of(step);
    if (step + 1 < NBLK) gload(step + 1);
    const char* base = smem + (step & 1) * BUFB;
    const u16* Qs = (const u16*)base + r * QS + h * 8;
    const u16* Ks = (const u16*)(base + OFF_K) + r * QS + h * 8;
    const u16* KTs = (const u16*)(base + OFF_KT) + r * KTS + h * 8;
    const float* Ds = (const float*)(base + OFF_D) + 4 * h;
    bf16x8 qf[NF];
    f32x16 P0, P1;
#pragma unroll
    for (int e = 0; e < 16; e++) { P0[e] = 0.f; P1[e] = 0.f; }
#pragma unroll
    for (int f = 0; f < NF; f += 2) {
      qf[f] = *(const bf16x8*)(Qs + f * 16);
      qf[f + 1] = *(const bf16x8*)(Qs + f * 16 + 16);
      P0 = MFMA32(*(const bf16x8*)(Ks + f * 16), qf[f], P0);
      P1 = MFMA32(*(const bf16x8*)(Ks + f * 16 + 16), qf[f + 1], P1);
    }
#pragma unroll
    for (int e = 0; e < 16; e++) {
      const int s = crow(e, h);
      const bool keep = dir ? (s >= r) : (s <= r);
      P0[e] = keep ? P0[e] + P1[e] : 0.f;
    }
    f32x16 oA, oB;
#pragma unroll
    for (int e = 0; e < 16; e++) { oA[e] = 0.f; oB[e] = 0.f; }
    oA = MFMA32(vf0, pack_frag(P0, 0), oA);
    oA = MFMA32(vf1, pack_frag(P0, 1), oA);
#pragma unroll
    for (int kt = 0; kt < NT; kt++) {
      if (kt & 1) {
        oA = MFMA32(pack_frag(S[kt], 0), qf[kt * 2], oA);
        oA = MFMA32(pack_frag(S[kt], 1), qf[kt * 2 + 1], oA);
      } else {
        oB = MFMA32(pack_frag(S[kt], 0), qf[kt * 2], oB);
        oB = MFMA32(pack_frag(S[kt], 1), qf[kt * 2 + 1], oB);
      }
    }
#pragma unroll
    for (int kt = 0; kt < NT; kt++) {
      S[kt] = MFMA32(*(const bf16x8*)(KTs + kt * 32 * KTS), vf0, S[kt]);
      S[kt] = MFMA32(*(const bf16x8*)(KTs + kt * 32 * KTS + 16), vf1, S[kt]);
#pragma unroll
      for (int g = 0; g < 4; g++) {
        const float4 dv = *(const float4*)(Ds + kt * 32 + 8 * g);
        S[kt][4 * g + 0] *= dv.x; S[kt][4 * g + 1] *= dv.y; S[kt][4 * g + 2] *= dv.z; S[kt][4 * g + 3] *= dv.w;
      }
    }
    {
      const int pos0 = blk * 32;
      int rbase, rstride;
      if (pos0 < CTX) { rbase = NLAT + b * CTX + pos0; rstride = 1; }
      else if (grp == 0) { rbase = b * SEQ + pos0 - CTX; rstride = 1; }
      else { const int pp = pos0 - CTX; rbase = b * SEQ + (pp & 127) * 64 + (pp >> 7); rstride = 64; }
      u16* orow = Ob + (size_t)(rbase + r * rstride) * D + 4 * h;
#pragma unroll
      for (int g = 0; g < 4; g++)
        *(uint2*)(orow + 8 * g) = make_uint2(pack2(oA[4 * g] + oB[4 * g], oA[4 * g + 1] + oB[4 * g + 1]),
                                             pack2(oA[4 * g + 2] + oB[4 * g + 2], oA[4 * g + 3] + oB[4 * g + 3]));
    }
    if (step + 1 < NBLK) lstore((step + 1) & 1);
    vf0 = vn0; vf1 = vn1;
    __syncthreads();
  }
}

DI void scan_phase(const Params& p, char* smem, int layer) {
  const int bid = obid(), nscan = gridDim.x > 64 ? 64 : gridDim.x;
  if (bid < nscan) {
    for (int w = bid; w < 64; w += nscan) {
      const int grp = w >> 5, dir = (w >> 4) & 1, hb = w & 15;
      if (grp == 0) scan_wg<128>(p, smem, 0, dir, hb);
      else scan_wg<64>(p, smem, 1, dir, hb);
    }
  }
  if (gridDim.x <= 64 || bid >= 64) {
    const int vbid = gridDim.x <= 64 ? bid : bid - 64, vgrid = gridDim.x <= 64 ? gridDim.x : gridDim.x - 64;
    peer_convert(p, layer, vbid, vgrid);
    if (layer + 1 < DEPTH) weight_convert(p, layer + 1, vbid, vgrid);
  }
}

DI void combine_phase(const Params& p, int layer, int nrows) {
  const int wave = otid() >> 6, lane = otid() & 63;
  const int c0 = lane * 16;
  const float* gain = (c0 < 512 ? p.hg_norm : p.gla_norm) + (size_t)layer * 128 + (c0 & 127);
  float gn[16];
#pragma unroll
  for (int j = 0; j < 16; j++) gn[j] = gain[j];
  for (int r = obid() * 4 + wave; r < nrows; r += gridDim.x * 4) {
    const uint4* of = (const uint4*)(p.U + (size_t)r * D + c0);
    const uint4* ob = (const uint4*)(p.U + (size_t)NROW * D + (size_t)r * D + c0);
    const uint4* gg = (const uint4*)(p.G + (size_t)r * D + c0);
    float o[16], g[16];
#pragma unroll
    for (int c = 0; c < 2; c++) {
      uint4 a = of[c], bq = ob[c], gq = gg[c];
      u32 aw[4] = {a.x, a.y, a.z, a.w}, bw[4] = {bq.x, bq.y, bq.z, bq.w}, gw[4] = {gq.x, gq.y, gq.z, gq.w};
#pragma unroll
      for (int j = 0; j < 4; j++) {
        o[c * 8 + 2 * j] = __uint_as_float(aw[j] << 16) + __uint_as_float(bw[j] << 16);
        o[c * 8 + 2 * j + 1] = __uint_as_float(aw[j] & 0xffff0000u) + __uint_as_float(bw[j] & 0xffff0000u);
        g[c * 8 + 2 * j] = __uint_as_float(gw[j] << 16);
        g[c * 8 + 2 * j + 1] = __uint_as_float(gw[j] & 0xffff0000u);
      }
    }
    float ss = 0;
#pragma unroll
    for (int j = 0; j < 16; j++) ss += o[j] * o[j];
    ss += __shfl_xor(ss, 1); ss += __shfl_xor(ss, 2); ss += __shfl_xor(ss, 4);
    float rs = rsqrtf(ss * (1.f / 128.f) + EPS);
    u32 ow[8];
#pragma unroll
    for (int j = 0; j < 8; j++) {
      float g0 = g[2 * j], g1 = g[2 * j + 1];
      float y0 = o[2 * j] * rs * gn[2 * j] * (g0 / (1.f + __expf(-g0)));
      float y1 = o[2 * j + 1] * rs * gn[2 * j + 1] * (g1 / (1.f + __expf(-g1)));
      ow[j] = pack2(y0, y1);
    }
    uint4* dst = (uint4*)(p.H + (size_t)r * D + c0);
    dst[0] = make_uint4(ow[0], ow[1], ow[2], ow[3]);
    dst[1] = make_uint4(ow[4], ow[5], ow[6], ow[7]);
  }
}

template <bool PAY>
DI void ce(u32& a, u32& b, u32& pa, u32& pb) {
  if (!PAY) { u32 hi = a > b ? a : b, lo = a > b ? b : a; a = hi; b = lo; }
  else { bool c = a >= b; u32 hi = c ? a : b, lo = c ? b : a, ph = c ? pa : pb, pl = c ? pb : pa; a = hi; b = lo; pa = ph; pb = pl; }
}
template <bool PAY>
DI void sort16(u32 (&k)[16], u32 (&q)[16]) {
#pragma unroll
  for (int size = 2; size <= 16; size <<= 1) {
#pragma unroll
    for (int stride = size >> 1; stride > 0; stride >>= 1) {
#pragma unroll
      for (int i = 0; i < 16; i++) {
        int j = i ^ stride;
        if (j > i) {
          if ((i & size) == 0) ce<PAY>(k[i], k[j], q[i], q[j]);
          else ce<PAY>(k[j], k[i], q[j], q[i]);
        }
      }
    }
  }
}
template <bool PAY>
DI void merge16(u32 (&R)[16], u32 (&RP)[16], u32 (&N)[16], u32 (&NP)[16]) {
#pragma unroll
  for (int i = 0; i < 16; i++) {
    bool c = N[15 - i] > R[i];
    R[i] = c ? N[15 - i] : R[i];
    if (PAY) RP[i] = c ? NP[15 - i] : RP[i];
  }
#pragma unroll
  for (int stride = 8; stride > 0; stride >>= 1) {
#pragma unroll
    for (int i = 0; i < 16; i++) {
      int j = i ^ stride;
      if (j > i) ce<PAY>(R[i], R[j], RP[i], RP[j]);
    }
  }
}
DI u32 ord_f(float f) { u32 u = __float_as_uint(f); return (u & 0x80000000u) ? ~u : (u | 0x80000000u); }
DI float unord_f(u32 u) { return __uint_as_float((u & 0x80000000u) ? (u ^ 0x80000000u) : ~u); }

DI void topk_phase(const Params& p, int layer, char* smem, int nrows) {
  const int tid = otid(), wave = tid >> 6, lane = tid & 63, r = lane & 31, h = lane >> 5;
  float* sc = (float*)smem + wave * 4096;
  const u16* Q = p.U;
  const u16* keys = p.keysb + (size_t)layer * 2 * 128 * 128;
  int* IDX = (int*)(p.S + OFF_IDX);
  float* GATE = (float*)(p.S + OFF_GATE);
  const int nunits = (nrows / 64) * 8;
  for (int wu = obid() * 4 + wave; wu < nunits; wu += gridDim.x * 4) {
    const int tok0 = (wu >> 3) * 64, head = wu & 7;
    u32 RA[16], RB[16], dummy[16];
#pragma unroll
    for (int i = 0; i < 16; i++) { RA[i] = 0; RB[i] = 0; dummy[i] = 0; }
    auto do_half = [&](const int half, u32 (&R)[16]) {
      bf16x8 qf[2][8];
#pragma unroll
      for (int nt = 0; nt < 2; nt++) {
        const u16* qp = Q + (size_t)(tok0 + nt * 32 + r) * 2048 + head * 256 + half * 128 + h * 8;
#pragma unroll
        for (int f = 0; f < 8; f++) qf[nt][f] = *(const bf16x8*)(qp + f * 16);
      }
      f32x16 acc0, acc1;
      auto mm = [&](const int kr) {
        const u16* kp = keys + ((size_t)half * 128 + kr * 32 + r) * 128 + h * 8;
#pragma unroll
        for (int e = 0; e < 16; e++) { acc0[e] = 0.f; acc1[e] = 0.f; }
        bf16x8 afk[8];
#pragma unroll
        for (int f = 0; f < 8; f++) afk[f] = *(const bf16x8*)(kp + f * 16);
        __builtin_amdgcn_s_setprio(1);
#pragma unroll
        for (int f = 0; f < 8; f++) {
          acc0 = MFMA32(afk[f], qf[0][f], acc0);
          acc1 = MFMA32(afk[f], qf[1][f], acc1);
        }
        __builtin_amdgcn_s_setprio(0);
      };
      auto put = [&](const int buf) {
        float* d = sc + buf * 2048;
#pragma unroll
        for (int e = 0; e < 16; e++) {
          d[crow(e, h) * 64 + r] = acc0[e];
          d[crow(e, h) * 64 + 32 + r] = acc1[e];
        }
      };
      mm(0);
      put(0);
#pragma unroll
      for (int kr = 0; kr < 4; kr++) {
        if (kr < 3) mm(kr + 1);
        __builtin_amdgcn_wave_barrier();
        const float* sp = sc + (kr & 1) * 2048 + lane;
#pragma unroll
        for (int grp = 0; grp < 2; grp++) {
          u32 N[16];
#pragma unroll
          for (int i = 0; i < 16; i++) {
            const float v = sp[(grp * 16 + i) * 64];
            N[i] = (ord_f(v) & 0xFFFFFF80u) | (u32)(127 - (kr * 32 + grp * 16 + i));
          }
          sort16<false>(N, dummy);
          merge16<false>(R, dummy, N, dummy);
        }
        __builtin_amdgcn_wave_barrier();
        if (kr < 3) put((kr + 1) & 1);
      }
    };
    do_half(0, RA);
    do_half(1, RB);
    {
      float v1[16], v2[16]; u32 i1[16], i2[16];
#pragma unroll
      for (int i = 0; i < 16; i++) {
        v1[i] = unord_f(RA[i] & 0xFFFFFF80u); i1[i] = 127 - (RA[i] & 127u);
        v2[i] = unord_f(RB[i] & 0xFFFFFF80u); i2[i] = 127 - (RB[i] & 127u);
      }
      u32 TK[16], TP[16], NK[16], NP[16];
#define CAND(slot, a, bq) { NK[slot] = ord_f(v1[a] + v2[bq]); NP[slot] = i1[a] * 128u + i2[bq]; }
#pragma unroll
      for (int bq = 0; bq < 16; bq++) { TK[bq] = ord_f(v1[0] + v2[bq]); TP[bq] = i1[0] * 128u + i2[bq]; }
      sort16<true>(TK, TP);
#pragma unroll
      for (int bq = 0; bq < 8; bq++) CAND(bq, 1, bq)
#pragma unroll
      for (int bq = 0; bq < 5; bq++) CAND(8 + bq, 2, bq)
#pragma unroll
      for (int bq = 0; bq < 3; bq++) CAND(13 + bq, 4, bq)
      sort16<true>(NK, NP); merge16<true>(TK, TP, NK, NP);
#pragma unroll
      for (int bq = 0; bq < 4; bq++) CAND(bq, 3, bq)
      CAND(4, 5, 0) CAND(5, 5, 1) CAND(6, 6, 0) CAND(7, 6, 1) CAND(8, 7, 0) CAND(9, 7, 1)
      CAND(10, 8, 0) CAND(11, 9, 0) CAND(12, 10, 0) CAND(13, 11, 0) CAND(14, 12, 0) CAND(15, 13, 0)
      sort16<true>(NK, NP); merge16<true>(TK, TP, NK, NP);
      CAND(0, 14, 0) CAND(1, 15, 0)
#pragma unroll
      for (int i = 2; i < 16; i++) { NK[i] = 0; NP[i] = 0; }
      sort16<true>(NK, NP); merge16<true>(TK, TP, NK, NP);
#undef CAND
      const float mx = unord_f(TK[0]);
      float ev[16], sum = 0.f;
#pragma unroll
      for (int i = 0; i < 16; i++) { ev[i] = __expf(unord_f(TK[i]) - mx); sum += ev[i]; }
      const float inv = 1.f / sum;
      u16* ip = (u16*)IDX + (size_t)(tok0 + lane) * 128 + head * 16;
      float* gp = GATE + (size_t)(tok0 + lane) * 128 + head * 16;
#pragma unroll
      for (int c = 0; c < 2; c++)
        *(uint4*)(ip + c * 8) = make_uint4(TP[c * 8] | (TP[c * 8 + 1] << 16), TP[c * 8 + 2] | (TP[c * 8 + 3] << 16),
                                           TP[c * 8 + 4] | (TP[c * 8 + 5] << 16), TP[c * 8 + 6] | (TP[c * 8 + 7] << 16));
#pragma unroll
      for (int c = 0; c < 4; c++)
        *(float4*)(gp + c * 4) = make_float4(ev[c * 4] * inv, ev[c * 4 + 1] * inv, ev[c * 4 + 2] * inv, ev[c * 4 + 3] * inv);
    }
  }
}

DI float row16_sum(float v) {
  v += __int_as_float(__builtin_amdgcn_update_dpp(0, __float_as_int(v), 0x128, 0xf, 0xf, false));
  v += __int_as_float(__builtin_amdgcn_update_dpp(0, __float_as_int(v), 0x124, 0xf, 0xf, false));
  v += __int_as_float(__builtin_amdgcn_update_dpp(0, __float_as_int(v), 0x122, 0xf, 0xf, false));
  v += __int_as_float(__builtin_amdgcn_update_dpp(0, __float_as_int(v), 0x121, 0xf, 0xf, false));
  return v;
}
DI float gelu_tanh(float x) {
  float u = 0.7978845608028654f * (x + 0.044715f * x * x * x);
  float e = __expf(2.f * u);
  float th = 1.f - 2.f / (e + 1.f);
  return 0.5f * x * (1.f + th);
}
DI float dot8(uint4 a, uint4 b, float acc) {
  acc = __builtin_amdgcn_fdot2_f32_bf16(__builtin_bit_cast(bf2, a.x), __builtin_bit_cast(bf2, b.x), acc, false);
  acc = __builtin_amdgcn_fdot2_f32_bf16(__builtin_bit_cast(bf2, a.y), __builtin_bit_cast(bf2, b.y), acc, false);
  acc = __builtin_amdgcn_fdot2_f32_bf16(__builtin_bit_cast(bf2, a.z), __builtin_bit_cast(bf2, b.z), acc, false);
  acc = __builtin_amdgcn_fdot2_f32_bf16(__builtin_bit_cast(bf2, a.w), __builtin_bit_cast(bf2, b.w), acc, false);
  return acc;
}

typedef float f2 __attribute__((ext_vector_type(2)));
DI void expert_dots(const Params& p, int nrows, char* smem) {
  const int tid = otid(), wave = tid >> 6, lane = tid & 63, g = lane >> 4, s = lane & 15;
  const int bid = obid(), x = bid & 7, jx = bid >> 3, wpx = (gridDim.x + 7 - x) >> 3;
  u32* list = (u32*)smem + wave * 128;
  const int* IDX = (const int*)(p.S + OFF_IDX);
  const float* GATE = (const float*)(p.S + OFF_GATE);
  u16* AV16 = (u16*)(p.S + OFF_PU);
  const unsigned char* PU = (const unsigned char*)(p.PT + PT_U) + s * 16;
  const float* PSU = (const float*)(p.PT + PT_SC);
  const float* PSV = PSU + 16384;
  const int tstep = wpx * 4;
  int t = jx * 4 + wave;
  int ni0 = 0, ni1 = 0;
  uint4 nh[8];
  auto prefetch = [&](int tt) {
    { const u32 w2 = ((const u32*)IDX)[(size_t)tt * 64 + lane]; ni0 = (int)(w2 & 0xffffu); ni1 = (int)(w2 >> 16); }
#pragma unroll
    for (int c = 0; c < 4; c++) {
      const u16* hp = p.H + (size_t)tt * D + (c * 16 + s) * 16;
      nh[2 * c] = *(const uint4*)(hp); nh[2 * c + 1] = *(const uint4*)(hp + 8);
    }
  };
  auto dot_row = [&](const int4 (&uu)[4], const f2 (&hf)[32]) {
    const int uw[16] = {uu[0].x, uu[0].y, uu[0].z, uu[0].w, uu[1].x, uu[1].y, uu[1].z, uu[1].w,
                        uu[2].x, uu[2].y, uu[2].z, uu[2].w, uu[3].x, uu[3].y, uu[3].z, uu[3].w};
    f2 acc = {0.f, 0.f}, acc2 = {0.f, 0.f};
#pragma unroll
    for (int j = 0; j < 16; j++) {
      acc = __builtin_elementwise_fma(__builtin_amdgcn_cvt_pk_f32_fp8(uw[j], false), hf[2 * j], acc);
      acc2 = __builtin_elementwise_fma(__builtin_amdgcn_cvt_pk_f32_fp8(uw[j], true), hf[2 * j + 1], acc2);
    }
    return row16_sum((acc.x + acc.y) + (acc2.x + acc2.y));
  };
  if (t < nrows) prefetch(t);
  for (; t < nrows; t += tstep) {
    const int i0 = ni0, i1 = ni1;
    f2 hf[32];
#pragma unroll
    for (int c = 0; c < 4; c++) {
      const u32 hw[8] = {nh[2 * c].x, nh[2 * c].y, nh[2 * c].z, nh[2 * c].w, nh[2 * c + 1].x, nh[2 * c + 1].y, nh[2 * c + 1].z, nh[2 * c + 1].w};
#pragma unroll
      for (int j = 0; j < 8; j++) { hf[c * 8 + j].x = __uint_as_float(hw[j] << 16); hf[c * 8 + j].y = __uint_as_float(hw[j] & 0xffff0000u); }
    }
    if (t + tstep < nrows) prefetch(t + tstep);
    const bool b0 = (i0 >> 11) == x, b1 = (i1 >> 11) == x;
    const unsigned long long m0 = __ballot(b0), m1 = __ballot(b1);
    const int n0 = __popcll(m0);
    const int r0 = __builtin_amdgcn_mbcnt_hi((u32)(m0 >> 32), __builtin_amdgcn_mbcnt_lo((u32)m0, 0u));
    const int r1 = n0 + __builtin_amdgcn_mbcnt_hi((u32)(m1 >> 32), __builtin_amdgcn_mbcnt_lo((u32)m1, 0u));
    const int n = n0 + __popcll(m1);
    __builtin_amdgcn_wave_barrier();
    if (b0) list[r0] = ((u32)(2 * lane) << 16) | (u32)i0;
    if (b1) list[r1] = ((u32)(2 * lane + 1) << 16) | (u32)i1;
    __builtin_amdgcn_wave_barrier();
    for (int cb = 0; cb < n; cb += 64) {
      const int nend = min(n, cb + 64);
      float dk = 0.f;
      for (int base = cb; base < nend; base += 8) {
        const int k0 = base + g, k1 = base + 4 + g;
        const u32 ent0 = list[min(k0, n - 1)], ent1 = list[min(k1, n - 1)];
        const unsigned char* ur0 = PU + (size_t)(ent0 & 0xffffu) * D;
        const unsigned char* ur1 = PU + (size_t)(ent1 & 0xffffu) * D;
        int4 ua[4], ub[4];
        ua[0] = *(const int4*)(ur0); ua[1] = *(const int4*)(ur0 + 256); ua[2] = *(const int4*)(ur0 + 512); ua[3] = *(const int4*)(ur0 + 768);
        ub[0] = *(const int4*)(ur1); ub[1] = *(const int4*)(ur1 + 256); ub[2] = *(const int4*)(ur1 + 512); ub[3] = *(const int4*)(ur1 + 768);
        const float d0 = dot_row(ua, hf);
        const float d1 = dot_row(ub, hf);
        const int it0 = (base - cb) >> 2;
        dk = (s == it0) ? d0 : dk;
        dk = (s == it0 + 1) ? d1 : dk;
      }
      const int kk = cb + 4 * s + g;
      if (kk < nend) {
        const u32 ent = list[kk];
        const int e = (int)(ent & 0xffffu), slot = (int)(ent >> 16);
        AV16[(size_t)t * 128 + slot] = f2bf(GATE[(size_t)t * 128 + slot] * PSV[e] * gelu_tanh(dk * PSU[e]));
      }
    }
  }
}

DI void expert_vsum(const Params& p, int nrows) {
  const int tid = otid(), wave = tid >> 6, lane = tid & 63, g = lane >> 3, s = lane & 7;
  const int bid = obid(), x = bid & 7, jx = bid >> 3, wpx = (gridDim.x + 7 - x) >> 3;
  const u16* IDX = (const u16*)(p.S + OFF_IDX) + g * 16;
  const u16* AV = (const u16*)(p.S + OFF_PU) + g * 16;
  const unsigned char* PV = (const unsigned char*)(p.PT + PT_V) + (size_t)x * 16384 * 128 + s * 16;
  u16* Y = (u16*)((char*)p.U + (size_t)NROW * 2048 * 2);
  const int b5 = (lane >> 5) & 1, b4 = (lane >> 4) & 1, b3 = (lane >> 3) & 1;
  const int tstep = wpx * 4;
  int t = jx * 4 + wave;
  uint4 ni[2], na[2];
  auto prefetch = [&](int tt) {
#pragma unroll
    for (int j = 0; j < 2; j++) { ni[j] = *(const uint4*)(IDX + (size_t)tt * 128 + j * 8); na[j] = *(const uint4*)(AV + (size_t)tt * 128 + j * 8); }
  };
  if (t < nrows) prefetch(t);
  for (; t < nrows; t += tstep) {
    const u32 iw[8] = {ni[0].x, ni[0].y, ni[0].z, ni[0].w, ni[1].x, ni[1].y, ni[1].z, ni[1].w};
    const u32 aw[8] = {na[0].x, na[0].y, na[0].z, na[0].w, na[1].x, na[1].y, na[1].z, na[1].w};
    int ee[16]; float aa[16];
#pragma unroll
    for (int j = 0; j < 8; j++) {
      ee[2 * j] = (int)(iw[j] & 0xffffu); ee[2 * j + 1] = (int)(iw[j] >> 16);
      aa[2 * j] = __uint_as_float(aw[j] << 16); aa[2 * j + 1] = __uint_as_float(aw[j] & 0xffff0000u);
    }
    int4 vv[16];
#pragma unroll
    for (int it = 0; it < 16; it++) vv[it] = *(const int4*)(PV + (size_t)ee[it] * 128);
    if (t + tstep < nrows) prefetch(t + tstep);
    f2 y[8];
#pragma unroll
    for (int i = 0; i < 8; i++) { y[i].x = 0.f; y[i].y = 0.f; }
#pragma unroll
    for (int it = 0; it < 16; it++) {
      const f2 a2 = {aa[it], aa[it]};
      const int vw[4] = {vv[it].x, vv[it].y, vv[it].z, vv[it].w};
#pragma unroll
      for (int j = 0; j < 4; j++) {
        y[2 * j] = __builtin_elementwise_fma(__builtin_amdgcn_cvt_pk_f32_fp8(vw[j], false), a2, y[2 * j]);
        y[2 * j + 1] = __builtin_elementwise_fma(__builtin_amdgcn_cvt_pk_f32_fp8(vw[j], true), a2, y[2 * j + 1]);
      }
    }
    f2 k4[4], k2[2], k1;
#pragma unroll
    for (int i = 0; i < 4; i++) {
      const f2 keep = b5 ? y[4 + i] : y[i], send = b5 ? y[i] : y[4 + i];
      k4[i].x = keep.x + __shfl_xor(send.x, 32); k4[i].y = keep.y + __shfl_xor(send.y, 32);
    }
#pragma unroll
    for (int i = 0; i < 2; i++) {
      const f2 keep = b4 ? k4[2 + i] : k4[i], send = b4 ? k4[i] : k4[2 + i];
      k2[i].x = keep.x + __shfl_xor(send.x, 16); k2[i].y = keep.y + __shfl_xor(send.y, 16);
    }
    {
      const f2 keep = b3 ? k2[1] : k2[0], send = b3 ? k2[0] : k2[1];
      k1.x = keep.x + __shfl_xor(send.x, 8); k1.y = keep.y + __shfl_xor(send.y, 8);
    }
    *(u32*)(Y + (size_t)t * D + x * 128 + s * 16 + b5 * 8 + b4 * 4 + b3 * 2) = pack2(k1.x, k1.y);
  }
}

DI void expert_epilogue(const Params& p, int layer, int nrows) {
  const int tid = otid(), wave = tid >> 6, lane = tid & 63, g = lane >> 5, s = lane & 31;
  const bool last = (layer == DEPTH - 1);
  const u16* Y = (const u16*)((const char*)p.U + (size_t)NROW * 2048 * 2);
  for (int tk = obid() * 4 + wave; tk < nrows; tk += gridDim.x * 4) {
    const int b = row_batch(tk);
    const int col = (g * 32 + s) * 16;
    const float* g2 = ada_ptr(p, layer, b, 5) + col;
    const float* gm = p.ln_gamma + (size_t)(layer * 2 + 1) * D + col;
    const float* bt = p.ln_beta + (size_t)(layer * 2 + 1) * D + col;
    const float* XP = (const float*)(p.S + OFF_XP) + (size_t)tk * D + col;
    float xin[16];
    {
      float s0 = 0.f;
#pragma unroll
      for (int j4 = 0; j4 < 4; j4++) {
        const float4 t4 = *(const float4*)(XP + j4 * 4);
        xin[j4 * 4] = t4.x; xin[j4 * 4 + 1] = t4.y; xin[j4 * 4 + 2] = t4.z; xin[j4 * 4 + 3] = t4.w;
        s0 += t4.x + t4.y + t4.z + t4.w;
      }
      const float m0 = wave_sum(s0) * (1.f / D);
      float q0 = 0.f;
#pragma unroll
      for (int j = 0; j < 16; j++) { xin[j] -= m0; q0 += xin[j] * xin[j]; }
      const float r0 = rsqrtf(wave_sum(q0) * (1.f / D) + EPS);
      const float* gm0 = p.ln_gamma + (size_t)(layer * 2 + 0) * D + col;
      const float* bt0 = p.ln_beta + (size_t)(layer * 2 + 0) * D + col;
#pragma unroll
      for (int j4 = 0; j4 < 4; j4++) {
        const float4 ga = *(const float4*)(gm0 + j4 * 4), be = *(const float4*)(bt0 + j4 * 4);
        xin[j4 * 4] = xin[j4 * 4] * r0 * ga.x + be.x; xin[j4 * 4 + 1] = xin[j4 * 4 + 1] * r0 * ga.y + be.y;
        xin[j4 * 4 + 2] = xin[j4 * 4 + 2] * r0 * ga.z + be.z; xin[j4 * 4 + 3] = xin[j4 * 4 + 3] * r0 * ga.w + be.w;
      }
    }
    float xv[16];
    float sum = 0.f;
    const uint4 yq0 = *(const uint4*)(Y + (size_t)tk * D + col), yq1 = *(const uint4*)(Y + (size_t)tk * D + col + 8);
    const u32 yw[8] = {yq0.x, yq0.y, yq0.z, yq0.w, yq1.x, yq1.y, yq1.z, yq1.w};
#pragma unroll
    for (int j4 = 0; j4 < 4; j4++) {
      const float4 xo = make_float4(xin[j4 * 4], xin[j4 * 4 + 1], xin[j4 * 4 + 2], xin[j4 * 4 + 3]);
      const float4 gg = *(const float4*)(g2 + j4 * 4);
      const float4 yy = make_float4(__uint_as_float(yw[2 * j4] << 16), __uint_as_float(yw[2 * j4] & 0xffff0000u),
                                    __uint_as_float(yw[2 * j4 + 1] << 16), __uint_as_float(yw[2 * j4 + 1] & 0xffff0000u));
      float* o = xv + j4 * 4;
      o[0] = ALPHA * xo.x + gg.x * yy.x; o[1] = ALPHA * xo.y + gg.y * yy.y;
      o[2] = ALPHA * xo.z + gg.z * yy.z; o[3] = ALPHA * xo.w + gg.w * yy.w;
      sum += o[0] + o[1] + o[2] + o[3];
    }
    float mu = wave_sum(sum) * (1.f / D);
    float q = 0.f;
#pragma unroll
    for (int j = 0; j < 16; j++) { xv[j] -= mu; q += xv[j] * xv[j]; }
    float rstd = rsqrtf(wave_sum(q) * (1.f / D) + EPS);
    float* dstx = (last ? p.out : p.X) + (size_t)tk * D + col;
    float s2 = 0.f;
    float4 gmq[4], btq[4];
#pragma unroll
    for (int j4 = 0; j4 < 4; j4++) { gmq[j4] = *(const float4*)(gm + j4 * 4); btq[j4] = *(const float4*)(bt + j4 * 4); }
#pragma unroll
    for (int j4 = 0; j4 < 4; j4++) {
      const float4 gmv = gmq[j4];
      const float4 btv = btq[j4];
      float* o = xv + j4 * 4;
      o[0] = o[0] * rstd * gmv.x + btv.x; o[1] = o[1] * rstd * gmv.y + btv.y;
      o[2] = o[2] * rstd * gmv.z + btv.z; o[3] = o[3] * rstd * gmv.w + btv.w;
      s2 += o[0] + o[1] + o[2] + o[3];
      *(float4*)(dstx + j4 * 4) = make_float4(o[0], o[1], o[2], o[3]);
    }
    if (!last) {
      float mu2 = wave_sum(s2) * (1.f / D);
      float q2 = 0.f;
#pragma unroll
      for (int j = 0; j < 16; j++) { xv[j] -= mu2; q2 += xv[j] * xv[j]; }
      float rstd2 = rsqrtf(wave_sum(q2) * (1.f / D) + EPS);
      const float* sh = ada_ptr(p, layer + 1, b, 0) + col;
      const float* sc = ada_ptr(p, layer + 1, b, 1) + col;
      u32 ow[8];
#pragma unroll
      for (int j = 0; j < 8; j++) {
        float y0 = xv[2 * j] * rstd2 * (1.f + sc[2 * j]) + sh[2 * j];
        float y1 = xv[2 * j + 1] * rstd2 * (1.f + sc[2 * j + 1]) + sh[2 * j + 1];
        ow[j] = pack2(y0, y1);
      }
      *(uint4*)(p.H + (size_t)tk * D + col) = make_uint4(ow[0], ow[1], ow[2], ow[3]);
      *(uint4*)(p.H + (size_t)tk * D + col + 8) = make_uint4(ow[4], ow[5], ow[6], ow[7]);
    }
  }
}

#define XB_TMO      128
#define XB_XCNT(j)  (256  + 64 * (j))
#define XB_XSUB(j)  (1280 + 64 * (j))
#define XB_XGEN(j)  (2304 + 64 * (j))
#define XB_TOP      3328
#define XB_TOPGEN   3392
#define XCD_BAR_WORDS 3456
#define XB_SPIN_CAP (1u << 18)
#define LAS __attribute__((address_space(3)))

__device__ __forceinline__ unsigned xb_ld(unsigned* p)              { return __hip_atomic_load(p, __ATOMIC_RELAXED, __HIP_MEMORY_SCOPE_AGENT); }
__device__ __forceinline__ unsigned xb_add(unsigned* p, unsigned v) { return __hip_atomic_fetch_add(p, v, __ATOMIC_RELAXED, __HIP_MEMORY_SCOPE_AGENT); }
__device__ __forceinline__ unsigned xb_xcc_id() { return (unsigned)__builtin_amdgcn_s_getreg((3 << 11) | 20) & 0xFu; }
#define XB_SPIN(cond, bar) do { unsigned _sp = 0; while (cond) { __builtin_amdgcn_s_sleep(1); \
    if ((++_sp & 255u) == 0u) { if (xb_ld(&(bar)[XB_TMO])) break; if (_sp > XB_SPIN_CAP) { atomicAdd(&(bar)[XB_TMO], 1u); break; } } } } while (0)

struct XcdBarrier {
    unsigned* bar; unsigned x;
    volatile LAS unsigned* st;
};

__device__ __forceinline__ XcdBarrier xcd_barrier_post(unsigned* bar, volatile LAS unsigned* st) {
    XcdBarrier b; b.bar = bar; b.x = xb_xcc_id(); b.st = st;
    if (threadIdx.x == 0) (void)xb_add(&bar[XB_XCNT(b.x)], 1u);
    return b;
}
__device__ __forceinline__ void xcd_barrier_complete(unsigned* bar, unsigned x, unsigned& nloc, unsigned& nx) {
    const unsigned G = gridDim.x * gridDim.y * gridDim.z;
    unsigned sum, cnt, mine, sp = 0u;
    for (;;) {
        sum = 0u; cnt = 0u; mine = 0u;
#pragma unroll
        for (unsigned j = 0; j < 16; ++j) { const unsigned c = xb_ld(&bar[XB_XCNT(j)]); sum += c; cnt += (c > 0u) ? 1u : 0u; mine = (j == x) ? c : mine; }
        if (sum == G) break;
        __builtin_amdgcn_s_sleep(1);
        if ((++sp & 255u) == 0u) { if (xb_ld(&bar[XB_TMO])) break; if (sp > XB_SPIN_CAP) { atomicAdd(&bar[XB_TMO], 1u); break; } }
    }
    nloc = mine > 0u ? mine : 1u; nx = cnt > 0u ? cnt : 1u;
}

__device__ __forceinline__ void xcd_barrier(const XcdBarrier& b) {
    asm volatile("s_waitcnt vmcnt(0)" ::: "memory");
    __syncthreads();
    if (threadIdx.x == 0) {
        unsigned* bar = b.bar;
        __builtin_amdgcn_s_waitcnt(0);
        unsigned nloc = b.st[0], nx = b.st[1];
        if (nloc == 0u) { xcd_barrier_complete(bar, b.x, nloc, nx); b.st[0] = nloc; b.st[1] = nx; }
        const unsigned old = xb_add(&bar[XB_XSUB(b.x)], 1u);
        const unsigned gen = old / nloc;
        if (old + 1u == (gen + 1u) * nloc) {
            __builtin_amdgcn_fence(__ATOMIC_RELEASE, "agent");
            asm volatile("s_waitcnt vmcnt(0)" ::: "memory");
            const unsigned og = xb_add(&bar[XB_TOP], 1u);
            const unsigned tg = og / nx;
            if (og + 1u == (tg + 1u) * nx) xb_add(&bar[XB_TOPGEN], 1u);
            else XB_SPIN(xb_ld(&bar[XB_TOPGEN]) == tg, bar);
            __builtin_amdgcn_fence(__ATOMIC_ACQUIRE, "agent");
            xb_add(&bar[XB_XGEN(b.x)], 1u);
            asm volatile("s_waitcnt vmcnt(0)" ::: "memory");
        } else {
            XB_SPIN(xb_ld(&bar[XB_XGEN(b.x)]) == gen, bar);
            __builtin_amdgcn_fence(__ATOMIC_ACQUIRE, "agent");
            asm volatile("s_waitcnt vmcnt(0)" ::: "memory");
        }
    }
    __syncthreads();
}


DI void grid_barrier(unsigned* ctr, unsigned& target) {
  asm volatile("s_waitcnt vmcnt(0)" ::: "memory");
  __syncthreads();
  if (threadIdx.x == 0) {
    target += gridDim.x;
    __builtin_amdgcn_fence(__ATOMIC_RELEASE, "agent");
    asm volatile("s_waitcnt vmcnt(0)" ::: "memory");
    __hip_atomic_fetch_add(ctr, 1u, __ATOMIC_RELAXED, __HIP_MEMORY_SCOPE_AGENT);
    while (__hip_atomic_load(ctr, __ATOMIC_RELAXED, __HIP_MEMORY_SCOPE_AGENT) < target) __builtin_amdgcn_s_sleep(1);
    __builtin_amdgcn_fence(__ATOMIC_ACQUIRE, "agent");
    asm volatile("s_waitcnt vmcnt(0)" ::: "memory");
  }
  __syncthreads();
}

__global__ void __launch_bounds__(256, 2) mk_forward(Params p) {
  __shared__ __attribute__((aligned(16))) char smem[LDS_BYTES];
  cg::grid_group grid = cg::this_grid();
  int pc = 0;
#define GSYNC() xcd_barrier(xb)
#define PHASE(body) PHASER(15, body)
#define PHASER(kind, body)                              \
  {                                                     \
    if (pc >= p.ph_lo && pc < p.ph_hi) {                \
      if ((REPMASK >> (kind)) & 1) { const bool dry = true; (void)dry; body; GSYNC(); } \
      { const bool dry = false; (void)dry; body; }      \
      if (pc + 1 < p.ph_hi) GSYNC();                    \
    }                                                   \
    pc++;                                               \
  }
  __shared__ __attribute__((aligned(16))) unsigned xb_words[4];
  if (threadIdx.x == 0) { xb_words[0] = 0u; xb_words[1] = 0u; xb_words[2] = 0u; xb_words[3] = 0u; }
  __syncthreads();
  const XcdBarrier xb = xcd_barrier_post(p.bar, (volatile LAS unsigned*)xb_words);
  if (0 >= p.ph_lo && 0 < p.ph_hi) {
    phase0(p, (float*)smem);
    if (1 < p.ph_hi) grid.sync();
  }
  pc++;
  PHASE(phase0b(p))
  PHASE(lnmod_phase<0>(p, 0, NROW))
  for (int layer = 0; layer < DEPTH; layer++) {
    const bool last = (layer == DEPTH - 1);
    const int nrows = last ? NLAT : NROW;
    PHASER(0, gemm_phase<0>(p, layer, smem, p.H, p.wt_in + (size_t)layer * DINP * D, NROW / 256, DINP / 128, dry))
    PHASER(1, prep_phase(p, layer))
    PHASER(2, scan_phase(p, smem, layer))
    PHASER(3, combine_phase(p, layer, nrows))
    PHASER(4, { gemm_phase<1>(p, layer, smem, p.H, p.wt_out + (size_t)layer * D * D, NLAT / 256, 8, dry);
                 if (nrows > NLAT) gemm_thin<1>(p, layer, smem, p.H, p.wt_out + (size_t)layer * D * D, NLAT, NCTX / 64, 8, dry); })
    PHASER(5, lnmod_phase<1>(p, layer, nrows))
    PHASER(6, { gemm_phase<2>(p, layer, smem, p.H, p.wt_q + (size_t)layer * 2048 * D, NLAT / 256, 16, dry);
                 if (nrows > NLAT) gemm_thin<2>(p, layer, smem, p.H, p.wt_q + (size_t)layer * 2048 * D, NLAT, NCTX / 64, 16, dry); })
    PHASER(7, topk_phase(p, layer, smem, nrows))
    PHASER(8, expert_dots(p, nrows, smem))
    PHASER(9, expert_vsum(p, nrows))
    PHASER(10, expert_epilogue(p, layer, nrows))
  }
#undef PHASE
#undef PHASER
}
constexpr int NPHASES = 3 + 11 * DEPTH;

extern "C" void kernel_launch(void* const* d_in, const int* in_sizes, int n_in, void* d_out, int out_size, void* d_ws,
                              size_t ws_size, hipStream_t stream) {
  Params p{};
  p.x = (const float*)d_in[0]; p.c = (const float*)d_in[1]; p.ctx = (const float*)d_in[2]; p.c_ctx = (const float*)d_in[3];
  p.w_ada = (const float*)d_in[4]; p.b_ada = (const float*)d_in[5]; p.w_in = (const float*)d_in[6];
  p.w_gk2 = (const float*)d_in[7]; p.b_gk = (const float*)d_in[8]; p.hg_lb = (const float*)d_in[9];
  p.hg_norm = (const float*)d_in[10]; p.gla_norm = (const float*)d_in[11]; p.w_out = (const float*)d_in[12];
  p.ln_gamma = (const float*)d_in[13]; p.ln_beta = (const float*)d_in[14]; p.wq = (const float*)d_in[15];
  p.sub_keys = (const float*)d_in[16]; p.peer_u = (const float*)d_in[17]; p.peer_v = (const float*)d_in[18];
  p.out = (float*)d_out;
  char* w = (char*)d_ws;
  size_t off = 0;
  auto take = [&](size_t bytes) { char* q = w + off; off += (bytes + 255) & ~(size_t)255; return q; };
  p.wt_in = (u16*)take((size_t)4 * DINP * D * 2);
  p.wt_out = (u16*)take((size_t)4 * D * D * 2);
  p.wt_q = (u16*)take((size_t)4 * 2048 * D * 2);
  p.keysb = (u16*)take((size_t)4 * 2 * 128 * 128 * 2);
  p.ada_part = (float*)take((size_t)8 * 4 * 5 * 6144 * 4);
  p.ada = (float*)take((size_t)4 * 5 * 6144 * 4);
  p.X = (float*)take((size_t)NROW * D * 4);
  p.H = (u16*)take((size_t)NROW * D * 2);
  p.G = (u16*)take((size_t)NROW * D * 2);
  p.U = (u16*)take((size_t)NROW * DIN * 2);
  p.S = take(SZ_S);
  p.PT = take(SZ_PT);
  p.bar = (unsigned*)take(XCD_BAR_WORDS * 4);
  if (off > ws_size) { fprintf(stderr, "workspace too small: need %zu have %zu\n", off, ws_size); return; }

  static int grid_blocks = 0;
  if (!grid_blocks) {
    int dev = 0, cus = 0, per_cu = 0;
    hipGetDevice(&dev);
    hipDeviceGetAttribute(&cus, hipDeviceAttributeMultiprocessorCount, dev);
    hipOccupancyMaxActiveBlocksPerMultiprocessor(&per_cu, mk_forward, 256, 0);
    if (per_cu > 2) per_cu = 2;
    grid_blocks = cus * per_cu;
  }
#if ONE_LAUNCH
  hipMemsetAsync(p.bar, 0, XCD_BAR_WORDS * 4, stream);
  p.ph_lo = 0; p.ph_hi = NPHASES;
  void* args[] = {&p};
  hipError_t e = hipLaunchCooperativeKernel((void*)mk_forward, dim3(grid_blocks), dim3(256), args, 0, stream);
  if (e != hipSuccess) fprintf(stderr, "cooperative launch failed: %s (grid %d)\n", hipGetErrorString(e), grid_blocks);
#else
  for (int ph = 0; ph < NPHASES; ph++) {
    p.ph_lo = ph; p.ph_hi = ph + 1;
    hipLaunchKernelGGL(mk_forward, dim3(grid_blocks), dim3(256), 0, stream, p);
  }
#endif
}
```

```cpp
#include <hip/hip_runtime.h>
#include <hip/hip_cooperative_groups.h>
#include <cstdio>
namespace cg = cooperative_groups;

#define DI __device__ __forceinline__
typedef unsigned short u16;
typedef unsigned int u32;
typedef __attribute__((ext_vector_type(8))) short bf16x8;
typedef __attribute__((ext_vector_type(16))) float f32x16;
typedef __attribute__((ext_vector_type(2))) __bf16 bf2;

#ifndef REPMASK
#define REPMASK 0
#endif
#ifndef DRYVAR
#define DRYVAR 0
#endif
#ifndef ONE_LAUNCH
#define ONE_LAUNCH 1
#endif

constexpr int D = 1024, NB = 4, SEQ = 8192, DEPTH = 4, CTX = 256;
constexpr int NLAT = NB * SEQ;
constexpr int NCTX = NB * CTX;
constexpr int NROW = NLAT + NCTX;
constexpr int DIN = 4128, DINP = 4224;
constexpr int LPOS = CTX + SEQ;
constexpr int NBLK = LPOS / 32;
constexpr float ALPHA = 1.681792830507429f;
constexpr float EPS = 1e-6f;
constexpr int LDS_BYTES = 73728;

struct Params {
  const float *x, *c, *ctx, *c_ctx, *w_ada, *b_ada, *w_in, *w_gk2, *b_gk, *hg_lb, *hg_norm, *gla_norm,
      *w_out, *ln_gamma, *ln_beta, *wq, *sub_keys, *peer_u, *peer_v;
  float* out;
  u16 *wt_in, *wt_out, *wt_q, *keysb;
  float *ada_part, *ada;
  float* X;
  u16 *H, *G, *U;
  char* S;
  char* PT;
  unsigned* bar;
  int ph_lo, ph_hi;
};

constexpr size_t SZ_HQ = (size_t)2 * 16 * LPOS * 128 * 2;
constexpr size_t SZ_HVT = (size_t)16 * 128 * LPOS * 2;
constexpr size_t SZ_HD = (size_t)2 * 16 * NBLK * 128 * 4;
constexpr size_t SZ_GQ = (size_t)2 * 16 * LPOS * 64 * 2;
constexpr size_t SZ_GD = (size_t)2 * 16 * NBLK * 64 * 4;
constexpr size_t OFF_HQ = 0, OFF_HK = OFF_HQ + SZ_HQ, OFF_HKT = OFF_HK + SZ_HQ, OFF_HVT = OFF_HKT + SZ_HQ,
                 OFF_HD = OFF_HVT + SZ_HVT, OFF_GQ = OFF_HD + SZ_HD, OFF_GK = OFF_GQ + SZ_GQ, OFF_GKT = OFF_GK + SZ_GQ,
                 OFF_GVT = OFF_GKT + SZ_GQ, OFF_GD = OFF_GVT + SZ_HVT, SZ_S = OFF_GD + SZ_GD;
constexpr size_t OFF_XP = 0, SZ_XP = (size_t)NROW * D * 4;
constexpr size_t OFF_IDX = OFF_XP + SZ_XP, SZ_IDX = (size_t)NROW * 128 * 4;
constexpr size_t OFF_GATE = OFF_IDX + SZ_IDX;
constexpr size_t OFF_PU = OFF_GATE + SZ_IDX, SZ_PU = (size_t)16384 * D * 2;
constexpr size_t OFF_PV = OFF_PU + SZ_PU;
constexpr size_t OFF_PSC = OFF_PV + SZ_PU;
static_assert(OFF_PSC + 2 * 16384 * 4 <= SZ_S, "alias overflow");
constexpr size_t PT_U = 0, PT_V = (size_t)16384 * D, PT_SC = 2 * (size_t)16384 * D, SZ_PT = PT_SC + 2 * 16384 * 4;

DI int otid() { int t = threadIdx.x; asm volatile("" : "+v"(t)); return t; }
DI int obid() { int t = blockIdx.x; asm volatile("" : "+s"(t)); return t; }
DI float bf2f(u16 h) { return __uint_as_float(((u32)h) << 16); }
DI u16 f2bf(float x) { return __builtin_bit_cast(u16, (__bf16)x); }
typedef __attribute__((ext_vector_type(2))) float f32x2v;
typedef __attribute__((ext_vector_type(2))) __bf16 bf16x2v;
DI u32 pack2(float a, float b) { f32x2v v = {a, b}; return __builtin_bit_cast(u32, __builtin_convertvector(v, bf16x2v)); }
DI float wave_sum(float v) {
#pragma unroll
  for (int o = 32; o > 0; o >>= 1) v += __shfl_xor(v, o);
  return v;
}
DI int crow(int i, int h) { return (i & 3) + 8 * (i >> 2) + 4 * h; }
DI int perm16(int k) {
  int kk = k & 15;
  return (k & ~15) | (((kk >> 2) & 1) << 3) | ((kk >> 3) << 2) | (kk & 3);
}
DI bf16x8 pack_frag(const f32x16& x, int s) {
  union { bf16x8 v; u32 u[4]; } r;
#pragma unroll
  for (int j = 0; j < 4; j++) r.u[j] = pack2(x[8 * s + 2 * j], x[8 * s + 2 * j + 1]);
  return r.v;
}
#define MFMA32(a, b, c) __builtin_amdgcn_mfma_f32_32x32x16_bf16((a), (b), (c), 0, 0, 0)

DI const float* ada_ptr(const Params& p, int layer, int r, int j) { return p.ada + ((size_t)(layer * 5 + r) * 6 + j) * D; }
DI int row_batch(int r) { return r < NLAT ? (r >> 13) : 4; }

DI void weight_convert(const Params& p, int l, int vbid, int vgrid) {
  const size_t gtid = (size_t)vbid * 256 + otid(), gsz = (size_t)vgrid * 256;
  for (size_t i = gtid; i < (size_t)128 * DINP; i += gsz) {
    int n = i % DINP; int k8 = i / DINP;
    u32 o[4] = {0, 0, 0, 0};
    if (n < DIN) {
      const float* s = p.w_in + ((size_t)l * D + k8 * 8) * DIN + n;
#pragma unroll
      for (int j = 0; j < 4; j++) o[j] = pack2(s[(size_t)(2 * j) * DIN], s[(size_t)(2 * j + 1) * DIN]);
    }
    *(uint4*)(p.wt_in + ((size_t)l * DINP + n) * D + k8 * 8) = make_uint4(o[0], o[1], o[2], o[3]);
  }
  for (size_t i = gtid; i < (size_t)128 * 1024; i += gsz) {
    int n = i & 1023; int k8 = i >> 10;
    const float* s = p.w_out + ((size_t)l * D + k8 * 8) * D + n;
    u32 o[4];
#pragma unroll
    for (int j = 0; j < 4; j++) o[j] = pack2(s[(size_t)(2 * j) * D], s[(size_t)(2 * j + 1) * D]);
    *(uint4*)(p.wt_out + ((size_t)l * D + n) * D + k8 * 8) = make_uint4(o[0], o[1], o[2], o[3]);
  }
  for (size_t i = gtid; i < (size_t)128 * 2048; i += gsz) {
    int n = i & 2047; int k8 = i >> 11;
    const float* s = p.wq + ((size_t)l * D + k8 * 8) * 2048 + n;
    u32 o[4];
#pragma unroll
    for (int j = 0; j < 4; j++) o[j] = pack2(s[(size_t)(2 * j) * 2048], s[(size_t)(2 * j + 1) * 2048]);
    *(uint4*)(p.wt_q + ((size_t)l * 2048 + n) * D + k8 * 8) = make_uint4(o[0], o[1], o[2], o[3]);
  }
}

DI void phase0(const Params& p, float* lds) {
  for (int it = obid(); it < 768; it += gridDim.x) {
    int kp = it & 7, nb = (it >> 3) % 24, l = it / 192;
    __syncthreads();
    for (int i = otid(); i < 640; i += 256) {
      int r = i >> 7, k = i & 127;
      float v = (r < 4) ? p.c[r * D + kp * 128 + k] : p.c_ctx[kp * 128 + k];
      lds[i] = v / (1.f + __expf(-v));
    }
    __syncthreads();
    int n = nb * 256 + otid();
    const float* w = p.w_ada + ((size_t)l * D + kp * 128) * 6144 + n;
    float a0 = 0, a1 = 0, a2 = 0, a3 = 0, a4 = 0;
#pragma unroll 8
    for (int k = 0; k < 128; k++) {
      float wv = w[(size_t)k * 6144];
      a0 += lds[k] * wv; a1 += lds[128 + k] * wv; a2 += lds[256 + k] * wv; a3 += lds[384 + k] * wv; a4 += lds[512 + k] * wv;
    }
    float* o = p.ada_part + ((size_t)(kp * 4 + l) * 5) * 6144 + n;
    o[0] = a0; o[6144] = a1; o[2 * 6144] = a2; o[3 * 6144] = a3; o[4 * 6144] = a4;
  }
  weight_convert(p, 0, obid(), gridDim.x);
  const size_t gtid = (size_t)obid() * 256 + otid(), gsz = (size_t)gridDim.x * 256;
  for (size_t i = gtid; i < (size_t)4 * 2 * 128 * 128; i += gsz) p.keysb[i] = f2bf(p.sub_keys[i]);
}

DI void phase0b(const Params& p) {
  const size_t gtid = (size_t)obid() * 256 + otid(), gsz = (size_t)gridDim.x * 256;
  for (size_t i = gtid; i < (size_t)4 * 5 * 6144; i += gsz) {
    int n = i % 6144; int l = i / (5 * 6144);
    float a = p.b_ada[l * 6144 + n];
#pragma unroll
    for (int kp = 0; kp < 8; kp++) a += p.ada_part[(size_t)kp * 4 * 5 * 6144 + i];
    p.ada[i] = a;
  }
}

DI void peer_convert(const Params& p, int layer, int vbid, int vgrid) {
  const int tid = otid(), wave = tid >> 6, lane = tid & 63;
  unsigned char* du = (unsigned char*)(p.PT + PT_U);
  unsigned char* dv = (unsigned char*)(p.PT + PT_V);
  float* su = (float*)(p.PT + PT_SC);
  for (int it = vbid * 4 + wave; it < 2 * 16384; it += vgrid * 4) {
    const int tbl = it >> 14, e = it & 16383;
    const float* src = (tbl ? p.peer_v : p.peer_u) + ((size_t)layer * 16384 + e) * D + lane * 16;
    float4 a = *(const float4*)(src), b = *(const float4*)(src + 4), c = *(const float4*)(src + 8), d = *(const float4*)(src + 12);
    float m = fmaxf(fmaxf(fmaxf(fabsf(a.x), fabsf(a.y)), fmaxf(fabsf(a.z), fabsf(a.w))), fmaxf(fmaxf(fabsf(b.x), fabsf(b.y)), fmaxf(fabsf(b.z), fabsf(b.w))));
    m = fmaxf(m, fmaxf(fmaxf(fmaxf(fabsf(c.x), fabsf(c.y)), fmaxf(fabsf(c.z), fabsf(c.w))), fmaxf(fmaxf(fabsf(d.x), fabsf(d.y)), fmaxf(fabsf(d.z), fabsf(d.w)))));
#pragma unroll
    for (int o = 32; o > 0; o >>= 1) m = fmaxf(m, __shfl_xor(m, o));
    m = fmaxf(m, 1e-30f);
    const float sc = 224.f / m;
    int w0 = __builtin_amdgcn_cvt_pk_fp8_f32(a.x * sc, a.y * sc, 0, false); w0 = __builtin_amdgcn_cvt_pk_fp8_f32(a.z * sc, a.w * sc, w0, true);
    int w1 = __builtin_amdgcn_cvt_pk_fp8_f32(b.x * sc, b.y * sc, 0, false); w1 = __builtin_amdgcn_cvt_pk_fp8_f32(b.z * sc, b.w * sc, w1, true);
    int w2 = __builtin_amdgcn_cvt_pk_fp8_f32(c.x * sc, c.y * sc, 0, false); w2 = __builtin_amdgcn_cvt_pk_fp8_f32(c.z * sc, c.w * sc, w2, true);
    int w3 = __builtin_amdgcn_cvt_pk_fp8_f32(d.x * sc, d.y * sc, 0, false); w3 = __builtin_amdgcn_cvt_pk_fp8_f32(d.z * sc, d.w * sc, w3, true);
    if (tbl == 0) *(int4*)(du + (size_t)e * D + lane * 16) = make_int4(w0, w1, w2, w3);
    else *(int4*)(dv + ((size_t)(lane >> 3) * 16384 + e) * 128 + (lane & 7) * 16) = make_int4(w0, w1, w2, w3);
    if (lane == 0) su[it] = m * (1.f / 224.f);
  }
}

template <int MODE>
DI void lnmod_phase(const Params& p, int layer, int nrows) {
  const int wave = otid() >> 6, lane = otid() & 63;
  const float* XP = (const float*)(p.S + OFF_XP);
  for (int r = obid() * 4 + wave; r < nrows; r += gridDim.x * 4) {
    const float* src;
    if (MODE == 0) src = (r < NLAT) ? p.x + (size_t)r * D : p.ctx + (size_t)(r - NLAT) * D;
    else src = XP + (size_t)r * D;
    const int b = row_batch(r);
    float4 v[4];
#pragma unroll
    for (int c = 0; c < 4; c++) v[c] = *(const float4*)(src + c * 256 + lane * 4);
    float s = 0;
#pragma unroll
    for (int c = 0; c < 4; c++) s += v[c].x + v[c].y + v[c].z + v[c].w;
    float mu = wave_sum(s) * (1.f / D);
    float q = 0;
#pragma unroll
    for (int c = 0; c < 4; c++) {
      v[c].x -= mu; v[c].y -= mu; v[c].z -= mu; v[c].w -= mu;
      q += v[c].x * v[c].x + v[c].y * v[c].y + v[c].z * v[c].z + v[c].w * v[c].w;
    }
    float rstd = rsqrtf(wave_sum(q) * (1.f / D) + EPS);
    if (MODE == 1) {
      const float* gm = p.ln_gamma + (size_t)(layer * 2 + 0) * D;
      const float* bt = p.ln_beta + (size_t)(layer * 2 + 0) * D;
      float s2 = 0;
#pragma unroll
      for (int c = 0; c < 4; c++) {
        int col = c * 256 + lane * 4;
        float4 g = *(const float4*)(gm + col), be = *(const float4*)(bt + col);
        v[c].x = v[c].x * rstd * g.x + be.x; v[c].y = v[c].y * rstd * g.y + be.y;
        v[c].z = v[c].z * rstd * g.z + be.z; v[c].w = v[c].w * rstd * g.w + be.w;
        s2 += v[c].x + v[c].y + v[c].z + v[c].w;
      }
      float mu2 = wave_sum(s2) * (1.f / D);
      float q2 = 0;
#pragma unroll
      for (int c = 0; c < 4; c++) {
        v[c].x -= mu2; v[c].y -= mu2; v[c].z -= mu2; v[c].w -= mu2;
        q2 += v[c].x * v[c].x + v[c].y * v[c].y + v[c].z * v[c].z + v[c].w * v[c].w;
      }
      rstd = rsqrtf(wave_sum(q2) * (1.f / D) + EPS);
    }
    const float* sh = ada_ptr(p, layer, b, MODE == 0 ? 0 : 3);
    const float* sc = ada_ptr(p, layer, b, MODE == 0 ? 1 : 4);
    float4 av[4], mv[4];
#pragma unroll
    for (int c = 0; c < 4; c++) { av[c] = *(const float4*)(sh + c * 256 + lane * 4); mv[c] = *(const float4*)(sc + c * 256 + lane * 4); }
#pragma unroll
    for (int c = 0; c < 4; c++) {
      int col = c * 256 + lane * 4;
      float4 a = av[c], m = mv[c];
      float y0 = v[c].x * rstd * (1.f + m.x) + a.x, y1 = v[c].y * rstd * (1.f + m.y) + a.y;
      float y2 = v[c].z * rstd * (1.f + m.z) + a.z, y3 = v[c].w * rstd * (1.f + m.w) + a.w;
      *(uint2*)(p.H + (size_t)r * D + col) = make_uint2(pack2(y0, y1), pack2(y2, y3));
    }
  }
}

constexpr int LDS_STRIDE = 72;
constexpr int CT_STRIDE = 132;
template <int MODE>
DI void gemm_store(const Params& p, int layer, int row, int nt, int n0, int c4, const float4 v, const bool dry) {
  if (MODE == 0) {
          u16* dst;
          if (nt >= 16 && nt < 20) dst = p.G + (size_t)row * D + (n0 - 2048) + c4;
          else if (nt >= 28 && nt < 32) dst = p.G + (size_t)row * D + (n0 - 3584 + 512) + c4;
          else dst = p.U + (size_t)row * DIN + n0 + c4;
          if (dry) dst = (u16*)p.S + (size_t)row * DIN + n0 + c4;
          if (n0 + c4 < DIN) *(uint2*)dst = make_uint2(pack2(v.x, v.y), pack2(v.z, v.w));
        } else if (MODE == 1) {
          float* XP = dry ? (float*)p.U : (float*)(p.S + OFF_XP);
          const float* xo = (layer == 0) ? ((row < NLAT) ? p.x + (size_t)row * D : p.ctx + (size_t)(row - NLAT) * D) : p.X + (size_t)row * D;
          const float4 xv = *(const float4*)(xo + n0 + c4);
          const float4 g1 = *(const float4*)(ada_ptr(p, layer, row_batch(row), 2) + n0 + c4);
          *(float4*)(XP + (size_t)row * D + n0 + c4) =
              make_float4(ALPHA * xv.x + g1.x * v.x, ALPHA * xv.y + g1.y * v.y, ALPHA * xv.z + g1.z * v.z, ALPHA * xv.w + g1.w * v.w);
        } else {
          *(uint2*)((dry ? (u16*)(p.S + OFF_PU) : p.U) + (size_t)row * 2048 + n0 + c4) = make_uint2(pack2(v.x, v.y), pack2(v.z, v.w));
        }
}

template <int MODE>
DI void gemm_phase(const Params& p, int layer, char* smem, const u16* A, const u16* Bt, int Mtiles, int Ntiles, const bool dry) {
  u16* As = (u16*)smem;
  u16* Bs = (u16*)smem + 256 * LDS_STRIDE;
  float* Ct = (float*)smem;
  const int tid = otid(), wave = tid >> 6, lane = tid & 63, r = lane & 31, h = lane >> 5;
  const int wm = wave >> 1, wn = wave & 1;
  const int srow = tid >> 3, sc8 = (tid & 7) * 8;
  const int bid = obid(), xcd = bid & 7, jx = bid >> 3, wpx = (gridDim.x + 7 - xcd) >> 3;
  const int ntiles = Mtiles * Ntiles, nchunks = (ntiles + 63) >> 6;
  for (int ch = xcd; ch < nchunks; ch += 8)
  for (int jj = jx; jj < 64; jj += wpx) {
    const int L = ch * 64 + jj;
    if (L >= ntiles) continue;
    const int mt = (L / (4 * Ntiles)) * 4 + (L & 3), nt = (L >> 2) % Ntiles;
    const u16* Ag = A + ((size_t)mt * 256 + srow) * D + sc8;
    const u16* Bg = Bt + ((size_t)nt * 128 + srow) * D + sc8;
    f32x16 acc[4][2];
#pragma unroll
    for (int i = 0; i < 4; i++)
#pragma unroll
      for (int j = 0; j < 2; j++)
#pragma unroll
        for (int e = 0; e < 16; e++) acc[i][j][e] = 0.f;
    bf16x8 ra0, ra1, ra2, ra3, ra4, ra5, ra6, ra7, rb0, rb1, rb2, rb3;
#define GLOAD(kt_) { const u16* ag = Ag + (kt_) * 64; const u16* bg = Bg + (kt_) * 64; \
      ra0 = *(const bf16x8*)(ag); ra1 = *(const bf16x8*)(ag + 32 * D); ra2 = *(const bf16x8*)(ag + 64 * D); ra3 = *(const bf16x8*)(ag + 96 * D); \
      ra4 = *(const bf16x8*)(ag + 128 * D); ra5 = *(const bf16x8*)(ag + 160 * D); ra6 = *(const bf16x8*)(ag + 192 * D); ra7 = *(const bf16x8*)(ag + 224 * D); \
      rb0 = *(const bf16x8*)(bg); rb1 = *(const bf16x8*)(bg + 32 * D); rb2 = *(const bf16x8*)(bg + 64 * D); rb3 = *(const bf16x8*)(bg + 96 * D); }
#define LSTORE() { u16* ad = As + srow * LDS_STRIDE + sc8; u16* bd = Bs + srow * LDS_STRIDE + sc8; \
      *(bf16x8*)(ad) = ra0; *(bf16x8*)(ad + 32 * LDS_STRIDE) = ra1; *(bf16x8*)(ad + 64 * LDS_STRIDE) = ra2; *(bf16x8*)(ad + 96 * LDS_STRIDE) = ra3; \
      *(bf16x8*)(ad + 128 * LDS_STRIDE) = ra4; *(bf16x8*)(ad + 160 * LDS_STRIDE) = ra5; *(bf16x8*)(ad + 192 * LDS_STRIDE) = ra6; *(bf16x8*)(ad + 224 * LDS_STRIDE) = ra7; \
      *(bf16x8*)(bd) = rb0; *(bf16x8*)(bd + 32 * LDS_STRIDE) = rb1; *(bf16x8*)(bd + 64 * LDS_STRIDE) = rb2; *(bf16x8*)(bd + 96 * LDS_STRIDE) = rb3; }
    GLOAD(0)
    __syncthreads();
    LSTORE()
    __syncthreads();
#pragma unroll 1
    for (int kt = 0; kt < 16; kt++) {
      if (kt + 1 < 16 && !(dry && DRYVAR == 1)) GLOAD(kt + 1)
      const u16* as = As + (wm * 128 + r) * LDS_STRIDE + h * 8;
      const u16* bs = Bs + (wn * 64 + r) * LDS_STRIDE + h * 8;
      if (!(dry && DRYVAR == 2)) {
        bf16x8 af[2][4], b0, b1;
#pragma unroll
        for (int i = 0; i < 4; i++) af[0][i] = *(const bf16x8*)(as + i * 32 * LDS_STRIDE);
        b0 = *(const bf16x8*)(bs); b1 = *(const bf16x8*)(bs + 32 * LDS_STRIDE);
#pragma unroll
        for (int kk = 0; kk < 4; kk++) {
          const int cur = kk & 1, nxt = cur ^ 1;
          if (kk < 3) {
#pragma unroll
            for (int i = 0; i < 4; i++) af[nxt][i] = *(const bf16x8*)(as + i * 32 * LDS_STRIDE + (kk + 1) * 16);
          }
          __builtin_amdgcn_s_setprio(1);
#pragma unroll
          for (int i = 0; i < 4; i++) acc[i][0] = MFMA32(af[cur][i], b0, acc[i][0]);
          if (kk < 3) b0 = *(const bf16x8*)(bs + (kk + 1) * 16);
#pragma unroll
          for (int i = 0; i < 4; i++) acc[i][1] = MFMA32(af[cur][i], b1, acc[i][1]);
          if (kk < 3) b1 = *(const bf16x8*)(bs + 32 * LDS_STRIDE + (kk + 1) * 16);
          __builtin_amdgcn_s_setprio(0);
        }
      }
      __syncthreads();
      if (kt + 1 < 16 && !(dry && DRYVAR == 1)) LSTORE()
      __syncthreads();
    }
#undef GLOAD
#undef LSTORE
    const int m0 = mt * 256, n0 = nt * 128;
    const int c4 = (tid & 31) * 4, rr0 = tid >> 5;
#pragma unroll
    for (int ph = 0; ph < 2; ph++) {
      if (ph) __syncthreads();
#pragma unroll
      for (int ii = 0; ii < 2; ii++)
#pragma unroll
        for (int j = 0; j < 2; j++)
#pragma unroll
          for (int e = 0; e < 16; e++) Ct[(wm * 64 + ii * 32 + crow(e, h)) * CT_STRIDE + wn * 64 + j * 32 + r] = acc[ph * 2 + ii][j][e];
      __syncthreads();
      if (MODE == 1) {
        const float4 g1 = *(const float4*)(ada_ptr(p, layer, row_batch(m0), 2) + n0 + c4);
        float* XP = dry ? (float*)p.U : (float*)(p.S + OFF_XP);
#pragma unroll 1
        for (int q0 = 0; q0 < 16; q0 += 2) {
          float4 xv[2], cv[2];
#pragma unroll
          for (int j = 0; j < 2; j++) {
            const int rl = rr0 + (q0 + j) * 8, row = m0 + (rl >> 6) * 128 + ph * 64 + (rl & 63);
            const float* xo = (layer == 0) ? ((row < NLAT) ? p.x + (size_t)row * D : p.ctx + (size_t)(row - NLAT) * D) : p.X + (size_t)row * D;
            xv[j] = *(const float4*)(xo + n0 + c4);
            cv[j] = *(const float4*)(Ct + rl * CT_STRIDE + c4);
          }
#pragma unroll
          for (int j = 0; j < 2; j++) {
            const int rl = rr0 + (q0 + j) * 8, row = m0 + (rl >> 6) * 128 + ph * 64 + (rl & 63);
            *(float4*)(XP + (size_t)row * D + n0 + c4) = make_float4(ALPHA * xv[j].x + g1.x * cv[j].x, ALPHA * xv[j].y + g1.y * cv[j].y,
                                                                     ALPHA * xv[j].z + g1.z * cv[j].z, ALPHA * xv[j].w + g1.w * cv[j].w);
          }
        }
      } else {
#pragma unroll 2
        for (int q = 0; q < 16; q++) {
          const int rl = rr0 + q * 8, row = m0 + (rl >> 6) * 128 + ph * 64 + (rl & 63);
          const float4 v = *(const float4*)(Ct + rl * CT_STRIDE + c4);
          gemm_store<MODE>(p, layer, row, nt, n0, c4, v, dry);
        }
      }
    }
  }
}

template <int MODE>
DI void gemm_thin(const Params& p, int layer, char* smem, const u16* A, const u16* Bt, int row0, int Mtiles, int Ntiles, const bool dry) {
  u16* As = (u16*)smem;
  u16* Bs = (u16*)smem + 64 * LDS_STRIDE;
  float* Ct = (float*)smem;
  const int tid = otid(), wave = tid >> 6, lane = tid & 63, r = lane & 31, h = lane >> 5;
  const int wm = wave >> 1, wn = wave & 1;
  const int srow = tid >> 3, sc8 = (tid & 7) * 8;
  const int ntiles = Mtiles * Ntiles;
  for (int L = obid(); L < ntiles; L += gridDim.x) {
    const int mt = L / Ntiles, nt = L % Ntiles;
    const u16* Ag = A + ((size_t)row0 + mt * 64 + srow) * D + sc8;
    const u16* Bg = Bt + ((size_t)nt * 128 + srow) * D + sc8;
    f32x16 acc0, acc1;
#pragma unroll
    for (int e = 0; e < 16; e++) { acc0[e] = 0.f; acc1[e] = 0.f; }
    bf16x8 ra0, ra1, rb0, rb1, rb2, rb3;
#define GLOADT(kt_) { const u16* ag = Ag + (kt_) * 64; const u16* bg = Bg + (kt_) * 64; \
      ra0 = *(const bf16x8*)(ag); ra1 = *(const bf16x8*)(ag + 32 * D); \
      rb0 = *(const bf16x8*)(bg); rb1 = *(const bf16x8*)(bg + 32 * D); rb2 = *(const bf16x8*)(bg + 64 * D); rb3 = *(const bf16x8*)(bg + 96 * D); }
#define LSTORET() { u16* ad = As + srow * LDS_STRIDE + sc8; u16* bd = Bs + srow * LDS_STRIDE + sc8; \
      *(bf16x8*)(ad) = ra0; *(bf16x8*)(ad + 32 * LDS_STRIDE) = ra1; \
      *(bf16x8*)(bd) = rb0; *(bf16x8*)(bd + 32 * LDS_STRIDE) = rb1; *(bf16x8*)(bd + 64 * LDS_STRIDE) = rb2; *(bf16x8*)(bd + 96 * LDS_STRIDE) = rb3; }
    GLOADT(0)
    __syncthreads();
    LSTORET()
    __syncthreads();
#pragma unroll 1
    for (int kt = 0; kt < 16; kt++) {
      if (kt + 1 < 16) GLOADT(kt + 1)
      const u16* as = As + (wm * 32 + r) * LDS_STRIDE + h * 8;
      const u16* bs = Bs + (wn * 64 + r) * LDS_STRIDE + h * 8;
#pragma unroll
      for (int kk = 0; kk < 4; kk++) {
        const bf16x8 af = *(const bf16x8*)(as + kk * 16);
        const bf16x8 bf0 = *(const bf16x8*)(bs + kk * 16), bf1 = *(const bf16x8*)(bs + 32 * LDS_STRIDE + kk * 16);
        __builtin_amdgcn_s_setprio(1);
        acc0 = MFMA32(af, bf0, acc0);
        acc1 = MFMA32(af, bf1, acc1);
        __builtin_amdgcn_s_setprio(0);
      }
      __syncthreads();
      if (kt + 1 < 16) LSTORET()
      __syncthreads();
    }
#undef GLOADT
#undef LSTORET
#pragma unroll
    for (int e = 0; e < 16; e++) {
      Ct[(wm * 32 + crow(e, h)) * CT_STRIDE + wn * 64 + r] = acc0[e];
      Ct[(wm * 32 + crow(e, h)) * CT_STRIDE + wn * 64 + 32 + r] = acc1[e];
    }
    __syncthreads();
    const int n0 = nt * 128, c4 = (tid & 31) * 4, rr0 = tid >> 5;
#pragma unroll 2
    for (int q = 0; q < 8; q++) {
      const int rl = rr0 + q * 8, row = row0 + mt * 64 + rl;
      const float4 v = *(const float4*)(Ct + rl * CT_STRIDE + c4);
      gemm_store<MODE>(p, layer, row, nt, n0, c4, v, dry);
    }
  }
}

DI int tokrow(int grp, int b, int pos) {
  if (pos < CTX) return NLAT + b * CTX + pos;
  int pp = pos - CTX;
  return b * SEQ + (grp == 0 ? pp : ((pp & 127) * 64 + (pp >> 7)));
}
DI float log_sigmoid(float z) { return fminf(z, 0.f) - __logf(1.f + __expf(-fabsf(z))); }

template <int DK, int DIR>
DI void prep_k(const Params& p, int layer, int grp, int hb, int blk, int cgi) {
  constexpr int CH = DK / 32;
  const int b = hb >> 2, head = hb & 3, k0 = cgi * CH;
  float lb[CH], log_lb[CH], l1m[CH], wg[CH][16], bias[CH], bacc[CH];
#pragma unroll
  for (int c = 0; c < CH; c++) {
    bacc[c] = 0.f; lb[c] = 0.f; log_lb[c] = 0.f; l1m[c] = 0.f; bias[c] = 0.f;
    if (DK == 128) {
      const float* lbp = p.hg_lb + (size_t)DIR * DEPTH * 512 + head * 128 + k0 + c;
      float e0 = lbp[0], e1 = lbp[512], e2 = lbp[1024], e3 = lbp[1536];
      const float mx = fmaxf(fmaxf(e0, e1), fmaxf(e2, e3));
      e0 = __expf(e0 - mx); e1 = __expf(e1 - mx); e2 = __expf(e2 - mx); e3 = __expf(e3 - mx);
      const float inv = 1.f / (e0 + e1 + e2 + e3);
      float cs = 0.f;
      if (layer >= 1) cs += e1 * inv;
      if (layer >= 2) cs += e2 * inv;
      if (layer >= 3) cs += e3 * inv;
      lb[c] = fminf(fmaxf(cs, 0.f), 1.f - 1e-6f);
      log_lb[c] = __logf(fmaxf(lb[c], 1e-30f));
      l1m[c] = __logf(1.f - lb[c]);
    } else {
#pragma unroll
      for (int rr = 0; rr < 16; rr++) wg[c][rr] = p.w_gk2[((size_t)(layer * 2 + DIR) * 16 + rr) * 256 + head * 64 + k0 + c];
      bias[c] = p.b_gk[(size_t)(layer * 2 + DIR) * 256 + head * 64 + k0 + c];
    }
  }
  const size_t chain = (size_t)DIR * 16 + hb;
  const int pk0 = perm16(k0);
  u16* Qd = (u16*)(p.S + (DK == 128 ? OFF_HQ : OFF_GQ)) + (chain * LPOS + (size_t)blk * 32) * DK + pk0;
  u16* Kd = (u16*)(p.S + (DK == 128 ? OFF_HK : OFF_GK)) + (chain * LPOS + (size_t)blk * 32) * DK + pk0;
  u16* KTd = (u16*)(p.S + (DK == 128 ? OFF_HKT : OFF_GKT)) + ((chain * NBLK + blk) * DK + k0) * 32;
#pragma unroll 1
  for (int s2 = 0; s2 < 2; s2++) {
    const int tg = DIR ? 1 - s2 : s2;
    u16 kt[CH][16];
#pragma unroll
    for (int jb = 0; jb < 2; jb++) {
      uint2 zz[8], qq[8];
      u32 gq[8], gk[8];
      uint4 ga[8], gb[8];
#pragma unroll
      for (int j = 0; j < 8; j++) {
        const int j2 = jb * 8 + j;
        const int t16 = DIR ? 15 - j2 : j2;
        const u16* urow = p.U + (size_t)tokrow(grp, b, blk * 32 + tg * 16 + t16) * DIN;
        if (DK == 128) {
          zz[j] = *(const uint2*)(urow + 512 * (1 + DIR) + head * 128 + k0);
          qq[j] = *(const uint2*)(urow + head * 128 + k0);
        } else {
          gq[j] = *(const u32*)(urow + 2560 + head * 64 + k0);
          gk[j] = *(const u32*)(urow + 2816 + head * 64 + k0);
          const uint4* gr = (const uint4*)(urow + 4096 + DIR * 16);
          ga[j] = gr[0]; gb[j] = gr[1];
        }
      }
#pragma unroll
      for (int j = 0; j < 8; j++) {
        const int j2 = jb * 8 + j;
        const int t16 = DIR ? 15 - j2 : j2;
        const int t = tg * 16 + t16;
        float qv[CH], kv[CH], la[CH];
        if (DK == 128) {
          const u32 zw[2] = {zz[j].x, zz[j].y}, qw[2] = {qq[j].x, qq[j].y};
#pragma unroll
          for (int c = 0; c < CH; c++) {
            const float z = (c & 1) ? __uint_as_float(zw[c >> 1] & 0xffff0000u) : __uint_as_float(zw[c >> 1] << 16);
            qv[c] = (c & 1) ? __uint_as_float(qw[c >> 1] & 0xffff0000u) : __uint_as_float(qw[c >> 1] << 16);
            const float ez = __expf(-fabsf(z));
            const float rc = __frcp_rn(1.f + ez);
            const float sp = (z < 0.f) ? ez * rc : rc;
            const float sn = (z < 0.f) ? rc : ez * rc;
            la[c] = __logf(fmaxf(lb[c], 1e-30f) + (1.f - lb[c]) * sp);
            kv[c] = (1.f - lb[c]) * sn;
          }
        } else {
          const u32 gw[8] = {ga[j].x, ga[j].y, ga[j].z, ga[j].w, gb[j].x, gb[j].y, gb[j].z, gb[j].w};
#pragma unroll
          for (int c = 0; c < CH; c++) {
            qv[c] = ((c & 1) ? __uint_as_float(gq[j] & 0xffff0000u) : __uint_as_float(gq[j] << 16)) * 0.125f;
            kv[c] = (c & 1) ? __uint_as_float(gk[j] & 0xffff0000u) : __uint_as_float(gk[j] << 16);
            float d = bias[c];
#pragma unroll
            for (int rr = 0; rr < 8; rr++)
              d += __uint_as_float(gw[rr] << 16) * wg[c][2 * rr] + __uint_as_float(gw[rr] & 0xffff0000u) * wg[c][2 * rr + 1];
            la[c] = (fminf(d, 0.f) - __logf(1.f + __expf(-fabsf(d)))) * (1.f / 16.f);
          }
        }
        float qo[CH], ko[CH];
#pragma unroll
        for (int c = 0; c < CH; c++) {
          bacc[c] += la[c];
          const float eb = __expf(bacc[c]);
          qo[c] = qv[c] * eb;
          ko[c] = kv[c] * __expf(-bacc[c]);
          kt[c][perm16(t16)] = f2bf(ko[c]);
        }
        if (CH == 4) {
          *(uint2*)(Qd + (size_t)t * DK) = make_uint2(pack2(qo[0], qo[1]), pack2(qo[2], qo[3]));
          *(uint2*)(Kd + (size_t)t * DK) = make_uint2(pack2(ko[0], ko[1]), pack2(ko[2], ko[3]));
        } else {
          *(u32*)(Qd + (size_t)t * DK) = pack2(qo[0], qo[1]);
          *(u32*)(Kd + (size_t)t * DK) = pack2(ko[0], ko[1]);
        }
      }
    }
#pragma unroll
    for (int c = 0; c < CH; c++) {
      u16* dst = KTd + c * 32 + tg * 16;
#pragma unroll
      for (int q8 = 0; q8 < 2; q8++) {
        uint4 o;
        o.x = (u32)kt[c][q8 * 8 + 0] | ((u32)kt[c][q8 * 8 + 1] << 16); o.y = (u32)kt[c][q8 * 8 + 2] | ((u32)kt[c][q8 * 8 + 3] << 16);
        o.z = (u32)kt[c][q8 * 8 + 4] | ((u32)kt[c][q8 * 8 + 5] << 16); o.w = (u32)kt[c][q8 * 8 + 6] | ((u32)kt[c][q8 * 8 + 7] << 16);
        *(uint4*)(dst + q8 * 8) = o;
      }
    }
  }
  float* Dd = (float*)(p.S + (DK == 128 ? OFF_HD : OFF_GD)) + (chain * NBLK + blk) * DK + k0;
#pragma unroll
  for (int c = 0; c < CH; c++) Dd[c] = __expf(bacc[c]);
}

DI void prep_phase(const Params& p, int layer) {
  const int tid = otid();
  for (int it = obid(); it < 2 * 16 * (NBLK / 4); it += gridDim.x) {
    const int bg = it % (NBLK / 4), hb = (it / (NBLK / 4)) & 15, grp = it / ((NBLK / 4) * 16);
    const int b = hb >> 2, head = hb & 3;
    {
      const int dir = tid >> 7, blk = bg * 4 + ((tid >> 5) & 3), cgi = tid & 31;
      if (grp == 0) {
        if (dir == 0) prep_k<128, 0>(p, layer, 0, hb, blk, cgi);
        else prep_k<128, 1>(p, layer, 0, hb, blk, cgi);
      } else {
        if (dir == 0) prep_k<64, 0>(p, layer, 1, hb, blk, cgi);
        else prep_k<64, 1>(p, layer, 1, hb, blk, cgi);
      }
    }
    {
      const int vg = tid & 31, tg = tid >> 5;
      const int col = (grp == 0 ? 1536 : 3072) + head * 128 + vg * 4;
      const int pos0 = bg * 128 + tg * 16;
      u16 vt[4][16];
#pragma unroll
      for (int t = 0; t < 16; t++) {
        const uint2 vv = *(const uint2*)(p.U + (size_t)tokrow(grp, b, pos0 + t) * DIN + col);
        vt[0][perm16(t)] = (u16)(vv.x & 0xffffu); vt[1][perm16(t)] = (u16)(vv.x >> 16);
        vt[2][perm16(t)] = (u16)(vv.y & 0xffffu); vt[3][perm16(t)] = (u16)(vv.y >> 16);
      }
#pragma unroll
      for (int c = 0; c < 4; c++) {
        u16* dst = (u16*)(p.S + (grp == 0 ? OFF_HVT : OFF_GVT)) + (((size_t)hb * NBLK + (pos0 >> 5)) * 128 + vg * 4 + c) * 32 + (pos0 & 31);
#pragma unroll
        for (int q8 = 0; q8 < 2; q8++) {
          uint4 o;
          o.x = (u32)vt[c][q8 * 8 + 0] | ((u32)vt[c][q8 * 8 + 1] << 16); o.y = (u32)vt[c][q8 * 8 + 2] | ((u32)vt[c][q8 * 8 + 3] << 16);
          o.z = (u32)vt[c][q8 * 8 + 4] | ((u32)vt[c][q8 * 8 + 5] << 16); o.w = (u32)vt[c][q8 * 8 + 6] | ((u32)vt[c][q8 * 8 + 7] << 16);
          *(uint4*)(dst + q8 * 8) = o;
        }
      }
    }
  }
}

template <int DK>
DI void scan_wg(const Params& p, char* smem, int grp, int dir, int hb) {
  constexpr int NT = DK / 32, NF = DK / 16;
  constexpr int QS = DK + 8;
  constexpr int KTS = 40;
  constexpr int OFF_K = 32 * QS * 2, OFF_KT = 2 * 32 * QS * 2, OFF_D = OFF_KT + DK * KTS * 2, BUFB = OFF_D + DK * 4;
  constexpr int QN = DK / 64;
  constexpr int CPR = DK / 8;
  static_assert(2 * BUFB <= LDS_BYTES, "scan LDS");
  const int tid = otid(), vs = tid >> 6, lane = tid & 63, r = lane & 31, h = lane >> 5;
  const int b = hb >> 2, head = hb & 3;
  const size_t chain = (size_t)dir * 16 + hb;
  const u16* Qb = (const u16*)(p.S + (DK == 128 ? OFF_HQ : OFF_GQ)) + chain * LPOS * DK;
  const u16* Kb = (const u16*)(p.S + (DK == 128 ? OFF_HK : OFF_GK)) + chain * LPOS * DK;
  const u16* KTb = (const u16*)(p.S + (DK == 128 ? OFF_HKT : OFF_GKT)) + chain * NBLK * DK * 32;
  const u16* VTb = (const u16*)(p.S + (DK == 128 ? OFF_HVT : OFF_GVT)) + (size_t)hb * NBLK * 128 * 32 + (vs * 32 + r) * 32 + h * 8;
  const float* Db = (const float*)(p.S + (DK == 128 ? OFF_HD : OFF_GD)) + chain * NBLK * DK;
  u16* Ob = p.U + (size_t)dir * NROW * D + grp * 512 + head * 128 + vs * 32;
  f32x16 S[NT];
#pragma unroll
  for (int kt = 0; kt < NT; kt++)
#pragma unroll
    for (int e = 0; e < 16; e++) S[kt][e] = 0.f;
  bf16x8 sq[QN], sk[QN], skt[QN], vn0, vn1;
  float4 sd = make_float4(0.f, 0.f, 0.f, 0.f);
  auto blk_of = [&](int step) { return dir ? (step < 8 ? 7 - step : 271 - step) : step; };
  auto gload = [&](int step) {
    const size_t pos0 = (size_t)blk_of(step) * 32;
#pragma unroll
    for (int i = 0; i < QN; i++) {
      const int id = tid + i * 256;
      sq[i] = *(const bf16x8*)(Qb + (pos0 + id / CPR) * DK + (id % CPR) * 8);
      sk[i] = *(const bf16x8*)(Kb + (pos0 + id / CPR) * DK + (id % CPR) * 8);
      skt[i] = *(const bf16x8*)(KTb + (size_t)blk_of(step) * DK * 32 + id * 8);
    }
    if (tid < DK / 4) sd = *(const float4*)(Db + (size_t)blk_of(step) * DK + tid * 4);
    vn0 = *(const bf16x8*)(VTb + (size_t)blk_of(step) * 128 * 32);
    vn1 = *(const bf16x8*)(VTb + (size_t)blk_of(step) * 128 * 32 + 16);
  };
  auto lstore = [&](int buf) {
    char* base = smem + buf * BUFB;
#pragma unroll
    for (int i = 0; i < QN; i++) {
      const int id = tid + i * 256;
      *(bf16x8*)(base + ((id / CPR) * QS + (id % CPR) * 8) * 2) = sq[i];
      *(bf16x8*)(base + OFF_K + ((id / CPR) * QS + (id % CPR) * 8) * 2) = sk[i];
      *(bf16x8*)(base + OFF_KT + ((id >> 2) * KTS + (id & 3) * 8) * 2) = skt[i];
    }
    if (tid < DK / 4) *(float4*)(base + OFF_D + tid * 16) = sd;
  };
  __syncthreads();
  gload(0);
  lstore(0);
  bf16x8 vf0 = vn0, vf1 = vn1;
  __syncthreads();
#pragma unroll 1
  for (int step = 0; step < NBLK; step++) {
    const int blk = blk_of(step);
    if (step + 1 < NBLK) gload(step + 1);
    const char* base = smem + (step & 1) * BUFB;
    const u16* Qs = (const u16*)base + r * QS + h * 8;
    const u16* Ks = (const u16*)(base + OFF_K) + r * QS + h * 8;
    const u16* KTs = (const u16*)(base + OFF_KT) + r * KTS + h * 8;
    const float* Ds = (const float*)(base + OFF_D) + 4 * h;
    bf16x8 qf[NF];
    f32x16 P0, P1;
#pragma unroll
    for (int e = 0; e < 16; e++) { P0[e] = 0.f; P1[e] = 0.f; }
#pragma unroll
    for (int f = 0; f < NF; f += 2) {
      qf[f] = *(const bf16x8*)(Qs + f * 16);
      qf[f + 1] = *(const bf16x8*)(Qs + f * 16 + 16);
      P0 = MFMA32(*(const bf16x8*)(Ks + f * 16), qf[f], P0);
      P1 = MFMA32(*(const bf16x8*)(Ks + f * 16 + 16), qf[f + 1], P1);
    }
#pragma unroll
    for (int e = 0; e < 16; e++) {
      const int s = crow(e, h);
      const bool keep = dir ? (s >= r) : (s <= r);
      P0[e] = keep ? P0[e] + P1[e] : 0.f;
    }
    f32x16 oA, oB;
#pragma unroll
    for (int e = 0; e < 16; e++) { oA[e] = 0.f; oB[e] = 0.f; }
    oA = MFMA32(vf0, pack_frag(P0, 0), oA);
    oA = MFMA32(vf1, pack_frag(P0, 1), oA);
#pragma unroll
    for (int kt = 0; kt < NT; kt++) {
      if (kt & 1) {
        oA = MFMA32(pack_frag(S[kt], 0), qf[kt * 2], oA);
        oA = MFMA32(pack_frag(S[kt], 1), qf[kt * 2 + 1], oA);
      } else {
        oB = MFMA32(pack_frag(S[kt], 0), qf[kt * 2], oB);
        oB = MFMA32(pack_frag(S[kt], 1), qf[kt * 2 + 1], oB);
      }
    }
#pragma unroll
    for (int kt = 0; kt < NT; kt++) {
      S[kt] = MFMA32(*(const bf16x8*)(KTs + kt * 32 * KTS), vf0, S[kt]);
      S[kt] = MFMA32(*(const bf16x8*)(KTs + kt * 32 * KTS + 16), vf1, S[kt]);
#pragma unroll
      for (int g = 0; g < 4; g++) {
        const float4 dv = *(const float4*)(Ds + kt * 32 + 8 * g);
        S[kt][4 * g + 0] *= dv.x; S[kt][4 * g + 1] *= dv.y; S[kt][4 * g + 2] *= dv.z; S[kt][4 * g + 3] *= dv.w;
      }
    }
    {
      const int pos0 = blk * 32;
      int rbase, rstride;
      if (pos0 < CTX) { rbase = NLAT + b * CTX + pos0; rstride = 1; }
      else if (grp == 0) { rbase = b * SEQ + pos0 - CTX; rstride = 1; }
      else { const int pp = pos0 - CTX; rbase = b * SEQ + (pp & 127) * 64 + (pp >> 7); rstride = 64; }
      u16* orow = Ob + (size_t)(rbase + r * rstride) * D + 4 * h;
#pragma unroll
      for (int g = 0; g < 4; g++)
        *(uint2*)(orow + 8 * g) = make_uint2(pack2(oA[4 * g] + oB[4 * g], oA[4 * g + 1] + oB[4 * g + 1]),
                                             pack2(oA[4 * g + 2] + oB[4 * g + 2], oA[4 * g + 3] + oB[4 * g + 3]));
    }
    if (step + 1 < NBLK) lstore((step + 1) & 1);
    vf0 = vn0; vf1 = vn1;
    __syncthreads();
  }
}

DI void scan_phase(const Params& p, char* smem, int layer) {
  const int bid = obid(), nscan = gridDim.x > 64 ? 64 : gridDim.x;
  if (bid < nscan) {
    for (int w = bid; w < 64; w += nscan) {
      const int grp = w >> 5, dir = (w >> 4) & 1, hb = w & 15;
      if (grp == 0) scan_wg<128>(p, smem, 0, dir, hb);
      else scan_wg<64>(p, smem, 1, dir, hb);
    }
  }
  if (gridDim.x <= 64 || bid >= 64) {
    const int vbid = gridDim.x <= 64 ? bid : bid - 64, vgrid = gridDim.x <= 64 ? gridDim.x : gridDim.x - 64;
    peer_convert(p, layer, vbid, vgrid);
    if (layer + 1 < DEPTH) weight_convert(p, layer + 1, vbid, vgrid);
  }
}

DI void combine_phase(const Params& p, int layer, int nrows) {
  const int wave = otid() >> 6, lane = otid() & 63;
  const int c0 = lane * 16;
  const float* gain = (c0 < 512 ? p.hg_norm : p.gla_norm) + (size_t)layer * 128 + (c0 & 127);
  float gn[16];
#pragma unroll
  for (int j = 0; j < 16; j++) gn[j] = gain[j];
  for (int r = obid() * 4 + wave; r < nrows; r += gridDim.x * 4) {
    const uint4* of = (const uint4*)(p.U + (size_t)r * D + c0);
    const uint4* ob = (const uint4*)(p.U + (size_t)NROW * D + (size_t)r * D + c0);
    const uint4* gg = (const uint4*)(p.G + (size_t)r * D + c0);
    float o[16], g[16];
#pragma unroll
    for (int c = 0; c < 2; c++) {
      uint4 a = of[c], bq = ob[c], gq = gg[c];
      u32 aw[4] = {a.x, a.y, a.z, a.w}, bw[4] = {bq.x, bq.y, bq.z, bq.w}, gw[4] = {gq.x, gq.y, gq.z, gq.w};
#pragma unroll
      for (int j = 0; j < 4; j++) {
        o[c * 8 + 2 * j] = __uint_as_float(aw[j] << 16) + __uint_as_float(bw[j] << 16);
        o[c * 8 + 2 * j + 1] = __uint_as_float(aw[j] & 0xffff0000u) + __uint_as_float(bw[j] & 0xffff0000u);
        g[c * 8 + 2 * j] = __uint_as_float(gw[j] << 16);
        g[c * 8 + 2 * j + 1] = __uint_as_float(gw[j] & 0xffff0000u);
      }
    }
    float ss = 0;
#pragma unroll
    for (int j = 0; j < 16; j++) ss += o[j] * o[j];
    ss += __shfl_xor(ss, 1); ss += __shfl_xor(ss, 2); ss += __shfl_xor(ss, 4);
    float rs = rsqrtf(ss * (1.f / 128.f) + EPS);
    u32 ow[8];
#pragma unroll
    for (int j = 0; j < 8; j++) {
      float g0 = g[2 * j], g1 = g[2 * j + 1];
      float y0 = o[2 * j] * rs * gn[2 * j] * (g0 / (1.f + __expf(-g0)));
      float y1 = o[2 * j + 1] * rs * gn[2 * j + 1] * (g1 / (1.f + __expf(-g1)));
      ow[j] = pack2(y0, y1);
    }
    uint4* dst = (uint4*)(p.H + (size_t)r * D + c0);
    dst[0] = make_uint4(ow[0], ow[1], ow[2], ow[3]);
    dst[1] = make_uint4(ow[4], ow[5], ow[6], ow[7]);
  }
}

template <bool PAY>
DI void ce(u32& a, u32& b, u32& pa, u32& pb) {
  if (!PAY) { u32 hi = a > b ? a : b, lo = a > b ? b : a; a = hi; b = lo; }
  else { bool c = a >= b; u32 hi = c ? a : b, lo = c ? b : a, ph = c ? pa : pb, pl = c ? pb : pa; a = hi; b = lo; pa = ph; pb = pl; }
}
template <bool PAY>
DI void sort16(u32 (&k)[16], u32 (&q)[16]) {
#pragma unroll
  for (int size = 2; size <= 16; size <<= 1) {
#pragma unroll
    for (int stride = size >> 1; stride > 0; stride >>= 1) {
#pragma unroll
      for (int i = 0; i < 16; i++) {
        int j = i ^ stride;
        if (j > i) {
          if ((i & size) == 0) ce<PAY>(k[i], k[j], q[i], q[j]);
          else ce<PAY>(k[j], k[i], q[j], q[i]);
        }
      }
    }
  }
}
template <bool PAY>
DI void merge16(u32 (&R)[16], u32 (&RP)[16], u32 (&N)[16], u32 (&NP)[16]) {
#pragma unroll
  for (int i = 0; i < 16; i++) {
    bool c = N[15 - i] > R[i];
    R[i] = c ? N[15 - i] : R[i];
    if (PAY) RP[i] = c ? NP[15 - i] : RP[i];
  }
#pragma unroll
  for (int stride = 8; stride > 0; stride >>= 1) {
#pragma unroll
    for (int i = 0; i < 16; i++) {
      int j = i ^ stride;
      if (j > i) ce<PAY>(R[i], R[j], RP[i], RP[j]);
    }
  }
}
DI u32 ord_f(float f) { u32 u = __float_as_uint(f); return (u & 0x80000000u) ? ~u : (u | 0x80000000u); }
DI float unord_f(u32 u) { return __uint_as_float((u & 0x80000000u) ? (u ^ 0x80000000u) : ~u); }

DI void topk_phase(const Params& p, int layer, char* smem, int nrows) {
  const int tid = otid(), wave = tid >> 6, lane = tid & 63, r = lane & 31, h = lane >> 5;
  float* sc = (float*)smem + wave * 4096;
  const u16* Q = p.U;
  const u16* keys = p.keysb + (size_t)layer * 2 * 128 * 128;
  int* IDX = (int*)(p.S + OFF_IDX);
  float* GATE = (float*)(p.S + OFF_GATE);
  const int nunits = (nrows / 64) * 8;
  for (int wu = obid() * 4 + wave; wu < nunits; wu += gridDim.x * 4) {
    const int tok0 = (wu >> 3) * 64, head = wu & 7;
    u32 RA[16], RB[16], dummy[16];
#pragma unroll
    for (int i = 0; i < 16; i++) { RA[i] = 0; RB[i] = 0; dummy[i] = 0; }
    auto do_half = [&](const int half, u32 (&R)[16]) {
      bf16x8 qf[2][8];
#pragma unroll
      for (int nt = 0; nt < 2; nt++) {
        const u16* qp = Q + (size_t)(tok0 + nt * 32 + r) * 2048 + head * 256 + half * 128 + h * 8;
#pragma unroll
        for (int f = 0; f < 8; f++) qf[nt][f] = *(const bf16x8*)(qp + f * 16);
      }
      f32x16 acc0, acc1;
      auto mm = [&](const int kr) {
        const u16* kp = keys + ((size_t)half * 128 + kr * 32 + r) * 128 + h * 8;
#pragma unroll
        for (int e = 0; e < 16; e++) { acc0[e] = 0.f; acc1[e] = 0.f; }
        bf16x8 afk[8];
#pragma unroll
        for (int f = 0; f < 8; f++) afk[f] = *(const bf16x8*)(kp + f * 16);
        __builtin_amdgcn_s_setprio(1);
#pragma unroll
        for (int f = 0; f < 8; f++) {
          acc0 = MFMA32(afk[f], qf[0][f], acc0);
          acc1 = MFMA32(afk[f], qf[1][f], acc1);
        }
        __builtin_amdgcn_s_setprio(0);
      };
      auto put = [&](const int buf) {
        float* d = sc + buf * 2048;
#pragma unroll
        for (int e = 0; e < 16; e++) {
          d[crow(e, h) * 64 + r] = acc0[e];
          d[crow(e, h) * 64 + 32 + r] = acc1[e];
        }
      };
      mm(0);
      put(0);
#pragma unroll
      for (int kr = 0; kr < 4; kr++) {
        if (kr < 3) mm(kr + 1);
        __builtin_amdgcn_wave_barrier();
        const float* sp = sc + (kr & 1) * 2048 + lane;
#pragma unroll
        for (int grp = 0; grp < 2; grp++) {
          u32 N[16];
#pragma unroll
          for (int i = 0; i < 16; i++) {
            const float v = sp[(grp * 16 + i) * 64];
            N[i] = (ord_f(v) & 0xFFFFFF80u) | (u32)(127 - (kr * 32 + grp * 16 + i));
          }
          sort16<false>(N, dummy);
          merge16<false>(R, dummy, N, dummy);
        }
        __builtin_amdgcn_wave_barrier();
        if (kr < 3) put((kr + 1) & 1);
      }
    };
    do_half(0, RA);
    do_half(1, RB);
    {
      float v1[16], v2[16]; u32 i1[16], i2[16];
#pragma unroll
      for (int i = 0; i < 16; i++) {
        v1[i] = unord_f(RA[i] & 0xFFFFFF80u); i1[i] = 127 - (RA[i] & 127u);
        v2[i] = unord_f(RB[i] & 0xFFFFFF80u); i2[i] = 127 - (RB[i] & 127u);
      }
      u32 TK[16], TP[16], NK[16], NP[16];
#define CAND(slot, a, bq) { NK[slot] = ord_f(v1[a] + v2[bq]); NP[slot] = i1[a] * 128u + i2[bq]; }
#pragma unroll
      for (int bq = 0; bq < 16; bq++) { TK[bq] = ord_f(v1[0] + v2[bq]); TP[bq] = i1[0] * 128u + i2[bq]; }
      sort16<true>(TK, TP);
#pragma unroll
      for (int bq = 0; bq < 8; bq++) CAND(bq, 1, bq)
#pragma unroll
      for (int bq = 0; bq < 5; bq++) CAND(8 + bq, 2, bq)
#pragma unroll
      for (int bq = 0; bq < 3; bq++) CAND(13 + bq, 4, bq)
      sort16<true>(NK, NP); merge16<true>(TK, TP, NK, NP);
#pragma unroll
      for (int bq = 0; bq < 4; bq++) CAND(bq, 3, bq)
      CAND(4, 5, 0) CAND(5, 5, 1) CAND(6, 6, 0) CAND(7, 6, 1) CAND(8, 7, 0) CAND(9, 7, 1)
      CAND(10, 8, 0) CAND(11, 9, 0) CAND(12, 10, 0) CAND(13, 11, 0) CAND(14, 12, 0) CAND(15, 13, 0)
      sort16<true>(NK, NP); merge16<true>(TK, TP, NK, NP);
      CAND(0, 14, 0) CAND(1, 15, 0)
#pragma unroll
      for (int i = 2; i < 16; i++) { NK[i] = 0; NP[i] = 0; }
      sort16<true>(NK, NP); merge16<true>(TK, TP, NK, NP);
#undef CAND
      const float mx = unord_f(TK[0]);
      float ev[16], sum = 0.f;
#pragma unroll
      for (int i = 0; i < 16; i++) { ev[i] = __expf(unord_f(TK[i]) - mx); sum += ev[i]; }
      const float inv = 1.f / sum;
      u16* ip = (u16*)IDX + (size_t)(tok0 + lane) * 128 + head * 16;
      float* gp = GATE + (size_t)(tok0 + lane) * 128 + head * 16;
#pragma unroll
      for (int c = 0; c < 2; c++)
        *(uint4*)(ip + c * 8) = make_uint4(TP[c * 8] | (TP[c * 8 + 1] << 16), TP[c * 8 + 2] | (TP[c * 8 + 3] << 16),
                                           TP[c * 8 + 4] | (TP[c * 8 + 5] << 16), TP[c * 8 + 6] | (TP[c * 8 + 7] << 16));
#pragma unroll
      for (int c = 0; c < 4; c++)
        *(float4*)(gp + c * 4) = make_float4(ev[c * 4] * inv, ev[c * 4 + 1] * inv, ev[c * 4 + 2] * inv, ev[c * 4 + 3] * inv);
    }
  }
}

DI float row16_sum(float v) {
  v += __int_as_float(__builtin_amdgcn_update_dpp(0, __float_as_int(v), 0x128, 0xf, 0xf, false));
  v += __int_as_float(__builtin_amdgcn_update_dpp(0, __float_as_int(v), 0x124, 0xf, 0xf, false));
  v += __int_as_float(__builtin_amdgcn_update_dpp(0, __float_as_int(v), 0x122, 0xf, 0xf, false));
  v += __int_as_float(__builtin_amdgcn_update_dpp(0, __float_as_int(v), 0x121, 0xf, 0xf, false));
  return v;
}
DI float gelu_tanh(float x) {
  float u = 0.7978845608028654f * (x + 0.044715f * x * x * x);
  float e = __expf(2.f * u);
  float th = 1.f - 2.f / (e + 1.f);
  return 0.5f * x * (1.f + th);
}
DI float dot8(uint4 a, uint4 b, float acc) {
  acc = __builtin_amdgcn_fdot2_f32_bf16(__builtin_bit_cast(bf2, a.x), __builtin_bit_cast(bf2, b.x), acc, false);
  acc = __builtin_amdgcn_fdot2_f32_bf16(__builtin_bit_cast(bf2, a.y), __builtin_bit_cast(bf2, b.y), acc, false);
  acc = __builtin_amdgcn_fdot2_f32_bf16(__builtin_bit_cast(bf2, a.z), __builtin_bit_cast(bf2, b.z), acc, false);
  acc = __builtin_amdgcn_fdot2_f32_bf16(__builtin_bit_cast(bf2, a.w), __builtin_bit_cast(bf2, b.w), acc, false);
  return acc;
}

typedef float f2 __attribute__((ext_vector_type(2)));
DI void expert_dots(const Params& p, int nrows, char* smem) {
  const int tid = otid(), wave = tid >> 6, lane = tid & 63, g = lane >> 4, s = lane & 15;
  const int bid = obid(), x = bid & 7, jx = bid >> 3, wpx = (gridDim.x + 7 - x) >> 3;
  u32* list = (u32*)smem + wave * 128;
  const int* IDX = (const int*)(p.S + OFF_IDX);
  const float* GATE = (const float*)(p.S + OFF_GATE);
  u16* AV16 = (u16*)(p.S + OFF_PU);
  const unsigned char* PU = (const unsigned char*)(p.PT + PT_U) + s * 16;
  const float* PSU = (const float*)(p.PT + PT_SC);
  const float* PSV = PSU + 16384;
  const int tstep = wpx * 4;
  int t = jx * 4 + wave;
  int ni0 = 0, ni1 = 0;
  uint4 nh[8];
  auto prefetch = [&](int tt) {
    { const u32 w2 = ((const u32*)IDX)[(size_t)tt * 64 + lane]; ni0 = (int)(w2 & 0xffffu); ni1 = (int)(w2 >> 16); }
#pragma unroll
    for (int c = 0; c < 4; c++) {
      const u16* hp = p.H + (size_t)tt * D + (c * 16 + s) * 16;
      nh[2 * c] = *(const uint4*)(hp); nh[2 * c + 1] = *(const uint4*)(hp + 8);
    }
  };
  auto dot_row = [&](const int4 (&uu)[4], const f2 (&hf)[32]) {
    const int uw[16] = {uu[0].x, uu[0].y, uu[0].z, uu[0].w, uu[1].x, uu[1].y, uu[1].z, uu[1].w,
                        uu[2].x, uu[2].y, uu[2].z, uu[2].w, uu[3].x, uu[3].y, uu[3].z, uu[3].w};
    f2 acc = {0.f, 0.f}, acc2 = {0.f, 0.f};
#pragma unroll
    for (int j = 0; j < 16; j++) {
      acc = __builtin_elementwise_fma(__builtin_amdgcn_cvt_pk_f32_fp8(uw[j], false), hf[2 * j], acc);
      acc2 = __builtin_elementwise_fma(__builtin_amdgcn_cvt_pk_f32_fp8(uw[j], true), hf[2 * j + 1], acc2);
    }
    return row16_sum((acc.x + acc.y) + (acc2.x + acc2.y));
  };
  if (t < nrows) prefetch(t);
  for (; t < nrows; t += tstep) {
    const int i0 = ni0, i1 = ni1;
    f2 hf[32];
#pragma unroll
    for (int c = 0; c < 4; c++) {
      const u32 hw[8] = {nh[2 * c].x, nh[2 * c].y, nh[2 * c].z, nh[2 * c].w, nh[2 * c + 1].x, nh[2 * c + 1].y, nh[2 * c + 1].z, nh[2 * c + 1].w};
#pragma unroll
      for (int j = 0; j < 8; j++) { hf[c * 8 + j].x = __uint_as_float(hw[j] << 16); hf[c * 8 + j].y = __uint_as_float(hw[j] & 0xffff0000u); }
    }
    if (t + tstep < nrows) prefetch(t + tstep);
    const bool b0 = (i0 >> 11) == x, b1 = (i1 >> 11) == x;
    const unsigned long long m0 = __ballot(b0), m1 = __ballot(b1);
    const int n0 = __popcll(m0);
    const int r0 = __builtin_amdgcn_mbcnt_hi((u32)(m0 >> 32), __builtin_amdgcn_mbcnt_lo((u32)m0, 0u));
    const int r1 = n0 + __builtin_amdgcn_mbcnt_hi((u32)(m1 >> 32), __builtin_amdgcn_mbcnt_lo((u32)m1, 0u));
    const int n = n0 + __popcll(m1);
    __builtin_amdgcn_wave_barrier();
    if (b0) list[r0] = ((u32)(2 * lane) << 16) | (u32)i0;
    if (b1) list[r1] = ((u32)(2 * lane + 1) << 16) | (u32)i1;
    __builtin_amdgcn_wave_barrier();
    for (int cb = 0; cb < n; cb += 64) {
      const int nend = min(n, cb + 64);
      float dk = 0.f;
      for (int base = cb; base < nend; base += 8) {
        const int k0 = base + g, k1 = base + 4 + g;
        const u32 ent0 = list[min(k0, n - 1)], ent1 = list[min(k1, n - 1)];
        const unsigned char* ur0 = PU + (size_t)(ent0 & 0xffffu) * D;
        const unsigned char* ur1 = PU + (size_t)(ent1 & 0xffffu) * D;
        int4 ua[4], ub[4];
        ua[0] = *(const int4*)(ur0); ua[1] = *(const int4*)(ur0 + 256); ua[2] = *(const int4*)(ur0 + 512); ua[3] = *(const int4*)(ur0 + 768);
        ub[0] = *(const int4*)(ur1); ub[1] = *(const int4*)(ur1 + 256); ub[2] = *(const int4*)(ur1 + 512); ub[3] = *(const int4*)(ur1 + 768);
        const float d0 = dot_row(ua, hf);
        const float d1 = dot_row(ub, hf);
        const int it0 = (base - cb) >> 2;
        dk = (s == it0) ? d0 : dk;
        dk = (s == it0 + 1) ? d1 : dk;
      }
      const int kk = cb + 4 * s + g;
      if (kk < nend) {
        const u32 ent = list[kk];
        const int e = (int)(ent & 0xffffu), slot = (int)(ent >> 16);
        AV16[(size_t)t * 128 + slot] = f2bf(GATE[(size_t)t * 128 + slot] * PSV[e] * gelu_tanh(dk * PSU[e]));
      }
    }
  }
}

DI void expert_vsum(const Params& p, int nrows) {
  const int tid = otid(), wave = tid >> 6, lane = tid & 63, g = lane >> 3, s = lane & 7;
  const int bid = obid(), x = bid & 7, jx = bid >> 3, wpx = (gridDim.x + 7 - x) >> 3;
  const u16* IDX = (const u16*)(p.S + OFF_IDX) + g * 16;
  const u16* AV = (const u16*)(p.S + OFF_PU) + g * 16;
  const unsigned char* PV = (const unsigned char*)(p.PT + PT_V) + (size_t)x * 16384 * 128 + s * 16;
  u16* Y = (u16*)((char*)p.U + (size_t)NROW * 2048 * 2);
  const int b5 = (lane >> 5) & 1, b4 = (lane >> 4) & 1, b3 = (lane >> 3) & 1;
  const int tstep = wpx * 4;
  int t = jx * 4 + wave;
  uint4 ni[2], na[2];
  auto prefetch = [&](int tt) {
#pragma unroll
    for (int j = 0; j < 2; j++) { ni[j] = *(const uint4*)(IDX + (size_t)tt * 128 + j * 8); na[j] = *(const uint4*)(AV + (size_t)tt * 128 + j * 8); }
  };
  if (t < nrows) prefetch(t);
  for (; t < nrows; t += tstep) {
    const u32 iw[8] = {ni[0].x, ni[0].y, ni[0].z, ni[0].w, ni[1].x, ni[1].y, ni[1].z, ni[1].w};
    const u32 aw[8] = {na[0].x, na[0].y, na[0].z, na[0].w, na[1].x, na[1].y, na[1].z, na[1].w};
    int ee[16]; float aa[16];
#pragma unroll
    for (int j = 0; j < 8; j++) {
      ee[2 * j] = (int)(iw[j] & 0xffffu); ee[2 * j + 1] = (int)(iw[j] >> 16);
      aa[2 * j] = __uint_as_float(aw[j] << 16); aa[2 * j + 1] = __uint_as_float(aw[j] & 0xffff0000u);
    }
    int4 vv[16];
#pragma unroll
    for (int it = 0; it < 16; it++) vv[it] = *(const int4*)(PV + (size_t)ee[it] * 128);
    if (t + tstep < nrows) prefetch(t + tstep);
    f2 y[8];
#pragma unroll
    for (int i = 0; i < 8; i++) { y[i].x = 0.f; y[i].y = 0.f; }
#pragma unroll
    for (int it = 0; it < 16; it++) {
      const f2 a2 = {aa[it], aa[it]};
      const int vw[4] = {vv[it].x, vv[it].y, vv[it].z, vv[it].w};
#pragma unroll
      for (int j = 0; j < 4; j++) {
        y[2 * j] = __builtin_elementwise_fma(__builtin_amdgcn_cvt_pk_f32_fp8(vw[j], false), a2, y[2 * j]);
        y[2 * j + 1] = __builtin_elementwise_fma(__builtin_amdgcn_cvt_pk_f32_fp8(vw[j], true), a2, y[2 * j + 1]);
      }
    }
    f2 k4[4], k2[2], k1;
#pragma unroll
    for (int i = 0; i < 4; i++) {
      const f2 keep = b5 ? y[4 + i] : y[i], send = b5 ? y[i] : y[4 + i];
      k4[i].x = keep.x + __shfl_xor(send.x, 32); k4[i].y = keep.y + __shfl_xor(send.y, 32);
    }
#pragma unroll
    for (int i = 0; i < 2; i++) {
      const f2 keep = b4 ? k4[2 + i] : k4[i], send = b4 ? k4[i] : k4[2 + i];
      k2[i].x = keep.x + __shfl_xor(send.x, 16); k2[i].y = keep.y + __shfl_xor(send.y, 16);
    }
    {
      const f2 keep = b3 ? k2[1] : k2[0], send = b3 ? k2[0] : k2[1];
      k1.x = keep.x + __shfl_xor(send.x, 8); k1.y = keep.y + __shfl_xor(send.y, 8);
    }
    *(u32*)(Y + (size_t)t * D + x * 128 + s * 16 + b5 * 8 + b4 * 4 + b3 * 2) = pack2(k1.x, k1.y);
  }
}

DI void expert_epilogue(const Params& p, int layer, int nrows) {
  const int tid = otid(), wave = tid >> 6, lane = tid & 63, g = lane >> 5, s = lane & 31;
  const bool last = (layer == DEPTH - 1);
  const u16* Y = (const u16*)((const char*)p.U + (size_t)NROW * 2048 * 2);
  for (int tk = obid() * 4 + wave; tk < nrows; tk += gridDim.x * 4) {
    const int b = row_batch(tk);
    const int col = (g * 32 + s) * 16;
    const float* g2 = ada_ptr(p, layer, b, 5) + col;
    const float* gm = p.ln_gamma + (size_t)(layer * 2 + 1) * D + col;
    const float* bt = p.ln_beta + (size_t)(layer * 2 + 1) * D + col;
    const float* XP = (const float*)(p.S + OFF_XP) + (size_t)tk * D + col;
    float xin[16];
    {
      float s0 = 0.f;
#pragma unroll
      for (int j4 = 0; j4 < 4; j4++) {
        const float4 t4 = *(const float4*)(XP + j4 * 4);
        xin[j4 * 4] = t4.x; xin[j4 * 4 + 1] = t4.y; xin[j4 * 4 + 2] = t4.z; xin[j4 * 4 + 3] = t4.w;
        s0 += t4.x + t4.y + t4.z + t4.w;
      }
      const float m0 = wave_sum(s0) * (1.f / D);
      float q0 = 0.f;
#pragma unroll
      for (int j = 0; j < 16; j++) { xin[j] -= m0; q0 += xin[j] * xin[j]; }
      const float r0 = rsqrtf(wave_sum(q0) * (1.f / D) + EPS);
      const float* gm0 = p.ln_gamma + (size_t)(layer * 2 + 0) * D + col;
      const float* bt0 = p.ln_beta + (size_t)(layer * 2 + 0) * D + col;
#pragma unroll
      for (int j4 = 0; j4 < 4; j4++) {
        const float4 ga = *(const float4*)(gm0 + j4 * 4), be = *(const float4*)(bt0 + j4 * 4);
        xin[j4 * 4] = xin[j4 * 4] * r0 * ga.x + be.x; xin[j4 * 4 + 1] = xin[j4 * 4 + 1] * r0 * ga.y + be.y;
        xin[j4 * 4 + 2] = xin[j4 * 4 + 2] * r0 * ga.z + be.z; xin[j4 * 4 + 3] = xin[j4 * 4 + 3] * r0 * ga.w + be.w;
      }
    }
    float xv[16];
    float sum = 0.f;
    const uint4 yq0 = *(const uint4*)(Y + (size_t)tk * D + col), yq1 = *(const uint4*)(Y + (size_t)tk * D + col + 8);
    const u32 yw[8] = {yq0.x, yq0.y, yq0.z, yq0.w, yq1.x, yq1.y, yq1.z, yq1.w};
#pragma unroll
    for (int j4 = 0; j4 < 4; j4++) {
      const float4 xo = make_float4(xin[j4 * 4], xin[j4 * 4 + 1], xin[j4 * 4 + 2], xin[j4 * 4 + 3]);
      const float4 gg = *(const float4*)(g2 + j4 * 4);
      const float4 yy = make_float4(__uint_as_float(yw[2 * j4] << 16), __uint_as_float(yw[2 * j4] & 0xffff0000u),
                                    __uint_as_float(yw[2 * j4 + 1] << 16), __uint_as_float(yw[2 * j4 + 1] & 0xffff0000u));
      float* o = xv + j4 * 4;
      o[0] = ALPHA * xo.x + gg.x * yy.x; o[1] = ALPHA * xo.y + gg.y * yy.y;
      o[2] = ALPHA * xo.z + gg.z * yy.z; o[3] = ALPHA * xo.w + gg.w * yy.w;
      sum += o[0] + o[1] + o[2] + o[3];
    }
    float mu = wave_sum(sum) * (1.f / D);
    float q = 0.f;
#pragma unroll
    for (int j = 0; j < 16; j++) { xv[j] -= mu; q += xv[j] * xv[j]; }
    float rstd = rsqrtf(wave_sum(q) * (1.f / D) + EPS);
    float* dstx = (last ? p.out : p.X) + (size_t)tk * D + col;
    float s2 = 0.f;
    float4 gmq[4], btq[4];
#pragma unroll
    for (int j4 = 0; j4 < 4; j4++) { gmq[j4] = *(const float4*)(gm + j4 * 4); btq[j4] = *(const float4*)(bt + j4 * 4); }
#pragma unroll
    for (int j4 = 0; j4 < 4; j4++) {
      const float4 gmv = gmq[j4];
      const float4 btv = btq[j4];
      float* o = xv + j4 * 4;
      o[0] = o[0] * rstd * gmv.x + btv.x; o[1] = o[1] * rstd * gmv.y + btv.y;
      o[2] = o[2] * rstd * gmv.z + btv.z; o[3] = o[3] * rstd * gmv.w + btv.w;
      s2 += o[0] + o[1] + o[2] + o[3];
      *(float4*)(dstx + j4 * 4) = make_float4(o[0], o[1], o[2], o[3]);
    }
    if (!last) {
      float mu2 = wave_sum(s2) * (1.f / D);
      float q2 = 0.f;
#pragma unroll
      for (int j = 0; j < 16; j++) { xv[j] -= mu2; q2 += xv[j] * xv[j]; }
      float rstd2 = rsqrtf(wave_sum(q2) * (1.f / D) + EPS);
      const float* sh = ada_ptr(p, layer + 1, b, 0) + col;
      const float* sc = ada_ptr(p, layer + 1, b, 1) + col;
      u32 ow[8];
#pragma unroll
      for (int j = 0; j < 8; j++) {
        float y0 = xv[2 * j] * rstd2 * (1.f + sc[2 * j]) + sh[2 * j];
        float y1 = xv[2 * j + 1] * rstd2 * (1.f + sc[2 * j + 1]) + sh[2 * j + 1];
        ow[j] = pack2(y0, y1);
      }
      *(uint4*)(p.H + (size_t)tk * D + col) = make_uint4(ow[0], ow[1], ow[2], ow[3]);
      *(uint4*)(p.H + (size_t)tk * D + col + 8) = make_uint4(ow[4], ow[5], ow[6], ow[7]);
    }
  }
}

#define XB_TMO      128
#define XB_XCNT(j)  (256  + 64 * (j))
#define XB_XSUB(j)  (1280 + 64 * (j))
#define XB_XGEN(j)  (2304 + 64 * (j))
#define XB_TOP      3328
#define XB_TOPGEN   3392
#define XCD_BAR_WORDS 3456
#define XB_SPIN_CAP (1u << 18)
#define LAS __attribute__((address_space(3)))

__device__ __forceinline__ unsigned xb_ld(unsigned* p)              { return __hip_atomic_load(p, __ATOMIC_RELAXED, __HIP_MEMORY_SCOPE_AGENT); }
__device__ __forceinline__ unsigned xb_add(unsigned* p, unsigned v) { return __hip_atomic_fetch_add(p, v, __ATOMIC_RELAXED, __HIP_MEMORY_SCOPE_AGENT); }
__device__ __forceinline__ unsigned xb_xcc_id() { return (unsigned)__builtin_amdgcn_s_getreg((3 << 11) | 20) & 0xFu; }
#define XB_SPIN(cond, bar) do { unsigned _sp = 0; while (cond) { __builtin_amdgcn_s_sleep(1); \
    if ((++_sp & 255u) == 0u) { if (xb_ld(&(bar)[XB_TMO])) break; if (_sp > XB_SPIN_CAP) { atomicAdd(&(bar)[XB_TMO], 1u); break; } } } } while (0)

struct XcdBarrier {
    unsigned* bar; unsigned x;
    volatile LAS unsigned* st;
};

__device__ __forceinline__ XcdBarrier xcd_barrier_post(unsigned* bar, volatile LAS unsigned* st) {
    XcdBarrier b; b.bar = bar; b.x = xb_xcc_id(); b.st = st;
    if (threadIdx.x == 0) (void)xb_add(&bar[XB_XCNT(b.x)], 1u);
    return b;
}
__device__ __forceinline__ void xcd_barrier_complete(unsigned* bar, unsigned x, unsigned& nloc, unsigned& nx) {
    const unsigned G = gridDim.x * gridDim.y * gridDim.z;
    unsigned sum, cnt, mine, sp = 0u;
    for (;;) {
        sum = 0u; cnt = 0u; mine = 0u;
#pragma unroll
        for (unsigned j = 0; j < 16; ++j) { const unsigned c = xb_ld(&bar[XB_XCNT(j)]); sum += c; cnt += (c > 0u) ? 1u : 0u; mine = (j == x) ? c : mine; }
        if (sum == G) break;
        __builtin_amdgcn_s_sleep(1);
        if ((++sp & 255u) == 0u) { if (xb_ld(&bar[XB_TMO])) break; if (sp > XB_SPIN_CAP) { atomicAdd(&bar[XB_TMO], 1u); break; } }
    }
    nloc = mine > 0u ? mine : 1u; nx = cnt > 0u ? cnt : 1u;
}

__device__ __forceinline__ void xcd_barrier(const XcdBarrier& b) {
    asm volatile("s_waitcnt vmcnt(0)" ::: "memory");
    __syncthreads();
    if (threadIdx.x == 0) {
        unsigned* bar = b.bar;
        __builtin_amdgcn_s_waitcnt(0);
        unsigned nloc = b.st[0], nx = b.st[1];
        if (nloc == 0u) { xcd_barrier_complete(bar, b.x, nloc, nx); b.st[0] = nloc; b.st[1] = nx; }
        const unsigned old = xb_add(&bar[XB_XSUB(b.x)], 1u);
        const unsigned gen = old / nloc;
        if (old + 1u == (gen + 1u) * nloc) {
            __builtin_amdgcn_fence(__ATOMIC_RELEASE, "agent");
            asm volatile("s_waitcnt vmcnt(0)" ::: "memory");
            const unsigned og = xb_add(&bar[XB_TOP], 1u);
            const unsigned tg = og / nx;
            if (og + 1u == (tg + 1u) * nx) xb_add(&bar[XB_TOPGEN], 1u);
            else XB_SPIN(xb_ld(&bar[XB_TOPGEN]) == tg, bar);
            __builtin_amdgcn_fence(__ATOMIC_ACQUIRE, "agent");
            xb_add(&bar[XB_XGEN(b.x)], 1u);
            asm volatile("s_waitcnt vmcnt(0)" ::: "memory");
        } else {
            XB_SPIN(xb_ld(&bar[XB_XGEN(b.x)]) == gen, bar);
            __builtin_amdgcn_fence(__ATOMIC_ACQUIRE, "agent");
            asm volatile("s_waitcnt vmcnt(0)" ::: "memory");
        }
    }
    __syncthreads();
}


DI void grid_barrier(unsigned* ctr, unsigned& target) {
  asm volatile("s_waitcnt vmcnt(0)" ::: "memory");
  __syncthreads();
  if (threadIdx.x == 0) {
    target += gridDim.x;
    __builtin_amdgcn_fence(__ATOMIC_RELEASE, "agent");
    asm volatile("s_waitcnt vmcnt(0)" ::: "memory");
    __hip_atomic_fetch_add(ctr, 1u, __ATOMIC_RELAXED, __HIP_MEMORY_SCOPE_AGENT);
    while (__hip_atomic_load(ctr, __ATOMIC_RELAXED, __HIP_MEMORY_SCOPE_AGENT) < target) __builtin_amdgcn_s_sleep(1);
    __builtin_amdgcn_fence(__ATOMIC_ACQUIRE, "agent");
    asm volatile("s_waitcnt vmcnt(0)" ::: "memory");
  }
  __syncthreads();
}

__global__ void __launch_bounds__(256, 2) mk_forward(Params p) {
  __shared__ __attribute__((aligned(16))) char smem[LDS_BYTES];
  cg::grid_group grid = cg::this_grid();
  int pc = 0;
#define GSYNC() xcd_barrier(xb)
#define PHASE(body) PHASER(15, body)
#define PHASER(kind, body)                              \
  {                                                     \
    if (pc >= p.ph_lo && pc < p.ph_hi) {                \
      if ((REPMASK >> (kind)) & 1) { const bool dry = true; (void)dry; body; GSYNC(); } \
      { const bool dry = false; (void)dry; body; }      \
      if (pc + 1 < p.ph_hi) GSYNC();                    \
    }                                                   \
    pc++;                                               \
  }
  __shared__ __attribute__((aligned(16))) unsigned xb_words[4];
  if (threadIdx.x == 0) { xb_words[0] = 0u; xb_words[1] = 0u; xb_words[2] = 0u; xb_words[3] = 0u; }
  __syncthreads();
  const XcdBarrier xb = xcd_barrier_post(p.bar, (volatile LAS unsigned*)xb_words);
  if (0 >= p.ph_lo && 0 < p.ph_hi) {
    phase0(p, (float*)smem);
    if (1 < p.ph_hi) grid.sync();
  }
  pc++;
  PHASE(phase0b(p))
  PHASE(lnmod_phase<0>(p, 0, NROW))
  for (int layer = 0; layer < DEPTH; layer++) {
    const bool last = (layer == DEPTH - 1);
    const int nrows = last ? NLAT : NROW;
    PHASER(0, gemm_phase<0>(p, layer, smem, p.H, p.wt_in + (size_t)layer * DINP * D, NROW / 256, DINP / 128, dry))
    PHASER(1, prep_phase(p, layer))
    PHASER(2, scan_phase(p, smem, layer))
    PHASER(3, combine_phase(p, layer, nrows))
    PHASER(4, { gemm_phase<1>(p, layer, smem, p.H, p.wt_out + (size_t)layer * D * D, NLAT / 256, 8, dry);
                 if (nrows > NLAT) gemm_thin<1>(p, layer, smem, p.H, p.wt_out + (size_t)layer * D * D, NLAT, NCTX / 64, 8, dry); })
    PHASER(5, lnmod_phase<1>(p, layer, nrows))
    PHASER(6, { gemm_phase<2>(p, layer, smem, p.H, p.wt_q + (size_t)layer * 2048 * D, NLAT / 256, 16, dry);
                 if (nrows > NLAT) gemm_thin<2>(p, layer, smem, p.H, p.wt_q + (size_t)layer * 2048 * D, NLAT, NCTX / 64, 16, dry); })
    PHASER(7, topk_phase(p, layer, smem, nrows))
    PHASER(8, expert_dots(p, nrows, smem))
    PHASER(9, expert_vsum(p, nrows))
    PHASER(10, expert_epilogue(p, layer, nrows))
  }
#undef PHASE
#undef PHASER
}
constexpr int NPHASES = 3 + 11 * DEPTH;

extern "C" void kernel_launch(void* const* d_in, const int* in_sizes, int n_in, void* d_out, int out_size, void* d_ws,
                              size_t ws_size, hipStream_t stream) {
  Params p{};
  p.x = (const float*)d_in[0]; p.c = (const float*)d_in[1]; p.ctx = (const float*)d_in[2]; p.c_ctx = (const float*)d_in[3];
  p.w_ada = (const float*)d_in[4]; p.b_ada = (const float*)d_in[5]; p.w_in = (const float*)d_in[6];
  p.w_gk2 = (const float*)d_in[7]; p.b_gk = (const float*)d_in[8]; p.hg_lb = (const float*)d_in[9];
  p.hg_norm = (const float*)d_in[10]; p.gla_norm = (const float*)d_in[11]; p.w_out = (const float*)d_in[12];
  p.ln_gamma = (const float*)d_in[13]; p.ln_beta = (const float*)d_in[14]; p.wq = (const float*)d_in[15];
  p.sub_keys = (const float*)d_in[16]; p.peer_u = (const float*)d_in[17]; p.peer_v = (const float*)d_in[18];
  p.out = (float*)d_out;
  char* w = (char*)d_ws;
  size_t off = 0;
  auto take = [&](size_t bytes) { char* q = w + off; off += (bytes + 255) & ~(size_t)255; return q; };
  p.wt_in = (u16*)take((size_t)4 * DINP * D * 2);
  p.wt_out = (u16*)take((size_t)4 * D * D * 2);
  p.wt_q = (u16*)take((size_t)4 * 2048 * D * 2);
  p.keysb = (u16*)take((size_t)4 * 2 * 128 * 128 * 2);
  p.ada_part = (float*)take((size_t)8 * 4 * 5 * 6144 * 4);
  p.ada = (float*)take((size_t)4 * 5 * 6144 * 4);
  p.X = (float*)take((size_t)NROW * D * 4);
  p.H = (u16*)take((size_t)NROW * D * 2);
  p.G = (u16*)take((size_t)NROW * D * 2);
  p.U = (u16*)take((size_t)NROW * DIN * 2);
  p.S = take(SZ_S);
  p.PT = take(SZ_PT);
  p.bar = (unsigned*)take(XCD_BAR_WORDS * 4);
  if (off > ws_size) { fprintf(stderr, "workspace too small: need %zu have %zu\n", off, ws_size); return; }

  static int grid_blocks = 0;
  if (!grid_blocks) {
    int dev = 0, cus = 0, per_cu = 0;
    hipGetDevice(&dev);
    hipDeviceGetAttribute(&cus, hipDeviceAttributeMultiprocessorCount, dev);
    hipOccupancyMaxActiveBlocksPerMultiprocessor(&per_cu, mk_forward, 256, 0);
    if (per_cu > 2) per_cu = 2;
    grid_blocks = cus * per_cu;
  }
#if ONE_LAUNCH
  hipMemsetAsync(p.bar, 0, XCD_BAR_WORDS * 4, stream);
  p.ph_lo = 0; p.ph_hi = NPHASES;
  void* args[] = {&p};
  hipError_t e = hipLaunchCooperativeKernel((void*)mk_forward, dim3(grid_blocks), dim3(256), args, 0, stream);
  if (e != hipSuccess) fprintf(stderr, "cooperative launch failed: %s (grid %d)\n", hipGetErrorString(e), grid_blocks);
#else
  for (int ph = 0; ph < NPHASES; ph++) {
    p.ph_lo = ph; p.ph_hi = ph + 1;
    hipLaunchKernelGGL(mk_forward, dim3(grid_blocks), dim3(256), 0, stream, p);
  }
#endif
}
```

```cpp
#include <hip/hip_runtime.h>
#include <hip/hip_cooperative_groups.h>
#include <cstdio>
namespace cg = cooperative_groups;

#define DI __device__ __forceinline__
typedef unsigned short u16;
typedef unsigned int u32;
typedef __attribute__((ext_vector_type(8))) short bf16x8;
typedef __attribute__((ext_vector_type(16))) float f32x16;
typedef __attribute__((ext_vector_type(2))) __bf16 bf2;

#ifndef REPMASK
#define REPMASK 0
#endif
#ifndef DRYVAR
#define DRYVAR 0
#endif
#ifndef ONE_LAUNCH
#define ONE_LAUNCH 1
#endif

constexpr int D = 1024, NB = 4, SEQ = 8192, DEPTH = 4, CTX = 256;
constexpr int NLAT = NB * SEQ;
constexpr int NCTX = NB * CTX;
constexpr int NROW = NLAT + NCTX;
constexpr int DIN = 4128, DINP = 4224;
constexpr int LPOS = CTX + SEQ;
constexpr int NBLK = LPOS / 32;
constexpr float ALPHA = 1.681792830507429f;
constexpr float EPS = 1e-6f;
constexpr int LDS_BYTES = 73728;

struct Params {
  const float *x, *c, *ctx, *c_ctx, *w_ada, *b_ada, *w_in, *w_gk2, *b_gk, *hg_lb, *hg_norm, *gla_norm,
      *w_out, *ln_gamma, *ln_beta, *wq, *sub_keys, *peer_u, *peer_v;
  float* out;
  u16 *wt_in, *wt_out, *wt_q, *keysb;
  float *ada_part, *ada;
  float* X;
  u16 *H, *G, *U;
  char* S;
  char* PT;
  unsigned* bar;
  int ph_lo, ph_hi;
};

constexpr size_t SZ_HQ = (size_t)2 * 16 * LPOS * 128 * 2;
constexpr size_t SZ_HVT = (size_t)16 * 128 * LPOS * 2;
constexpr size_t SZ_HD = (size_t)2 * 16 * NBLK * 128 * 4;
constexpr size_t SZ_GQ = (size_t)2 * 16 * LPOS * 64 * 2;
constexpr size_t SZ_GD = (size_t)2 * 16 * NBLK * 64 * 4;
constexpr size_t OFF_HQ = 0, OFF_HK = OFF_HQ + SZ_HQ, OFF_HKT = OFF_HK + SZ_HQ, OFF_HVT = OFF_HKT + SZ_HQ,
                 OFF_HD = OFF_HVT + SZ_HVT, OFF_GQ = OFF_HD + SZ_HD, OFF_GK = OFF_GQ + SZ_GQ, OFF_GKT = OFF_GK + SZ_GQ,
                 OFF_GVT = OFF_GKT + SZ_GQ, OFF_GD = OFF_GVT + SZ_HVT, SZ_S = OFF_GD + SZ_GD;
constexpr size_t OFF_XP = 0, SZ_XP = (size_t)NROW * D * 4;
constexpr size_t OFF_IDX = OFF_XP + SZ_XP, SZ_IDX = (size_t)NROW * 128 * 4;
constexpr size_t OFF_GATE = OFF_IDX + SZ_IDX;
constexpr size_t OFF_PU = OFF_GATE + SZ_IDX, SZ_PU = (size_t)16384 * D * 2;
constexpr size_t OFF_PV = OFF_PU + SZ_PU;
constexpr size_t OFF_PSC = OFF_PV + SZ_PU;
static_assert(OFF_PSC + 2 * 16384 * 4 <= SZ_S, "alias overflow");
constexpr size_t PT_U = 0, PT_V = (size_t)16384 * D, PT_SC = 2 * (size_t)16384 * D, SZ_PT = PT_SC + 2 * 16384 * 4;

DI int otid() { int t = threadIdx.x; asm volatile("" : "+v"(t)); return t; }
DI int obid() { int t = blockIdx.x; asm volatile("" : "+s"(t)); return t; }
DI float bf2f(u16 h) { return __uint_as_float(((u32)h) << 16); }
DI u16 f2bf(float x) { return __builtin_bit_cast(u16, (__bf16)x); }
typedef __attribute__((ext_vector_type(2))) float f32x2v;
typedef __attribute__((ext_vector_type(2))) __bf16 bf16x2v;
DI u32 pack2(float a, float b) { f32x2v v = {a, b}; return __builtin_bit_cast(u32, __builtin_convertvector(v, bf16x2v)); }
DI float wave_sum(float v) {
#pragma unroll
  for (int o = 32; o > 0; o >>= 1) v += __shfl_xor(v, o);
  return v;
}
DI int crow(int i, int h) { return (i & 3) + 8 * (i >> 2) + 4 * h; }
DI int perm16(int k) {
  int kk = k & 15;
  return (k & ~15) | (((kk >> 2) & 1) << 3) | ((kk >> 3) << 2) | (kk & 3);
}
DI bf16x8 pack_frag(const f32x16& x, int s) {
  union { bf16x8 v; u32 u[4]; } r;
#pragma unroll
  for (int j = 0; j < 4; j++) r.u[j] = pack2(x[8 * s + 2 * j], x[8 * s + 2 * j + 1]);
  return r.v;
}
#define MFMA32(a, b, c) __builtin_amdgcn_mfma_f32_32x32x16_bf16((a), (b), (c), 0, 0, 0)

DI const float* ada_ptr(const Params& p, int layer, int r, int j) { return p.ada + ((size_t)(layer * 5 + r) * 6 + j) * D; }
DI int row_batch(int r) { return r < NLAT ? (r >> 13) : 4; }

DI void weight_convert(const Params& p, int l, int vbid, int vgrid) {
  const size_t gtid = (size_t)vbid * 256 + otid(), gsz = (size_t)vgrid * 256;
  for (size_t i = gtid; i < (size_t)128 * DINP; i += gsz) {
    int n = i % DINP; int k8 = i / DINP;
    u32 o[4] = {0, 0, 0, 0};
    if (n < DIN) {
      const float* s = p.w_in + ((size_t)l * D + k8 * 8) * DIN + n;
#pragma unroll
      for (int j = 0; j < 4; j++) o[j] = pack2(s[(size_t)(2 * j) * DIN], s[(size_t)(2 * j + 1) * DIN]);
    }
    *(uint4*)(p.wt_in + ((size_t)l * DINP + n) * D + k8 * 8) = make_uint4(o[0], o[1], o[2], o[3]);
  }
  for (size_t i = gtid; i < (size_t)128 * 1024; i += gsz) {
    int n = i & 1023; int k8 = i >> 10;
    const float* s = p.w_out + ((size_t)l * D + k8 * 8) * D + n;
    u32 o[4];
#pragma unroll
    for (int j = 0; j < 4; j++) o[j] = pack2(s[(size_t)(2 * j) * D], s[(size_t)(2 * j + 1) * D]);
    *(uint4*)(p.wt_out + ((size_t)l * D + n) * D + k8 * 8) = make_uint4(o[0], o[1], o[2], o[3]);
  }
  for (size_t i = gtid; i < (size_t)128 * 2048; i += gsz) {
    int n = i & 2047; int k8 = i >> 11;
    const float* s = p.wq + ((size_t)l * D + k8 * 8) * 2048 + n;
    u32 o[4];
#pragma unroll
    for (int j = 0; j < 4; j++) o[j] = pack2(s[(size_t)(2 * j) * 2048], s[(size_t)(2 * j + 1) * 2048]);
    *(uint4*)(p.wt_q + ((size_t)l * 2048 + n) * D + k8 * 8) = make_uint4(o[0], o[1], o[2], o[3]);
  }
}

DI void phase0(const Params& p, float* lds) {
  for (int it = obid(); it < 768; it += gridDim.x) {
    int kp = it & 7, nb = (it >> 3) % 24, l = it / 192;
    __syncthreads();
    for (int i = otid(); i < 640; i += 256) {
      int r = i >> 7, k = i & 127;
      float v = (r < 4) ? p.c[r * D + kp * 128 + k] : p.c_ctx[kp * 128 + k];
      lds[i] = v / (1.f + __expf(-v));
    }
    __syncthreads();
    int n = nb * 256 + otid();
    const float* w = p.w_ada + ((size_t)l * D + kp * 128) * 6144 + n;
    float a0 = 0, a1 = 0, a2 = 0, a3 = 0, a4 = 0;
#pragma unroll 8
    for (int k = 0; k < 128; k++) {
      float wv = w[(size_t)k * 6144];
      a0 += lds[k] * wv; a1 += lds[128 + k] * wv; a2 += lds[256 + k] * wv; a3 += lds[384 + k] * wv; a4 += lds[512 + k] * wv;
    }
    float* o = p.ada_part + ((size_t)(kp * 4 + l) * 5) * 6144 + n;
    o[0] = a0; o[6144] = a1; o[2 * 6144] = a2; o[3 * 6144] = a3; o[4 * 6144] = a4;
  }
  weight_convert(p, 0, obid(), gridDim.x);
  const size_t gtid = (size_t)obid() * 256 + otid(), gsz = (size_t)gridDim.x * 256;
  for (size_t i = gtid; i < (size_t)4 * 2 * 128 * 128; i += gsz) p.keysb[i] = f2bf(p.sub_keys[i]);
}

DI void phase0b(const Params& p) {
  const size_t gtid = (size_t)obid() * 256 + otid(), gsz = (size_t)gridDim.x * 256;
  for (size_t i = gtid; i < (size_t)4 * 5 * 6144; i += gsz) {
    int n = i % 6144; int l = i / (5 * 6144);
    float a = p.b_ada[l * 6144 + n];
#pragma unroll
    for (int kp = 0; kp < 8; kp++) a += p.ada_part[(size_t)kp * 4 * 5 * 6144 + i];
    p.ada[i] = a;
  }
}

DI void peer_convert(const Params& p, int layer, int vbid, int vgrid) {
  const int tid = otid(), wave = tid >> 6, lane = tid & 63;
  unsigned char* du = (unsigned char*)(p.PT + PT_U);
  unsigned char* dv = (unsigned char*)(p.PT + PT_V);
  float* su = (float*)(p.PT + PT_SC);
  for (int it = vbid * 4 + wave; it < 2 * 16384; it += vgrid * 4) {
    const int tbl = it >> 14, e = it & 16383;
    const float* src = (tbl ? p.peer_v : p.peer_u) + ((size_t)layer * 16384 + e) * D + lane * 16;
    float4 a = *(const float4*)(src), b = *(const float4*)(src + 4), c = *(const float4*)(src + 8), d = *(const float4*)(src + 12);
    float m = fmaxf(fmaxf(fmaxf(fabsf(a.x), fabsf(a.y)), fmaxf(fabsf(a.z), fabsf(a.w))), fmaxf(fmaxf(fabsf(b.x), fabsf(b.y)), fmaxf(fabsf(b.z), fabsf(b.w))));
    m = fmaxf(m, fmaxf(fmaxf(fmaxf(fabsf(c.x), fabsf(c.y)), fmaxf(fabsf(c.z), fabsf(c.w))), fmaxf(fmaxf(fabsf(d.x), fabsf(d.y)), fmaxf(fabsf(d.z), fabsf(d.w)))));
#pragma unroll
    for (int o = 32; o > 0; o >>= 1) m = fmaxf(m, __shfl_xor(m, o));
    m = fmaxf(m, 1e-30f);
    const float sc = 224.f / m;
    int w0 = __builtin_amdgcn_cvt_pk_fp8_f32(a.x * sc, a.y * sc, 0, false); w0 = __builtin_amdgcn_cvt_pk_fp8_f32(a.z * sc, a.w * sc, w0, true);
    int w1 = __builtin_amdgcn_cvt_pk_fp8_f32(b.x * sc, b.y * sc, 0, false); w1 = __builtin_amdgcn_cvt_pk_fp8_f32(b.z * sc, b.w * sc, w1, true);
    int w2 = __builtin_amdgcn_cvt_pk_fp8_f32(c.x * sc, c.y * sc, 0, false); w2 = __builtin_amdgcn_cvt_pk_fp8_f32(c.z * sc, c.w * sc, w2, true);
    int w3 = __builtin_amdgcn_cvt_pk_fp8_f32(d.x * sc, d.y * sc, 0, false); w3 = __builtin_amdgcn_cvt_pk_fp8_f32(d.z * sc, d.w * sc, w3, true);
    if (tbl == 0) *(int4*)(du + (size_t)e * D + lane * 16) = make_int4(w0, w1, w2, w3);
    else *(int4*)(dv + ((size_t)(lane >> 3) * 16384 + e) * 128 + (lane & 7) * 16) = make_int4(w0, w1, w2, w3);
    if (lane == 0) su[it] = m * (1.f / 224.f);
  }
}

template <int MODE>
DI void lnmod_phase(const Params& p, int layer, int nrows) {
  const int wave = otid() >> 6, lane = otid() & 63;
  const float* XP = (const float*)(p.S + OFF_XP);
  for (int r = obid() * 4 + wave; r < nrows; r += gridDim.x * 4) {
    const float* src;
    if (MODE == 0) src = (r < NLAT) ? p.x + (size_t)r * D : p.ctx + (size_t)(r - NLAT) * D;
    else src = XP + (size_t)r * D;
    const int b = row_batch(r);
    float4 v[4];
#pragma unroll
    for (int c = 0; c < 4; c++) v[c] = *(const float4*)(src + c * 256 + lane * 4);
    float s = 0;
#pragma unroll
    for (int c = 0; c < 4; c++) s += v[c].x + v[c].y + v[c].z + v[c].w;
    float mu = wave_sum(s) * (1.f / D);
    float q = 0;
#pragma unroll
    for (int c = 0; c < 4; c++) {
      v[c].x -= mu; v[c].y -= mu; v[c].z -= mu; v[c].w -= mu;
      q += v[c].x * v[c].x + v[c].y * v[c].y + v[c].z * v[c].z + v[c].w * v[c].w;
    }
    float rstd = rsqrtf(wave_sum(q) * (1.f / D) + EPS);
    if (MODE == 1) {
      const float* gm = p.ln_gamma + (size_t)(layer * 2 + 0) * D;
      const float* bt = p.ln_beta + (size_t)(layer * 2 + 0) * D;
      float s2 = 0;
#pragma unroll
      for (int c = 0; c < 4; c++) {
        int col = c * 256 + lane * 4;
        float4 g = *(const float4*)(gm + col), be = *(const float4*)(bt + col);
        v[c].x = v[c].x * rstd * g.x + be.x; v[c].y = v[c].y * rstd * g.y + be.y;
        v[c].z = v[c].z * rstd * g.z + be.z; v[c].w = v[c].w * rstd * g.w + be.w;
        s2 += v[c].x + v[c].y + v[c].z + v[c].w;
      }
      float mu2 = wave_sum(s2) * (1.f / D);
      float q2 = 0;
#pragma unroll
      for (int c = 0; c < 4; c++) {
        v[c].x -= mu2; v[c].y -= mu2; v[c].z -= mu2; v[c].w -= mu2;
        q2 += v[c].x * v[c].x + v[c].y * v[c].y + v[c].z * v[c].z + v[c].w * v[c].w;
      }
      rstd = rsqrtf(wave_sum(q2) * (1.f / D) + EPS);
    }
    const float* sh = ada_ptr(p, layer, b, MODE == 0 ? 0 : 3);
    const float* sc = ada_ptr(p, layer, b, MODE == 0 ? 1 : 4);
    float4 av[4], mv[4];
#pragma unroll
    for (int c = 0; c < 4; c++) { av[c] = *(const float4*)(sh + c * 256 + lane * 4); mv[c] = *(const float4*)(sc + c * 256 + lane * 4); }
#pragma unroll
    for (int c = 0; c < 4; c++) {
      int col = c * 256 + lane * 4;
      float4 a = av[c], m = mv[c];
      float y0 = v[c].x * rstd * (1.f + m.x) + a.x, y1 = v[c].y * rstd * (1.f + m.y) + a.y;
      float y2 = v[c].z * rstd * (1.f + m.z) + a.z, y3 = v[c].w * rstd * (1.f + m.w) + a.w;
      *(uint2*)(p.H + (size_t)r * D + col) = make_uint2(pack2(y0, y1), pack2(y2, y3));
    }
  }
}

constexpr int LDS_STRIDE = 72;
constexpr int CT_STRIDE = 132;
template <int MODE>
DI void gemm_store(const Params& p, int layer, int row, int nt, int n0, int c4, const float4 v, const bool dry) {
  if (MODE == 0) {
          u16* dst;
          if (nt >= 16 && nt < 20) dst = p.G + (size_t)row * D + (n0 - 2048) + c4;
          else if (nt >= 28 && nt < 32) dst = p.G + (size_t)row * D + (n0 - 3584 + 512) + c4;
          else dst = p.U + (size_t)row * DIN + n0 + c4;
          if (dry) dst = (u16*)p.S + (size_t)row * DIN + n0 + c4;
          if (n0 + c4 < DIN) *(uint2*)dst = make_uint2(pack2(v.x, v.y), pack2(v.z, v.w));
        } else if (MODE == 1) {
          float* XP = dry ? (float*)p.U : (float*)(p.S + OFF_XP);
          const float* xo = (layer == 0) ? ((row < NLAT) ? p.x + (size_t)row * D : p.ctx + (size_t)(row - NLAT) * D) : p.X + (size_t)row * D;
          const float4 xv = *(const float4*)(xo + n0 + c4);
          const float4 g1 = *(const float4*)(ada_ptr(p, layer, row_batch(row), 2) + n0 + c4);
          *(float4*)(XP + (size_t)row * D + n0 + c4) =
              make_float4(ALPHA * xv.x + g1.x * v.x, ALPHA * xv.y + g1.y * v.y, ALPHA * xv.z + g1.z * v.z, ALPHA * xv.w + g1.w * v.w);
        } else {
          *(uint2*)((dry ? (u16*)(p.S + OFF_PU) : p.U) + (size_t)row * 2048 + n0 + c4) = make_uint2(pack2(v.x, v.y), pack2(v.z, v.w));
        }
}

template <int MODE>
DI void gemm_phase(const Params& p, int layer, char* smem, const u16* A, const u16* Bt, int Mtiles, int Ntiles, const bool dry) {
  u16* As = (u16*)smem;
  u16* Bs = (u16*)smem + 256 * LDS_STRIDE;
  float* Ct = (float*)smem;
  const int tid = otid(), wave = tid >> 6, lane = tid & 63, r = lane & 31, h = lane >> 5;
  const int wm = wave >> 1, wn = wave & 1;
  const int srow = tid >> 3, sc8 = (tid & 7) * 8;
  const int bid = obid(), xcd = bid & 7, jx = bid >> 3, wpx = (gridDim.x + 7 - xcd) >> 3;
  const int ntiles = Mtiles * Ntiles, nchunks = (ntiles + 63) >> 6;
  for (int ch = xcd; ch < nchunks; ch += 8)
  for (int jj = jx; jj < 64; jj += wpx) {
    const int L = ch * 64 + jj;
    if (L >= ntiles) continue;
    const int mt = (L / (4 * Ntiles)) * 4 + (L & 3), nt = (L >> 2) % Ntiles;
    const u16* Ag = A + ((size_t)mt * 256 + srow) * D + sc8;
    const u16* Bg = Bt + ((size_t)nt * 128 + srow) * D + sc8;
    f32x16 acc[4][2];
#pragma unroll
    for (int i = 0; i < 4; i++)
#pragma unroll
      for (int j = 0; j < 2; j++)
#pragma unroll
        for (int e = 0; e < 16; e++) acc[i][j][e] = 0.f;
    bf16x8 ra0, ra1, ra2, ra3, ra4, ra5, ra6, ra7, rb0, rb1, rb2, rb3;
#define GLOAD(kt_) { const u16* ag = Ag + (kt_) * 64; const u16* bg = Bg + (kt_) * 64; \
      ra0 = *(const bf16x8*)(ag); ra1 = *(const bf16x8*)(ag + 32 * D); ra2 = *(const bf16x8*)(ag + 64 * D); ra3 = *(const bf16x8*)(ag + 96 * D); \
      ra4 = *(const bf16x8*)(ag + 128 * D); ra5 = *(const bf16x8*)(ag + 160 * D); ra6 = *(const bf16x8*)(ag + 192 * D); ra7 = *(const bf16x8*)(ag + 224 * D); \
      rb0 = *(const bf16x8*)(bg); rb1 = *(const bf16x8*)(bg + 32 * D); rb2 = *(const bf16x8*)(bg + 64 * D); rb3 = *(const bf16x8*)(bg + 96 * D); }
#define LSTORE() { u16* ad = As + srow * LDS_STRIDE + sc8; u16* bd = Bs + srow * LDS_STRIDE + sc8; \
      *(bf16x8*)(ad) = ra0; *(bf16x8*)(ad + 32 * LDS_STRIDE) = ra1; *(bf16x8*)(ad + 64 * LDS_STRIDE) = ra2; *(bf16x8*)(ad + 96 * LDS_STRIDE) = ra3; \
      *(bf16x8*)(ad + 128 * LDS_STRIDE) = ra4; *(bf16x8*)(ad + 160 * LDS_STRIDE) = ra5; *(bf16x8*)(ad + 192 * LDS_STRIDE) = ra6; *(bf16x8*)(ad + 224 * LDS_STRIDE) = ra7; \
      *(bf16x8*)(bd) = rb0; *(bf16x8*)(bd + 32 * LDS_STRIDE) = rb1; *(bf16x8*)(bd + 64 * LDS_STRIDE) = rb2; *(bf16x8*)(bd + 96 * LDS_STRIDE) = rb3; }
    GLOAD(0)
    __syncthreads();
    LSTORE()
    __syncthreads();
#pragma unroll 1
    for (int kt = 0; kt < 16; kt++) {
      if (kt + 1 < 16 && !(dry && DRYVAR == 1)) GLOAD(kt + 1)
      const u16* as = As + (wm * 128 + r) * LDS_STRIDE + h * 8;
      const u16* bs = Bs + (wn * 64 + r) * LDS_STRIDE + h * 8;
      if (!(dry && DRYVAR == 2)) {
        bf16x8 af[2][4], b0, b1;
#pragma unroll
        for (int i = 0; i < 4; i++) af[0][i] = *(const bf16x8*)(as + i * 32 * LDS_STRIDE);
        b0 = *(const bf16x8*)(bs); b1 = *(const bf16x8*)(bs + 32 * LDS_STRIDE);
#pragma unroll
        for (int kk = 0; kk < 4; kk++) {
          const int cur = kk & 1, nxt = cur ^ 1;
          if (kk < 3) {
#pragma unroll
            for (int i = 0; i < 4; i++) af[nxt][i] = *(const bf16x8*)(as + i * 32 * LDS_STRIDE + (kk + 1) * 16);
          }
          __builtin_amdgcn_s_setprio(1);
#pragma unroll
          for (int i = 0; i < 4; i++) acc[i][0] = MFMA32(af[cur][i], b0, acc[i][0]);
          if (kk < 3) b0 = *(const bf16x8*)(bs + (kk + 1) * 16);
#pragma unroll
          for (int i = 0; i < 4; i++) acc[i][1] = MFMA32(af[cur][i], b1, acc[i][1]);
          if (kk < 3) b1 = *(const bf16x8*)(bs + 32 * LDS_STRIDE + (kk + 1) * 16);
          __builtin_amdgcn_s_setprio(0);
        }
      }
      __syncthreads();
      if (kt + 1 < 16 && !(dry && DRYVAR == 1)) LSTORE()
      __syncthreads();
    }
#undef GLOAD
#undef LSTORE
    const int m0 = mt * 256, n0 = nt * 128;
    const int c4 = (tid & 31) * 4, rr0 = tid >> 5;
#pragma unroll
    for (int ph = 0; ph < 2; ph++) {
      if (ph) __syncthreads();
#pragma unroll
      for (int ii = 0; ii < 2; ii++)
#pragma unroll
        for (int j = 0; j < 2; j++)
#pragma unroll
          for (int e = 0; e < 16; e++) Ct[(wm * 64 + ii * 32 + crow(e, h)) * CT_STRIDE + wn * 64 + j * 32 + r] = acc[ph * 2 + ii][j][e];
      __syncthreads();
      if (MODE == 1) {
        const float4 g1 = *(const float4*)(ada_ptr(p, layer, row_batch(m0), 2) + n0 + c4);
        float* XP = dry ? (float*)p.U : (float*)(p.S + OFF_XP);
#pragma unroll 1
        for (int q0 = 0; q0 < 16; q0 += 2) {
          float4 xv[2], cv[2];
#pragma unroll
          for (int j = 0; j < 2; j++) {
            const int rl = rr0 + (q0 + j) * 8, row = m0 + (rl >> 6) * 128 + ph * 64 + (rl & 63);
            const float* xo = (layer == 0) ? ((row < NLAT) ? p.x + (size_t)row * D : p.ctx + (size_t)(row - NLAT) * D) : p.X + (size_t)row * D;
            xv[j] = *(const float4*)(xo + n0 + c4);
            cv[j] = *(const float4*)(Ct + rl * CT_STRIDE + c4);
          }
#pragma unroll
          for (int j = 0; j < 2; j++) {
            const int rl = rr0 + (q0 + j) * 8, row = m0 + (rl >> 6) * 128 + ph * 64 + (rl & 63);
            *(float4*)(XP + (size_t)row * D + n0 + c4) = make_float4(ALPHA * xv[j].x + g1.x * cv[j].x, ALPHA * xv[j].y + g1.y * cv[j].y,
                                                                     ALPHA * xv[j].z + g1.z * cv[j].z, ALPHA * xv[j].w + g1.w * cv[j].w);
          }
        }
      } else {
#pragma unroll 2
        for (int q = 0; q < 16; q++) {
          const int rl = rr0 + q * 8, row = m0 + (rl >> 6) * 128 + ph * 64 + (rl & 63);
          const float4 v = *(const float4*)(Ct + rl * CT_STRIDE + c4);
          gemm_store<MODE>(p, layer, row, nt, n0, c4, v, dry);
        }
      }
    }
  }
}

template <int MODE>
DI void gemm_thin(const Params& p, int layer, char* smem, const u16* A, const u16* Bt, int row0, int Mtiles, int Ntiles, const bool dry) {
  u16* As = (u16*)smem;
  u16* Bs = (u16*)smem + 64 * LDS_STRIDE;
  float* Ct = (float*)smem;
  const int tid = otid(), wave = tid >> 6, lane = tid & 63, r = lane & 31, h = lane >> 5;
  const int wm = wave >> 1, wn = wave & 1;
  const int srow = tid >> 3, sc8 = (tid & 7) * 8;
  const int ntiles = Mtiles * Ntiles;
  for (int L = obid(); L < ntiles; L += gridDim.x) {
    const int mt = L / Ntiles, nt = L % Ntiles;
    const u16* Ag = A + ((size_t)row0 + mt * 64 + srow) * D + sc8;
    const u16* Bg = Bt + ((size_t)nt * 128 + srow) * D + sc8;
    f32x16 acc0, acc1;
#pragma unroll
    for (int e = 0; e < 16; e++) { acc0[e] = 0.f; acc1[e] = 0.f; }
    bf16x8 ra0, ra1, rb0, rb1, rb2, rb3;
#define GLOADT(kt_) { const u16* ag = Ag + (kt_) * 64; const u16* bg = Bg + (kt_) * 64; \
      ra0 = *(const bf16x8*)(ag); ra1 = *(const bf16x8*)(ag + 32 * D); \
      rb0 = *(const bf16x8*)(bg); rb1 = *(const bf16x8*)(bg + 32 * D); rb2 = *(const bf16x8*)(bg + 64 * D); rb3 = *(const bf16x8*)(bg + 96 * D); }
#define LSTORET() { u16* ad = As + srow * LDS_STRIDE + sc8; u16* bd = Bs + srow * LDS_STRIDE + sc8; \
      *(bf16x8*)(ad) = ra0; *(bf16x8*)(ad + 32 * LDS_STRIDE) = ra1; \
      *(bf16x8*)(bd) = rb0; *(bf16x8*)(bd + 32 * LDS_STRIDE) = rb1; *(bf16x8*)(bd + 64 * LDS_STRIDE) = rb2; *(bf16x8*)(bd + 96 * LDS_STRIDE) = rb3; }
    GLOADT(0)
    __syncthreads();
    LSTORET()
    __syncthreads();
#pragma unroll 1
    for (int kt = 0; kt < 16; kt++) {
      if (kt + 1 < 16) GLOADT(kt + 1)
      const u16* as = As + (wm * 32 + r) * LDS_STRIDE + h * 8;
      const u16* bs = Bs + (wn * 64 + r) * LDS_STRIDE + h * 8;
#pragma unroll
      for (int kk = 0; kk < 4; kk++) {
        const bf16x8 af = *(const bf16x8*)(as + kk * 16);
        const bf16x8 bf0 = *(const bf16x8*)(bs + kk * 16), bf1 = *(const bf16x8*)(bs + 32 * LDS_STRIDE + kk * 16);
        __builtin_amdgcn_s_setprio(1);
        acc0 = MFMA32(af, bf0, acc0);
        acc1 = MFMA32(af, bf1, acc1);
        __builtin_amdgcn_s_setprio(0);
      }
      __syncthreads();
      if (kt + 1 < 16) LSTORET()
      __syncthreads();
    }
#undef GLOADT
#undef LSTORET
#pragma unroll
    for (int e = 0; e < 16; e++) {
      Ct[(wm * 32 + crow(e, h)) * CT_STRIDE + wn * 64 + r] = acc0[e];
      Ct[(wm * 32 + crow(e, h)) * CT_STRIDE + wn * 64 + 32 + r] = acc1[e];
    }
    __syncthreads();
    const int n0 = nt * 128, c4 = (tid & 31) * 4, rr0 = tid >> 5;
#pragma unroll 2
    for (int q = 0; q < 8; q++) {
      const int rl = rr0 + q * 8, row = row0 + mt * 64 + rl;
      const float4 v = *(const float4*)(Ct + rl * CT_STRIDE + c4);
      gemm_store<MODE>(p, layer, row, nt, n0, c4, v, dry);
    }
  }
}

DI int tokrow(int grp, int b, int pos) {
  if (pos < CTX) return NLAT + b * CTX + pos;
  int pp = pos - CTX;
  return b * SEQ + (grp == 0 ? pp : ((pp & 127) * 64 + (pp >> 7)));
}
DI float log_sigmoid(float z) { return fminf(z, 0.f) - __logf(1.f + __expf(-fabsf(z))); }

template <int DK, int DIR>
DI void prep_k(const Params& p, int layer, int grp, int hb, int blk, int cgi) {
  constexpr int CH = DK / 32;
  const int b = hb >> 2, head = hb & 3, k0 = cgi * CH;
  float lb[CH], log_lb[CH], l1m[CH], wg[CH][16], bias[CH], bacc[CH];
#pragma unroll
  for (int c = 0; c < CH; c++) {
    bacc[c] = 0.f; lb[c] = 0.f; log_lb[c] = 0.f; l1m[c] = 0.f; bias[c] = 0.f;
    if (DK == 128) {
      const float* lbp = p.hg_lb + (size_t)DIR * DEPTH * 512 + head * 128 + k0 + c;
      float e0 = lbp[0], e1 = lbp[512], e2 = lbp[1024], e3 = lbp[1536];
      const float mx = fmaxf(fmaxf(e0, e1), fmaxf(e2, e3));
      e0 = __expf(e0 - mx); e1 = __expf(e1 - mx); e2 = __expf(e2 - mx); e3 = __expf(e3 - mx);
      const float inv = 1.f / (e0 + e1 + e2 + e3);
      float cs = 0.f;
      if (layer >= 1) cs += e1 * inv;
      if (layer >= 2) cs += e2 * inv;
      if (layer >= 3) cs += e3 * inv;
      lb[c] = fminf(fmaxf(cs, 0.f), 1.f - 1e-6f);
      log_lb[c] = __logf(fmaxf(lb[c], 1e-30f));
      l1m[c] = __logf(1.f - lb[c]);
    } else {
#pragma unroll
      for (int rr = 0; rr < 16; rr++) wg[c][rr] = p.w_gk2[((size_t)(layer * 2 + DIR) * 16 + rr) * 256 + head * 64 + k0 + c];
      bias[c] = p.b_gk[(size_t)(layer * 2 + DIR) * 256 + head * 64 + k0 + c];
    }
  }
  const size_t chain = (size_t)DIR * 16 + hb;
  const int pk0 = perm16(k0);
  u16* Qd = (u16*)(p.S + (DK == 128 ? OFF_HQ : OFF_GQ)) + (chain * LPOS + (size_t)blk * 32) * DK + pk0;
  u16* Kd = (u16*)(p.S + (DK == 128 ? OFF_HK : OFF_GK)) + (chain * LPOS + (size_t)blk * 32) * DK + pk0;
  u16* KTd = (u16*)(p.S + (DK == 128 ? OFF_HKT : OFF_GKT)) + ((chain * NBLK + blk) * DK + k0) * 32;
#pragma unroll 1
  for (int s2 = 0; s2 < 2; s2++) {
    const int tg = DIR ? 1 - s2 : s2;
    u16 kt[CH][16];
#pragma unroll
    for (int jb = 0; jb < 2; jb++) {
      uint2 zz[8], qq[8];
      u32 gq[8], gk[8];
      uint4 ga[8], gb[8];
#pragma unroll
      for (int j = 0; j < 8; j++) {
        const int j2 = jb * 8 + j;
        const int t16 = DIR ? 15 - j2 : j2;
        const u16* urow = p.U + (size_t)tokrow(grp, b, blk * 32 + tg * 16 + t16) * DIN;
        if (DK == 128) {
          zz[j] = *(const uint2*)(urow + 512 * (1 + DIR) + head * 128 + k0);
          qq[j] = *(const uint2*)(urow + head * 128 + k0);
        } else {
          gq[j] = *(const u32*)(urow + 2560 + head * 64 + k0);
          gk[j] = *(const u32*)(urow + 2816 + head * 64 + k0);
          const uint4* gr = (const uint4*)(urow + 4096 + DIR * 16);
          ga[j] = gr[0]; gb[j] = gr[1];
        }
      }
#pragma unroll
      for (int j = 0; j < 8; j++) {
        const int j2 = jb * 8 + j;
        const int t16 = DIR ? 15 - j2 : j2;
        const int t = tg * 16 + t16;
        float qv[CH], kv[CH], la[CH];
        if (DK == 128) {
          const u32 zw[2] = {zz[j].x, zz[j].y}, qw[2] = {qq[j].x, qq[j].y};
#pragma unroll
          for (int c = 0; c < CH; c++) {
            const float z = (c & 1) ? __uint_as_float(zw[c >> 1] & 0xffff0000u) : __uint_as_float(zw[c >> 1] << 16);
            qv[c] = (c & 1) ? __uint_as_float(qw[c >> 1] & 0xffff0000u) : __uint_as_float(qw[c >> 1] << 16);
            const float ez = __expf(-fabsf(z));
            const float rc = __frcp_rn(1.f + ez);
            const float sp = (z < 0.f) ? ez * rc : rc;
            const float sn = (z < 0.f) ? rc : ez * rc;
            la[c] = __logf(fmaxf(lb[c], 1e-30f) + (1.f - lb[c]) * sp);
            kv[c] = (1.f - lb[c]) * sn;
          }
        } else {
          const u32 gw[8] = {ga[j].x, ga[j].y, ga[j].z, ga[j].w, gb[j].x, gb[j].y, gb[j].z, gb[j].w};
#pragma unroll
          for (int c = 0; c < CH; c++) {
            qv[c] = ((c & 1) ? __uint_as_float(gq[j] & 0xffff0000u) : __uint_as_float(gq[j] << 16)) * 0.125f;
            kv[c] = (c & 1) ? __uint_as_float(gk[j] & 0xffff0000u) : __uint_as_float(gk[j] << 16);
            float d = bias[c];
#pragma unroll
            for (int rr = 0; rr < 8; rr++)
              d += __uint_as_float(gw[rr] << 16) * wg[c][2 * rr] + __uint_as_float(gw[rr] & 0xffff0000u) * wg[c][2 * rr + 1];
            la[c] = (fminf(d, 0.f) - __logf(1.f + __expf(-fabsf(d)))) * (1.f / 16.f);
          }
        }
        float qo[CH], ko[CH];
#pragma unroll
        for (int c = 0; c < CH; c++) {
          bacc[c] += la[c];
          const float eb = __expf(bacc[c]);
          qo[c] = qv[c] * eb;
          ko[c] = kv[c] * __expf(-bacc[c]);
          kt[c][perm16(t16)] = f2bf(ko[c]);
        }
        if (CH == 4) {
          *(uint2*)(Qd + (size_t)t * DK) = make_uint2(pack2(qo[0], qo[1]), pack2(qo[2], qo[3]));
          *(uint2*)(Kd + (size_t)t * DK) = make_uint2(pack2(ko[0], ko[1]), pack2(ko[2], ko[3]));
        } else {
          *(u32*)(Qd + (size_t)t * DK) = pack2(qo[0], qo[1]);
          *(u32*)(Kd + (size_t)t * DK) = pack2(ko[0], ko[1]);
        }
      }
    }
#pragma unroll
    for (int c = 0; c < CH; c++) {
      u16* dst = KTd + c * 32 + tg * 16;
#pragma unroll
      for (int q8 = 0; q8 < 2; q8++) {
        uint4 o;
        o.x = (u32)kt[c][q8 * 8 + 0] | ((u32)kt[c][q8 * 8 + 1] << 16); o.y = (u32)kt[c][q8 * 8 + 2] | ((u32)kt[c][q8 * 8 + 3] << 16);
        o.z = (u32)kt[c][q8 * 8 + 4] | ((u32)kt[c][q8 * 8 + 5] << 16); o.w = (u32)kt[c][q8 * 8 + 6] | ((u32)kt[c][q8 * 8 + 7] << 16);
        *(uint4*)(dst + q8 * 8) = o;
      }
    }
  }
  float* Dd = (float*)(p.S + (DK == 128 ? OFF_HD : OFF_GD)) + (chain * NBLK + blk) * DK + k0;
#pragma unroll
  for (int c = 0; c < CH; c++) Dd[c] = __expf(bacc[c]);
}

DI void prep_phase(const Params& p, int layer) {
  const int tid = otid();
  for (int it = obid(); it < 2 * 16 * (NBLK / 4); it += gridDim.x) {
    const int bg = it % (NBLK / 4), hb = (it / (NBLK / 4)) & 15, grp = it / ((NBLK / 4) * 16);
    const int b = hb >> 2, head = hb & 3;
    {
      const int dir = tid >> 7, blk = bg * 4 + ((tid >> 5) & 3), cgi = tid & 31;
      if (grp == 0) {
        if (dir == 0) prep_k<128, 0>(p, layer, 0, hb, blk, cgi);
        else prep_k<128, 1>(p, layer, 0, hb, blk, cgi);
      } else {
        if (dir == 0) prep_k<64, 0>(p, layer, 1, hb, blk, cgi);
        else prep_k<64, 1>(p, layer, 1, hb, blk, cgi);
      }
    }
    {
      const int vg = tid & 31, tg = tid >> 5;
      const int col = (grp == 0 ? 1536 : 3072) + head * 128 + vg * 4;
      const int pos0 = bg * 128 + tg * 16;
      u16 vt[4][16];
#pragma unroll
      for (int t = 0; t < 16; t++) {
        const uint2 vv = *(const uint2*)(p.U + (size_t)tokrow(grp, b, pos0 + t) * DIN + col);
        vt[0][perm16(t)] = (u16)(vv.x & 0xffffu); vt[1][perm16(t)] = (u16)(vv.x >> 16);
        vt[2][perm16(t)] = (u16)(vv.y & 0xffffu); vt[3][perm16(t)] = (u16)(vv.y >> 16);
      }
#pragma unroll
      for (int c = 0; c < 4; c++) {
        u16* dst = (u16*)(p.S + (grp == 0 ? OFF_HVT : OFF_GVT)) + (((size_t)hb * NBLK + (pos0 >> 5)) * 128 + vg * 4 + c) * 32 + (pos0 & 31);
#pragma unroll
        for (int q8 = 0; q8 < 2; q8++) {
          uint4 o;
          o.x = (u32)vt[c][q8 * 8 + 0] | ((u32)vt[c][q8 * 8 + 1] << 16); o.y = (u32)vt[c][q8 * 8 + 2] | ((u32)vt[c][q8 * 8 + 3] << 16);
          o.z = (u32)vt[c][q8 * 8 + 4] | ((u32)vt[c][q8 * 8 + 5] << 16); o.w = (u32)vt[c][q8 * 8 + 6] | ((u32)vt[c][q8 * 8 + 7] << 16);
          *(uint4*)(dst + q8 * 8) = o;
        }
      }
    }
  }
}

template <int DK>
DI void scan_wg(const Params& p, char* smem, int grp, int dir, int hb) {
  constexpr int NT = DK / 32, NF = DK / 16;
  constexpr int QS = DK + 8;
  constexpr int KTS = 40;
  constexpr int OFF_K = 32 * QS * 2, OFF_KT = 2 * 32 * QS * 2, OFF_D = OFF_KT + DK * KTS * 2, BUFB = OFF_D + DK * 4;
  constexpr int QN = DK / 64;
  constexpr int CPR = DK / 8;
  static_assert(2 * BUFB <= LDS_BYTES, "scan LDS");
  const int tid = otid(), vs = tid >> 6, lane = tid & 63, r = lane & 31, h = lane >> 5;
  const int b = hb >> 2, head = hb & 3;
  const size_t chain = (size_t)dir * 16 + hb;
  const u16* Qb = (const u16*)(p.S + (DK == 128 ? OFF_HQ : OFF_GQ)) + chain * LPOS * DK;
  const u16* Kb = (const u16*)(p.S + (DK == 128 ? OFF_HK : OFF_GK)) + chain * LPOS * DK;
  const u16* KTb = (const u16*)(p.S + (DK == 128 ? OFF_HKT : OFF_GKT)) + chain * NBLK * DK * 32;
  const u16* VTb = (const u16*)(p.S + (DK == 128 ? OFF_HVT : OFF_GVT)) + (size_t)hb * NBLK * 128 * 32 + (vs * 32 + r) * 32 + h * 8;
  const float* Db = (const float*)(p.S + (DK == 128 ? OFF_HD : OFF_GD)) + chain * NBLK * DK;
  u16* Ob = p.U + (size_t)dir * NROW * D + grp * 512 + head * 128 + vs * 32;
  f32x16 S[NT];
#pragma unroll
  for (int kt = 0; kt < NT; kt++)
#pragma unroll
    for (int e = 0; e < 16; e++) S[kt][e] = 0.f;
  bf16x8 sq[QN], sk[QN], skt[QN], vn0, vn1;
  float4 sd = make_float4(0.f, 0.f, 0.f, 0.f);
  auto blk_of = [&](int step) { return dir ? (step < 8 ? 7 - step : 271 - step) : step; };
  auto gload = [&](int step) {
    const size_t pos0 = (size_t)blk_of(step) * 32;
#pragma unroll
    for (int i = 0; i < QN; i++) {
      const int id = tid + i * 256;
      sq[i] = *(const bf16x8*)(Qb + (pos0 + id / CPR) * DK + (id % CPR) * 8);
      sk[i] = *(const bf16x8*)(Kb + (pos0 + id / CPR) * DK + (id % CPR) * 8);
      skt[i] = *(const bf16x8*)(KTb + (size_t)blk_of(step) * DK * 32 + id * 8);
    }
    if (tid < DK / 4) sd = *(const float4*)(Db + (size_t)blk_of(step) * DK + tid * 4);
    vn0 = *(const bf16x8*)(VTb + (size_t)blk_of(step) * 128 * 32);
    vn1 = *(const bf16x8*)(VTb + (size_t)blk_of(step) * 128 * 32 + 16);
  };
  auto lstore = [&](int buf) {
    char* base = smem + buf * BUFB;
#pragma unroll
    for (int i = 0; i < QN; i++) {
      const int id = tid + i * 256;
      *(bf16x8*)(base + ((id / CPR) * QS + (id % CPR) * 8) * 2) = sq[i];
      *(bf16x8*)(base + OFF_K + ((id / CPR) * QS + (id % CPR) * 8) * 2) = sk[i];
      *(bf16x8*)(base + OFF_KT + ((id >> 2) * KTS + (id & 3) * 8) * 2) = skt[i];
    }
    if (tid < DK / 4) *(float4*)(base + OFF_D + tid * 16) = sd;
  };
  __builtin_amdgcn_s_setprio(3);
  __syncthreads();
  gload(0);
  lstore(0);
  bf16x8 vf0 = vn0, vf1 = vn1;
  __syncthreads();
#pragma unroll 1
  for (int step = 0; step < NBLK; step++) {
    const int blk = blk_of(step);
    if (step + 1 < NBLK) gload(step + 1);
    const char* base = smem + (step & 1) * BUFB;
    const u16* Qs = (const u16*)base + r * QS + h * 8;
    const u16* Ks = (const u16*)(base + OFF_K) + r * QS + h * 8;
    const u16* KTs = (const u16*)(base + OFF_KT) + r * KTS + h * 8;
    const float* Ds = (const float*)(base + OFF_D) + 4 * h;
    bf16x8 qf[NF];
    f32x16 P0, P1;
#pragma unroll
    for (int e = 0; e < 16; e++) { P0[e] = 0.f; P1[e] = 0.f; }
#pragma unroll
    for (int f = 0; f < NF; f += 2) {
      qf[f] = *(const bf16x8*)(Qs + f * 16);
      qf[f + 1] = *(const bf16x8*)(Qs + f * 16 + 16);
      P0 = MFMA32(*(const bf16x8*)(Ks + f * 16), qf[f], P0);
      P1 = MFMA32(*(const bf16x8*)(Ks + f * 16 + 16), qf[f + 1], P1);
    }
#pragma unroll
    for (int e = 0; e < 16; e++) {
      const int s = crow(e, h);
      const bool keep = dir ? (s >= r) : (s <= r);
      P0[e] = keep ? P0[e] + P1[e] : 0.f;
    }
    f32x16 oA, oB;
#pragma unroll
    for (int e = 0; e < 16; e++) { oA[e] = 0.f; oB[e] = 0.f; }
    oA = MFMA32(vf0, pack_frag(P0, 0), oA);
    oA = MFMA32(vf1, pack_frag(P0, 1), oA);
#pragma unroll
    for (int kt = 0; kt < NT; kt++) {
      if (kt & 1) {
        oA = MFMA32(pack_frag(S[kt], 0), qf[kt * 2], oA);
        oA = MFMA32(pack_frag(S[kt], 1), qf[kt * 2 + 1], oA);
      } else {
        oB = MFMA32(pack_frag(S[kt], 0), qf[kt * 2], oB);
        oB = MFMA32(pack_frag(S[kt], 1), qf[kt * 2 + 1], oB);
      }
    }
#pragma unroll
    for (int kt = 0; kt < NT; kt++) {
      S[kt] = MFMA32(*(const bf16x8*)(KTs + kt * 32 * KTS), vf0, S[kt]);
      S[kt] = MFMA32(*(const bf16x8*)(KTs + kt * 32 * KTS + 16), vf1, S[kt]);
#pragma unroll
      for (int g = 0; g < 4; g++) {
        const float4 dv = *(const float4*)(Ds + kt * 32 + 8 * g);
        S[kt][4 * g + 0] *= dv.x; S[kt][4 * g + 1] *= dv.y; S[kt][4 * g + 2] *= dv.z; S[kt][4 * g + 3] *= dv.w;
      }
    }
    {
      const int pos0 = blk * 32;
      int rbase, rstride;
      if (pos0 < CTX) { rbase = NLAT + b * CTX + pos0; rstride = 1; }
      else if (grp == 0) { rbase = b * SEQ + pos0 - CTX; rstride = 1; }
      else { const int pp = pos0 - CTX; rbase = b * SEQ + (pp & 127) * 64 + (pp >> 7); rstride = 64; }
      u16* orow = Ob + (size_t)(rbase + r * rstride) * D + 4 * h;
#pragma unroll
      for (int g = 0; g < 4; g++)
        *(uint2*)(orow + 8 * g) = make_uint2(pack2(oA[4 * g] + oB[4 * g], oA[4 * g + 1] + oB[4 * g + 1]),
                                             pack2(oA[4 * g + 2] + oB[4 * g + 2], oA[4 * g + 3] + oB[4 * g + 3]));
    }
    if (step + 1 < NBLK) lstore((step + 1) & 1);
    vf0 = vn0; vf1 = vn1;
    __syncthreads();
  }
  __builtin_amdgcn_s_setprio(0);
}

DI void scan_phase(const Params& p, char* smem, int layer) {
  const int bid = obid(), nscan = gridDim.x > 64 ? 64 : gridDim.x;
  if (bid < nscan) {
    for (int w = bid; w < 64; w += nscan) {
      const int grp = w >> 5, dir = (w >> 4) & 1, hb = w & 15;
      if (grp == 0) scan_wg<128>(p, smem, 0, dir, hb);
      else scan_wg<64>(p, smem, 1, dir, hb);
    }
  }
  if (gridDim.x <= 64 || bid >= 64) {
    const int vbid = gridDim.x <= 64 ? bid : bid - 64, vgrid = gridDim.x <= 64 ? gridDim.x : gridDim.x - 64;
    peer_convert(p, layer, vbid, vgrid);
    if (layer + 1 < DEPTH) weight_convert(p, layer + 1, vbid, vgrid);
  }
}

DI void combine_phase(const Params& p, int layer, int nrows) {
  const int wave = otid() >> 6, lane = otid() & 63;
  const int c0 = lane * 16;
  const float* gain = (c0 < 512 ? p.hg_norm : p.gla_norm) + (size_t)layer * 128 + (c0 & 127);
  float gn[16];
#pragma unroll
  for (int j = 0; j < 16; j++) gn[j] = gain[j];
  for (int r = obid() * 4 + wave; r < nrows; r += gridDim.x * 4) {
    const uint4* of = (const uint4*)(p.U + (size_t)r * D + c0);
    const uint4* ob = (const uint4*)(p.U + (size_t)NROW * D + (size_t)r * D + c0);
    const uint4* gg = (const uint4*)(p.G + (size_t)r * D + c0);
    float o[16], g[16];
#pragma unroll
    for (int c = 0; c < 2; c++) {
      uint4 a = of[c], bq = ob[c], gq = gg[c];
      u32 aw[4] = {a.x, a.y, a.z, a.w}, bw[4] = {bq.x, bq.y, bq.z, bq.w}, gw[4] = {gq.x, gq.y, gq.z, gq.w};
#pragma unroll
      for (int j = 0; j < 4; j++) {
        o[c * 8 + 2 * j] = __uint_as_float(aw[j] << 16) + __uint_as_float(bw[j] << 16);
        o[c * 8 + 2 * j + 1] = __uint_as_float(aw[j] & 0xffff0000u) + __uint_as_float(bw[j] & 0xffff0000u);
        g[c * 8 + 2 * j] = __uint_as_float(gw[j] << 16);
        g[c * 8 + 2 * j + 1] = __uint_as_float(gw[j] & 0xffff0000u);
      }
    }
    float ss = 0;
#pragma unroll
    for (int j = 0; j < 16; j++) ss += o[j] * o[j];
    ss += __shfl_xor(ss, 1); ss += __shfl_xor(ss, 2); ss += __shfl_xor(ss, 4);
    float rs = rsqrtf(ss * (1.f / 128.f) + EPS);
    u32 ow[8];
#pragma unroll
    for (int j = 0; j < 8; j++) {
      float g0 = g[2 * j], g1 = g[2 * j + 1];
      float y0 = o[2 * j] * rs * gn[2 * j] * (g0 / (1.f + __expf(-g0)));
      float y1 = o[2 * j + 1] * rs * gn[2 * j + 1] * (g1 / (1.f + __expf(-g1)));
      ow[j] = pack2(y0, y1);
    }
    uint4* dst = (uint4*)(p.H + (size_t)r * D + c0);
    dst[0] = make_uint4(ow[0], ow[1], ow[2], ow[3]);
    dst[1] = make_uint4(ow[4], ow[5], ow[6], ow[7]);
  }
}

template <bool PAY>
DI void ce(u32& a, u32& b, u32& pa, u32& pb) {
  if (!PAY) { u32 hi = a > b ? a : b, lo = a > b ? b : a; a = hi; b = lo; }
  else { bool c = a >= b; u32 hi = c ? a : b, lo = c ? b : a, ph = c ? pa : pb, pl = c ? pb : pa; a = hi; b = lo; pa = ph; pb = pl; }
}
template <bool PAY>
DI void sort16(u32 (&k)[16], u32 (&q)[16]) {
#pragma unroll
  for (int size = 2; size <= 16; size <<= 1) {
#pragma unroll
    for (int stride = size >> 1; stride > 0; stride >>= 1) {
#pragma unroll
      for (int i = 0; i < 16; i++) {
        int j = i ^ stride;
        if (j > i) {
          if ((i & size) == 0) ce<PAY>(k[i], k[j], q[i], q[j]);
          else ce<PAY>(k[j], k[i], q[j], q[i]);
        }
      }
    }
  }
}
template <bool PAY>
DI void merge16(u32 (&R)[16], u32 (&RP)[16], u32 (&N)[16], u32 (&NP)[16]) {
#pragma unroll
  for (int i = 0; i < 16; i++) {
    bool c = N[15 - i] > R[i];
    R[i] = c ? N[15 - i] : R[i];
    if (PAY) RP[i] = c ? NP[15 - i] : RP[i];
  }
#pragma unroll
  for (int stride = 8; stride > 0; stride >>= 1) {
#pragma unroll
    for (int i = 0; i < 16; i++) {
      int j = i ^ stride;
      if (j > i) ce<PAY>(R[i], R[j], RP[i], RP[j]);
    }
  }
}
DI u32 ord_f(float f) { u32 u = __float_as_uint(f); return (u & 0x80000000u) ? ~u : (u | 0x80000000u); }
DI float unord_f(u32 u) { return __uint_as_float((u & 0x80000000u) ? (u ^ 0x80000000u) : ~u); }

DI void topk_phase(const Params& p, int layer, char* smem, int nrows) {
  const int tid = otid(), wave = tid >> 6, lane = tid & 63, r = lane & 31, h = lane >> 5;
  float* sc = (float*)smem + wave * 4096;
  const u16* Q = p.U;
  const u16* keys = p.keysb + (size_t)layer * 2 * 128 * 128;
  int* IDX = (int*)(p.S + OFF_IDX);
  float* GATE = (float*)(p.S + OFF_GATE);
  const int nunits = (nrows / 64) * 8;
  for (int wu = obid() * 4 + wave; wu < nunits; wu += gridDim.x * 4) {
    const int tok0 = (wu >> 3) * 64, head = wu & 7;
    u32 RA[16], RB[16], dummy[16];
#pragma unroll
    for (int i = 0; i < 16; i++) { RA[i] = 0; RB[i] = 0; dummy[i] = 0; }
    auto do_half = [&](const int half, u32 (&R)[16]) {
      bf16x8 qf[2][8];
#pragma unroll
      for (int nt = 0; nt < 2; nt++) {
        const u16* qp = Q + (size_t)(tok0 + nt * 32 + r) * 2048 + head * 256 + half * 128 + h * 8;
#pragma unroll
        for (int f = 0; f < 8; f++) qf[nt][f] = *(const bf16x8*)(qp + f * 16);
      }
      f32x16 acc0, acc1;
      auto mm = [&](const int kr) {
        const u16* kp = keys + ((size_t)half * 128 + kr * 32 + r) * 128 + h * 8;
#pragma unroll
        for (int e = 0; e < 16; e++) { acc0[e] = 0.f; acc1[e] = 0.f; }
        bf16x8 afk[8];
#pragma unroll
        for (int f = 0; f < 8; f++) afk[f] = *(const bf16x8*)(kp + f * 16);
        __builtin_amdgcn_s_setprio(1);
#pragma unroll
        for (int f = 0; f < 8; f++) {
          acc0 = MFMA32(afk[f], qf[0][f], acc0);
          acc1 = MFMA32(afk[f], qf[1][f], acc1);
        }
        __builtin_amdgcn_s_setprio(0);
      };
      auto put = [&](const int buf) {
        float* d = sc + buf * 2048;
#pragma unroll
        for (int e = 0; e < 16; e++) {
          d[crow(e, h) * 64 + r] = acc0[e];
          d[crow(e, h) * 64 + 32 + r] = acc1[e];
        }
      };
      mm(0);
      put(0);
#pragma unroll
      for (int kr = 0; kr < 4; kr++) {
        if (kr < 3) mm(kr + 1);
        __builtin_amdgcn_wave_barrier();
        const float* sp = sc + (kr & 1) * 2048 + lane;
#pragma unroll
        for (int grp = 0; grp < 2; grp++) {
          u32 N[16];
#pragma unroll
          for (int i = 0; i < 16; i++) {
            const float v = sp[(grp * 16 + i) * 64];
            N[i] = (ord_f(v) & 0xFFFFFF80u) | (u32)(127 - (kr * 32 + grp * 16 + i));
          }
          sort16<false>(N, dummy);
          merge16<false>(R, dummy, N, dummy);
        }
        __builtin_amdgcn_wave_barrier();
        if (kr < 3) put((kr + 1) & 1);
      }
    };
    do_half(0, RA);
    do_half(1, RB);
    {
      float v1[16], v2[16]; u32 i1[16], i2[16];
#pragma unroll
      for (int i = 0; i < 16; i++) {
        v1[i] = unord_f(RA[i] & 0xFFFFFF80u); i1[i] = 127 - (RA[i] & 127u);
        v2[i] = unord_f(RB[i] & 0xFFFFFF80u); i2[i] = 127 - (RB[i] & 127u);
      }
      u32 TK[16], TP[16], NK[16], NP[16];
#define CAND(slot, a, bq) { NK[slot] = ord_f(v1[a] + v2[bq]); NP[slot] = i1[a] * 128u + i2[bq]; }
#pragma unroll
      for (int bq = 0; bq < 16; bq++) { TK[bq] = ord_f(v1[0] + v2[bq]); TP[bq] = i1[0] * 128u + i2[bq]; }
      sort16<true>(TK, TP);
#pragma unroll
      for (int bq = 0; bq < 8; bq++) CAND(bq, 1, bq)
#pragma unroll
      for (int bq = 0; bq < 5; bq++) CAND(8 + bq, 2, bq)
#pragma unroll
      for (int bq = 0; bq < 3; bq++) CAND(13 + bq, 4, bq)
      sort16<true>(NK, NP); merge16<true>(TK, TP, NK, NP);
#pragma unroll
      for (int bq = 0; bq < 4; bq++) CAND(bq, 3, bq)
      CAND(4, 5, 0) CAND(5, 5, 1) CAND(6, 6, 0) CAND(7, 6, 1) CAND(8, 7, 0) CAND(9, 7, 1)
      CAND(10, 8, 0) CAND(11, 9, 0) CAND(12, 10, 0) CAND(13, 11, 0) CAND(14, 12, 0) CAND(15, 13, 0)
      sort16<true>(NK, NP); merge16<true>(TK, TP, NK, NP);
      CAND(0, 14, 0) CAND(1, 15, 0)
#pragma unroll
      for (int i = 2; i < 16; i++) { NK[i] = 0; NP[i] = 0; }
      sort16<true>(NK, NP); merge16<true>(TK, TP, NK, NP);
#undef CAND
      const float mx = unord_f(TK[0]);
      float ev[16], sum = 0.f;
#pragma unroll
      for (int i = 0; i < 16; i++) { ev[i] = __expf(unord_f(TK[i]) - mx); sum += ev[i]; }
      const float inv = 1.f / sum;
      u16* ip = (u16*)IDX + (size_t)(tok0 + lane) * 128 + head * 16;
      float* gp = GATE + (size_t)(tok0 + lane) * 128 + head * 16;
#pragma unroll
      for (int c = 0; c < 2; c++)
        *(uint4*)(ip + c * 8) = make_uint4(TP[c * 8] | (TP[c * 8 + 1] << 16), TP[c * 8 + 2] | (TP[c * 8 + 3] << 16),
                                           TP[c * 8 + 4] | (TP[c * 8 + 5] << 16), TP[c * 8 + 6] | (TP[c * 8 + 7] << 16));
#pragma unroll
      for (int c = 0; c < 4; c++)
        *(float4*)(gp + c * 4) = make_float4(ev[c * 4] * inv, ev[c * 4 + 1] * inv, ev[c * 4 + 2] * inv, ev[c * 4 + 3] * inv);
    }
  }
}

DI float row16_sum(float v) {
  v += __int_as_float(__builtin_amdgcn_update_dpp(0, __float_as_int(v), 0x128, 0xf, 0xf, false));
  v += __int_as_float(__builtin_amdgcn_update_dpp(0, __float_as_int(v), 0x124, 0xf, 0xf, false));
  v += __int_as_float(__builtin_amdgcn_update_dpp(0, __float_as_int(v), 0x122, 0xf, 0xf, false));
  v += __int_as_float(__builtin_amdgcn_update_dpp(0, __float_as_int(v), 0x121, 0xf, 0xf, false));
  return v;
}
DI float gelu_tanh(float x) {
  float u = 0.7978845608028654f * (x + 0.044715f * x * x * x);
  float e = __expf(2.f * u);
  float th = 1.f - 2.f / (e + 1.f);
  return 0.5f * x * (1.f + th);
}
DI float dot8(uint4 a, uint4 b, float acc) {
  acc = __builtin_amdgcn_fdot2_f32_bf16(__builtin_bit_cast(bf2, a.x), __builtin_bit_cast(bf2, b.x), acc, false);
  acc = __builtin_amdgcn_fdot2_f32_bf16(__builtin_bit_cast(bf2, a.y), __builtin_bit_cast(bf2, b.y), acc, false);
  acc = __builtin_amdgcn_fdot2_f32_bf16(__builtin_bit_cast(bf2, a.z), __builtin_bit_cast(bf2, b.z), acc, false);
  acc = __builtin_amdgcn_fdot2_f32_bf16(__builtin_bit_cast(bf2, a.w), __builtin_bit_cast(bf2, b.w), acc, false);
  return acc;
}

typedef float f2 __attribute__((ext_vector_type(2)));
DI void expert_dots(const Params& p, int nrows, char* smem) {
  const int tid = otid(), wave = tid >> 6, lane = tid & 63, g = lane >> 4, s = lane & 15;
  const int bid = obid(), x = bid & 7, jx = bid >> 3, wpx = (gridDim.x + 7 - x) >> 3;
  u32* list = (u32*)smem + wave * 128;
  const int* IDX = (const int*)(p.S + OFF_IDX);
  const float* GATE = (const float*)(p.S + OFF_GATE);
  u16* AV16 = (u16*)(p.S + OFF_PU);
  const unsigned char* PU = (const unsigned char*)(p.PT + PT_U) + s * 16;
  const float* PSU = (const float*)(p.PT + PT_SC);
  const float* PSV = PSU + 16384;
  const int tstep = wpx * 4;
  int t = jx * 4 + wave;
  int ni0 = 0, ni1 = 0;
  uint4 nh[8];
  auto prefetch = [&](int tt) {
    { const u32 w2 = ((const u32*)IDX)[(size_t)tt * 64 + lane]; ni0 = (int)(w2 & 0xffffu); ni1 = (int)(w2 >> 16); }
#pragma unroll
    for (int c = 0; c < 4; c++) {
      const u16* hp = p.H + (size_t)tt * D + (c * 16 + s) * 16;
      nh[2 * c] = *(const uint4*)(hp); nh[2 * c + 1] = *(const uint4*)(hp + 8);
    }
  };
  auto dot_row = [&](const int4 (&uu)[4], const f2 (&hf)[32]) {
    const int uw[16] = {uu[0].x, uu[0].y, uu[0].z, uu[0].w, uu[1].x, uu[1].y, uu[1].z, uu[1].w,
                        uu[2].x, uu[2].y, uu[2].z, uu[2].w, uu[3].x, uu[3].y, uu[3].z, uu[3].w};
    f2 acc = {0.f, 0.f}, acc2 = {0.f, 0.f};
#pragma unroll
    for (int j = 0; j < 16; j++) {
      acc = __builtin_elementwise_fma(__builtin_amdgcn_cvt_pk_f32_fp8(uw[j], false), hf[2 * j], acc);
      acc2 = __builtin_elementwise_fma(__builtin_amdgcn_cvt_pk_f32_fp8(uw[j], true), hf[2 * j + 1], acc2);
    }
    return row16_sum((acc.x + acc.y) + (acc2.x + acc2.y));
  };
  if (t < nrows) prefetch(t);
  for (; t < nrows; t += tstep) {
    const int i0 = ni0, i1 = ni1;
    f2 hf[32];
#pragma unroll
    for (int c = 0; c < 4; c++) {
      const u32 hw[8] = {nh[2 * c].x, nh[2 * c].y, nh[2 * c].z, nh[2 * c].w, nh[2 * c + 1].x, nh[2 * c + 1].y, nh[2 * c + 1].z, nh[2 * c + 1].w};
#pragma unroll
      for (int j = 0; j < 8; j++) { hf[c * 8 + j].x = __uint_as_float(hw[j] << 16); hf[c * 8 + j].y = __uint_as_float(hw[j] & 0xffff0000u); }
    }
    if (t + tstep < nrows) prefetch(t + tstep);
    const bool b0 = (i0 >> 11) == x, b1 = (i1 >> 11) == x;
    const unsigned long long m0 = __ballot(b0), m1 = __ballot(b1);
    const int n0 = __popcll(m0);
    const int r0 = __builtin_amdgcn_mbcnt_hi((u32)(m0 >> 32), __builtin_amdgcn_mbcnt_lo((u32)m0, 0u));
    const int r1 = n0 + __builtin_amdgcn_mbcnt_hi((u32)(m1 >> 32), __builtin_amdgcn_mbcnt_lo((u32)m1, 0u));
    const int n = n0 + __popcll(m1);
    __builtin_amdgcn_wave_barrier();
    if (b0) list[r0] = ((u32)(2 * lane) << 16) | (u32)i0;
    if (b1) list[r1] = ((u32)(2 * lane + 1) << 16) | (u32)i1;
    __builtin_amdgcn_wave_barrier();
    for (int cb = 0; cb < n; cb += 64) {
      const int nend = min(n, cb + 64);
      float dk = 0.f;
      for (int base = cb; base < nend; base += 8) {
        const int k0 = base + g, k1 = base + 4 + g;
        const u32 ent0 = list[min(k0, n - 1)], ent1 = list[min(k1, n - 1)];
        const unsigned char* ur0 = PU + (size_t)(ent0 & 0xffffu) * D;
        const unsigned char* ur1 = PU + (size_t)(ent1 & 0xffffu) * D;
        int4 ua[4], ub[4];
        ua[0] = *(const int4*)(ur0); ua[1] = *(const int4*)(ur0 + 256); ua[2] = *(const int4*)(ur0 + 512); ua[3] = *(const int4*)(ur0 + 768);
        ub[0] = *(const int4*)(ur1); ub[1] = *(const int4*)(ur1 + 256); ub[2] = *(const int4*)(ur1 + 512); ub[3] = *(const int4*)(ur1 + 768);
        const float d0 = dot_row(ua, hf);
        const float d1 = dot_row(ub, hf);
        const int it0 = (base - cb) >> 2;
        dk = (s == it0) ? d0 : dk;
        dk = (s == it0 + 1) ? d1 : dk;
      }
      const int kk = cb + 4 * s + g;
      if (kk < nend) {
        const u32 ent = list[kk];
        const int e = (int)(ent & 0xffffu), slot = (int)(ent >> 16);
        AV16[(size_t)t * 128 + slot] = f2bf(GATE[(size_t)t * 128 + slot] * PSV[e] * gelu_tanh(dk * PSU[e]));
      }
    }
  }
}

DI void expert_vsum(const Params& p, int nrows) {
  const int tid = otid(), wave = tid >> 6, lane = tid & 63, g = lane >> 3, s = lane & 7;
  const int bid = obid(), x = bid & 7, jx = bid >> 3, wpx = (gridDim.x + 7 - x) >> 3;
  const u16* IDX = (const u16*)(p.S + OFF_IDX) + g * 16;
  const u16* AV = (const u16*)(p.S + OFF_PU) + g * 16;
  const unsigned char* PV = (const unsigned char*)(p.PT + PT_V) + (size_t)x * 16384 * 128 + s * 16;
  u16* Y = (u16*)((char*)p.U + (size_t)NROW * 2048 * 2);
  const int b5 = (lane >> 5) & 1, b4 = (lane >> 4) & 1, b3 = (lane >> 3) & 1;
  const int tstep = wpx * 4;
  int t = jx * 4 + wave;
  uint4 ni[2], na[2];
  auto prefetch = [&](int tt) {
#pragma unroll
    for (int j = 0; j < 2; j++) { ni[j] = *(const uint4*)(IDX + (size_t)tt * 128 + j * 8); na[j] = *(const uint4*)(AV + (size_t)tt * 128 + j * 8); }
  };
  if (t < nrows) prefetch(t);
  for (; t < nrows; t += tstep) {
    const u32 iw[8] = {ni[0].x, ni[0].y, ni[0].z, ni[0].w, ni[1].x, ni[1].y, ni[1].z, ni[1].w};
    const u32 aw[8] = {na[0].x, na[0].y, na[0].z, na[0].w, na[1].x, na[1].y, na[1].z, na[1].w};
    int ee[16]; float aa[16];
#pragma unroll
    for (int j = 0; j < 8; j++) {
      ee[2 * j] = (int)(iw[j] & 0xffffu); ee[2 * j + 1] = (int)(iw[j] >> 16);
      aa[2 * j] = __uint_as_float(aw[j] << 16); aa[2 * j + 1] = __uint_as_float(aw[j] & 0xffff0000u);
    }
    int4 vv[16];
#pragma unroll
    for (int it = 0; it < 16; it++) vv[it] = *(const int4*)(PV + (size_t)ee[it] * 128);
    if (t + tstep < nrows) prefetch(t + tstep);
    f2 y[8];
#pragma unroll
    for (int i = 0; i < 8; i++) { y[i].x = 0.f; y[i].y = 0.f; }
#pragma unroll
    for (int it = 0; it < 16; it++) {
      const f2 a2 = {aa[it], aa[it]};
      const int vw[4] = {vv[it].x, vv[it].y, vv[it].z, vv[it].w};
#pragma unroll
      for (int j = 0; j < 4; j++) {
        y[2 * j] = __builtin_elementwise_fma(__builtin_amdgcn_cvt_pk_f32_fp8(vw[j], false), a2, y[2 * j]);
        y[2 * j + 1] = __builtin_elementwise_fma(__builtin_amdgcn_cvt_pk_f32_fp8(vw[j], true), a2, y[2 * j + 1]);
      }
    }
    f2 k4[4], k2[2], k1;
#pragma unroll
    for (int i = 0; i < 4; i++) {
      const f2 keep = b5 ? y[4 + i] : y[i], send = b5 ? y[i] : y[4 + i];
      k4[i].x = keep.x + __shfl_xor(send.x, 32); k4[i].y = keep.y + __shfl_xor(send.y, 32);
    }
#pragma unroll
    for (int i = 0; i < 2; i++) {
      const f2 keep = b4 ? k4[2 + i] : k4[i], send = b4 ? k4[i] : k4[2 + i];
      k2[i].x = keep.x + __shfl_xor(send.x, 16); k2[i].y = keep.y + __shfl_xor(send.y, 16);
    }
    {
      const f2 keep = b3 ? k2[1] : k2[0], send = b3 ? k2[0] : k2[1];
      k1.x = keep.x + __shfl_xor(send.x, 8); k1.y = keep.y + __shfl_xor(send.y, 8);
    }
    *(u32*)(Y + (size_t)t * D + x * 128 + s * 16 + b5 * 8 + b4 * 4 + b3 * 2) = pack2(k1.x, k1.y);
  }
}

DI void expert_epilogue(const Params& p, int layer, int nrows) {
  const int tid = otid(), wave = tid >> 6, lane = tid & 63, g = lane >> 5, s = lane & 31;
  const bool last = (layer == DEPTH - 1);
  const u16* Y = (const u16*)((const char*)p.U + (size_t)NROW * 2048 * 2);
  for (int tk = obid() * 4 + wave; tk < nrows; tk += gridDim.x * 4) {
    const int b = row_batch(tk);
    const int col = (g * 32 + s) * 16;
    const float* g2 = ada_ptr(p, layer, b, 5) + col;
    const float* gm = p.ln_gamma + (size_t)(layer * 2 + 1) * D + col;
    const float* bt = p.ln_beta + (size_t)(layer * 2 + 1) * D + col;
    const float* XP = (const float*)(p.S + OFF_XP) + (size_t)tk * D + col;
    float xin[16];
    {
      float s0 = 0.f;
#pragma unroll
      for (int j4 = 0; j4 < 4; j4++) {
        const float4 t4 = *(const float4*)(XP + j4 * 4);
        xin[j4 * 4] = t4.x; xin[j4 * 4 + 1] = t4.y; xin[j4 * 4 + 2] = t4.z; xin[j4 * 4 + 3] = t4.w;
        s0 += t4.x + t4.y + t4.z + t4.w;
      }
      const float m0 = wave_sum(s0) * (1.f / D);
      float q0 = 0.f;
#pragma unroll
      for (int j = 0; j < 16; j++) { xin[j] -= m0; q0 += xin[j] * xin[j]; }
      const float r0 = rsqrtf(wave_sum(q0) * (1.f / D) + EPS);
      const float* gm0 = p.ln_gamma + (size_t)(layer * 2 + 0) * D + col;
      const float* bt0 = p.ln_beta + (size_t)(layer * 2 + 0) * D + col;
#pragma unroll
      for (int j4 = 0; j4 < 4; j4++) {
        const float4 ga = *(const float4*)(gm0 + j4 * 4), be = *(const float4*)(bt0 + j4 * 4);
        xin[j4 * 4] = xin[j4 * 4] * r0 * ga.x + be.x; xin[j4 * 4 + 1] = xin[j4 * 4 + 1] * r0 * ga.y + be.y;
        xin[j4 * 4 + 2] = xin[j4 * 4 + 2] * r0 * ga.z + be.z; xin[j4 * 4 + 3] = xin[j4 * 4 + 3] * r0 * ga.w + be.w;
      }
    }
    float xv[16];
    float sum = 0.f;
    const uint4 yq0 = *(const uint4*)(Y + (size_t)tk * D + col), yq1 = *(const uint4*)(Y + (size_t)tk * D + col + 8);
    const u32 yw[8] = {yq0.x, yq0.y, yq0.z, yq0.w, yq1.x, yq1.y, yq1.z, yq1.w};
#pragma unroll
    for (int j4 = 0; j4 < 4; j4++) {
      const float4 xo = make_float4(xin[j4 * 4], xin[j4 * 4 + 1], xin[j4 * 4 + 2], xin[j4 * 4 + 3]);
      const float4 gg = *(const float4*)(g2 + j4 * 4);
      const float4 yy = make_float4(__uint_as_float(yw[2 * j4] << 16), __uint_as_float(yw[2 * j4] & 0xffff0000u),
                                    __uint_as_float(yw[2 * j4 + 1] << 16), __uint_as_float(yw[2 * j4 + 1] & 0xffff0000u));
      float* o = xv + j4 * 4;
      o[0] = ALPHA * xo.x + gg.x * yy.x; o[1] = ALPHA * xo.y + gg.y * yy.y;
      o[2] = ALPHA * xo.z + gg.z * yy.z; o[3] = ALPHA * xo.w + gg.w * yy.w;
      sum += o[0] + o[1] + o[2] + o[3];
    }
    float mu = wave_sum(sum) * (1.f / D);
    float q = 0.f;
#pragma unroll
    for (int j = 0; j < 16; j++) { xv[j] -= mu; q += xv[j] * xv[j]; }
    float rstd = rsqrtf(wave_sum(q) * (1.f / D) + EPS);
    float* dstx = (last ? p.out : p.X) + (size_t)tk * D + col;
    float s2 = 0.f;
    float4 gmq[4], btq[4];
#pragma unroll
    for (int j4 = 0; j4 < 4; j4++) { gmq[j4] = *(const float4*)(gm + j4 * 4); btq[j4] = *(const float4*)(bt + j4 * 4); }
#pragma unroll
    for (int j4 = 0; j4 < 4; j4++) {
      const float4 gmv = gmq[j4];
      const float4 btv = btq[j4];
      float* o = xv + j4 * 4;
      o[0] = o[0] * rstd * gmv.x + btv.x; o[1] = o[1] * rstd * gmv.y + btv.y;
      o[2] = o[2] * rstd * gmv.z + btv.z; o[3] = o[3] * rstd * gmv.w + btv.w;
      s2 += o[0] + o[1] + o[2] + o[3];
      *(float4*)(dstx + j4 * 4) = make_float4(o[0], o[1], o[2], o[3]);
    }
    if (!last) {
      float mu2 = wave_sum(s2) * (1.f / D);
      float q2 = 0.f;
#pragma unroll
      for (int j = 0; j < 16; j++) { xv[j] -= mu2; q2 += xv[j] * xv[j]; }
      float rstd2 = rsqrtf(wave_sum(q2) * (1.f / D) + EPS);
      const float* sh = ada_ptr(p, layer + 1, b, 0) + col;
      const float* sc = ada_ptr(p, layer + 1, b, 1) + col;
      u32 ow[8];
#pragma unroll
      for (int j = 0; j < 8; j++) {
        float y0 = xv[2 * j] * rstd2 * (1.f + sc[2 * j]) + sh[2 * j];
        float y1 = xv[2 * j + 1] * rstd2 * (1.f + sc[2 * j + 1]) + sh[2 * j + 1];
        ow[j] = pack2(y0, y1);
      }
      *(uint4*)(p.H + (size_t)tk * D + col) = make_uint4(ow[0], ow[1], ow[2], ow[3]);
      *(uint4*)(p.H + (size_t)tk * D + col + 8) = make_uint4(ow[4], ow[5], ow[6], ow[7]);
    }
  }
}

#define XB_TMO      128
#define XB_XCNT(j)  (256  + 64 * (j))
#define XB_XSUB(j)  (1280 + 64 * (j))
#define XB_XGEN(j)  (2304 + 64 * (j))
#define XB_TOP      3328
#define XB_TOPGEN   3392
#define XCD_BAR_WORDS 3456
#define XB_SPIN_CAP (1u << 18)
#define LAS __attribute__((address_space(3)))

__device__ __forceinline__ unsigned xb_ld(unsigned* p)              { return __hip_atomic_load(p, __ATOMIC_RELAXED, __HIP_MEMORY_SCOPE_AGENT); }
__device__ __forceinline__ unsigned xb_add(unsigned* p, unsigned v) { return __hip_atomic_fetch_add(p, v, __ATOMIC_RELAXED, __HIP_MEMORY_SCOPE_AGENT); }
__device__ __forceinline__ unsigned xb_xcc_id() { return (unsigned)__builtin_amdgcn_s_getreg((3 << 11) | 20) & 0xFu; }
#define XB_SPIN(cond, bar) do { unsigned _sp = 0; while (cond) { __builtin_amdgcn_s_sleep(1); \
    if ((++_sp & 255u) == 0u) { if (xb_ld(&(bar)[XB_TMO])) break; if (_sp > XB_SPIN_CAP) { atomicAdd(&(bar)[XB_TMO], 1u); break; } } } } while (0)

struct XcdBarrier {
    unsigned* bar; unsigned x;
    volatile LAS unsigned* st;
};

__device__ __forceinline__ XcdBarrier xcd_barrier_post(unsigned* bar, volatile LAS unsigned* st) {
    XcdBarrier b; b.bar = bar; b.x = xb_xcc_id(); b.st = st;
    if (threadIdx.x == 0) (void)xb_add(&bar[XB_XCNT(b.x)], 1u);
    return b;
}
__device__ __forceinline__ void xcd_barrier_complete(unsigned* bar, unsigned x, unsigned& nloc, unsigned& nx) {
    const unsigned G = gridDim.x * gridDim.y * gridDim.z;
    unsigned sum, cnt, mine, sp = 0u;
    for (;;) {
        sum = 0u; cnt = 0u; mine = 0u;
#pragma unroll
        for (unsigned j = 0; j < 16; ++j) { const unsigned c = xb_ld(&bar[XB_XCNT(j)]); sum += c; cnt += (c > 0u) ? 1u : 0u; mine = (j == x) ? c : mine; }
        if (sum == G) break;
        __builtin_amdgcn_s_sleep(1);
        if ((++sp & 255u) == 0u) { if (xb_ld(&bar[XB_TMO])) break; if (sp > XB_SPIN_CAP) { atomicAdd(&bar[XB_TMO], 1u); break; } }
    }
    nloc = mine > 0u ? mine : 1u; nx = cnt > 0u ? cnt : 1u;
}

__device__ __forceinline__ void xcd_barrier(const XcdBarrier& b) {
    asm volatile("s_waitcnt vmcnt(0)" ::: "memory");
    __syncthreads();
    if (threadIdx.x == 0) {
        unsigned* bar = b.bar;
        __builtin_amdgcn_s_waitcnt(0);
        unsigned nloc = b.st[0], nx = b.st[1];
        if (nloc == 0u) { xcd_barrier_complete(bar, b.x, nloc, nx); b.st[0] = nloc; b.st[1] = nx; }
        const unsigned old = xb_add(&bar[XB_XSUB(b.x)], 1u);
        const unsigned gen = old / nloc;
        if (old + 1u == (gen + 1u) * nloc) {
            __builtin_amdgcn_fence(__ATOMIC_RELEASE, "agent");
            asm volatile("s_waitcnt vmcnt(0)" ::: "memory");
            const unsigned og = xb_add(&bar[XB_TOP], 1u);
            const unsigned tg = og / nx;
            if (og + 1u == (tg + 1u) * nx) xb_add(&bar[XB_TOPGEN], 1u);
            else XB_SPIN(xb_ld(&bar[XB_TOPGEN]) == tg, bar);
            __builtin_amdgcn_fence(__ATOMIC_ACQUIRE, "agent");
            xb_add(&bar[XB_XGEN(b.x)], 1u);
            asm volatile("s_waitcnt vmcnt(0)" ::: "memory");
        } else {
            XB_SPIN(xb_ld(&bar[XB_XGEN(b.x)]) == gen, bar);
            __builtin_amdgcn_fence(__ATOMIC_ACQUIRE, "agent");
            asm volatile("s_waitcnt vmcnt(0)" ::: "memory");
        }
    }
    __syncthreads();
}


DI void grid_barrier(unsigned* ctr, unsigned& target) {
  asm volatile("s_waitcnt vmcnt(0)" ::: "memory");
  __syncthreads();
  if (threadIdx.x == 0) {
    target += gridDim.x;
    __builtin_amdgcn_fence(__ATOMIC_RELEASE, "agent");
    asm volatile("s_waitcnt vmcnt(0)" ::: "memory");
    __hip_atomic_fetch_add(ctr, 1u, __ATOMIC_RELAXED, __HIP_MEMORY_SCOPE_AGENT);
    while (__hip_atomic_load(ctr, __ATOMIC_RELAXED, __HIP_MEMORY_SCOPE_AGENT) < target) __builtin_amdgcn_s_sleep(1);
    __builtin_amdgcn_fence(__ATOMIC_ACQUIRE, "agent");
    asm volatile("s_waitcnt vmcnt(0)" ::: "memory");
  }
  __syncthreads();
}

__global__ void __launch_bounds__(256, 2) mk_forward(Params p) {
  __shared__ __attribute__((aligned(16))) char smem[LDS_BYTES];
  cg::grid_group grid = cg::this_grid();
  int pc = 0;
#define GSYNC() xcd_barrier(xb)
#define PHASE(body) PHASER(15, body)
#define PHASER(kind, body)                              \
  {                                                     \
    if (pc >= p.ph_lo && pc < p.ph_hi) {                \
      if ((REPMASK >> (kind)) & 1) { const bool dry = true; (void)dry; body; GSYNC(); } \
      { const bool dry = false; (void)dry; body; }      \
      if (pc + 1 < p.ph_hi) GSYNC();                    \
    }                                                   \
    pc++;                                               \
  }
  __shared__ __attribute__((aligned(16))) unsigned xb_words[4];
  if (threadIdx.x == 0) { xb_words[0] = 0u; xb_words[1] = 0u; xb_words[2] = 0u; xb_words[3] = 0u; }
  __syncthreads();
  const XcdBarrier xb = xcd_barrier_post(p.bar, (volatile LAS unsigned*)xb_words);
  if (0 >= p.ph_lo && 0 < p.ph_hi) {
    phase0(p, (float*)smem);
    if (1 < p.ph_hi) grid.sync();
  }
  pc++;
  PHASE(phase0b(p))
  PHASE(lnmod_phase<0>(p, 0, NROW))
  for (int layer = 0; layer < DEPTH; layer++) {
    const bool last = (layer == DEPTH - 1);
    const int nrows = last ? NLAT : NROW;
    PHASER(0, gemm_phase<0>(p, layer, smem, p.H, p.wt_in + (size_t)layer * DINP * D, NROW / 256, DINP / 128, dry))
    PHASER(1, prep_phase(p, layer))
    PHASER(2, scan_phase(p, smem, layer))
    PHASER(3, combine_phase(p, layer, nrows))
    PHASER(4, { gemm_phase<1>(p, layer, smem, p.H, p.wt_out + (size_t)layer * D * D, NLAT / 256, 8, dry);
                 if (nrows > NLAT) gemm_thin<1>(p, layer, smem, p.H, p.wt_out + (size_t)layer * D * D, NLAT, NCTX / 64, 8, dry); })
    PHASER(5, lnmod_phase<1>(p, layer, nrows))
    PHASER(6, { gemm_phase<2>(p, layer, smem, p.H, p.wt_q + (size_t)layer * 2048 * D, NLAT / 256, 16, dry);
                 if (nrows > NLAT) gemm_thin<2>(p, layer, smem, p.H, p.wt_q + (size_t)layer * 2048 * D, NLAT, NCTX / 64, 16, dry); })
    PHASER(7, topk_phase(p, layer, smem, nrows))
    PHASER(8, expert_dots(p, nrows, smem))
    PHASER(9, expert_vsum(p, nrows))
    PHASER(10, expert_epilogue(p, layer, nrows))
  }
#undef PHASE
#undef PHASER
}
constexpr int NPHASES = 3 + 11 * DEPTH;

extern "C" void kernel_launch(void* const* d_in, const int* in_sizes, int n_in, void* d_out, int out_size, void* d_ws,
                              size_t ws_size, hipStream_t stream) {
  Params p{};
  p.x = (const float*)d_in[0]; p.c = (const float*)d_in[1]; p.ctx = (const float*)d_in[2]; p.c_ctx = (const float*)d_in[3];
  p.w_ada = (const float*)d_in[4]; p.b_ada = (const float*)d_in[5]; p.w_in = (const float*)d_in[6];
  p.w_gk2 = (const float*)d_in[7]; p.b_gk = (const float*)d_in[8]; p.hg_lb = (const float*)d_in[9];
  p.hg_norm = (const float*)d_in[10]; p.gla_norm = (const float*)d_in[11]; p.w_out = (const float*)d_in[12];
  p.ln_gamma = (const float*)d_in[13]; p.ln_beta = (const float*)d_in[14]; p.wq = (const float*)d_in[15];
  p.sub_keys = (const float*)d_in[16]; p.peer_u = (const float*)d_in[17]; p.peer_v = (const float*)d_in[18];
  p.out = (float*)d_out;
  char* w = (char*)d_ws;
  size_t off = 0;
  auto take = [&](size_t bytes) { char* q = w + off; off += (bytes + 255) & ~(size_t)255; return q; };
  p.wt_in = (u16*)take((size_t)4 * DINP * D * 2);
  p.wt_out = (u16*)take((size_t)4 * D * D * 2);
  p.wt_q = (u16*)take((size_t)4 * 2048 * D * 2);
  p.keysb = (u16*)take((size_t)4 * 2 * 128 * 128 * 2);
  p.ada_part = (float*)take((size_t)8 * 4 * 5 * 6144 * 4);
  p.ada = (float*)take((size_t)4 * 5 * 6144 * 4);
  p.X = (float*)take((size_t)NROW * D * 4);
  p.H = (u16*)take((size_t)NROW * D * 2);
  p.G = (u16*)take((size_t)NROW * D * 2);
  p.U = (u16*)take((size_t)NROW * DIN * 2);
  p.S = take(SZ_S);
  p.PT = take(SZ_PT);
  p.bar = (unsigned*)take(XCD_BAR_WORDS * 4);
  if (off > ws_size) { fprintf(stderr, "workspace too small: need %zu have %zu\n", off, ws_size); return; }

  static int grid_blocks = 0;
  if (!grid_blocks) {
    int dev = 0, cus = 0, per_cu = 0;
    hipGetDevice(&dev);
    hipDeviceGetAttribute(&cus, hipDeviceAttributeMultiprocessorCount, dev);
    hipOccupancyMaxActiveBlocksPerMultiprocessor(&per_cu, mk_forward, 256, 0);
    if (per_cu > 2) per_cu = 2;
    grid_blocks = cus * per_cu;
  }
#if ONE_LAUNCH
  hipMemsetAsync(p.bar, 0, XCD_BAR_WORDS * 4, stream);
  p.ph_lo = 0; p.ph_hi = NPHASES;
  void* args[] = {&p};
  hipError_t e = hipLaunchCooperativeKernel((void*)mk_forward, dim3(grid_blocks), dim3(256), args, 0, stream);
  if (e != hipSuccess) fprintf(stderr, "cooperative launch failed: %s (grid %d)\n", hipGetErrorString(e), grid_blocks);
#else
  for (int ph = 0; ph < NPHASES; ph++) {
    p.ph_lo = ph; p.ph_hi = ph + 1;
    hipLaunchKernelGGL(mk_forward, dim3(grid_blocks), dim3(256), 0, stream, p);
  }
#endif
}
```
